# Optimizing an MI355X kernel written in HIP

```python
import jax, jax.numpy as jnp
from jax import lax
import numpy as np

D_MODEL = 1024
BATCH = 8
SEQ = 8192
DEPTH = 4

GMLP_CHUNK = 128
GMLP_GROUPS = 8
GMLP_GROUP_DIM = 128
GMLP_WIDTH = GMLP_GROUPS * GMLP_GROUP_DIM
HGRN_HEADS = 8
HGRN_DK = 128
HGRN_DV = 128
HGRN_KWIDTH = HGRN_HEADS * HGRN_DK
HGRN_VWIDTH = HGRN_HEADS * HGRN_DV
HGRN_CHUNK = 64
FFN_HIDDEN = 2816
N_ADA = 9
EPS = 1e-6
IN_SPLITS = (GMLP_WIDTH, GMLP_WIDTH,
             HGRN_KWIDTH, HGRN_KWIDTH,
             HGRN_VWIDTH, HGRN_VWIDTH,
             D_MODEL, D_MODEL)
IN_WIDTH = sum(IN_SPLITS)

kernel_name = 'hybrid_gmlp_hgrn2_macaron_adaln'


def _rms_norm(x, w):
    xf = x.astype(jnp.float32)
    y = xf * lax.rsqrt(jnp.mean(xf * xf, axis=-1, keepdims=True) + EPS)
    return (y * w.astype(jnp.float32)).astype(x.dtype)


def _split_cols(z, widths):
    idx = [int(v) for v in np.cumsum(widths)[:-1]]
    return jnp.split(z, idx, axis=-1)


def _swiglu(xn, w13, w2):
    a, b = jnp.split(xn @ w13, 2, axis=-1)
    return (jax.nn.silu(a) * b) @ w2


def _gmlp_branch(u, v, ws, bs):
    b, s, _ = v.shape
    nc = s // GMLP_CHUNK
    vg = v.reshape(b, nc, GMLP_CHUNK, GMLP_GROUPS, GMLP_GROUP_DIM).astype(jnp.float32)
    mu = jnp.mean(vg, axis=-1, keepdims=True)
    var = jnp.mean(jnp.square(vg - mu), axis=-1, keepdims=True)
    vn = ((vg - mu) * lax.rsqrt(var + EPS)).astype(v.dtype)
    ws_causal = jnp.tril(ws)
    mixed = jnp.einsum('gts,bnsgc->bntgc', ws_causal, vn) + bs.T[None, None, :, :, None]
    return u * mixed.reshape(b, s, GMLP_WIDTH)


def _to_chunks(t, heads, d):
    b, s, _ = t.shape
    return t.reshape(b, s // HGRN_CHUNK, HGRN_CHUNK, heads, d).transpose(1, 0, 3, 2, 4)


def _hgrn2_branch(q_pre, f_pre, i_in, og, lb):
    b, s, _ = q_pre.shape
    lb = lb.astype(jnp.float32)
    fz = f_pre.astype(jnp.float32)
    q = jax.nn.silu(q_pre.astype(jnp.float32))
    logf = jnp.logaddexp(jnp.log(lb), jnp.log1p(-lb) + jax.nn.log_sigmoid(fz))
    k = (1.0 - lb) * jax.nn.sigmoid(-fz)
    v = i_in.astype(jnp.float32)

    qc = _to_chunks(q, HGRN_HEADS, HGRN_DK)
    kc = _to_chunks(k, HGRN_HEADS, HGRN_DK)
    vc = _to_chunks(v, HGRN_HEADS, HGRN_DV)
    bcum = jnp.cumsum(_to_chunks(logf, HGRN_HEADS, HGRN_DK), axis=3)
    causal = jnp.tril(jnp.ones((HGRN_CHUNK, HGRN_CHUNK), dtype=bool))

    def step(state, inp):
        q_t, k_t, v_t, b_t = inp
        diff = b_t[:, :, :, None, :] - b_t[:, :, None, :, :]
        decay = jnp.exp(jnp.where(causal[:, :, None], diff, -jnp.inf))
        scores = jnp.einsum('bhtk,bhsk,bhtsk->bhts', q_t, k_t, decay)
        o = jnp.einsum('bhts,bhsv->bhtv', scores, v_t) + \
            jnp.einsum('bhtk,bhkv->bhtv', q_t * jnp.exp(b_t), state)
        b_last = b_t[:, :, -1:, :]
        new_state = jnp.exp(b_last[:, :, 0, :])[..., None] * state + \
            jnp.einsum('bhsk,bhsv->bhkv', k_t * jnp.exp(b_last - b_t), v_t)
        return new_state, o

    s0 = jnp.zeros((b, HGRN_HEADS, HGRN_DK, HGRN_DV), jnp.float32)
    _, o = lax.scan(step, s0, (qc, kc, vc, bcum))
    o = o.transpose(1, 0, 3, 2, 4).reshape(b, s, HGRN_HEADS, HGRN_DV)
    o = o * lax.rsqrt(jnp.mean(o * o, axis=-1, keepdims=True) + EPS)
    o = o.reshape(b, s, HGRN_VWIDTH) * jax.nn.sigmoid(og.astype(jnp.float32))
    return o.astype(q_pre.dtype)


def _mixer(hn, w_in, ws, bs, lb, w_a, w_b, w_o):
    z = hn @ w_in
    u, v, q, fz, i_in, og, ga, gb = _split_cols(z, IN_SPLITS)
    ya = _gmlp_branch(jax.nn.gelu(u), jax.nn.gelu(v), ws, bs) @ w_a
    yb = _hgrn2_branch(q, fz, i_in, og, lb) @ w_b
    m = jax.nn.sigmoid(ga) * ya + jax.nn.sigmoid(gb) * yb
    return m @ w_o


def setup_inputs(seed: int = 0) -> dict:
    key = jax.random.key(seed)
    ks = jax.random.split(key, 15)
    nrm = jax.random.normal
    f32 = jnp.float32
    return {
        'x': nrm(ks[0], (BATCH, SEQ, D_MODEL), f32),
        'c': nrm(ks[1], (BATCH, D_MODEL), f32),
        'w_in': nrm(ks[2], (DEPTH, D_MODEL, IN_WIDTH), f32) * D_MODEL ** -0.5,
        'gmlp_ws': nrm(ks[3], (DEPTH, GMLP_GROUPS, GMLP_CHUNK, GMLP_CHUNK), f32) * (0.5 * GMLP_CHUNK ** -0.5),
        'gmlp_b': 1.0 + 0.1 * nrm(ks[4], (DEPTH, GMLP_GROUPS, GMLP_CHUNK), f32),
        'hgrn_lb_logits': 0.5 * nrm(ks[5], (DEPTH, HGRN_KWIDTH), f32),
        'w_branch_a': nrm(ks[6], (DEPTH, GMLP_WIDTH, D_MODEL), f32) * GMLP_WIDTH ** -0.5,
        'w_branch_b': nrm(ks[7], (DEPTH, HGRN_VWIDTH, D_MODEL), f32) * HGRN_VWIDTH ** -0.5,
        'w_out': nrm(ks[8], (DEPTH, D_MODEL, D_MODEL), f32) * D_MODEL ** -0.5,
        'ffn_w13': nrm(ks[9], (DEPTH, 2, D_MODEL, 2 * FFN_HIDDEN), f32) * D_MODEL ** -0.5,
        'ffn_w2': nrm(ks[10], (DEPTH, 2, FFN_HIDDEN, D_MODEL), f32) * FFN_HIDDEN ** -0.5,
        'norm_w': 1.0 + 0.05 * nrm(ks[11], (DEPTH, 3, D_MODEL), f32),
        'ada_w': nrm(ks[12], (DEPTH, D_MODEL, N_ADA * D_MODEL), f32) * (0.1 * D_MODEL ** -0.5),
        'ada_b': 0.02 * nrm(ks[13], (DEPTH, N_ADA * D_MODEL), f32),
        'final_norm_w': 1.0 + 0.05 * nrm(ks[14], (D_MODEL,), f32),
    }


def reference(x, c, w_in, gmlp_ws, gmlp_b, hgrn_lb_logits, w_branch_a, w_branch_b, w_out,
              ffn_w13, ffn_w2, norm_w, ada_w, ada_b, final_norm_w):
    lb_all = jnp.cumsum(jax.nn.softmax(hgrn_lb_logits.astype(jnp.float32), axis=0), axis=0)
    lb_all = lb_all - lb_all[0:1]
    c_act = jax.nn.silu(c)
    h = x
    for l in range(DEPTH):
        mod = (c_act @ ada_w[l] + ada_b[l]).reshape(c.shape[0], N_ADA, 1, D_MODEL)
        sh1, sc1, g1, sh2, sc2, g2, sh3, sc3, g3 = [mod[:, j] for j in range(N_ADA)]
        hn = _rms_norm(h, norm_w[l, 0]) * (1.0 + sc1) + sh1
        h = h + 0.5 * (1.0 + g1) * _swiglu(hn, ffn_w13[l, 0], ffn_w2[l, 0])
        hn = _rms_norm(h, norm_w[l, 1]) * (1.0 + sc2) + sh2
        h = h + (1.0 + g2) * _mixer(hn, w_in[l], gmlp_ws[l], gmlp_b[l], lb_all[l],
                                    w_branch_a[l], w_branch_b[l], w_out[l])
        hn = _rms_norm(h, norm_w[l, 2]) * (1.0 + sc3) + sh3
        h = h + 0.5 * (1.0 + g3) * _swiglu(hn, ffn_w13[l, 1], ffn_w2[l, 1])
    return _rms_norm(h, final_norm_w)
```

```cpp
#include <hip/hip_runtime.h>
#include <hip/hip_cooperative_groups.h>
#include <cstdio>
namespace cg = cooperative_groups;
#ifndef MK_COOP
#define MK_COOP 1
#endif
namespace pg8 {
#define PG8_LAS __attribute__((address_space(3)))
typedef unsigned short bf16_t;
typedef short bf16x8 __attribute__((ext_vector_type(8)));
typedef float f32x4 __attribute__((ext_vector_type(4)));
typedef unsigned u32x4 __attribute__((ext_vector_type(4)));
constexpr int BM = 256, BK = 64, HALF = 128, HTB = HALF * BK * 2  , STAGE_BYTES = 8 * HTB, NXCD = 8, WGM = 8;

__host__ __device__ __forceinline__ int lds_byte(int r, int c) { const int st = (r >> 4) * 2 + (c >> 5), rr = r & 15, cc = c & 31, ob = rr * 64 + cc * 2; return st * 1024 + (ob ^ (((ob >> 9) & 1) << 5)); }
__host__ __device__ __forceinline__ void stage_rc(int b, int& R, int& C) { const int st = b / 1024, sb = b % 1024, swz = sb ^ (((sb >> 9) & 1) << 5); R = (st >> 1) * 16 + swz / 64; C = (st & 1) * 32 + (swz % 64) / 2; }
__host__ __device__ __forceinline__ int perm32(int rho) { const int n = rho >> 4, i = rho & 15; return 8 * (i >> 2) + 4 * n + (i & 3); }

struct Unit { int pm, pn; };
struct Gemm { const bf16_t* A; const bf16_t* Bt; int M, N, K; };

struct StaticOrder {
    int nM, nN, nwg, G, c;
    __host__ __device__ void init(int M, int N, int G_, int c_) { nM = M / BM; nN = N / BM; nwg = nM * nN; G = G_; c = c_; }
    __host__ __device__ bool next(int i, Unit& u) const {
        const long L = (long)i * G + c; if (L >= nwg) return false;
        int wgid = (int)L; { const int q = nwg / NXCD, r = nwg % NXCD, xcd = wgid % NXCD, off = wgid / NXCD; wgid = (xcd < r ? xcd * (q + 1) : r * (q + 1) + (xcd - r) * q) + off; }
        const int nig = WGM * nN, gid = wgid / nig, fm = gid * WGM, gsz = (nM - fm) < WGM ? (nM - fm) : WGM;
        u.pm = fm + ((wgid % nig) % gsz); u.pn = (wgid % nig) / gsz; return true;
    }
    __device__ __forceinline__ void a_ready(const Unit&) const {}
    __device__ __forceinline__ void done(const Unit&) const {}
};
__device__ __forceinline__ int opaque_tid() { int t = threadIdx.x; asm volatile("" : "+v"(t)); return t; }
__device__ __forceinline__ unsigned cvt_pk_bf16(float lo, float hi) { unsigned r; asm volatile("v_cvt_pk_bf16_f32 %0, %1, %2" : "=v"(r) : "v"(lo), "v"(hi)); return r; }
__device__ __forceinline__ float bf_lo(unsigned w) { return __uint_as_float(w << 16); }
__device__ __forceinline__ float bf_hi(unsigned w) { return __uint_as_float(w & 0xffff0000u); }
template <int ACT> __device__ __forceinline__ float actf(float x) {
    if (ACT == 0) return x;
    if (ACT == 1) { const float u = 1.5957691216f * (x + 0.044715f * x * x * x); return x / (1.0f + __expf(-u)); }
    if (ACT == 2) return x / (1.0f + __expf(-x));
    return 1.0f / (1.0f + __expf(-x));
}
struct EpiSwiGLU {
    static constexpr bool PERM = true, AFTER_DRAIN = false;
    bf16_t* O;
    __device__ __forceinline__ void operator()(const f32x4 (&acc)[2][2][4][2], const Unit& u, int wr, int wc, int fr, int fq) const {
        const int row0 = u.pm * BM + wr * 64 + fr, col0 = u.pn * HALF + wc * 32 + 8 * fq;
#pragma unroll
        for (int ai = 0; ai < 2; ++ai)
#pragma unroll
            for (int m = 0; m < 4; ++m) {
                const f32x4 a0 = acc[ai][0][m][0], a1 = acc[ai][0][m][1], b0 = acc[ai][1][m][0], b1 = acc[ai][1][m][1];
                float v[8];
#pragma unroll
                for (int j = 0; j < 4; ++j) { v[j] = actf<2>(a0[j]) * b0[j]; v[4 + j] = actf<2>(a1[j]) * b1[j]; }
                u32x4 w; w.x = cvt_pk_bf16(v[0], v[1]); w.y = cvt_pk_bf16(v[2], v[3]); w.z = cvt_pk_bf16(v[4], v[5]); w.w = cvt_pk_bf16(v[6], v[7]);
                *(u32x4*)(O + (size_t)(row0 + ai * HALF + m * 16) * 2816 + col0) = w;
            }
    }
};
struct EpiResid {
    static constexpr bool PERM = false, AFTER_DRAIN = false;
    const float* hin; float* hout; const float* gmod; float scale;
    __device__ __forceinline__ void operator()(const f32x4 (&acc)[2][2][4][2], const Unit& u, int wr, int wc, int fr, int fq) const {
        const int row0 = u.pm * BM + wr * 64 + fr, col0 = u.pn * BM + wc * 32 + 4 * fq;
        const float* gp = gmod + (size_t)((u.pm * BM) >> 13) * 9216 + col0;
        f32x4 cf[2][2];
#pragma unroll
        for (int bj = 0; bj < 2; ++bj)
#pragma unroll
            for (int n = 0; n < 2; ++n) { const f32x4 g = *(const f32x4*)(gp + bj * HALF + n * 16); cf[bj][n] = (g + 1.0f) * scale; }
#pragma unroll
        for (int ai = 0; ai < 2; ++ai)
#pragma unroll
            for (int m = 0; m < 4; ++m) { const size_t off = (size_t)(row0 + ai * HALF + m * 16) * 1024 + col0;
#pragma unroll
                for (int bj = 0; bj < 2; ++bj)
#pragma unroll
                    for (int n = 0; n < 2; ++n) { const f32x4 h = *(const f32x4*)(hin + off + bj * HALF + n * 16); *(f32x4*)(hout + off + bj * HALF + n * 16) = h + cf[bj][n] * acc[ai][bj][m][n]; }
                asm volatile("" ::: "memory"); }
    }
};
struct EpiInproj {
    static constexpr bool PERM = true, AFTER_DRAIN = false;
    bf16_t* U; bf16_t* V; bf16_t* Q; float* F; bf16_t* I; bf16_t* OG; bf16_t* GA; bf16_t* GB; const float* lb;
    template <int ACT> __device__ __forceinline__ void st16(const f32x4 (&acc)[2][2][4][2], bf16_t* dst, int row0, int colg) const {
#pragma unroll
        for (int ai = 0; ai < 2; ++ai)
#pragma unroll
            for (int m = 0; m < 4; ++m)
#pragma unroll
                for (int bj = 0; bj < 2; ++bj) { const f32x4 v0 = acc[ai][bj][m][0], v1 = acc[ai][bj][m][1];
                    u32x4 w; w.x = cvt_pk_bf16(actf<ACT>(v0[0]), actf<ACT>(v0[1])); w.y = cvt_pk_bf16(actf<ACT>(v0[2]), actf<ACT>(v0[3]));
                    w.z = cvt_pk_bf16(actf<ACT>(v1[0]), actf<ACT>(v1[1])); w.w = cvt_pk_bf16(actf<ACT>(v1[2]), actf<ACT>(v1[3]));
                    *(u32x4*)(dst + (size_t)(row0 + ai * HALF + m * 16) * 1024 + colg + bj * HALF) = w; }
    }
    __device__ __forceinline__ void operator()(const f32x4 (&acc)[2][2][4][2], const Unit& u, int wr, int wc, int fr, int fq) const {
        const int grp = u.pn >> 2, colg = (u.pn & 3) * BM + wc * 32 + 8 * fq, row0 = u.pm * BM + wr * 64 + fr;
        if (grp == 3) {
#pragma unroll
            for (int bj = 0; bj < 2; ++bj) { const f32x4 l0 = *(const f32x4*)(lb + colg + bj * HALF), l1 = *(const f32x4*)(lb + colg + bj * HALF + 4);
#pragma unroll
                for (int ai = 0; ai < 2; ++ai)
#pragma unroll
                    for (int m = 0; m < 4; ++m) { const f32x4 v0 = acc[ai][bj][m][0], v1 = acc[ai][bj][m][1]; f32x4 o0, o1;
#pragma unroll
                        for (int j = 0; j < 4; ++j) { o0[j] = __logf(fmaxf(l0[j] + (1.0f - l0[j]) * actf<3>(v0[j]), 1e-30f)); o1[j] = __logf(fmaxf(l1[j] + (1.0f - l1[j]) * actf<3>(v1[j]), 1e-30f)); }
                        float* d = F + (size_t)(row0 + ai * HALF + m * 16) * 1024 + colg + bj * HALF; *(f32x4*)d = o0; *(f32x4*)(d + 4) = o1; } }
        } else if (grp < 2) st16<1>(acc, grp == 0 ? U : V, row0, colg);
        else if (grp == 2) st16<2>(acc, Q, row0, colg);
        else if (grp == 4) st16<0>(acc, I, row0, colg);
        else st16<3>(acc, grp == 5 ? OG : (grp == 6 ? GA : GB), row0, colg);
    }
};
template <int MODE> struct EpiBranch {
    static constexpr bool PERM = true, AFTER_DRAIN = false;
    const bf16_t* G; const bf16_t* P; bf16_t* O;
    __device__ __forceinline__ void operator()(const f32x4 (&acc)[2][2][4][2], const Unit& u, int wr, int wc, int fr, int fq) const {
        const int row0 = u.pm * BM + wr * 64 + fr, col0 = u.pn * BM + wc * 32 + 8 * fq;
#pragma unroll
        for (int ai = 0; ai < 2; ++ai)
#pragma unroll
            for (int m = 0; m < 4; ++m)
#pragma unroll
                for (int bj = 0; bj < 2; ++bj) { const size_t off = (size_t)(row0 + ai * HALF + m * 16) * 1024 + col0 + bj * HALF;
                    const u32x4 g = *(const u32x4*)(G + off); const f32x4 v0 = acc[ai][bj][m][0], v1 = acc[ai][bj][m][1];
                    float r[8] = { bf_lo(g.x) * v0[0], bf_hi(g.x) * v0[1], bf_lo(g.y) * v0[2], bf_hi(g.y) * v0[3], bf_lo(g.z) * v1[0], bf_hi(g.z) * v1[1], bf_lo(g.w) * v1[2], bf_hi(g.w) * v1[3] };
                    if (MODE == 1) { const u32x4 p = *(const u32x4*)(P + off);
                        r[0] += bf_lo(p.x); r[1] += bf_hi(p.x); r[2] += bf_lo(p.y); r[3] += bf_hi(p.y); r[4] += bf_lo(p.z); r[5] += bf_hi(p.z); r[6] += bf_lo(p.w); r[7] += bf_hi(p.w); }
                    u32x4 w; w.x = cvt_pk_bf16(r[0], r[1]); w.y = cvt_pk_bf16(r[2], r[3]); w.z = cvt_pk_bf16(r[4], r[5]); w.w = cvt_pk_bf16(r[6], r[7]);
                    *(u32x4*)(O + off) = w; }
    }
};

template <class Epi, class Sched, bool STAMP = false>
__device__ __forceinline__ void gemm_phase(PG8_LAS unsigned char* lds, const Gemm g, const Sched& S, const Epi& E, unsigned long long* stamps) {
    const int tid = opaque_tid(), wid = __builtin_amdgcn_readfirstlane(tid >> 6), lane = tid & 63, wr = wid >> 2, wc = wid & 3, fr = lane & 15, fq = lane >> 4;
    const int K = g.K, nt = K / BK;
    int ts_lo = 0, ts_hi = 0, nts = 0; const unsigned long long rt_entry = STAMP ? (unsigned long long)wall_clock64() : 0ull;
#define PG8_STAMP() do { if (STAMP && wid == 0 && nts < 64) { const unsigned long long _c = (unsigned long long)clock64(); \
        ts_lo = (lane == nts) ? (int)(unsigned)_c : ts_lo; ts_hi = (lane == nts) ? (int)(unsigned)(_c >> 32) : ts_hi; ++nts; } } while (0)
    PG8_STAMP();
    unsigned voffA[2], voffB[2];
#pragma unroll
    for (int i = 0; i < 2; ++i) { int R, C; stage_rc(tid * 16 + i * 8192, R, C); const int Rb = Epi::PERM ? ((R & ~31) + perm32(R & 31)) : R;
        voffA[i] = (unsigned)(R * K + C) * 2u; voffB[i] = (unsigned)(Rb * K + C) * 2u; }
    const size_t kstep = (size_t)(BK * 2);
    const size_t hstep = (size_t)HALF * K * 2;
    const size_t tstep = 2 * hstep;
    const unsigned ldsw = (unsigned)wid * 1024u;
    const int aoff = lds_byte(wr * 64 + fr, fq * 8), boff = lds_byte(wc * 32 + fr, fq * 8);
#define PG8_SA(b, h) (((b) * 2 + (h)) * HTB)
#define PG8_SB(b, h) ((4 + (b) * 2 + (h)) * HTB)
#define PG8_STAGE(bufoff, gbase, voff) do { _Pragma("unroll") for (int _i = 0; _i < 2; ++_i) \
        __builtin_amdgcn_global_load_lds((const unsigned*)((const char*)(gbase) + (voff)[_i]), (PG8_LAS unsigned*)(lds + (bufoff) + ldsw + _i * 8192), 16, 0, 0); } while (0)
#define PG8_LDA(dst, b, h) do { _Pragma("unroll") for (int m = 0; m < 4; ++m) _Pragma("unroll") for (int k = 0; k < 2; ++k) dst[m][k] = *(const PG8_LAS bf16x8*)(lds + PG8_SA(b, h) + aoff + m * 2048 + k * 1024); } while (0)
#define PG8_LDB(dst, b, h) do { _Pragma("unroll") for (int n = 0; n < 2; ++n) _Pragma("unroll") for (int k = 0; k < 2; ++k) dst[n][k] = *(const PG8_LAS bf16x8*)(lds + PG8_SB(b, h) + boff + n * 2048 + k * 1024); } while (0)
#define PG8_MMA(ai, bj, At, Bt) do { __builtin_amdgcn_s_setprio(1); _Pragma("unroll") for (int m = 0; m < 4; ++m) _Pragma("unroll") for (int n = 0; n < 2; ++n) _Pragma("unroll") for (int k = 0; k < 2; ++k) \
        acc[ai][bj][m][n] = __builtin_amdgcn_mfma_f32_16x16x32_bf16(Bt[n][k], At[m][k], acc[ai][bj][m][n], 0, 0, 0); __builtin_amdgcn_s_setprio(0); } while (0)
#define PG8_WAIT_V(n) asm volatile("s_waitcnt vmcnt(" #n ")" ::: "memory")
#define PG8_WAIT_L(n) asm volatile("s_waitcnt lgkmcnt(" #n ")" ::: "memory")
#define PG8_BAR __builtin_amdgcn_s_barrier()
#define PG8_SCHED __builtin_amdgcn_sched_barrier(0)
    Unit cur, nxt; int ui = 0;
    if (!S.next(0, cur)) return;
    f32x4 acc[2][2][4][2];
#pragma unroll
    for (int a = 0; a < 2; ++a)
#pragma unroll
        for (int b = 0; b < 2; ++b)
#pragma unroll
            for (int m = 0; m < 4; ++m)
#pragma unroll
                for (int n = 0; n < 2; ++n) acc[a][b][m][n] = (f32x4){0.f, 0.f, 0.f, 0.f};
    bf16x8 At[4][2], B0[2][2], B1[2][2];
    const char* cA = (const char*)g.A + (size_t)cur.pm * tstep; const char* cB = (const char*)g.Bt + (size_t)cur.pn * tstep;
    S.a_ready(cur);
    PG8_STAGE(PG8_SB(0, 0), cB, voffB); PG8_STAGE(PG8_SA(0, 0), cA, voffA); PG8_STAGE(PG8_SB(0, 1), cB + hstep, voffB); PG8_STAGE(PG8_SA(0, 1), cA + hstep, voffA);
    if (wr == 1) PG8_BAR;
    PG8_WAIT_V(4); PG8_BAR;
    PG8_STAGE(PG8_SB(1, 0), cB + kstep, voffB); PG8_STAGE(PG8_SA(1, 0), cA + kstep, voffA); PG8_STAGE(PG8_SB(1, 1), cB + hstep + kstep, voffB);
    PG8_WAIT_V(6); PG8_BAR;
    PG8_STAMP();
    for (;;) {
        const bool has_next = S.next(ui + 1, nxt);
        const char* nA = has_next ? (const char*)g.A + (size_t)nxt.pm * tstep : cA; const char* nB = has_next ? (const char*)g.Bt + (size_t)nxt.pn * tstep : cB;
        for (int t = 0; t < nt; t += 2) {
            const bool last = (t == nt - 2);
            const char* a1 = cA + (size_t)(t + 1) * kstep;
            const char* a2 = last ? nA : cA + (size_t)(t + 2) * kstep; const char* b2 = last ? nB : cB + (size_t)(t + 2) * kstep;
            const char* a3 = a2 + kstep; const char* b3 = b2 + kstep;
            if (last && has_next) S.a_ready(nxt);
            PG8_LDB(B0, 0, 0); PG8_SCHED; PG8_LDA(At, 0, 0); PG8_STAGE(PG8_SA(1, 1), a1 + hstep, voffA);
            PG8_WAIT_L(8); PG8_BAR; PG8_WAIT_L(0); PG8_MMA(0, 0, At, B0); PG8_BAR; PG8_SCHED;
            PG8_LDB(B1, 0, 1); PG8_STAGE(PG8_SB(0, 0), b2, voffB);
            PG8_BAR; PG8_WAIT_L(0); PG8_MMA(0, 1, At, B1); PG8_BAR;
            PG8_LDA(At, 0, 1); PG8_STAGE(PG8_SA(0, 0), a2, voffA);
            PG8_BAR; PG8_WAIT_L(0); PG8_MMA(1, 0, At, B0); PG8_BAR; PG8_SCHED;
            PG8_STAGE(PG8_SB(0, 1), b2 + hstep, voffB);
            PG8_WAIT_V(6); PG8_BAR; PG8_MMA(1, 1, At, B1); PG8_BAR;
            PG8_LDB(B0, 1, 0); PG8_SCHED; PG8_LDA(At, 1, 0); PG8_STAGE(PG8_SA(0, 1), a2 + hstep, voffA);
            PG8_WAIT_L(8); PG8_BAR; PG8_WAIT_L(0); PG8_MMA(0, 0, At, B0); PG8_BAR; PG8_SCHED;
            PG8_LDB(B1, 1, 1); PG8_STAGE(PG8_SB(1, 0), b3, voffB);
            PG8_BAR; PG8_WAIT_L(0); PG8_MMA(0, 1, At, B1); PG8_BAR;
            PG8_LDA(At, 1, 1); PG8_STAGE(PG8_SA(1, 0), a3, voffA);
            PG8_BAR; PG8_WAIT_L(0); PG8_MMA(1, 0, At, B0); PG8_BAR; PG8_SCHED;
            PG8_STAGE(PG8_SB(1, 1), b3 + hstep, voffB);
            PG8_WAIT_V(6); PG8_BAR; PG8_MMA(1, 1, At, B1); PG8_BAR;
        }
        PG8_STAMP();
        if constexpr (!Epi::AFTER_DRAIN) { E(acc, cur, wr, wc, fr, fq); S.done(cur); }
        PG8_STAMP();
        if (!has_next) break;
#pragma unroll
        for (int a = 0; a < 2; ++a)
#pragma unroll
            for (int b = 0; b < 2; ++b)
#pragma unroll
                for (int m = 0; m < 4; ++m)
#pragma unroll
                    for (int n = 0; n < 2; ++n) acc[a][b][m][n] = (f32x4){0.f, 0.f, 0.f, 0.f};
        cur = nxt; cA = nA; cB = nB; ++ui;
    }
    PG8_WAIT_V(0);
    if (wr == 0) PG8_BAR;
    PG8_BAR;
    if constexpr (Epi::AFTER_DRAIN) { E.fused(acc, cur, wr, wc, fr, fq, lds, wid, lane); S.done(cur); }
    PG8_STAMP();
    if (STAMP && wid == 0) { stamps[lane] = lane < nts ? (((unsigned long long)(unsigned)ts_hi << 32) | (unsigned)ts_lo) : 0ull;
        if (lane == 62) stamps[62] = rt_entry; if (lane == 63) stamps[63] = (unsigned long long)wall_clock64(); }
#undef PG8_STAMP
#undef PG8_SA
#undef PG8_SB
#undef PG8_STAGE
#undef PG8_LDA
#undef PG8_LDB
#undef PG8_MMA
#undef PG8_WAIT_V
#undef PG8_WAIT_L
#undef PG8_BAR
#undef PG8_SCHED
}
}
using pg8::bf16_t; using pg8::bf16x8; using pg8::f32x4; using pg8::u32x4; using pg8::cvt_pk_bf16; using pg8::bf_lo; using pg8::bf_hi; using pg8::opaque_tid;
#define LAS __attribute__((address_space(3)))
typedef unsigned u32x2 __attribute__((ext_vector_type(2)));

constexpr int NT = 65536, DM = 1024, NL = 4, SEQ = 8192, FH = 2816, TH = 32768  ;
constexpr int LDS_BYTES = 144 * 1024;
constexpr size_t MiB = 1024ull * 1024ull;
constexpr size_t WS_MOD = 64 * 1024;
constexpr size_t WS_WST = 2 * MiB;
constexpr size_t WS_LB = 3 * MiB;
constexpr size_t WS_WIN = 4 * MiB;
constexpr size_t WS_W13 = 68 * MiB;
constexpr size_t WS_W2 = 156 * MiB;
constexpr size_t WS_WA = 200 * MiB, WS_WB = 208 * MiB, WS_WO = 216 * MiB;
constexpr size_t WS_HN = 224 * MiB;
constexpr size_t WS_BIG = 352 * MiB;
constexpr size_t ZB = 64 * MiB;
constexpr size_t WS_U = WS_BIG, WS_V = WS_BIG + ZB, WS_Q = WS_BIG + 2 * ZB, WS_F = WS_BIG + 3 * ZB  , WS_I = WS_BIG + 5 * ZB, WS_OG = WS_BIG + 6 * ZB, WS_GA = WS_BIG + 7 * ZB, WS_GB = WS_BIG + 8 * ZB;
constexpr size_t WS_END = WS_BIG + 9 * ZB;

struct Params { const float* in[15]; float* out; unsigned char* ws; int ph_lo, ph_hi; };
typedef const Params __attribute__((address_space(4))) * KP;

__device__ __forceinline__ float wave_sum(float v) {
#pragma unroll
    for (int o = 1; o < 64; o <<= 1) v += __shfl_xor(v, o);
    return v;
}

__device__ __forceinline__ void transpose_item(const float* __restrict__ W, int K, int N, bf16_t* __restrict__ WT, int item, int remap, LAS float* scr, int lane) {
    const int nblk = N / 32, kb = item / nblk, nb = item - kb * nblk, k0 = 64 * kb, n0 = 32 * nb;
    int drow0 = n0;
    if (remap) { const int bj = n0 / FH, nn = n0 - bj * FH; drow0 = (nn >> 7) * 256 + bj * 128 + (nn & 127); }
#pragma unroll 8
    for (int i = 0; i < 32; ++i) { const int kk = 2 * i + (lane >> 5); scr[kk * 33 + (lane & 31)] = W[(size_t)(k0 + kk) * N + n0 + (lane & 31)]; }
    asm volatile("s_waitcnt lgkmcnt(0)" ::: "memory");
    const int c = lane & 7;
#pragma unroll
    for (int j = 0; j < 4; ++j) { const int n = (lane >> 3) + 8 * j; const LAS float* s = scr + (8 * c) * 33 + n;
        u32x4 o; o.x = cvt_pk_bf16(s[0 * 33], s[1 * 33]); o.y = cvt_pk_bf16(s[2 * 33], s[3 * 33]); o.z = cvt_pk_bf16(s[4 * 33], s[5 * 33]); o.w = cvt_pk_bf16(s[6 * 33], s[7 * 33]);
        *(u32x4*)(WT + (size_t)(drow0 + n) * K + k0 + 8 * c) = o; }
    asm volatile("s_waitcnt lgkmcnt(0)" ::: "memory");
}

__device__ __forceinline__ void prologue_phase(KP p, LAS unsigned char* lds) {
    const int tid = opaque_tid(), lane = tid & 63, wave = tid >> 6, G = gridDim.x;
    unsigned char* ws = p->ws;
    if (blockIdx.x < 72) {
        LAS float* cact = (LAS float*)lds;
        const float* c = p->in[1];
        for (int i = tid; i < 8192; i += 512) { const int b = i >> 10, k = i & 1023; const float x = c[i]; cact[k * 8 + b] = x / (1.0f + __expf(-x)); }
        __syncthreads();
        const int idx = blockIdx.x * 512 + tid, l = idx / 9216, n = idx - l * 9216;
        const float* aw = p->in[12] + (size_t)l * 1024 * 9216 + n;
        float a[8];
#pragma unroll
        for (int b = 0; b < 8; ++b) a[b] = 0.f;
#pragma unroll 4
        for (int k = 0; k < 1024; ++k) { const float w = aw[(size_t)k * 9216]; const f32x4 c0 = *(const LAS f32x4*)(cact + k * 8), c1 = *(const LAS f32x4*)(cact + k * 8 + 4);
            a[0] += c0[0] * w; a[1] += c0[1] * w; a[2] += c0[2] * w; a[3] += c0[3] * w; a[4] += c1[0] * w; a[5] += c1[1] * w; a[6] += c1[2] * w; a[7] += c1[3] * w; }
        const float bias = p->in[13][idx];
        float* mod = (float*)(ws + WS_MOD);
#pragma unroll
        for (int b = 0; b < 8; ++b) mod[((size_t)l * 8 + b) * 9216 + n] = a[b] + bias;
        __syncthreads();
    }
    if (blockIdx.x == 72 % G) {
        const float* lg = p->in[5]; float* lb = (float*)(ws + WS_LB);
        for (int k = tid; k < 1024; k += 512) { const float a0 = lg[k], a1 = lg[1024 + k], a2 = lg[2048 + k], a3 = lg[3072 + k]; const float mx = fmaxf(fmaxf(a0, a1), fmaxf(a2, a3));
            const float e0 = __expf(a0 - mx), e1 = __expf(a1 - mx), e2 = __expf(a2 - mx), e3 = __expf(a3 - mx), inv = 1.0f / (e0 + e1 + e2 + e3);
            lb[k] = 0.f; lb[1024 + k] = e1 * inv; lb[2048 + k] = (e1 + e2) * inv; lb[3072 + k] = (e1 + e2 + e3) * inv; }
    }
    { const float* wsrc = p->in[3]; bf16_t* wst = (bf16_t*)(ws + WS_WST);
      for (int i = blockIdx.x * 512 + tid; i < 4 * 8 * 128 * 128 / 2; i += G * 512) { const int e = 2 * i, s = e & 127, t = (e >> 7) & 127;
          const float v0 = s <= t ? wsrc[e] : 0.f, v1 = (s + 1) <= t ? wsrc[e + 1] : 0.f; ((unsigned*)wst)[i] = cvt_pk_bf16(v0, v1); } }
    LAS float* scr = (LAS float*)(lds + 32768 + wave * 8704);
    const int gw = blockIdx.x * 8 + wave, NGW = G * 8;
    constexpr int I_IN = 16 * 256, I_13 = 16 * 176, I_2 = 44 * 32, I_SQ = 16 * 32, I_LAYER = I_IN + 2 * I_13 + 2 * I_2 + 3 * I_SQ;
    for (int it = gw; it < NL * I_LAYER; it += NGW) {
        const int l = it / I_LAYER; int r = it - l * I_LAYER;
        if (r < I_IN) { transpose_item(p->in[2] + (size_t)l * 1024 * 8192, 1024, 8192, (bf16_t*)(ws + WS_WIN) + (size_t)l * 8192 * 1024, r, 0, scr, lane); continue; } r -= I_IN;
        if (r < 2 * I_13) { const int s = r / I_13; r -= s * I_13; transpose_item(p->in[9] + (size_t)(l * 2 + s) * 1024 * 5632, 1024, 5632, (bf16_t*)(ws + WS_W13) + (size_t)(l * 2 + s) * 5632 * 1024, r, 1, scr, lane); continue; } r -= 2 * I_13;
        if (r < 2 * I_2) { const int s = r / I_2; r -= s * I_2; transpose_item(p->in[10] + (size_t)(l * 2 + s) * FH * 1024, FH, 1024, (bf16_t*)(ws + WS_W2) + (size_t)(l * 2 + s) * 1024 * FH, r, 0, scr, lane); continue; } r -= 2 * I_2;
        const int m = r / I_SQ; r -= m * I_SQ;
        const float* src = (m == 0 ? p->in[6] : (m == 1 ? p->in[7] : p->in[8])) + (size_t)l * 1024 * 1024;
        bf16_t* dst = (bf16_t*)(ws + (m == 0 ? WS_WA : (m == 1 ? WS_WB : WS_WO))) + (size_t)l * 1024 * 1024;
        transpose_item(src, 1024, 1024, dst, r, 0, scr, lane);
    }
}

template <bool FINAL> __device__ __forceinline__ void norm_phase(const float* hin, bf16_t* hn, float* fout, const float* nw, const float* modl  , int sub) {
    const int tid = opaque_tid(), lane = tid & 63, gw = blockIdx.x * 8 + (tid >> 6), NGW = gridDim.x * 8;
    f32x4 w4[4];
#pragma unroll
    for (int j = 0; j < 4; ++j) w4[j] = *(const f32x4*)(nw + 4 * lane + 256 * j);
    for (int row = gw; row < NT; row += NGW) {
        const float* xr = hin + (size_t)row * DM + 4 * lane;
        f32x4 v[4]; float s = 0.f;
#pragma unroll
        for (int j = 0; j < 4; ++j) { v[j] = *(const f32x4*)(xr + 256 * j); s += (v[j][0] * v[j][0] + v[j][1] * v[j][1]) + (v[j][2] * v[j][2] + v[j][3] * v[j][3]); }
        const float rstd = rsqrtf(wave_sum(s) * (1.0f / DM) + 1e-6f);
        if (FINAL) {
#pragma unroll
            for (int j = 0; j < 4; ++j) *(f32x4*)(fout + (size_t)row * DM + 4 * lane + 256 * j) = v[j] * rstd * w4[j];
        } else {
            const float* sh = modl + (size_t)(row >> 13) * 9216 + (3 * sub) * 1024 + 4 * lane; const float* sc = sh + 1024;
#pragma unroll
            for (int j = 0; j < 4; ++j) { const f32x4 a = *(const f32x4*)(sc + 256 * j), b = *(const f32x4*)(sh + 256 * j); const f32x4 o = v[j] * rstd * w4[j] * (a + 1.0f) + b;
                u32x2 w; w.x = cvt_pk_bf16(o[0], o[1]); w.y = cvt_pk_bf16(o[2], o[3]); *(u32x2*)(hn + (size_t)row * DM + 4 * lane + 256 * j) = w; }
        }
    }
}

__device__ __forceinline__ int tr64_off(int row, int col) { return row * 128 + ((((col >> 3) ^ (row ^ (row >> 3))) & 7) << 4) + ((col & 7) << 1); }
__device__ __forceinline__ int tr128_off(int row, int col) { return row * 256 + ((((col >> 3) ^ (row ^ (row >> 3))) & 15) << 4) + ((col & 7) << 1); }
constexpr int H_LF = 0, H_P = 0  , H_TOT = 32768, H_VEC = 34816, H_SS = 36864, H_QP = 38912, H_KP = 56320, H_KT = 73728, H_VT = 90112, H_ST = 106496, H_END = 141312;
static_assert(H_END <= LDS_BYTES, "LDS");
#define MFMA16(a, b, c) __builtin_amdgcn_mfma_f32_16x16x32_bf16((a), (b), (c), 0, 0, 0)

__device__ __forceinline__ void hgrn_seq(LAS unsigned char* lds, const bf16_t* __restrict__ Qb, const float* __restrict__ Fb, const bf16_t* __restrict__ Ib, bf16_t* OGb, size_t row_base, int colbase, int nchunks) {
    const int tid = opaque_tid(), lane = tid & 63, w = __builtin_amdgcn_readfirstlane(tid >> 6), q4 = lane >> 4, l15 = lane & 15;
    const int pt = tid >> 4, pc8 = (tid & 15) * 8;
    LAS float* Lf = (LAS float*)(lds + H_LF); LAS float* Ltot = (LAS float*)(lds + H_TOT); LAS float* Lvec = (LAS float*)(lds + H_VEC); LAS float* Lss = (LAS float*)(lds + H_SS);
    f32x4 S[8];
#pragma unroll
    for (int i = 0; i < 8; ++i) S[i] = (f32x4){0.f, 0.f, 0.f, 0.f};
    u32x4 rq[2], rv[2]; f32x4 rf[2][2];
#define HG_LOAD(c) do { _Pragma("unroll") for (int i_ = 0; i_ < 2; ++i_) { const size_t go_ = (row_base + (size_t)(c) * 64 + pt + 32 * i_) * 1024 + colbase + pc8; \
        rq[i_] = *(const u32x4*)(Qb + go_); rv[i_] = *(const u32x4*)(Ib + go_); rf[i_][0] = *(const f32x4*)(Fb + go_); rf[i_][1] = *(const f32x4*)(Fb + go_ + 4); } } while (0)
    HG_LOAD(0);
    for (int c = 0; c < nchunks; ++c) {
        u32x2 rog[4];
#pragma unroll
        for (int ti = 0; ti < 4; ++ti) rog[ti] = *(const u32x2*)(OGb + (row_base + (size_t)c * 64 + 16 * ti + l15) * 1024 + colbase + 16 * w + 4 * q4);
#pragma unroll
        for (int i = 0; i < 2; ++i) { *(LAS f32x4*)(Lf + (pt + 32 * i) * 128 + pc8) = rf[i][0]; *(LAS f32x4*)(Lf + (pt + 32 * i) * 128 + pc8 + 4) = rf[i][1]; }
        __syncthreads();
        { const int k = tid & 127, seg = tid >> 7; float run = 0.f;
#pragma unroll
          for (int i = 0; i < 16; ++i) { const int idx = (16 * seg + i) * 128 + k; run += Lf[idx]; Lf[idx] = run; }
          Ltot[seg * 128 + k] = run; }
        __syncthreads();
        { const int k = tid & 127, seg = tid >> 7; const float t0 = Ltot[k], t1 = Ltot[128 + k], t2 = Ltot[256 + k], t3 = Ltot[384 + k];
          const float off = seg == 0 ? 0.f : (seg == 1 ? t0 : (seg == 2 ? t0 + t1 : t0 + t1 + t2));
          if (seg > 0) {
#pragma unroll
              for (int i = 0; i < 16; ++i) { const int idx = (16 * seg + i) * 128 + k; Lf[idx] += off; } }
          else { const float b31 = t0 + t1, b63 = b31 + t2 + t3; Lvec[k] = __expf(b31); Lvec[128 + k] = __expf(b63); Lvec[256 + k] = __expf(b63 - b31); Lvec[384 + k] = b31; } }
        __syncthreads();
#pragma unroll
        for (int i = 0; i < 2; ++i) { const int t = pt + 32 * i;
            const f32x4 b0 = *(const LAS f32x4*)(Lf + t * 128 + pc8), b1 = *(const LAS f32x4*)(Lf + t * 128 + pc8 + 4), r0 = *(const LAS f32x4*)(Lvec + 384 + pc8), r1 = *(const LAS f32x4*)(Lvec + 384 + pc8 + 4);
            const unsigned qw[4] = {rq[i].x, rq[i].y, rq[i].z, rq[i].w}, vw[4] = {rv[i].x, rv[i].y, rv[i].z, rv[i].w};
            float qp[8], kp[8];
#pragma unroll
            for (int j = 0; j < 8; ++j) { const float bb = j < 4 ? b0[j & 3] : b1[j & 3], rr = j < 4 ? r0[j & 3] : r1[j & 3], lf = j < 4 ? rf[i][0][j & 3] : rf[i][1][j & 3];
                const float d = fminf(fmaxf(bb - rr, -80.f), 80.f); const float qv = (j & 1) ? bf_hi(qw[j >> 1]) : bf_lo(qw[j >> 1]);
                qp[j] = qv * __expf(d); kp[j] = (1.0f - __expf(lf)) * __expf(-d); }
            u32x4 wq, wk; wq.x = cvt_pk_bf16(qp[0], qp[1]); wq.y = cvt_pk_bf16(qp[2], qp[3]); wq.z = cvt_pk_bf16(qp[4], qp[5]); wq.w = cvt_pk_bf16(qp[6], qp[7]);
            wk.x = cvt_pk_bf16(kp[0], kp[1]); wk.y = cvt_pk_bf16(kp[2], kp[3]); wk.z = cvt_pk_bf16(kp[4], kp[5]); wk.w = cvt_pk_bf16(kp[6], kp[7]);
            *(LAS u32x4*)(lds + H_QP + t * 272 + pc8 * 2) = wq; *(LAS u32x4*)(lds + H_KP + t * 272 + pc8 * 2) = wk;
            const unsigned kw[4] = {wk.x, wk.y, wk.z, wk.w};
#pragma unroll
            for (int j = 0; j < 8; ++j) { const unsigned short kk = (unsigned short)((j & 1) ? (kw[j >> 1] >> 16) : (kw[j >> 1] & 0xffffu)), vv = (unsigned short)((j & 1) ? (vw[j >> 1] >> 16) : (vw[j >> 1] & 0xffffu));
                *(LAS unsigned short*)(lds + H_KT + tr64_off(pc8 + j, t)) = kk; *(LAS unsigned short*)(lds + H_VT + tr64_off(pc8 + j, t)) = vv; } }
        { const f32x4 e4 = *(const LAS f32x4*)(Lvec + 16 * w + 4 * q4);
#pragma unroll
          for (int vt = 0; vt < 8; ++vt) { const f32x4 sv = S[vt] * e4; u32x2 o; o.x = cvt_pk_bf16(sv[0], sv[1]); o.y = cvt_pk_bf16(sv[2], sv[3]);
              *(LAS u32x2*)(lds + H_ST + (16 * vt + l15) * 272 + (16 * w + 4 * q4) * 2) = o; } }
        if (c + 1 < nchunks) HG_LOAD(c + 1);
        __syncthreads();
        { const int ti = w >> 1;
#pragma unroll
          for (int sj = 0; sj < 2; ++sj) { const int si = 2 * (w & 1) + sj; f32x4 a4 = (f32x4){0.f, 0.f, 0.f, 0.f};
              if (si <= ti) {
#pragma unroll
                  for (int kb = 0; kb < 4; ++kb) { const bf16x8 a = *(const LAS bf16x8*)(lds + H_KP + (16 * si + l15) * 272 + kb * 64 + q4 * 16), b = *(const LAS bf16x8*)(lds + H_QP + (16 * ti + l15) * 272 + kb * 64 + q4 * 16); a4 = MFMA16(a, b, a4); }
                  const int t = 16 * ti + l15, s0 = 16 * si + 4 * q4;
#pragma unroll
                  for (int r = 0; r < 4; ++r) a4[r] = (s0 + r <= t) ? a4[r] : 0.f; }
              u32x2 o; o.x = cvt_pk_bf16(a4[0], a4[1]); o.y = cvt_pk_bf16(a4[2], a4[3]);
              *(LAS u32x2*)(lds + H_P + (16 * ti + l15) * 144 + (16 * si + 4 * q4) * 2) = o; } }
        f32x4 oT[4];
#pragma unroll
        for (int ti = 0; ti < 4; ++ti) oT[ti] = (f32x4){0.f, 0.f, 0.f, 0.f};
#pragma unroll
        for (int kb = 0; kb < 4; ++kb) { const bf16x8 a = *(const LAS bf16x8*)(lds + H_ST + (16 * w + l15) * 272 + kb * 64 + q4 * 16);
#pragma unroll
            for (int ti = 0; ti < 4; ++ti) { const bf16x8 b = *(const LAS bf16x8*)(lds + H_QP + (16 * ti + l15) * 272 + kb * 64 + q4 * 16); oT[ti] = MFMA16(a, b, oT[ti]); } }
        __syncthreads();
        { f32x4 U[8];
#pragma unroll
          for (int vt = 0; vt < 8; ++vt) U[vt] = (f32x4){0.f, 0.f, 0.f, 0.f};
#pragma unroll
          for (int kb = 0; kb < 2; ++kb) { const bf16x8 av = *(const LAS bf16x8*)(lds + H_VT + tr64_off(16 * w + l15, 32 * kb + 8 * q4)), ak = *(const LAS bf16x8*)(lds + H_KT + tr64_off(16 * w + l15, 32 * kb + 8 * q4));
#pragma unroll
              for (int ti = 0; ti < 4; ++ti) { const bf16x8 b = *(const LAS bf16x8*)(lds + H_P + (16 * ti + l15) * 144 + (32 * kb + 8 * q4) * 2); oT[ti] = MFMA16(av, b, oT[ti]); }
#pragma unroll
              for (int vt = 0; vt < 8; ++vt) { const bf16x8 b = *(const LAS bf16x8*)(lds + H_VT + tr64_off(16 * vt + l15, 32 * kb + 8 * q4)); U[vt] = MFMA16(ak, b, U[vt]); } }
          const f32x4 d4 = *(const LAS f32x4*)(Lvec + 128 + 16 * w + 4 * q4), c4 = *(const LAS f32x4*)(Lvec + 256 + 16 * w + 4 * q4);
#pragma unroll
          for (int vt = 0; vt < 8; ++vt) S[vt] = S[vt] * d4 + U[vt] * c4; }
#pragma unroll
        for (int ti = 0; ti < 4; ++ti) { float ss = (oT[ti][0] * oT[ti][0] + oT[ti][1] * oT[ti][1]) + (oT[ti][2] * oT[ti][2] + oT[ti][3] * oT[ti][3]); ss += __shfl_xor(ss, 16); ss += __shfl_xor(ss, 32);
            if (q4 == 0) Lss[w * 64 + 16 * ti + l15] = ss; }
        __syncthreads();
#pragma unroll
        for (int ti = 0; ti < 4; ++ti) { const int t = 16 * ti + l15; float tot = 0.f;
#pragma unroll
            for (int ww = 0; ww < 8; ++ww) tot += Lss[ww * 64 + t];
            const float rs = rsqrtf(tot * (1.0f / 128.0f) + 1e-6f);
            u32x2 o; o.x = cvt_pk_bf16(oT[ti][0] * rs * bf_lo(rog[ti].x), oT[ti][1] * rs * bf_hi(rog[ti].x)); o.y = cvt_pk_bf16(oT[ti][2] * rs * bf_lo(rog[ti].y), oT[ti][3] * rs * bf_hi(rog[ti].y));
            *(u32x2*)(OGb + (row_base + (size_t)c * 64 + t) * 1024 + colbase + 16 * w + 4 * q4) = o; }
    }
    __syncthreads();
#undef HG_LOAD
}

__device__ __forceinline__ void gmlp_item(LAS unsigned char* lds, const bf16_t* __restrict__ Vb, bf16_t* Ub, const bf16_t* __restrict__ Wt  , const float* __restrict__ bias  , size_t row0, int col0, int tid) {
     const int lane = tid & 63, w = __builtin_amdgcn_readfirstlane(tid >> 6), q4 = lane >> 4, l15 = lane & 15;
    const int ps = tid >> 4, pc8 = (tid & 15) * 8, nkb = (w >> 1) + 1;
    bf16x8 wf[4];
#pragma unroll
    for (int kb = 0; kb < 4; ++kb) if (kb < nkb) wf[kb] = *(const bf16x8*)(Wt + (16 * w + l15) * 128 + kb * 32 + q4 * 8);
#pragma unroll
    for (int i = 0; i < 4; ++i) { const int s = ps + 32 * i; const u32x4 raw = *(const u32x4*)(Vb + (row0 + s) * 1024 + col0 + pc8);
        float x[8] = {bf_lo(raw.x), bf_hi(raw.x), bf_lo(raw.y), bf_hi(raw.y), bf_lo(raw.z), bf_hi(raw.z), bf_lo(raw.w), bf_hi(raw.w)};
        float sm = ((x[0] + x[1]) + (x[2] + x[3])) + ((x[4] + x[5]) + (x[6] + x[7]));
        sm += __shfl_xor(sm, 1); sm += __shfl_xor(sm, 2); sm += __shfl_xor(sm, 4); sm += __shfl_xor(sm, 8);
        const float mu = sm * (1.0f / 128.0f); float vs = 0.f;
#pragma unroll
        for (int j = 0; j < 8; ++j) { x[j] -= mu; vs += x[j] * x[j]; }
        vs += __shfl_xor(vs, 1); vs += __shfl_xor(vs, 2); vs += __shfl_xor(vs, 4); vs += __shfl_xor(vs, 8);
        const float rstd = rsqrtf(vs * (1.0f / 128.0f) + 1e-6f);
#pragma unroll
        for (int j = 0; j < 4; ++j) { const unsigned pk = cvt_pk_bf16(x[2 * j] * rstd, x[2 * j + 1] * rstd);
            *(LAS unsigned short*)(lds + tr128_off(pc8 + 2 * j, s)) = (unsigned short)(pk & 0xffffu); *(LAS unsigned short*)(lds + tr128_off(pc8 + 2 * j + 1, s)) = (unsigned short)(pk >> 16); } }
    __syncthreads();
    f32x4 acc[8];
#pragma unroll
    for (int ct = 0; ct < 8; ++ct) acc[ct] = (f32x4){0.f, 0.f, 0.f, 0.f};
#pragma unroll
    for (int kb = 0; kb < 4; ++kb) if (kb < nkb) {
#pragma unroll
        for (int ct = 0; ct < 8; ++ct) { const bf16x8 a = *(const LAS bf16x8*)(lds + tr128_off(16 * ct + l15, 32 * kb + 8 * q4)); acc[ct] = MFMA16(a, wf[kb], acc[ct]); } }
    const int t = 16 * w + l15; const float bt = bias[t];
#pragma unroll
    for (int ct = 0; ct < 8; ++ct) { bf16_t* up = Ub + (row0 + t) * 1024 + col0 + 16 * ct + 4 * q4; const u32x2 uu = *(const u32x2*)up;
        u32x2 o; o.x = cvt_pk_bf16(bf_lo(uu.x) * (acc[ct][0] + bt), bf_hi(uu.x) * (acc[ct][1] + bt)); o.y = cvt_pk_bf16(bf_lo(uu.y) * (acc[ct][2] + bt), bf_hi(uu.y) * (acc[ct][3] + bt));
        *(u32x2*)up = o; }
    __syncthreads();
}

constexpr int HGRN_WGS = 32;
#ifndef PHMASK
#define PHMASK 0xffff
#endif
__global__ void __launch_bounds__(512, 2) mk_fwd(Params p_arg) {
    extern __shared__ __attribute__((aligned(16))) unsigned char lds_raw[];
    LAS unsigned char* lds = (LAS unsigned char*)lds_raw;
    int pc = 0;
#define GETP KP pp = (KP)__builtin_amdgcn_kernarg_segment_ptr(); asm volatile("" : "+s"(pp))
#define PH_BEGIN(bit) { GETP; if (pc >= pp->ph_lo && pc < pp->ph_hi && (PHMASK & (bit))) {
#define PH_END } } { GETP; ++pc; if (pc > pp->ph_lo && pc < pp->ph_hi) cg::this_grid().sync(); }

    PH_BEGIN(1) prologue_phase(pp, lds); PH_END

    for (int blk = 0; blk < 3 * NL; ++blk) {
        const int l = blk / 3, kind = blk - 3 * l;
        PH_BEGIN(2) unsigned char* ws = pp->ws; const float* hin = (blk == 0) ? pp->in[0] : pp->out;
            norm_phase<false>(hin, (bf16_t*)(ws + WS_HN), nullptr, pp->in[11] + (size_t)(l * 3 + kind) * 1024, (const float*)(ws + WS_MOD) + (size_t)l * 8 * 9216, kind); PH_END
        if (kind != 1) {
            const int s = kind >> 1;
            PH_BEGIN(4) unsigned char* ws = pp->ws;
                pg8::Gemm g{(const bf16_t*)(ws + WS_HN), (const bf16_t*)(ws + WS_W13) + (size_t)(l * 2 + s) * 5632 * 1024, NT, 5632, 1024}; pg8::StaticOrder S; S.init(NT, 5632, (int)gridDim.x, (int)blockIdx.x);
                pg8::EpiSwiGLU E{(bf16_t*)(ws + WS_BIG)}; pg8::gemm_phase<pg8::EpiSwiGLU, pg8::StaticOrder, false>(lds, g, S, E, nullptr); PH_END
            PH_BEGIN(8) unsigned char* ws = pp->ws; const float* hin = (blk == 0) ? pp->in[0] : pp->out;
                pg8::Gemm g{(const bf16_t*)(ws + WS_BIG), (const bf16_t*)(ws + WS_W2) + (size_t)(l * 2 + s) * 1024 * FH, NT, 1024, FH}; pg8::StaticOrder S; S.init(NT, 1024, (int)gridDim.x, (int)blockIdx.x);
                pg8::EpiResid E{hin, pp->out, (const float*)(ws + WS_MOD) + (size_t)l * 8 * 9216 + (3 * kind + 2) * 1024, 0.5f}; pg8::gemm_phase<pg8::EpiResid, pg8::StaticOrder, false>(lds, g, S, E, nullptr); PH_END
        } else {
            for (int half = 0; half < 2; ++half) {
                PH_BEGIN(16) unsigned char* ws = pp->ws;
                    pg8::Gemm g{(const bf16_t*)(ws + WS_HN) + (size_t)half * TH * 1024, (const bf16_t*)(ws + WS_WIN) + (size_t)l * 8192 * 1024, TH, 8192, 1024}; pg8::StaticOrder S; S.init(TH, 8192, (int)gridDim.x, (int)blockIdx.x);
                    pg8::EpiInproj E{(bf16_t*)(ws + WS_U), (bf16_t*)(ws + WS_V), (bf16_t*)(ws + WS_Q), (float*)(ws + WS_F), (bf16_t*)(ws + WS_I), (bf16_t*)(ws + WS_OG), (bf16_t*)(ws + WS_GA), (bf16_t*)(ws + WS_GB), (const float*)(ws + WS_LB) + l * 1024};
                    pg8::gemm_phase<pg8::EpiInproj, pg8::StaticOrder, false>(lds, g, S, E, nullptr); PH_END
                PH_BEGIN(32) unsigned char* ws = pp->ws;
                    if ((int)blockIdx.x < HGRN_WGS) hgrn_seq(lds, (const bf16_t*)(ws + WS_Q), (const float*)(ws + WS_F), (const bf16_t*)(ws + WS_I), (bf16_t*)(ws + WS_OG), (size_t)(blockIdx.x >> 3) * SEQ, (blockIdx.x & 7) * 128, SEQ / 64);
                    else { const bf16_t* wst = (const bf16_t*)(ws + WS_WST) + (size_t)l * 8 * 128 * 128; const float* gb = pp->in[4] + (size_t)l * 8 * 128; const int G = (int)gridDim.x, tid = opaque_tid();
                        for (int it = (int)blockIdx.x - HGRN_WGS; it < 4 * 64 * 8; it += G - HGRN_WGS) { const int g8 = it & 7, ch = (it >> 3) & 63, bl = it >> 9;
                            gmlp_item(lds, (const bf16_t*)(ws + WS_V), (bf16_t*)(ws + WS_U), wst + g8 * 128 * 128, gb + g8 * 128, (size_t)bl * SEQ + ch * 128, g8 * 128, tid); } }
                PH_END
                PH_BEGIN(128) unsigned char* ws = pp->ws;
                    pg8::Gemm g{(const bf16_t*)(ws + WS_U), (const bf16_t*)(ws + WS_WA) + (size_t)l * 1024 * 1024, TH, 1024, 1024}; pg8::StaticOrder S; S.init(TH, 1024, (int)gridDim.x, (int)blockIdx.x);
                    pg8::EpiBranch<0> E{(const bf16_t*)(ws + WS_GA), nullptr, (bf16_t*)(ws + WS_V)}; pg8::gemm_phase<pg8::EpiBranch<0>, pg8::StaticOrder, false>(lds, g, S, E, nullptr); PH_END
                PH_BEGIN(256) unsigned char* ws = pp->ws;
                    pg8::Gemm g{(const bf16_t*)(ws + WS_OG), (const bf16_t*)(ws + WS_WB) + (size_t)l * 1024 * 1024, TH, 1024, 1024}; pg8::StaticOrder S; S.init(TH, 1024, (int)gridDim.x, (int)blockIdx.x);
                    pg8::EpiBranch<1> E{(const bf16_t*)(ws + WS_GB), (const bf16_t*)(ws + WS_V), (bf16_t*)(ws + WS_Q)}; pg8::gemm_phase<pg8::EpiBranch<1>, pg8::StaticOrder, false>(lds, g, S, E, nullptr); PH_END
                PH_BEGIN(512) unsigned char* ws = pp->ws; float* hh = pp->out + (size_t)half * TH * 1024;
                    pg8::Gemm g{(const bf16_t*)(ws + WS_Q), (const bf16_t*)(ws + WS_WO) + (size_t)l * 1024 * 1024, TH, 1024, 1024}; pg8::StaticOrder S; S.init(TH, 1024, (int)gridDim.x, (int)blockIdx.x);
                    pg8::EpiResid E{hh, hh, (const float*)(ws + WS_MOD) + (size_t)l * 8 * 9216 + (size_t)(half * 4) * 9216 + 5 * 1024, 1.0f}; pg8::gemm_phase<pg8::EpiResid, pg8::StaticOrder, false>(lds, g, S, E, nullptr); PH_END
            }
        }
    }
    PH_BEGIN(1024) norm_phase<true>(pp->out, nullptr, pp->out, pp->in[14], nullptr, 0); PH_END
}
constexpr int N_PHASES = 1 + NL * (3 + 4 + 10) + 1;

extern "C" void kernel_launch(void* const* d_in, const int* in_sizes, int n_in, void* d_out, int out_size, void* d_ws, size_t ws_size, hipStream_t stream) {
    static int grid = 0;
    if (grid == 0) {
        if (n_in != 15 || out_size != NT * DM || ws_size < WS_END) { fprintf(stderr, "kernel_launch: unexpected shapes (n_in %d, out %d, ws %zu < %zu)\n", n_in, out_size, ws_size, (size_t)WS_END); grid = -1; return; }
        int dev = 0, cus = 0, per_cu = 0;
        hipGetDevice(&dev); hipDeviceGetAttribute(&cus, hipDeviceAttributeMultiprocessorCount, dev);
        if (hipFuncSetAttribute((const void*)mk_fwd, hipFuncAttributeMaxDynamicSharedMemorySize, LDS_BYTES) != hipSuccess) { fprintf(stderr, "kernel_launch: hipFuncSetAttribute failed\n"); grid = -1; return; }
        if (hipOccupancyMaxActiveBlocksPerMultiprocessor(&per_cu, (const void*)mk_fwd, 512, LDS_BYTES) != hipSuccess || per_cu < 1) { fprintf(stderr, "kernel_launch: occupancy query says %d\n", per_cu); per_cu = 1; }
        (void)hipGetLastError();
        grid = cus * 1;
        if (grid <= HGRN_WGS) { fprintf(stderr, "kernel_launch: grid %d too small\n", grid); grid = -1; return; }
    }
    if (grid < 0) return;
    Params p{};
    for (int i = 0; i < 15; ++i) p.in[i] = (const float*)d_in[i];
    p.out = (float*)d_out; p.ws = (unsigned char*)d_ws;
#if MK_COOP
    p.ph_lo = 0; p.ph_hi = N_PHASES;
    void* args[] = {&p};
    hipError_t e = hipLaunchCooperativeKernel((const void*)mk_fwd, dim3(grid), dim3(512), args, LDS_BYTES, stream);
    if (e != hipSuccess) fprintf(stderr, "cooperative launch failed: %s (grid %d)\n", hipGetErrorString(e), grid);
#else
    for (int i = 0; i < N_PHASES; ++i) { p.ph_lo = i; p.ph_hi = i + 1; hipLaunchKernelGGL(mk_fwd, dim3(grid), dim3(512), LDS_BYTES, stream, p); }
#endif
}
```

```cpp
#include <hip/hip_runtime.h>
#include <hip/hip_cooperative_groups.h>
#include <cstdio>
namespace cg = cooperative_groups;
#ifndef MK_COOP
#define MK_COOP 1
#endif
namespace pg8 {
#define PG8_LAS __attribute__((address_space(3)))
typedef unsigned short bf16_t;
typedef short bf16x8 __attribute__((ext_vector_type(8)));
typedef float f32x4 __attribute__((ext_vector_type(4)));
typedef unsigned u32x4 __attribute__((ext_vector_type(4)));
constexpr int BM = 256, BK = 64, HALF = 128, HTB = HALF * BK * 2  , STAGE_BYTES = 8 * HTB, NXCD = 8, WGM = 8;

__host__ __device__ __forceinline__ int lds_byte(int r, int c) { const int st = (r >> 4) * 2 + (c >> 5), rr = r & 15, cc = c & 31, ob = rr * 64 + cc * 2; return st * 1024 + (ob ^ (((ob >> 9) & 1) << 5)); }
__host__ __device__ __forceinline__ void stage_rc(int b, int& R, int& C) { const int st = b / 1024, sb = b % 1024, swz = sb ^ (((sb >> 9) & 1) << 5); R = (st >> 1) * 16 + swz / 64; C = (st & 1) * 32 + (swz % 64) / 2; }
__host__ __device__ __forceinline__ int perm32(int rho) { const int n = rho >> 4, i = rho & 15; return 8 * (i >> 2) + 4 * n + (i & 3); }

struct Unit { int pm, pn; };
struct Gemm { const bf16_t* A; const bf16_t* Bt; int M, N, K; };

struct StaticOrder {
    int nM, nN, nwg, G, c;
    __host__ __device__ void init(int M, int N, int G_, int c_) { nM = M / BM; nN = N / BM; nwg = nM * nN; G = G_; c = c_; }
    __host__ __device__ bool next(int i, Unit& u) const {
        const long L = (long)i * G + c; if (L >= nwg) return false;
        int wgid = (int)L; { const int q = nwg / NXCD, r = nwg % NXCD, xcd = wgid % NXCD, off = wgid / NXCD; wgid = (xcd < r ? xcd * (q + 1) : r * (q + 1) + (xcd - r) * q) + off; }
        const int nig = WGM * nN, gid = wgid / nig, fm = gid * WGM, gsz = (nM - fm) < WGM ? (nM - fm) : WGM;
        u.pm = fm + ((wgid % nig) % gsz); u.pn = (wgid % nig) / gsz; return true;
    }
    __device__ __forceinline__ void a_ready(const Unit&) const {}
    __device__ __forceinline__ void done(const Unit&) const {}
};
__device__ __forceinline__ int opaque_tid() { int t = threadIdx.x; asm volatile("" : "+v"(t)); return t; }
typedef __bf16 bf16x2_t __attribute__((ext_vector_type(2)));
typedef float f32x2_t __attribute__((ext_vector_type(2)));
__device__ __forceinline__ unsigned cvt_pk_bf16(float lo, float hi) { const f32x2_t v = {lo, hi}; const bf16x2_t b = __builtin_convertvector(v, bf16x2_t); return __builtin_bit_cast(unsigned, b); }
__device__ __forceinline__ float bf_lo(unsigned w) { return __uint_as_float(w << 16); }
__device__ __forceinline__ float bf_hi(unsigned w) { return __uint_as_float(w & 0xffff0000u); }
template <int ACT> __device__ __forceinline__ float actf(float x) {
    if (ACT == 0) return x;
    if (ACT == 1) { const float u = 1.5957691216f * (x + 0.044715f * x * x * x); return x * __builtin_amdgcn_rcpf(1.0f + __expf(-u)); }
    if (ACT == 2) return x * __builtin_amdgcn_rcpf(1.0f + __expf(-x));
    return __builtin_amdgcn_rcpf(1.0f + __expf(-x));
}
struct EpiSwiGLU {
    static constexpr bool PERM = true, AFTER_DRAIN = false;
    bf16_t* O;
    __device__ __forceinline__ void operator()(const f32x4 (&acc)[2][2][4][2], const Unit& u, int wr, int wc, int fr, int fq) const {
        const int row0 = u.pm * BM + wr * 64 + fr, col0 = u.pn * HALF + wc * 32 + 8 * fq;
#pragma unroll
        for (int ai = 0; ai < 2; ++ai)
#pragma unroll
            for (int m = 0; m < 4; ++m) {
                const f32x4 a0 = acc[ai][0][m][0], a1 = acc[ai][0][m][1], b0 = acc[ai][1][m][0], b1 = acc[ai][1][m][1];
                float v[8];
#pragma unroll
                for (int j = 0; j < 4; ++j) { v[j] = actf<2>(a0[j]) * b0[j]; v[4 + j] = actf<2>(a1[j]) * b1[j]; }
                u32x4 w; w.x = cvt_pk_bf16(v[0], v[1]); w.y = cvt_pk_bf16(v[2], v[3]); w.z = cvt_pk_bf16(v[4], v[5]); w.w = cvt_pk_bf16(v[6], v[7]);
                *(u32x4*)(O + (size_t)(row0 + ai * HALF + m * 16) * 2816 + col0) = w;
            }
    }
};
struct EpiResid {
    static constexpr bool PERM = false, AFTER_DRAIN = false;
    const float* hin; float* hout; const float* gmod; float scale;
    __device__ __forceinline__ void operator()(const f32x4 (&acc)[2][2][4][2], const Unit& u, int wr, int wc, int fr, int fq) const {
        const int row0 = u.pm * BM + wr * 64 + fr, col0 = u.pn * BM + wc * 32 + 4 * fq;
        const float* gp = gmod + (size_t)((u.pm * BM) >> 13) * 9216 + col0;
        f32x4 cf[2][2];
#pragma unroll
        for (int bj = 0; bj < 2; ++bj)
#pragma unroll
            for (int n = 0; n < 2; ++n) { const f32x4 g = *(const f32x4*)(gp + bj * HALF + n * 16); cf[bj][n] = (g + 1.0f) * scale; }
#pragma unroll
        for (int ai = 0; ai < 2; ++ai)
#pragma unroll
            for (int m = 0; m < 4; ++m) { const size_t off = (size_t)(row0 + ai * HALF + m * 16) * 1024 + col0;
#pragma unroll
                for (int bj = 0; bj < 2; ++bj)
#pragma unroll
                    for (int n = 0; n < 2; ++n) { const f32x4 h = *(const f32x4*)(hin + off + bj * HALF + n * 16); *(f32x4*)(hout + off + bj * HALF + n * 16) = h + cf[bj][n] * acc[ai][bj][m][n]; }
                asm volatile("" ::: "memory"); }
    }
};
struct EpiInproj {
    static constexpr bool PERM = true, AFTER_DRAIN = false;
    bf16_t* U; bf16_t* V; bf16_t* Q; float* F; bf16_t* I; bf16_t* OG; bf16_t* GA; bf16_t* GB; const float* lb;
    template <int ACT> __device__ __forceinline__ void st16(const f32x4 (&acc)[2][2][4][2], bf16_t* dst, int row0, int colg) const {
#pragma unroll
        for (int ai = 0; ai < 2; ++ai)
#pragma unroll
            for (int m = 0; m < 4; ++m)
#pragma unroll
                for (int bj = 0; bj < 2; ++bj) { const f32x4 v0 = acc[ai][bj][m][0], v1 = acc[ai][bj][m][1];
                    u32x4 w; w.x = cvt_pk_bf16(actf<ACT>(v0[0]), actf<ACT>(v0[1])); w.y = cvt_pk_bf16(actf<ACT>(v0[2]), actf<ACT>(v0[3]));
                    w.z = cvt_pk_bf16(actf<ACT>(v1[0]), actf<ACT>(v1[1])); w.w = cvt_pk_bf16(actf<ACT>(v1[2]), actf<ACT>(v1[3]));
                    *(u32x4*)(dst + (size_t)(row0 + ai * HALF + m * 16) * 1024 + colg + bj * HALF) = w; }
    }
    __device__ __forceinline__ void operator()(const f32x4 (&acc)[2][2][4][2], const Unit& u, int wr, int wc, int fr, int fq) const {
        const int grp = u.pn >> 2, colg = (u.pn & 3) * BM + wc * 32 + 8 * fq, row0 = u.pm * BM + wr * 64 + fr;
        if (grp == 3) {
#pragma unroll
            for (int bj = 0; bj < 2; ++bj) { const f32x4 l0 = *(const f32x4*)(lb + colg + bj * HALF), l1 = *(const f32x4*)(lb + colg + bj * HALF + 4);
#pragma unroll
                for (int ai = 0; ai < 2; ++ai)
#pragma unroll
                    for (int m = 0; m < 4; ++m) { const f32x4 v0 = acc[ai][bj][m][0], v1 = acc[ai][bj][m][1]; f32x4 o0, o1;
#pragma unroll
                        for (int j = 0; j < 4; ++j) { o0[j] = __logf(fmaxf(l0[j] + (1.0f - l0[j]) * actf<3>(v0[j]), 1e-30f)); o1[j] = __logf(fmaxf(l1[j] + (1.0f - l1[j]) * actf<3>(v1[j]), 1e-30f)); }
                        float* d = F + (size_t)(row0 + ai * HALF + m * 16) * 1024 + colg + bj * HALF; *(f32x4*)d = o0; *(f32x4*)(d + 4) = o1; } }
        } else if (grp < 2) st16<1>(acc, grp == 0 ? U : V, row0, colg);
        else if (grp == 2) st16<2>(acc, Q, row0, colg);
        else if (grp == 4) st16<0>(acc, I, row0, colg);
        else st16<3>(acc, grp == 5 ? OG : (grp == 6 ? GA : GB), row0, colg);
    }
};
template <int MODE> struct EpiBranch {
    static constexpr bool PERM = true, AFTER_DRAIN = false;
    const bf16_t* G; const bf16_t* P; bf16_t* O;
    __device__ __forceinline__ void operator()(const f32x4 (&acc)[2][2][4][2], const Unit& u, int wr, int wc, int fr, int fq) const {
        const int row0 = u.pm * BM + wr * 64 + fr, col0 = u.pn * BM + wc * 32 + 8 * fq;
#pragma unroll
        for (int ai = 0; ai < 2; ++ai)
#pragma unroll
            for (int m = 0; m < 4; ++m)
#pragma unroll
                for (int bj = 0; bj < 2; ++bj) { const size_t off = (size_t)(row0 + ai * HALF + m * 16) * 1024 + col0 + bj * HALF;
                    const u32x4 g = *(const u32x4*)(G + off); const f32x4 v0 = acc[ai][bj][m][0], v1 = acc[ai][bj][m][1];
                    float r[8] = { bf_lo(g.x) * v0[0], bf_hi(g.x) * v0[1], bf_lo(g.y) * v0[2], bf_hi(g.y) * v0[3], bf_lo(g.z) * v1[0], bf_hi(g.z) * v1[1], bf_lo(g.w) * v1[2], bf_hi(g.w) * v1[3] };
                    if (MODE == 1) { const u32x4 p = *(const u32x4*)(P + off);
                        r[0] += bf_lo(p.x); r[1] += bf_hi(p.x); r[2] += bf_lo(p.y); r[3] += bf_hi(p.y); r[4] += bf_lo(p.z); r[5] += bf_hi(p.z); r[6] += bf_lo(p.w); r[7] += bf_hi(p.w); }
                    u32x4 w; w.x = cvt_pk_bf16(r[0], r[1]); w.y = cvt_pk_bf16(r[2], r[3]); w.z = cvt_pk_bf16(r[4], r[5]); w.w = cvt_pk_bf16(r[6], r[7]);
                    *(u32x4*)(O + off) = w; }
    }
};

template <class Epi, class Sched, bool STAMP = false>
__device__ __forceinline__ void gemm_phase(PG8_LAS unsigned char* lds, const Gemm g, const Sched& S, const Epi& E, unsigned long long* stamps) {
    const int tid = opaque_tid(), wid = __builtin_amdgcn_readfirstlane(tid >> 6), lane = tid & 63, wr = wid >> 2, wc = wid & 3, fr = lane & 15, fq = lane >> 4;
    const int K = g.K, nt = K / BK;
    int ts_lo = 0, ts_hi = 0, nts = 0; const unsigned long long rt_entry = STAMP ? (unsigned long long)wall_clock64() : 0ull;
#define PG8_STAMP() do { if (STAMP && wid == 0 && nts < 64) { const unsigned long long _c = (unsigned long long)clock64(); \
        ts_lo = (lane == nts) ? (int)(unsigned)_c : ts_lo; ts_hi = (lane == nts) ? (int)(unsigned)(_c >> 32) : ts_hi; ++nts; } } while (0)
    PG8_STAMP();
    unsigned voffA[2], voffB[2];
#pragma unroll
    for (int i = 0; i < 2; ++i) { int R, C; stage_rc(tid * 16 + i * 8192, R, C); const int Rb = Epi::PERM ? ((R & ~31) + perm32(R & 31)) : R;
        voffA[i] = (unsigned)(R * K + C) * 2u; voffB[i] = (unsigned)(Rb * K + C) * 2u; }
    const size_t kstep = (size_t)(BK * 2);
    const size_t hstep = (size_t)HALF * K * 2;
    const size_t tstep = 2 * hstep;
    const unsigned ldsw = (unsigned)wid * 1024u;
    const int aoff = lds_byte(wr * 64 + fr, fq * 8), boff = lds_byte(wc * 32 + fr, fq * 8);
#define PG8_SA(b, h) (((b) * 2 + (h)) * HTB)
#define PG8_SB(b, h) ((4 + (b) * 2 + (h)) * HTB)
#define PG8_STAGE(bufoff, gbase, voff) do { _Pragma("unroll") for (int _i = 0; _i < 2; ++_i) \
        __builtin_amdgcn_global_load_lds((const unsigned*)((const char*)(gbase) + (voff)[_i]), (PG8_LAS unsigned*)(lds + (bufoff) + ldsw + _i * 8192), 16, 0, 0); } while (0)
#define PG8_LDA(dst, b, h) do { _Pragma("unroll") for (int m = 0; m < 4; ++m) _Pragma("unroll") for (int k = 0; k < 2; ++k) dst[m][k] = *(const PG8_LAS bf16x8*)(lds + PG8_SA(b, h) + aoff + m * 2048 + k * 1024); } while (0)
#define PG8_LDB(dst, b, h) do { _Pragma("unroll") for (int n = 0; n < 2; ++n) _Pragma("unroll") for (int k = 0; k < 2; ++k) dst[n][k] = *(const PG8_LAS bf16x8*)(lds + PG8_SB(b, h) + boff + n * 2048 + k * 1024); } while (0)
#define PG8_MMA(ai, bj, At, Bt) do { __builtin_amdgcn_s_setprio(1); _Pragma("unroll") for (int m = 0; m < 4; ++m) _Pragma("unroll") for (int n = 0; n < 2; ++n) _Pragma("unroll") for (int k = 0; k < 2; ++k) \
        acc[ai][bj][m][n] = __builtin_amdgcn_mfma_f32_16x16x32_bf16(Bt[n][k], At[m][k], acc[ai][bj][m][n], 0, 0, 0); __builtin_amdgcn_s_setprio(0); } while (0)
#define PG8_WAIT_V(n) asm volatile("s_waitcnt vmcnt(" #n ")" ::: "memory")
#define PG8_WAIT_L(n) asm volatile("s_waitcnt lgkmcnt(" #n ")" ::: "memory")
#define PG8_BAR __builtin_amdgcn_s_barrier()
#define PG8_SCHED __builtin_amdgcn_sched_barrier(0)
    Unit cur, nxt; int ui = 0;
    if (!S.next(0, cur)) return;
    f32x4 acc[2][2][4][2];
#pragma unroll
    for (int a = 0; a < 2; ++a)
#pragma unroll
        for (int b = 0; b < 2; ++b)
#pragma unroll
            for (int m = 0; m < 4; ++m)
#pragma unroll
                for (int n = 0; n < 2; ++n) acc[a][b][m][n] = (f32x4){0.f, 0.f, 0.f, 0.f};
    bf16x8 At[4][2], B0[2][2], B1[2][2];
    const char* cA = (const char*)g.A + (size_t)cur.pm * tstep; const char* cB = (const char*)g.Bt + (size_t)cur.pn * tstep;
    S.a_ready(cur);
    PG8_STAGE(PG8_SB(0, 0), cB, voffB); PG8_STAGE(PG8_SA(0, 0), cA, voffA); PG8_STAGE(PG8_SB(0, 1), cB + hstep, voffB); PG8_STAGE(PG8_SA(0, 1), cA + hstep, voffA);
    if (wr == 1) PG8_BAR;
    PG8_WAIT_V(4); PG8_BAR;
    PG8_STAGE(PG8_SB(1, 0), cB + kstep, voffB); PG8_STAGE(PG8_SA(1, 0), cA + kstep, voffA); PG8_STAGE(PG8_SB(1, 1), cB + hstep + kstep, voffB);
    PG8_WAIT_V(6); PG8_BAR;
    PG8_STAMP();
    for (;;) {
        const bool has_next = S.next(ui + 1, nxt);
        const char* nA = has_next ? (const char*)g.A + (size_t)nxt.pm * tstep : cA; const char* nB = has_next ? (const char*)g.Bt + (size_t)nxt.pn * tstep : cB;
        for (int t = 0; t < nt; t += 2) {
            const bool last = (t == nt - 2);
            const char* a1 = cA + (size_t)(t + 1) * kstep;
            const char* a2 = last ? nA : cA + (size_t)(t + 2) * kstep; const char* b2 = last ? nB : cB + (size_t)(t + 2) * kstep;
            const char* a3 = a2 + kstep; const char* b3 = b2 + kstep;
            if (last && has_next) S.a_ready(nxt);
            PG8_LDB(B0, 0, 0); PG8_SCHED; PG8_LDA(At, 0, 0); PG8_STAGE(PG8_SA(1, 1), a1 + hstep, voffA);
            PG8_WAIT_L(8); PG8_BAR; PG8_WAIT_L(0); PG8_MMA(0, 0, At, B0); PG8_BAR; PG8_SCHED;
            PG8_LDB(B1, 0, 1); PG8_STAGE(PG8_SB(0, 0), b2, voffB);
            PG8_BAR; PG8_WAIT_L(0); PG8_MMA(0, 1, At, B1); PG8_BAR;
            PG8_LDA(At, 0, 1); PG8_STAGE(PG8_SA(0, 0), a2, voffA);
            PG8_BAR; PG8_WAIT_L(0); PG8_MMA(1, 0, At, B0); PG8_BAR; PG8_SCHED;
            PG8_STAGE(PG8_SB(0, 1), b2 + hstep, voffB);
            PG8_WAIT_V(6); PG8_BAR; PG8_MMA(1, 1, At, B1); PG8_BAR;
            PG8_LDB(B0, 1, 0); PG8_SCHED; PG8_LDA(At, 1, 0); PG8_STAGE(PG8_SA(0, 1), a2 + hstep, voffA);
            PG8_WAIT_L(8); PG8_BAR; PG8_WAIT_L(0); PG8_MMA(0, 0, At, B0); PG8_BAR; PG8_SCHED;
            PG8_LDB(B1, 1, 1); PG8_STAGE(PG8_SB(1, 0), b3, voffB);
            PG8_BAR; PG8_WAIT_L(0); PG8_MMA(0, 1, At, B1); PG8_BAR;
            PG8_LDA(At, 1, 1); PG8_STAGE(PG8_SA(1, 0), a3, voffA);
            PG8_BAR; PG8_WAIT_L(0); PG8_MMA(1, 0, At, B0); PG8_BAR; PG8_SCHED;
            PG8_STAGE(PG8_SB(1, 1), b3 + hstep, voffB);
            PG8_WAIT_V(6); PG8_BAR; PG8_MMA(1, 1, At, B1); PG8_BAR;
        }
        PG8_STAMP();
        if constexpr (!Epi::AFTER_DRAIN) { E(acc, cur, wr, wc, fr, fq); S.done(cur); }
        PG8_STAMP();
        if (!has_next) break;
#pragma unroll
        for (int a = 0; a < 2; ++a)
#pragma unroll
            for (int b = 0; b < 2; ++b)
#pragma unroll
                for (int m = 0; m < 4; ++m)
#pragma unroll
                    for (int n = 0; n < 2; ++n) acc[a][b][m][n] = (f32x4){0.f, 0.f, 0.f, 0.f};
        cur = nxt; cA = nA; cB = nB; ++ui;
    }
    PG8_WAIT_V(0);
    if (wr == 0) PG8_BAR;
    PG8_BAR;
    if constexpr (Epi::AFTER_DRAIN) { E.fused(acc, cur, wr, wc, fr, fq, lds, wid, lane); S.done(cur); }
    PG8_STAMP();
    if (STAMP && wid == 0) { stamps[lane] = lane < nts ? (((unsigned long long)(unsigned)ts_hi << 32) | (unsigned)ts_lo) : 0ull;
        if (lane == 62) stamps[62] = rt_entry; if (lane == 63) stamps[63] = (unsigned long long)wall_clock64(); }
#undef PG8_STAMP
#undef PG8_SA
#undef PG8_SB
#undef PG8_STAGE
#undef PG8_LDA
#undef PG8_LDB
#undef PG8_MMA
#undef PG8_WAIT_V
#undef PG8_WAIT_L
#undef PG8_BAR
#undef PG8_SCHED
}
}
using pg8::bf16_t; using pg8::bf16x8; using pg8::f32x4; using pg8::u32x4; using pg8::cvt_pk_bf16; using pg8::bf_lo; using pg8::bf_hi; using pg8::opaque_tid;
#define LAS __attribute__((address_space(3)))
typedef unsigned u32x2 __attribute__((ext_vector_type(2)));

constexpr int NT = 65536, DM = 1024, NL = 4, SEQ = 8192, FH = 2816, TH = 32768  ;
constexpr int LDS_BYTES = 144 * 1024, XB_ST_OFF = 143616;
constexpr size_t MiB = 1024ull * 1024ull;
constexpr size_t WS_MOD = 64 * 1024;
constexpr size_t WS_WST = 2 * MiB;
constexpr size_t WS_LB = 3 * MiB;
constexpr size_t WS_WIN = 4 * MiB;
constexpr size_t WS_W13 = 68 * MiB;
constexpr size_t WS_W2 = 156 * MiB;
constexpr size_t WS_WA = 200 * MiB, WS_WB = 208 * MiB, WS_WO = 216 * MiB;
constexpr size_t WS_HN = 224 * MiB;
constexpr size_t WS_BIG = 352 * MiB;
constexpr size_t ZB = 64 * MiB;
constexpr size_t WS_U = WS_BIG, WS_V = WS_BIG + ZB, WS_Q = WS_BIG + 2 * ZB, WS_F = WS_BIG + 3 * ZB  , WS_I = WS_BIG + 5 * ZB, WS_OG = WS_BIG + 6 * ZB, WS_GA = WS_BIG + 7 * ZB, WS_GB = WS_BIG + 8 * ZB;
constexpr size_t WS_HU = WS_BIG + 9 * ZB;
constexpr size_t WS_HD = WS_HU + 16 * MiB;
constexpr size_t WS_END = WS_HD + 1 * MiB;

struct Params { const float* in[15]; float* out; unsigned char* ws; int ph_lo, ph_hi; };
typedef const Params __attribute__((address_space(4))) * KP;

__device__ __forceinline__ float wave_sum(float v) {
#pragma unroll
    for (int o = 1; o < 64; o <<= 1) v += __shfl_xor(v, o);
    return v;
}

__device__ __forceinline__ void transpose_item(const float* __restrict__ W, int K, int N, bf16_t* __restrict__ WT, int item, int remap, LAS float* scr, int lane) {
    const int nblk = N / 32, kb = item / nblk, nb = item - kb * nblk, k0 = 64 * kb, n0 = 32 * nb;
    int drow0 = n0;
    if (remap) { const int bj = n0 / FH, nn = n0 - bj * FH; drow0 = (nn >> 7) * 256 + bj * 128 + (nn & 127); }
#pragma unroll 8
    for (int i = 0; i < 32; ++i) { const int kk = 2 * i + (lane >> 5); scr[kk * 33 + (lane & 31)] = W[(size_t)(k0 + kk) * N + n0 + (lane & 31)]; }
    asm volatile("s_waitcnt lgkmcnt(0)" ::: "memory");
    const int c = lane & 7;
#pragma unroll
    for (int j = 0; j < 4; ++j) { const int n = (lane >> 3) + 8 * j; const LAS float* s = scr + (8 * c) * 33 + n;
        u32x4 o; o.x = cvt_pk_bf16(s[0 * 33], s[1 * 33]); o.y = cvt_pk_bf16(s[2 * 33], s[3 * 33]); o.z = cvt_pk_bf16(s[4 * 33], s[5 * 33]); o.w = cvt_pk_bf16(s[6 * 33], s[7 * 33]);
        *(u32x4*)(WT + (size_t)(drow0 + n) * K + k0 + 8 * c) = o; }
    asm volatile("s_waitcnt lgkmcnt(0)" ::: "memory");
}

__device__ __forceinline__ void prologue_phase(KP p, LAS unsigned char* lds) {
    const int tid = opaque_tid(), lane = tid & 63, wave = tid >> 6, G = gridDim.x;
    unsigned char* ws = p->ws;
    {
        LAS float* cact = (LAS float*)lds;
        LAS float* red = (LAS float*)(lds + 32768);
        const float* c = p->in[1];
        for (int i = tid; i < 8192; i += 512) { const int b = i >> 10, k = i & 1023; const float x = c[i]; cact[k * 8 + b] = x / (1.0f + __expf(-x)); }
        __syncthreads();
        for (int task = blockIdx.x; task < 288; task += G) {
            const int idx = task * 128 + (tid & 127), kq = tid >> 7, l = idx / 9216, n = idx - l * 9216;
            const float* aw = p->in[12] + (size_t)l * 1024 * 9216 + n;
            float a[8];
#pragma unroll
            for (int b = 0; b < 8; ++b) a[b] = 0.f;
#pragma unroll 8
            for (int k = kq * 256; k < kq * 256 + 256; ++k) { const float w = aw[(size_t)k * 9216]; const f32x4 c0 = *(const LAS f32x4*)(cact + k * 8), c1 = *(const LAS f32x4*)(cact + k * 8 + 4);
                a[0] += c0[0] * w; a[1] += c0[1] * w; a[2] += c0[2] * w; a[3] += c0[3] * w; a[4] += c1[0] * w; a[5] += c1[1] * w; a[6] += c1[2] * w; a[7] += c1[3] * w; }
#pragma unroll
            for (int b = 0; b < 8; ++b) red[(kq * 8 + b) * 128 + (tid & 127)] = a[b];
            __syncthreads();
            if (kq == 0) { const float bias = p->in[13][idx]; float* mod = (float*)(ws + WS_MOD);
#pragma unroll
                for (int b = 0; b < 8; ++b) mod[((size_t)l * 8 + b) * 9216 + n] = ((red[b * 128 + tid] + red[(8 + b) * 128 + tid]) + (red[(16 + b) * 128 + tid] + red[(24 + b) * 128 + tid])) + bias; }
            __syncthreads();
        }
    }
    if (blockIdx.x == 72 % G) {
        const float* lg = p->in[5]; float* lb = (float*)(ws + WS_LB);
        for (int k = tid; k < 1024; k += 512) { const float a0 = lg[k], a1 = lg[1024 + k], a2 = lg[2048 + k], a3 = lg[3072 + k]; const float mx = fmaxf(fmaxf(a0, a1), fmaxf(a2, a3));
            const float e0 = __expf(a0 - mx), e1 = __expf(a1 - mx), e2 = __expf(a2 - mx), e3 = __expf(a3 - mx), inv = 1.0f / (e0 + e1 + e2 + e3);
            lb[k] = 0.f; lb[1024 + k] = e1 * inv; lb[2048 + k] = (e1 + e2) * inv; lb[3072 + k] = (e1 + e2 + e3) * inv; }
    }
    { const float* wsrc = p->in[3]; bf16_t* wst = (bf16_t*)(ws + WS_WST);
      for (int i = blockIdx.x * 512 + tid; i < 4 * 8 * 128 * 128 / 2; i += G * 512) { const int e = 2 * i, s = e & 127, t = (e >> 7) & 127;
          const float v0 = s <= t ? wsrc[e] : 0.f, v1 = (s + 1) <= t ? wsrc[e + 1] : 0.f; ((unsigned*)wst)[i] = cvt_pk_bf16(v0, v1); } }
    LAS float* scr = (LAS float*)(lds + 32768 + wave * 8704);
    const int gw = blockIdx.x * 8 + wave, NGW = G * 8;
    constexpr int I_IN = 16 * 256, I_13 = 16 * 176, I_2 = 44 * 32, I_SQ = 16 * 32, I_LAYER = I_IN + 2 * I_13 + 2 * I_2 + 3 * I_SQ;
    for (int it = gw; it < NL * I_LAYER; it += NGW) {
        const int l = it / I_LAYER; int r = it - l * I_LAYER;
        if (r < I_IN) { transpose_item(p->in[2] + (size_t)l * 1024 * 8192, 1024, 8192, (bf16_t*)(ws + WS_WIN) + (size_t)l * 8192 * 1024, r, 0, scr, lane); continue; } r -= I_IN;
        if (r < 2 * I_13) { const int s = r / I_13; r -= s * I_13; transpose_item(p->in[9] + (size_t)(l * 2 + s) * 1024 * 5632, 1024, 5632, (bf16_t*)(ws + WS_W13) + (size_t)(l * 2 + s) * 5632 * 1024, r, 1, scr, lane); continue; } r -= 2 * I_13;
        if (r < 2 * I_2) { const int s = r / I_2; r -= s * I_2; transpose_item(p->in[10] + (size_t)(l * 2 + s) * FH * 1024, FH, 1024, (bf16_t*)(ws + WS_W2) + (size_t)(l * 2 + s) * 1024 * FH, r, 0, scr, lane); continue; } r -= 2 * I_2;
        const int m = r / I_SQ; r -= m * I_SQ;
        const float* src = (m == 0 ? p->in[6] : (m == 1 ? p->in[7] : p->in[8])) + (size_t)l * 1024 * 1024;
        bf16_t* dst = (bf16_t*)(ws + (m == 0 ? WS_WA : (m == 1 ? WS_WB : WS_WO))) + (size_t)l * 1024 * 1024;
        transpose_item(src, 1024, 1024, dst, r, 0, scr, lane);
    }
}

template <bool FINAL> __device__ __forceinline__ void norm_phase(const float* hin, bf16_t* hn, float* fout, const float* nw, const float* modl  , int sub) {
    const int tid = opaque_tid(), lane = tid & 63, gw = blockIdx.x * 8 + (tid >> 6), NGW = gridDim.x * 8;
    f32x4 w4[4];
#pragma unroll
    for (int j = 0; j < 4; ++j) w4[j] = *(const f32x4*)(nw + 4 * lane + 256 * j);
    for (int row = gw; row < NT; row += NGW) {
        const float* xr = hin + (size_t)row * DM + 4 * lane;
        f32x4 v[4]; float s = 0.f;
#pragma unroll
        for (int j = 0; j < 4; ++j) { v[j] = *(const f32x4*)(xr + 256 * j); s += (v[j][0] * v[j][0] + v[j][1] * v[j][1]) + (v[j][2] * v[j][2] + v[j][3] * v[j][3]); }
        const float rstd = rsqrtf(wave_sum(s) * (1.0f / DM) + 1e-6f);
        if (FINAL) {
#pragma unroll
            for (int j = 0; j < 4; ++j) *(f32x4*)(fout + (size_t)row * DM + 4 * lane + 256 * j) = v[j] * rstd * w4[j];
        } else {
            const float* sh = modl + (size_t)(row >> 13) * 9216 + (3 * sub) * 1024 + 4 * lane; const float* sc = sh + 1024;
#pragma unroll
            for (int j = 0; j < 4; ++j) { const f32x4 a = *(const f32x4*)(sc + 256 * j), b = *(const f32x4*)(sh + 256 * j); const f32x4 o = v[j] * rstd * w4[j] * (a + 1.0f) + b;
                u32x2 w; w.x = cvt_pk_bf16(o[0], o[1]); w.y = cvt_pk_bf16(o[2], o[3]); *(u32x2*)(hn + (size_t)row * DM + 4 * lane + 256 * j) = w; }
        }
    }
}

__device__ __forceinline__ int tr64_off(int row, int col) { return row * 128 + ((((col >> 3) ^ (row ^ (row >> 3))) & 7) << 4) + ((col & 7) << 1); }
__device__ __forceinline__ int tr128_off(int row, int col) { return row * 256 + ((((col >> 3) ^ (row ^ (row >> 3))) & 15) << 4) + ((col & 7) << 1); }
constexpr int H_LF = 0, H_P = 0  , H_TOT = 32768, H_VEC = 34816, H_SS = 36864, H_QP = 38912, H_KP = 56320, H_KT = 73728, H_VT = 90112, H_ST = 106496, H_END = 141312;
static_assert(H_END <= LDS_BYTES, "LDS");
#define MFMA16(a, b, c) __builtin_amdgcn_mfma_f32_16x16x32_bf16((a), (b), (c), 0, 0, 0)

template <bool PRE> __device__ __forceinline__ void hgrn_seq(LAS unsigned char* lds, const bf16_t* __restrict__ Qb, const float* __restrict__ Fb, const bf16_t* __restrict__ Ib, const bf16_t* OGb, bf16_t* OUTb, size_t row_base, int colbase, int c0, int nch, float* Ubuf, float* Dbuf, int item0, int nprev) {
    const int tid = opaque_tid(), lane = tid & 63, w = __builtin_amdgcn_readfirstlane(tid >> 6), q4 = lane >> 4, l15 = lane & 15;
    const int pt = tid >> 4, pc8 = (tid & 15) * 8;
    LAS float* Lf = (LAS float*)(lds + H_LF); LAS float* Ltot = (LAS float*)(lds + H_TOT); LAS float* Lvec = (LAS float*)(lds + H_VEC); LAS float* Lss = (LAS float*)(lds + H_SS);
    f32x4 S[8];
#pragma unroll
    for (int i = 0; i < 8; ++i) S[i] = (f32x4){0.f, 0.f, 0.f, 0.f};
    if (!PRE) { for (int j = 0; j < nprev; ++j) { const float* Uj = Ubuf + (size_t)(item0 + j) * 16384; const f32x4 dj = *(const f32x4*)(Dbuf + (size_t)(item0 + j) * 128 + 16 * w + 4 * q4);
#pragma unroll
            for (int vt = 0; vt < 8; ++vt) S[vt] = S[vt] * dj + *(const f32x4*)(Uj + (vt * 512 + tid) * 4); } }
    float dacc = 1.0f;
    u32x4 rq[2], rv[2]; f32x4 rf[2][2];
#define HG_LOAD(c) do { _Pragma("unroll") for (int i_ = 0; i_ < 2; ++i_) { const size_t go_ = (row_base + (size_t)(c) * 64 + pt + 32 * i_) * 1024 + colbase + pc8; \
        if (!PRE) rq[i_] = *(const u32x4*)(Qb + go_); rv[i_] = *(const u32x4*)(Ib + go_); rf[i_][0] = *(const f32x4*)(Fb + go_); rf[i_][1] = *(const f32x4*)(Fb + go_ + 4); } } while (0)
    HG_LOAD(c0);
    for (int c = c0; c < c0 + nch; ++c) {
        u32x2 rog[4];
        if (!PRE) {
#pragma unroll
        for (int ti = 0; ti < 4; ++ti) rog[ti] = *(const u32x2*)(OGb + (row_base + (size_t)c * 64 + 16 * ti + l15) * 1024 + colbase + 16 * w + 4 * q4); }
#pragma unroll
        for (int i = 0; i < 2; ++i) { *(LAS f32x4*)(Lf + (pt + 32 * i) * 128 + pc8) = rf[i][0]; *(LAS f32x4*)(Lf + (pt + 32 * i) * 128 + pc8 + 4) = rf[i][1]; }
        __syncthreads();
        { const int k = tid & 127, seg = tid >> 7; float run = 0.f;
#pragma unroll
          for (int i = 0; i < 16; ++i) { const int idx = (16 * seg + i) * 128 + k; run += Lf[idx]; Lf[idx] = run; }
          Ltot[seg * 128 + k] = run; }
        __syncthreads();
        { const int k = tid & 127, seg = tid >> 7; const float t0 = Ltot[k], t1 = Ltot[128 + k], t2 = Ltot[256 + k], t3 = Ltot[384 + k];
          const float off = seg == 0 ? 0.f : (seg == 1 ? t0 : (seg == 2 ? t0 + t1 : t0 + t1 + t2));
          if (seg > 0) {
#pragma unroll
              for (int i = 0; i < 16; ++i) { const int idx = (16 * seg + i) * 128 + k; Lf[idx] += off; } }
          else { const float b31 = t0 + t1, b63 = b31 + t2 + t3; Lvec[k] = __expf(b31); Lvec[128 + k] = __expf(b63); Lvec[256 + k] = __expf(b63 - b31); Lvec[384 + k] = b31; } }
        __syncthreads();
#pragma unroll
        for (int i = 0; i < 2; ++i) { const int t = pt + 32 * i;
            const f32x4 b0 = *(const LAS f32x4*)(Lf + t * 128 + pc8), b1 = *(const LAS f32x4*)(Lf + t * 128 + pc8 + 4), r0 = *(const LAS f32x4*)(Lvec + 384 + pc8), r1 = *(const LAS f32x4*)(Lvec + 384 + pc8 + 4);
            unsigned qw[4] = {0u, 0u, 0u, 0u}; if (!PRE) { qw[0] = rq[i].x; qw[1] = rq[i].y; qw[2] = rq[i].z; qw[3] = rq[i].w; } const unsigned vw[4] = {rv[i].x, rv[i].y, rv[i].z, rv[i].w};
            float qp[8], kp[8];
#pragma unroll
            for (int j = 0; j < 8; ++j) { const float bb = j < 4 ? b0[j & 3] : b1[j & 3], rr = j < 4 ? r0[j & 3] : r1[j & 3], lf = j < 4 ? rf[i][0][j & 3] : rf[i][1][j & 3];
                const float d = fminf(fmaxf(bb - rr, -80.f), 80.f);
                if (!PRE) { const float qv = (j & 1) ? bf_hi(qw[j >> 1]) : bf_lo(qw[j >> 1]); qp[j] = qv * __expf(d); } else qp[j] = 0.f;
                kp[j] = (1.0f - __expf(lf)) * __expf(-d); }
            u32x4 wq, wk; wq.x = cvt_pk_bf16(qp[0], qp[1]); wq.y = cvt_pk_bf16(qp[2], qp[3]); wq.z = cvt_pk_bf16(qp[4], qp[5]); wq.w = cvt_pk_bf16(qp[6], qp[7]);
            wk.x = cvt_pk_bf16(kp[0], kp[1]); wk.y = cvt_pk_bf16(kp[2], kp[3]); wk.z = cvt_pk_bf16(kp[4], kp[5]); wk.w = cvt_pk_bf16(kp[6], kp[7]);
            if (!PRE) { *(LAS u32x4*)(lds + H_QP + t * 272 + pc8 * 2) = wq; *(LAS u32x4*)(lds + H_KP + t * 272 + pc8 * 2) = wk; }
            const unsigned kw[4] = {wk.x, wk.y, wk.z, wk.w};
#pragma unroll
            for (int j = 0; j < 8; ++j) { const unsigned short kk = (unsigned short)((j & 1) ? (kw[j >> 1] >> 16) : (kw[j >> 1] & 0xffffu)), vv = (unsigned short)((j & 1) ? (vw[j >> 1] >> 16) : (vw[j >> 1] & 0xffffu));
                *(LAS unsigned short*)(lds + H_KT + tr64_off(pc8 + j, t)) = kk; *(LAS unsigned short*)(lds + H_VT + tr64_off(pc8 + j, t)) = vv; } }
        if (PRE) { if (tid < 128) dacc *= Lvec[128 + tid]; }
        if (!PRE) { const f32x4 e4 = *(const LAS f32x4*)(Lvec + 16 * w + 4 * q4);
#pragma unroll
          for (int vt = 0; vt < 8; ++vt) { const f32x4 sv = S[vt] * e4; u32x2 o; o.x = cvt_pk_bf16(sv[0], sv[1]); o.y = cvt_pk_bf16(sv[2], sv[3]);
              *(LAS u32x2*)(lds + H_ST + (16 * vt + l15) * 272 + (16 * w + 4 * q4) * 2) = o; } }
        if (c + 1 < c0 + nch) HG_LOAD(c + 1);
        __syncthreads();
        f32x4 oT[4];
        if (!PRE) {
        { const int ti = w >> 1;
#pragma unroll
          for (int sj = 0; sj < 2; ++sj) { const int si = 2 * (w & 1) + sj; f32x4 a4 = (f32x4){0.f, 0.f, 0.f, 0.f};
              if (si <= ti) {
#pragma unroll
                  for (int kb = 0; kb < 4; ++kb) { const bf16x8 a = *(const LAS bf16x8*)(lds + H_KP + (16 * si + l15) * 272 + kb * 64 + q4 * 16), b = *(const LAS bf16x8*)(lds + H_QP + (16 * ti + l15) * 272 + kb * 64 + q4 * 16); a4 = MFMA16(a, b, a4); }
                  const int t = 16 * ti + l15, s0 = 16 * si + 4 * q4;
#pragma unroll
                  for (int r = 0; r < 4; ++r) a4[r] = (s0 + r <= t) ? a4[r] : 0.f; }
              u32x2 o; o.x = cvt_pk_bf16(a4[0], a4[1]); o.y = cvt_pk_bf16(a4[2], a4[3]);
              *(LAS u32x2*)(lds + H_P + (16 * ti + l15) * 144 + (16 * si + 4 * q4) * 2) = o; } }
#pragma unroll
        for (int ti = 0; ti < 4; ++ti) oT[ti] = (f32x4){0.f, 0.f, 0.f, 0.f};
#pragma unroll
        for (int kb = 0; kb < 4; ++kb) { const bf16x8 a = *(const LAS bf16x8*)(lds + H_ST + (16 * w + l15) * 272 + kb * 64 + q4 * 16);
#pragma unroll
            for (int ti = 0; ti < 4; ++ti) { const bf16x8 b = *(const LAS bf16x8*)(lds + H_QP + (16 * ti + l15) * 272 + kb * 64 + q4 * 16); oT[ti] = MFMA16(a, b, oT[ti]); } }
        __syncthreads();
        }
        { f32x4 U[8];
#pragma unroll
          for (int vt = 0; vt < 8; ++vt) U[vt] = (f32x4){0.f, 0.f, 0.f, 0.f};
#pragma unroll
          for (int kb = 0; kb < 2; ++kb) { const bf16x8 av = *(const LAS bf16x8*)(lds + H_VT + tr64_off(16 * w + l15, 32 * kb + 8 * q4)), ak = *(const LAS bf16x8*)(lds + H_KT + tr64_off(16 * w + l15, 32 * kb + 8 * q4));
#pragma unroll
              for (int ti = 0; ti < 4; ++ti) { if (!PRE) { const bf16x8 b = *(const LAS bf16x8*)(lds + H_P + (16 * ti + l15) * 144 + (32 * kb + 8 * q4) * 2); oT[ti] = MFMA16(av, b, oT[ti]); } }
#pragma unroll
              for (int vt = 0; vt < 8; ++vt) { const bf16x8 b = *(const LAS bf16x8*)(lds + H_VT + tr64_off(16 * vt + l15, 32 * kb + 8 * q4)); U[vt] = MFMA16(ak, b, U[vt]); } }
          const f32x4 d4 = *(const LAS f32x4*)(Lvec + 128 + 16 * w + 4 * q4), c4 = *(const LAS f32x4*)(Lvec + 256 + 16 * w + 4 * q4);
#pragma unroll
          for (int vt = 0; vt < 8; ++vt) S[vt] = S[vt] * d4 + U[vt] * c4; }
        if (!PRE) {
#pragma unroll
        for (int ti = 0; ti < 4; ++ti) { float ss = (oT[ti][0] * oT[ti][0] + oT[ti][1] * oT[ti][1]) + (oT[ti][2] * oT[ti][2] + oT[ti][3] * oT[ti][3]); ss += __shfl_xor(ss, 16); ss += __shfl_xor(ss, 32);
            if (q4 == 0) Lss[w * 64 + 16 * ti + l15] = ss; }
        __syncthreads();
#pragma unroll
        for (int ti = 0; ti < 4; ++ti) { const int t = 16 * ti + l15; float tot = 0.f;
#pragma unroll
            for (int ww = 0; ww < 8; ++ww) tot += Lss[ww * 64 + t];
            const float rs = rsqrtf(tot * (1.0f / 128.0f) + 1e-6f);
            u32x2 o; o.x = cvt_pk_bf16(oT[ti][0] * rs * bf_lo(rog[ti].x), oT[ti][1] * rs * bf_hi(rog[ti].x)); o.y = cvt_pk_bf16(oT[ti][2] * rs * bf_lo(rog[ti].y), oT[ti][3] * rs * bf_hi(rog[ti].y));
            *(u32x2*)(OUTb + (row_base + (size_t)c * 64 + t) * 1024 + colbase + 16 * w + 4 * q4) = o; }
        }
    }
    if (PRE) { float* Uo = Ubuf + (size_t)item0 * 16384;
#pragma unroll
        for (int vt = 0; vt < 8; ++vt) *(f32x4*)(Uo + (vt * 512 + tid) * 4) = S[vt];
        if (tid < 128) Dbuf[(size_t)item0 * 128 + tid] = dacc; }
    __syncthreads();
#undef HG_LOAD
}

__device__ __forceinline__ void gmlp_item(LAS unsigned char* lds, const bf16_t* __restrict__ Vb, const bf16_t* Ub, bf16_t* Ob, const bf16_t* __restrict__ Wt  , const float* __restrict__ bias  , size_t row0, int col0, int tid) {
     const int lane = tid & 63, w = __builtin_amdgcn_readfirstlane(tid >> 6), q4 = lane >> 4, l15 = lane & 15;
    const int ps = tid >> 4, pc8 = (tid & 15) * 8, nkb = (w >> 1) + 1;
    bf16x8 wf[4];
#pragma unroll
    for (int kb = 0; kb < 4; ++kb) if (kb < nkb) wf[kb] = *(const bf16x8*)(Wt + (16 * w + l15) * 128 + kb * 32 + q4 * 8);
#pragma unroll
    for (int i = 0; i < 4; ++i) { const int s = ps + 32 * i; const u32x4 raw = *(const u32x4*)(Vb + (row0 + s) * 1024 + col0 + pc8);
        float x[8] = {bf_lo(raw.x), bf_hi(raw.x), bf_lo(raw.y), bf_hi(raw.y), bf_lo(raw.z), bf_hi(raw.z), bf_lo(raw.w), bf_hi(raw.w)};
        float sm = ((x[0] + x[1]) + (x[2] + x[3])) + ((x[4] + x[5]) + (x[6] + x[7]));
        sm += __shfl_xor(sm, 1); sm += __shfl_xor(sm, 2); sm += __shfl_xor(sm, 4); sm += __shfl_xor(sm, 8);
        const float mu = sm * (1.0f / 128.0f); float vs = 0.f;
#pragma unroll
        for (int j = 0; j < 8; ++j) { x[j] -= mu; vs += x[j] * x[j]; }
        vs += __shfl_xor(vs, 1); vs += __shfl_xor(vs, 2); vs += __shfl_xor(vs, 4); vs += __shfl_xor(vs, 8);
        const float rstd = rsqrtf(vs * (1.0f / 128.0f) + 1e-6f);
#pragma unroll
        for (int j = 0; j < 4; ++j) { const unsigned pk = cvt_pk_bf16(x[2 * j] * rstd, x[2 * j + 1] * rstd);
            *(LAS unsigned short*)(lds + tr128_off(pc8 + 2 * j, s)) = (unsigned short)(pk & 0xffffu); *(LAS unsigned short*)(lds + tr128_off(pc8 + 2 * j + 1, s)) = (unsigned short)(pk >> 16); } }
    __syncthreads();
    f32x4 acc[8];
#pragma unroll
    for (int ct = 0; ct < 8; ++ct) acc[ct] = (f32x4){0.f, 0.f, 0.f, 0.f};
#pragma unroll
    for (int kb = 0; kb < 4; ++kb) if (kb < nkb) {
#pragma unroll
        for (int ct = 0; ct < 8; ++ct) { const bf16x8 a = *(const LAS bf16x8*)(lds + tr128_off(16 * ct + l15, 32 * kb + 8 * q4)); acc[ct] = MFMA16(a, wf[kb], acc[ct]); } }
    const int t = 16 * w + l15; const float bt = bias[t];
#pragma unroll
    for (int ct = 0; ct < 8; ++ct) { const size_t uo = (row0 + t) * 1024 + col0 + 16 * ct + 4 * q4; const u32x2 uu = *(const u32x2*)(Ub + uo);
        u32x2 o; o.x = cvt_pk_bf16(bf_lo(uu.x) * (acc[ct][0] + bt), bf_hi(uu.x) * (acc[ct][1] + bt)); o.y = cvt_pk_bf16(bf_lo(uu.y) * (acc[ct][2] + bt), bf_hi(uu.y) * (acc[ct][3] + bt));
        *(u32x2*)(Ob + uo) = o; }
    __syncthreads();
}

#define XB_TMO      128
#define XB_XCNT(j)  (256  + 64 * (j))
#define XB_XSUB(j)  (1280 + 64 * (j))
#define XB_XGEN(j)  (2304 + 64 * (j))
#define XB_TOP      3328
#define XB_TOPGEN   3392
#define XCD_BAR_WORDS 3456
#define XB_SPIN_CAP (1u << 18)

__device__ __forceinline__ unsigned xb_ld(unsigned* p)              { return __hip_atomic_load(p, __ATOMIC_RELAXED, __HIP_MEMORY_SCOPE_AGENT); }
__device__ __forceinline__ unsigned xb_add(unsigned* p, unsigned v) { return __hip_atomic_fetch_add(p, v, __ATOMIC_RELAXED, __HIP_MEMORY_SCOPE_AGENT); }
__device__ __forceinline__ unsigned xb_xcc_id() { return (unsigned)__builtin_amdgcn_s_getreg((3 << 11) | 20) & 0xFu; }
#define XB_SPIN(cond, bar) do { unsigned _sp = 0; while (cond) { __builtin_amdgcn_s_sleep(1); \
    if ((++_sp & 255u) == 0u) { if (xb_ld(&(bar)[XB_TMO])) break; if (_sp > XB_SPIN_CAP) { atomicAdd(&(bar)[XB_TMO], 1u); break; } } } } while (0)

struct XcdBarrier {
    unsigned* bar; unsigned x;
    volatile LAS unsigned* st;
};

__device__ __forceinline__ XcdBarrier xcd_barrier_post(unsigned* bar, volatile LAS unsigned* st) {
    XcdBarrier b; b.bar = bar; b.x = xb_xcc_id(); b.st = st;
    if (threadIdx.x == 0) (void)xb_add(&bar[XB_XCNT(b.x)], 1u);
    return b;
}
__device__ __forceinline__ void xcd_barrier_complete(unsigned* bar, unsigned x, unsigned& nloc, unsigned& nx) {
    const unsigned G = gridDim.x * gridDim.y * gridDim.z;
    unsigned sum, cnt, mine, sp = 0u;
    for (;;) {
        sum = 0u; cnt = 0u; mine = 0u;
#pragma unroll
        for (unsigned j = 0; j < 16; ++j) { const unsigned c = xb_ld(&bar[XB_XCNT(j)]); sum += c; cnt += (c > 0u) ? 1u : 0u; mine = (j == x) ? c : mine; }
        if (sum == G) break;
        __builtin_amdgcn_s_sleep(1);
        if ((++sp & 255u) == 0u) { if (xb_ld(&bar[XB_TMO])) break; if (sp > XB_SPIN_CAP) { atomicAdd(&bar[XB_TMO], 1u); break; } }
    }
    nloc = mine > 0u ? mine : 1u; nx = cnt > 0u ? cnt : 1u;
}

__device__ __forceinline__ void xcd_barrier(const XcdBarrier& b) {
    asm volatile("s_waitcnt vmcnt(0)" ::: "memory");
    __syncthreads();
    if (threadIdx.x == 0) {
        unsigned* bar = b.bar;
        __builtin_amdgcn_s_waitcnt(0);
        unsigned nloc = b.st[0], nx = b.st[1];
        if (nloc == 0u) { xcd_barrier_complete(bar, b.x, nloc, nx); b.st[0] = nloc; b.st[1] = nx; }
        const unsigned old = xb_add(&bar[XB_XSUB(b.x)], 1u);
        const unsigned gen = old / nloc;
        if (old + 1u == (gen + 1u) * nloc) {
            __builtin_amdgcn_fence(__ATOMIC_RELEASE, "agent");
            asm volatile("s_waitcnt vmcnt(0)" ::: "memory");
            const unsigned og = xb_add(&bar[XB_TOP], 1u);
            const unsigned tg = og / nx;
            if (og + 1u == (tg + 1u) * nx) xb_add(&bar[XB_TOPGEN], 1u);
            else XB_SPIN(xb_ld(&bar[XB_TOPGEN]) == tg, bar);
            __builtin_amdgcn_fence(__ATOMIC_ACQUIRE, "agent");
            xb_add(&bar[XB_XGEN(b.x)], 1u);
            asm volatile("s_waitcnt vmcnt(0)" ::: "memory");
        } else {
            XB_SPIN(xb_ld(&bar[XB_XGEN(b.x)]) == gen, bar);
            __builtin_amdgcn_fence(__ATOMIC_ACQUIRE, "agent");
            asm volatile("s_waitcnt vmcnt(0)" ::: "memory");
        }
    }
    __syncthreads();
}


__device__ __forceinline__ void flat_barrier(unsigned* bar, unsigned round) {
    asm volatile("s_waitcnt vmcnt(0)" ::: "memory");
    __syncthreads();
    if (threadIdx.x == 0) {
        __builtin_amdgcn_fence(__ATOMIC_RELEASE, "agent");
        asm volatile("s_waitcnt vmcnt(0)" ::: "memory");
        const unsigned G = gridDim.x, old = __hip_atomic_fetch_add(bar + 64, 1u, __ATOMIC_RELAXED, __HIP_MEMORY_SCOPE_AGENT);
        if (old + 1u == round * G) __hip_atomic_store(bar + 128, round, __ATOMIC_RELAXED, __HIP_MEMORY_SCOPE_AGENT);
        else { unsigned sp = 0; while (__hip_atomic_load(bar + 128, __ATOMIC_RELAXED, __HIP_MEMORY_SCOPE_AGENT) < round) { __builtin_amdgcn_s_sleep(2); if (++sp > (1u << 22)) break; } }
        __builtin_amdgcn_fence(__ATOMIC_ACQUIRE, "agent");
        asm volatile("s_waitcnt vmcnt(0)" ::: "memory");
    }
    __syncthreads();
}
constexpr int HSEG = 8, HCH = SEQ / 64 / HSEG;
#ifndef PHMASK
#define PHMASK 0xffff
#endif
__global__ void __launch_bounds__(512, 2) mk_fwd(Params p_arg) {
    extern __shared__ __attribute__((aligned(16))) unsigned char lds_raw[];
    LAS unsigned char* lds = (LAS unsigned char*)lds_raw;
    int pc = 0;
    { if (threadIdx.x == 0) { *(LAS u32x4*)(lds + XB_ST_OFF) = (u32x4){0u, 0u, 0u, 0u}; } __syncthreads();
      KP pp0 = (KP)__builtin_amdgcn_kernarg_segment_ptr(); if (blockIdx.x == 0) { unsigned* bar0 = (unsigned*)pp0->ws; for (int i = threadIdx.x; i < XCD_BAR_WORDS; i += 512) __hip_atomic_store(bar0 + i, 0u, __ATOMIC_RELAXED, __HIP_MEMORY_SCOPE_AGENT); } }
#define GETP KP pp = (KP)__builtin_amdgcn_kernarg_segment_ptr(); asm volatile("" : "+s"(pp))
#ifdef MK_TIME
    LAS unsigned long long* tacc = (LAS unsigned long long*)(lds + 143360); const bool timer = (blockIdx.x == 0 && threadIdx.x == 0); unsigned long long tph0 = 0, tph1 = 0; int tcls = 0;
    if (timer) { for (int i = 0; i < 16; ++i) tacc[i] = 0ull; }
#define T_BEGIN(c) if (timer) { tph0 = __builtin_amdgcn_s_memrealtime(); tcls = (c); }
#define T_MID if (timer) { tph1 = __builtin_amdgcn_s_memrealtime(); tacc[tcls] += tph1 - tph0; }
#define T_END if (timer) { tacc[15] += __builtin_amdgcn_s_memrealtime() - tph1; }
#else
#define T_BEGIN(c)
#define T_MID
#define T_END
#endif
#ifndef MK_DUP
#define MK_DUP 0
#endif
#define PH_BEGIN(bit, cls) { GETP; T_BEGIN(cls) if (pc >= pp->ph_lo && pc < pp->ph_hi && (PHMASK & (bit))) for (int rep_ = 0; rep_ < (((MK_DUP) & (bit)) ? 2 : 1); ++rep_) {
#define PH_END } } { GETP; T_MID ++pc; if (pc > pp->ph_lo && pc < pp->ph_hi) { if (pc == 1) { cg::this_grid().sync(); (void)xcd_barrier_post((unsigned*)pp->ws, (volatile LAS unsigned*)(lds + XB_ST_OFF)); } else { XcdBarrier xb_; xb_.bar = (unsigned*)pp->ws; xb_.x = xb_xcc_id(); xb_.st = (volatile LAS unsigned*)(lds + XB_ST_OFF); xcd_barrier(xb_); } } T_END }

    PH_BEGIN(1, 0) prologue_phase(pp, lds); PH_END

    for (int blk = 0; blk < 3 * NL; ++blk) {
        const int l = blk / 3, kind = blk - 3 * l;
        PH_BEGIN(2, 1) unsigned char* ws = pp->ws; const float* hin = (blk == 0) ? pp->in[0] : pp->out;
            norm_phase<false>(hin, (bf16_t*)(ws + WS_HN), nullptr, pp->in[11] + (size_t)(l * 3 + kind) * 1024, (const float*)(ws + WS_MOD) + (size_t)l * 8 * 9216, kind); PH_END
        if (kind != 1) {
            const int s = kind >> 1;
            PH_BEGIN(4, 2) unsigned char* ws = pp->ws;
                pg8::Gemm g{(const bf16_t*)(ws + WS_HN), (const bf16_t*)(ws + WS_W13) + (size_t)(l * 2 + s) * 5632 * 1024, NT, 5632, 1024}; pg8::StaticOrder S; S.init(NT, 5632, (int)gridDim.x, (int)blockIdx.x);
                pg8::EpiSwiGLU E{(bf16_t*)(ws + WS_BIG)}; pg8::gemm_phase<pg8::EpiSwiGLU, pg8::StaticOrder, false>(lds, g, S, E, nullptr); PH_END
            PH_BEGIN(8, 3) unsigned char* ws = pp->ws; const float* hin = (blk == 0) ? pp->in[0] : pp->out;
                pg8::Gemm g{(const bf16_t*)(ws + WS_BIG), (const bf16_t*)(ws + WS_W2) + (size_t)(l * 2 + s) * 1024 * FH, NT, 1024, FH}; pg8::StaticOrder S; S.init(NT, 1024, (int)gridDim.x, (int)blockIdx.x);
                pg8::EpiResid E{hin, pp->out, (const float*)(ws + WS_MOD) + (size_t)l * 8 * 9216 + (3 * kind + 2) * 1024, 0.5f}; pg8::gemm_phase<pg8::EpiResid, pg8::StaticOrder, false>(lds, g, S, E, nullptr); PH_END
        } else {
            for (int half = 0; half < 2; ++half) {
                PH_BEGIN(16, 4) unsigned char* ws = pp->ws;
                    pg8::Gemm g{(const bf16_t*)(ws + WS_HN) + (size_t)half * TH * 1024, (const bf16_t*)(ws + WS_WIN) + (size_t)l * 8192 * 1024, TH, 8192, 1024}; pg8::StaticOrder S; S.init(TH, 8192, (int)gridDim.x, (int)blockIdx.x);
                    pg8::EpiInproj E{(bf16_t*)(ws + WS_U), (bf16_t*)(ws + WS_V), (bf16_t*)(ws + WS_Q), (float*)(ws + WS_F), (bf16_t*)(ws + WS_I), (bf16_t*)(ws + WS_OG), (bf16_t*)(ws + WS_GA), (bf16_t*)(ws + WS_GB), (const float*)(ws + WS_LB) + l * 1024};
                    pg8::gemm_phase<pg8::EpiInproj, pg8::StaticOrder, false>(lds, g, S, E, nullptr); PH_END
                PH_BEGIN(32, 5) unsigned char* ws = pp->ws; const int G = (int)gridDim.x;
                    for (int it = (int)blockIdx.x; it < 32 * (HSEG - 1); it += G) { const int sq = it / (HSEG - 1), sg = it - sq * (HSEG - 1);
                        hgrn_seq<true>(lds, nullptr, (const float*)(ws + WS_F), (const bf16_t*)(ws + WS_I), nullptr, nullptr, (size_t)(sq >> 3) * SEQ, (sq & 7) * 128, sg * HCH, HCH, (float*)(ws + WS_HU), (float*)(ws + WS_HD), sq * HSEG + sg, 0); }
                    { const bf16_t* wst = (const bf16_t*)(ws + WS_WST) + (size_t)l * 8 * 128 * 128; const float* gb = pp->in[4] + (size_t)l * 8 * 128; const int tid = opaque_tid();
                        for (int it = (int)blockIdx.x; it < 4 * 64 * 8; it += G) { const int g8 = it & 7, ch = (it >> 3) & 63, bl = it >> 9;
                            gmlp_item(lds, (const bf16_t*)(ws + WS_V), (const bf16_t*)(ws + WS_U), (bf16_t*)(ws + ((MK_DUP & 32) && rep_ == 0 ? WS_END : WS_U)), wst + g8 * 128 * 128, gb + g8 * 128, (size_t)bl * SEQ + ch * 128, g8 * 128, tid); } }
                PH_END
                PH_BEGIN(64, 6) unsigned char* ws = pp->ws; const int G = (int)gridDim.x;
                    for (int it = (int)blockIdx.x; it < 32 * HSEG; it += G) { const int sq = it / HSEG, sg = it - sq * HSEG;
                        hgrn_seq<false>(lds, (const bf16_t*)(ws + WS_Q), (const float*)(ws + WS_F), (const bf16_t*)(ws + WS_I), (const bf16_t*)(ws + WS_OG), (bf16_t*)(ws + ((MK_DUP & 64) && rep_ == 0 ? WS_END : WS_OG)), (size_t)(sq >> 3) * SEQ, (sq & 7) * 128, sg * HCH, HCH, (float*)(ws + WS_HU), (float*)(ws + WS_HD), sq * HSEG, sg); }
                PH_END
                PH_BEGIN(128, 7) unsigned char* ws = pp->ws;
                    pg8::Gemm g{(const bf16_t*)(ws + WS_U), (const bf16_t*)(ws + WS_WA) + (size_t)l * 1024 * 1024, TH, 1024, 1024}; pg8::StaticOrder S; S.init(TH, 1024, (int)gridDim.x, (int)blockIdx.x);
                    pg8::EpiBranch<0> E{(const bf16_t*)(ws + WS_GA), nullptr, (bf16_t*)(ws + WS_V)}; pg8::gemm_phase<pg8::EpiBranch<0>, pg8::StaticOrder, false>(lds, g, S, E, nullptr); PH_END
                PH_BEGIN(256, 8) unsigned char* ws = pp->ws;
                    pg8::Gemm g{(const bf16_t*)(ws + WS_OG), (const bf16_t*)(ws + WS_WB) + (size_t)l * 1024 * 1024, TH, 1024, 1024}; pg8::StaticOrder S; S.init(TH, 1024, (int)gridDim.x, (int)blockIdx.x);
                    pg8::EpiBranch<1> E{(const bf16_t*)(ws + WS_GB), (const bf16_t*)(ws + WS_V), (bf16_t*)(ws + WS_Q)}; pg8::gemm_phase<pg8::EpiBranch<1>, pg8::StaticOrder, false>(lds, g, S, E, nullptr); PH_END
                PH_BEGIN(512, 9) unsigned char* ws = pp->ws; float* hh = pp->out + (size_t)half * TH * 1024;
                    pg8::Gemm g{(const bf16_t*)(ws + WS_Q), (const bf16_t*)(ws + WS_WO) + (size_t)l * 1024 * 1024, TH, 1024, 1024}; pg8::StaticOrder S; S.init(TH, 1024, (int)gridDim.x, (int)blockIdx.x);
                    pg8::EpiResid E{hh, hh, (const float*)(ws + WS_MOD) + (size_t)l * 8 * 9216 + (size_t)(half * 4) * 9216 + 5 * 1024, 1.0f}; pg8::gemm_phase<pg8::EpiResid, pg8::StaticOrder, false>(lds, g, S, E, nullptr); PH_END
            }
        }
    }
    PH_BEGIN(1024, 10) norm_phase<true>(pp->out, nullptr, pp->out, pp->in[14], nullptr, 0); PH_END
#ifdef MK_TIME
    __syncthreads(); asm volatile("s_waitcnt vmcnt(0)" ::: "memory");
    if (timer) { GETP; unsigned long long a = 0, b = 0; for (int i = 0; i < 16; ++i) { if ((MK_TA >> i) & 1) a += tacc[i]; if ((MK_TB >> i) & 1) b += tacc[i]; }
        const float V = (float)a * 0.01f; int n = (int)((float)b * 0.01f / 20.0f); if (n < 1) n = 1; if (n > 1024) n = 1024;
        float* o = pp->out; for (int i = 0; i < n; ++i) o[i] = V; }
#endif
}
constexpr int N_PHASES = 1 + NL * (3 + 4 + 12) + 1;

extern "C" void kernel_launch(void* const* d_in, const int* in_sizes, int n_in, void* d_out, int out_size, void* d_ws, size_t ws_size, hipStream_t stream) {
    static int grid = 0;
    if (grid == 0) {
        if (n_in != 15 || out_size != NT * DM || ws_size < WS_END) { fprintf(stderr, "kernel_launch: unexpected shapes (n_in %d, out %d, ws %zu < %zu)\n", n_in, out_size, ws_size, (size_t)WS_END); grid = -1; return; }
        int dev = 0, cus = 0, per_cu = 0;
        hipGetDevice(&dev); hipDeviceGetAttribute(&cus, hipDeviceAttributeMultiprocessorCount, dev);
        if (hipFuncSetAttribute((const void*)mk_fwd, hipFuncAttributeMaxDynamicSharedMemorySize, LDS_BYTES) != hipSuccess) { fprintf(stderr, "kernel_launch: hipFuncSetAttribute failed\n"); grid = -1; return; }
        if (hipOccupancyMaxActiveBlocksPerMultiprocessor(&per_cu, (const void*)mk_fwd, 512, LDS_BYTES) != hipSuccess || per_cu < 1) { fprintf(stderr, "kernel_launch: occupancy query says %d\n", per_cu); per_cu = 1; }
        (void)hipGetLastError();
        grid = cus * 1;
    }
    if (grid < 0) return;
    Params p{};
    for (int i = 0; i < 15; ++i) p.in[i] = (const float*)d_in[i];
    p.out = (float*)d_out; p.ws = (unsigned char*)d_ws;
#if MK_COOP
    p.ph_lo = 0; p.ph_hi = N_PHASES;
    void* args[] = {&p};
    hipError_t e = hipLaunchCooperativeKernel((const void*)mk_fwd, dim3(grid), dim3(512), args, LDS_BYTES, stream);
    if (e != hipSuccess) fprintf(stderr, "cooperative launch failed: %s (grid %d)\n", hipGetErrorString(e), grid);
#else
    for (int i = 0; i < N_PHASES; ++i) { p.ph_lo = i; p.ph_hi = i + 1; hipLaunchKernelGGL(mk_fwd, dim3(grid), dim3(512), LDS_BYTES, stream, p); }
#endif
}
```

```cpp
#include <hip/hip_runtime.h>
#include <hip/hip_cooperative_groups.h>
#include <cstdio>
namespace cg = cooperative_groups;
#ifndef MK_COOP
#define MK_COOP 1
#endif
namespace pg8 {
#define PG8_LAS __attribute__((address_space(3)))
typedef unsigned short bf16_t;
typedef short bf16x8 __attribute__((ext_vector_type(8)));
typedef float f32x4 __attribute__((ext_vector_type(4)));
typedef unsigned u32x4 __attribute__((ext_vector_type(4)));
constexpr int BM = 256, BK = 64, HALF = 128, HTB = HALF * BK * 2  , STAGE_BYTES = 8 * HTB, NXCD = 8, WGM = 8;

__host__ __device__ __forceinline__ int lds_byte(int r, int c) { const int st = (r >> 4) * 2 + (c >> 5), rr = r & 15, cc = c & 31, ob = rr * 64 + cc * 2; return st * 1024 + (ob ^ (((ob >> 9) & 1) << 5)); }
__host__ __device__ __forceinline__ void stage_rc(int b, int& R, int& C) { const int st = b / 1024, sb = b % 1024, swz = sb ^ (((sb >> 9) & 1) << 5); R = (st >> 1) * 16 + swz / 64; C = (st & 1) * 32 + (swz % 64) / 2; }
__host__ __device__ __forceinline__ int perm32(int rho) { const int n = rho >> 4, i = rho & 15; return 8 * (i >> 2) + 4 * n + (i & 3); }

struct Unit { int pm, pn; };
struct Gemm { const bf16_t* A; const bf16_t* Bt; int M, N, K; };

struct StaticOrder {
    int nM, nN, nwg, G, c;
    __host__ __device__ void init(int M, int N, int G_, int c_) { nM = M / BM; nN = N / BM; nwg = nM * nN; G = G_; c = c_; }
    __host__ __device__ bool next(int i, Unit& u) const {
        const long L = (long)i * G + c; if (L >= nwg) return false;
        int wgid = (int)L; { const int q = nwg / NXCD, r = nwg % NXCD, xcd = wgid % NXCD, off = wgid / NXCD; wgid = (xcd < r ? xcd * (q + 1) : r * (q + 1) + (xcd - r) * q) + off; }
        const int nig = WGM * nN, gid = wgid / nig, fm = gid * WGM, gsz = (nM - fm) < WGM ? (nM - fm) : WGM;
        u.pm = fm + ((wgid % nig) % gsz); u.pn = (wgid % nig) / gsz; return true;
    }
    __device__ __forceinline__ void a_ready(const Unit&) const {}
    __device__ __forceinline__ void done(const Unit&) const {}
};
__device__ __forceinline__ int opaque_tid() { int t = threadIdx.x; asm volatile("" : "+v"(t)); return t; }
typedef __bf16 bf16x2_t __attribute__((ext_vector_type(2)));
typedef float f32x2_t __attribute__((ext_vector_type(2)));
__device__ __forceinline__ unsigned cvt_pk_bf16(float lo, float hi) { const f32x2_t v = {lo, hi}; const bf16x2_t b = __builtin_convertvector(v, bf16x2_t); return __builtin_bit_cast(unsigned, b); }
__device__ __forceinline__ float bf_lo(unsigned w) { return __uint_as_float(w << 16); }
__device__ __forceinline__ float bf_hi(unsigned w) { return __uint_as_float(w & 0xffff0000u); }
template <int ACT> __device__ __forceinline__ float actf(float x) {
    if (ACT == 0) return x;
    if (ACT == 1) { const float u = 1.5957691216f * (x + 0.044715f * x * x * x); return x * __builtin_amdgcn_rcpf(1.0f + __expf(-u)); }
    if (ACT == 2) return x * __builtin_amdgcn_rcpf(1.0f + __expf(-x));
    return __builtin_amdgcn_rcpf(1.0f + __expf(-x));
}
struct EpiSwiGLU {
    static constexpr bool PERM = true, AFTER_DRAIN = false;
    bf16_t* O;
    __device__ __forceinline__ void operator()(const f32x4 (&acc)[2][2][4][2], const Unit& u, int wr, int wc, int fr, int fq) const {
        const int row0 = u.pm * BM + wr * 64 + fr, col0 = u.pn * HALF + wc * 32 + 8 * fq;
#pragma unroll
        for (int ai = 0; ai < 2; ++ai)
#pragma unroll
            for (int m = 0; m < 4; ++m) {
                const f32x4 a0 = acc[ai][0][m][0], a1 = acc[ai][0][m][1], b0 = acc[ai][1][m][0], b1 = acc[ai][1][m][1];
                float v[8];
#pragma unroll
                for (int j = 0; j < 4; ++j) { v[j] = actf<2>(a0[j]) * b0[j]; v[4 + j] = actf<2>(a1[j]) * b1[j]; }
                u32x4 w; w.x = cvt_pk_bf16(v[0], v[1]); w.y = cvt_pk_bf16(v[2], v[3]); w.z = cvt_pk_bf16(v[4], v[5]); w.w = cvt_pk_bf16(v[6], v[7]);
                *(u32x4*)(O + (size_t)(row0 + ai * HALF + m * 16) * 2816 + col0) = w;
            }
    }
};
struct EpiResid {
    static constexpr bool PERM = false, AFTER_DRAIN = false;
    const float* hin; float* hout; const float* gmod; float scale;
    __device__ __forceinline__ void operator()(const f32x4 (&acc)[2][2][4][2], const Unit& u, int wr, int wc, int fr, int fq) const {
        const int row0 = u.pm * BM + wr * 64 + fr, col0 = u.pn * BM + wc * 32 + 4 * fq;
        const float* gp = gmod + (size_t)((u.pm * BM) >> 13) * 9216 + col0;
        f32x4 cf[2][2];
#pragma unroll
        for (int bj = 0; bj < 2; ++bj)
#pragma unroll
            for (int n = 0; n < 2; ++n) { const f32x4 g = *(const f32x4*)(gp + bj * HALF + n * 16); cf[bj][n] = (g + 1.0f) * scale; }
#pragma unroll
        for (int ai = 0; ai < 2; ++ai) {
            f32x4 hv[4][2][2];
#pragma unroll
            for (int m = 0; m < 4; ++m) { const size_t off = (size_t)(row0 + ai * HALF + m * 16) * 1024 + col0;
#pragma unroll
                for (int bj = 0; bj < 2; ++bj)
#pragma unroll
                    for (int n = 0; n < 2; ++n) hv[m][bj][n] = *(const f32x4*)(hin + off + bj * HALF + n * 16); }
#pragma unroll
            for (int m = 0; m < 4; ++m) { const size_t off = (size_t)(row0 + ai * HALF + m * 16) * 1024 + col0;
#pragma unroll
                for (int bj = 0; bj < 2; ++bj)
#pragma unroll
                    for (int n = 0; n < 2; ++n) *(f32x4*)(hout + off + bj * HALF + n * 16) = hv[m][bj][n] + cf[bj][n] * acc[ai][bj][m][n]; }
            asm volatile("" ::: "memory"); }
    }
};
struct EpiInproj {
    static constexpr bool PERM = true, AFTER_DRAIN = false;
    bf16_t* U; bf16_t* V; bf16_t* Q; float* F; bf16_t* I; bf16_t* OG; bf16_t* GA; bf16_t* GB; const float* lb;
    template <int ACT> __device__ __forceinline__ void st16(const f32x4 (&acc)[2][2][4][2], bf16_t* dst, int row0, int colg) const {
#pragma unroll
        for (int ai = 0; ai < 2; ++ai)
#pragma unroll
            for (int m = 0; m < 4; ++m)
#pragma unroll
                for (int bj = 0; bj < 2; ++bj) { const f32x4 v0 = acc[ai][bj][m][0], v1 = acc[ai][bj][m][1];
                    u32x4 w; w.x = cvt_pk_bf16(actf<ACT>(v0[0]), actf<ACT>(v0[1])); w.y = cvt_pk_bf16(actf<ACT>(v0[2]), actf<ACT>(v0[3]));
                    w.z = cvt_pk_bf16(actf<ACT>(v1[0]), actf<ACT>(v1[1])); w.w = cvt_pk_bf16(actf<ACT>(v1[2]), actf<ACT>(v1[3]));
                    *(u32x4*)(dst + (size_t)(row0 + ai * HALF + m * 16) * 1024 + colg + bj * HALF) = w; }
    }
    __device__ __forceinline__ void operator()(const f32x4 (&acc)[2][2][4][2], const Unit& u, int wr, int wc, int fr, int fq) const {
        const int grp = u.pn >> 2, colg = (u.pn & 3) * BM + wc * 32 + 8 * fq, row0 = u.pm * BM + wr * 64 + fr;
        if (grp == 3) {
#pragma unroll
            for (int bj = 0; bj < 2; ++bj) { const f32x4 l0 = *(const f32x4*)(lb + colg + bj * HALF), l1 = *(const f32x4*)(lb + colg + bj * HALF + 4);
#pragma unroll
                for (int ai = 0; ai < 2; ++ai)
#pragma unroll
                    for (int m = 0; m < 4; ++m) { const f32x4 v0 = acc[ai][bj][m][0], v1 = acc[ai][bj][m][1]; f32x4 o0, o1;
#pragma unroll
                        for (int j = 0; j < 4; ++j) { o0[j] = __logf(fmaxf(l0[j] + (1.0f - l0[j]) * actf<3>(v0[j]), 1e-30f)); o1[j] = __logf(fmaxf(l1[j] + (1.0f - l1[j]) * actf<3>(v1[j]), 1e-30f)); }
                        float* d = F + (size_t)(row0 + ai * HALF + m * 16) * 1024 + colg + bj * HALF; *(f32x4*)d = o0; *(f32x4*)(d + 4) = o1; } }
        } else if (grp < 2) st16<1>(acc, grp == 0 ? U : V, row0, colg);
        else if (grp == 2) st16<2>(acc, Q, row0, colg);
        else if (grp == 4) st16<0>(acc, I, row0, colg);
        else st16<3>(acc, grp == 5 ? OG : (grp == 6 ? GA : GB), row0, colg);
    }
};
template <int MODE> struct EpiBranch {
    static constexpr bool PERM = true, AFTER_DRAIN = false;
    const bf16_t* G; const bf16_t* P; bf16_t* O;
    __device__ __forceinline__ void operator()(const f32x4 (&acc)[2][2][4][2], const Unit& u, int wr, int wc, int fr, int fq) const {
        const int row0 = u.pm * BM + wr * 64 + fr, col0 = u.pn * BM + wc * 32 + 8 * fq;
#pragma unroll
        for (int ai = 0; ai < 2; ++ai)
#pragma unroll
            for (int m = 0; m < 4; ++m)
#pragma unroll
                for (int bj = 0; bj < 2; ++bj) { const size_t off = (size_t)(row0 + ai * HALF + m * 16) * 1024 + col0 + bj * HALF;
                    const u32x4 g = *(const u32x4*)(G + off); const f32x4 v0 = acc[ai][bj][m][0], v1 = acc[ai][bj][m][1];
                    float r[8] = { bf_lo(g.x) * v0[0], bf_hi(g.x) * v0[1], bf_lo(g.y) * v0[2], bf_hi(g.y) * v0[3], bf_lo(g.z) * v1[0], bf_hi(g.z) * v1[1], bf_lo(g.w) * v1[2], bf_hi(g.w) * v1[3] };
                    if (MODE == 1) { const u32x4 p = *(const u32x4*)(P + off);
                        r[0] += bf_lo(p.x); r[1] += bf_hi(p.x); r[2] += bf_lo(p.y); r[3] += bf_hi(p.y); r[4] += bf_lo(p.z); r[5] += bf_hi(p.z); r[6] += bf_lo(p.w); r[7] += bf_hi(p.w); }
                    u32x4 w; w.x = cvt_pk_bf16(r[0], r[1]); w.y = cvt_pk_bf16(r[2], r[3]); w.z = cvt_pk_bf16(r[4], r[5]); w.w = cvt_pk_bf16(r[6], r[7]);
                    *(u32x4*)(O + off) = w; }
    }
};

template <class Epi, class Sched, bool STAMP = false>
__device__ __forceinline__ void gemm_phase(PG8_LAS unsigned char* lds, const Gemm g, const Sched& S, const Epi& E, unsigned long long* stamps) {
    const int tid = opaque_tid(), wid = __builtin_amdgcn_readfirstlane(tid >> 6), lane = tid & 63, wr = wid >> 2, wc = wid & 3, fr = lane & 15, fq = lane >> 4;
    const int K = g.K, nt = K / BK;
    int ts_lo = 0, ts_hi = 0, nts = 0; const unsigned long long rt_entry = STAMP ? (unsigned long long)wall_clock64() : 0ull;
#define PG8_STAMP() do { if (STAMP && wid == 0 && nts < 64) { const unsigned long long _c = (unsigned long long)clock64(); \
        ts_lo = (lane == nts) ? (int)(unsigned)_c : ts_lo; ts_hi = (lane == nts) ? (int)(unsigned)(_c >> 32) : ts_hi; ++nts; } } while (0)
    PG8_STAMP();
    unsigned voffA[2], voffB[2];
#pragma unroll
    for (int i = 0; i < 2; ++i) { int R, C; stage_rc(tid * 16 + i * 8192, R, C); const int Rb = Epi::PERM ? ((R & ~31) + perm32(R & 31)) : R;
        voffA[i] = (unsigned)(R * K + C) * 2u; voffB[i] = (unsigned)(Rb * K + C) * 2u; }
    const size_t kstep = (size_t)(BK * 2);
    const size_t hstep = (size_t)HALF * K * 2;
    const size_t tstep = 2 * hstep;
    const unsigned ldsw = (unsigned)wid * 1024u;
    const int aoff = lds_byte(wr * 64 + fr, fq * 8), boff = lds_byte(wc * 32 + fr, fq * 8);
#define PG8_SA(b, h) (((b) * 2 + (h)) * HTB)
#define PG8_SB(b, h) ((4 + (b) * 2 + (h)) * HTB)
#define PG8_STAGE(bufoff, gbase, voff) do { _Pragma("unroll") for (int _i = 0; _i < 2; ++_i) \
        __builtin_amdgcn_global_load_lds((const unsigned*)((const char*)(gbase) + (voff)[_i]), (PG8_LAS unsigned*)(lds + (bufoff) + ldsw + _i * 8192), 16, 0, 0); } while (0)
#define PG8_LDA(dst, b, h) do { _Pragma("unroll") for (int m = 0; m < 4; ++m) _Pragma("unroll") for (int k = 0; k < 2; ++k) dst[m][k] = *(const PG8_LAS bf16x8*)(lds + PG8_SA(b, h) + aoff + m * 2048 + k * 1024); } while (0)
#define PG8_LDB(dst, b, h) do { _Pragma("unroll") for (int n = 0; n < 2; ++n) _Pragma("unroll") for (int k = 0; k < 2; ++k) dst[n][k] = *(const PG8_LAS bf16x8*)(lds + PG8_SB(b, h) + boff + n * 2048 + k * 1024); } while (0)
#define PG8_MMA(ai, bj, At, Bt) do { __builtin_amdgcn_s_setprio(1); _Pragma("unroll") for (int m = 0; m < 4; ++m) _Pragma("unroll") for (int n = 0; n < 2; ++n) _Pragma("unroll") for (int k = 0; k < 2; ++k) \
        acc[ai][bj][m][n] = __builtin_amdgcn_mfma_f32_16x16x32_bf16(Bt[n][k], At[m][k], acc[ai][bj][m][n], 0, 0, 0); __builtin_amdgcn_s_setprio(0); } while (0)
#define PG8_WAIT_V(n) asm volatile("s_waitcnt vmcnt(" #n ")" ::: "memory")
#define PG8_WAIT_L(n) asm volatile("s_waitcnt lgkmcnt(" #n ")" ::: "memory")
#define PG8_BAR __builtin_amdgcn_s_barrier()
#define PG8_SCHED __builtin_amdgcn_sched_barrier(0)
    Unit cur, nxt; int ui = 0;
    if (!S.next(0, cur)) return;
    f32x4 acc[2][2][4][2];
#pragma unroll
    for (int a = 0; a < 2; ++a)
#pragma unroll
        for (int b = 0; b < 2; ++b)
#pragma unroll
            for (int m = 0; m < 4; ++m)
#pragma unroll
                for (int n = 0; n < 2; ++n) acc[a][b][m][n] = (f32x4){0.f, 0.f, 0.f, 0.f};
    bf16x8 At[4][2], B0[2][2], B1[2][2];
    const char* cA = (const char*)g.A + (size_t)cur.pm * tstep; const char* cB = (const char*)g.Bt + (size_t)cur.pn * tstep;
    S.a_ready(cur);
    PG8_STAGE(PG8_SB(0, 0), cB, voffB); PG8_STAGE(PG8_SA(0, 0), cA, voffA); PG8_STAGE(PG8_SB(0, 1), cB + hstep, voffB); PG8_STAGE(PG8_SA(0, 1), cA + hstep, voffA);
    if (wr == 1) PG8_BAR;
    PG8_WAIT_V(4); PG8_BAR;
    PG8_STAGE(PG8_SB(1, 0), cB + kstep, voffB); PG8_STAGE(PG8_SA(1, 0), cA + kstep, voffA); PG8_STAGE(PG8_SB(1, 1), cB + hstep + kstep, voffB);
    PG8_WAIT_V(6); PG8_BAR;
    PG8_STAMP();
    for (;;) {
        const bool has_next = S.next(ui + 1, nxt);
        const char* nA = has_next ? (const char*)g.A + (size_t)nxt.pm * tstep : cA; const char* nB = has_next ? (const char*)g.Bt + (size_t)nxt.pn * tstep : cB;
        for (int t = 0; t < nt; t += 2) {
            const bool last = (t == nt - 2);
            const char* a1 = cA + (size_t)(t + 1) * kstep;
            const char* a2 = last ? nA : cA + (size_t)(t + 2) * kstep; const char* b2 = last ? nB : cB + (size_t)(t + 2) * kstep;
            const char* a3 = a2 + kstep; const char* b3 = b2 + kstep;
            if (last && has_next) S.a_ready(nxt);
            PG8_LDB(B0, 0, 0); PG8_SCHED; PG8_LDA(At, 0, 0); PG8_STAGE(PG8_SA(1, 1), a1 + hstep, voffA);
            PG8_WAIT_L(8); PG8_BAR; PG8_WAIT_L(0); PG8_MMA(0, 0, At, B0); PG8_BAR; PG8_SCHED;
            PG8_LDB(B1, 0, 1); PG8_STAGE(PG8_SB(0, 0), b2, voffB);
            PG8_BAR; PG8_WAIT_L(0); PG8_MMA(0, 1, At, B1); PG8_BAR;
            PG8_LDA(At, 0, 1); PG8_STAGE(PG8_SA(0, 0), a2, voffA);
            PG8_BAR; PG8_WAIT_L(0); PG8_MMA(1, 0, At, B0); PG8_BAR; PG8_SCHED;
            PG8_STAGE(PG8_SB(0, 1), b2 + hstep, voffB);
            PG8_WAIT_V(6); PG8_BAR; PG8_MMA(1, 1, At, B1); PG8_BAR;
            PG8_LDB(B0, 1, 0); PG8_SCHED; PG8_LDA(At, 1, 0); PG8_STAGE(PG8_SA(0, 1), a2 + hstep, voffA);
            PG8_WAIT_L(8); PG8_BAR; PG8_WAIT_L(0); PG8_MMA(0, 0, At, B0); PG8_BAR; PG8_SCHED;
            PG8_LDB(B1, 1, 1); PG8_STAGE(PG8_SB(1, 0), b3, voffB);
            PG8_BAR; PG8_WAIT_L(0); PG8_MMA(0, 1, At, B1); PG8_BAR;
            PG8_LDA(At, 1, 1); PG8_STAGE(PG8_SA(1, 0), a3, voffA);
            PG8_BAR; PG8_WAIT_L(0); PG8_MMA(1, 0, At, B0); PG8_BAR; PG8_SCHED;
            PG8_STAGE(PG8_SB(1, 1), b3 + hstep, voffB);
            PG8_WAIT_V(6); PG8_BAR; PG8_MMA(1, 1, At, B1); PG8_BAR;
        }
        PG8_STAMP();
        if constexpr (!Epi::AFTER_DRAIN) { E(acc, cur, wr, wc, fr, fq); S.done(cur); }
        PG8_STAMP();
        if (!has_next) break;
#pragma unroll
        for (int a = 0; a < 2; ++a)
#pragma unroll
            for (int b = 0; b < 2; ++b)
#pragma unroll
                for (int m = 0; m < 4; ++m)
#pragma unroll
                    for (int n = 0; n < 2; ++n) acc[a][b][m][n] = (f32x4){0.f, 0.f, 0.f, 0.f};
        cur = nxt; cA = nA; cB = nB; ++ui;
    }
    PG8_WAIT_V(0);
    if (wr == 0) PG8_BAR;
    PG8_BAR;
    if constexpr (Epi::AFTER_DRAIN) { E.fused(acc, cur, wr, wc, fr, fq, lds, wid, lane); S.done(cur); }
    PG8_STAMP();
    if (STAMP && wid == 0) { stamps[lane] = lane < nts ? (((unsigned long long)(unsigned)ts_hi << 32) | (unsigned)ts_lo) : 0ull;
        if (lane == 62) stamps[62] = rt_entry; if (lane == 63) stamps[63] = (unsigned long long)wall_clock64(); }
#undef PG8_STAMP
#undef PG8_SA
#undef PG8_SB
#undef PG8_STAGE
#undef PG8_LDA
#undef PG8_LDB
#undef PG8_MMA
#undef PG8_WAIT_V
#undef PG8_WAIT_L
#undef PG8_BAR
#undef PG8_SCHED
}
}
using pg8::bf16_t; using pg8::bf16x8; using pg8::f32x4; using pg8::u32x4; using pg8::cvt_pk_bf16; using pg8::bf_lo; using pg8::bf_hi; using pg8::opaque_tid;
#define LAS __attribute__((address_space(3)))
typedef unsigned u32x2 __attribute__((ext_vector_type(2)));

constexpr int NT = 65536, DM = 1024, NL = 4, SEQ = 8192, FH = 2816, TH = 32768  ;
constexpr int LDS_BYTES = 144 * 1024, XB_ST_OFF = 143616;
constexpr size_t MiB = 1024ull * 1024ull;
constexpr size_t WS_MOD = 64 * 1024;
constexpr size_t WS_WST = 2 * MiB;
constexpr size_t WS_LB = 3 * MiB;
constexpr size_t WS_WIN = 4 * MiB;
constexpr size_t WS_W13 = 68 * MiB;
constexpr size_t WS_W2 = 156 * MiB;
constexpr size_t WS_WA = 200 * MiB, WS_WB = 208 * MiB, WS_WO = 216 * MiB;
constexpr size_t WS_HN = 224 * MiB;
constexpr size_t WS_BIG = 352 * MiB;
constexpr size_t ZB = 64 * MiB;
constexpr size_t WS_U = WS_BIG, WS_V = WS_BIG + ZB, WS_Q = WS_BIG + 2 * ZB, WS_F = WS_BIG + 3 * ZB  , WS_I = WS_BIG + 5 * ZB, WS_OG = WS_BIG + 6 * ZB, WS_GA = WS_BIG + 7 * ZB, WS_GB = WS_BIG + 8 * ZB;
constexpr size_t WS_HU = WS_BIG + 9 * ZB;
constexpr size_t WS_HD = WS_HU + 16 * MiB;
constexpr size_t WS_END = WS_HD + 1 * MiB;

struct Params { const float* in[15]; float* out; unsigned char* ws; int ph_lo, ph_hi; };
typedef const Params __attribute__((address_space(4))) * KP;

__device__ __forceinline__ float wave_sum(float v) {
#pragma unroll
    for (int o = 1; o < 64; o <<= 1) v += __shfl_xor(v, o);
    return v;
}

__device__ __forceinline__ void transpose_item(const float* __restrict__ W, int K, int N, bf16_t* __restrict__ WT, int item, int remap, LAS float* scr, int lane) {
    const int nblk = N / 32, kb = item / nblk, nb = item - kb * nblk, k0 = 64 * kb, n0 = 32 * nb;
    int drow0 = n0;
    if (remap) { const int bj = n0 / FH, nn = n0 - bj * FH; drow0 = (nn >> 7) * 256 + bj * 128 + (nn & 127); }
#pragma unroll 8
    for (int i = 0; i < 32; ++i) { const int kk = 2 * i + (lane >> 5); scr[kk * 33 + (lane & 31)] = W[(size_t)(k0 + kk) * N + n0 + (lane & 31)]; }
    asm volatile("s_waitcnt lgkmcnt(0)" ::: "memory");
    const int c = lane & 7;
#pragma unroll
    for (int j = 0; j < 4; ++j) { const int n = (lane >> 3) + 8 * j; const LAS float* s = scr + (8 * c) * 33 + n;
        u32x4 o; o.x = cvt_pk_bf16(s[0 * 33], s[1 * 33]); o.y = cvt_pk_bf16(s[2 * 33], s[3 * 33]); o.z = cvt_pk_bf16(s[4 * 33], s[5 * 33]); o.w = cvt_pk_bf16(s[6 * 33], s[7 * 33]);
        *(u32x4*)(WT + (size_t)(drow0 + n) * K + k0 + 8 * c) = o; }
    asm volatile("s_waitcnt lgkmcnt(0)" ::: "memory");
}

__device__ __forceinline__ void prologue_phase(KP p, LAS unsigned char* lds) {
    const int tid = opaque_tid(), lane = tid & 63, wave = tid >> 6, G = gridDim.x;
    unsigned char* ws = p->ws;
    {
        LAS float* cact = (LAS float*)lds;
        LAS float* red = (LAS float*)(lds + 32768);
        const float* c = p->in[1];
        for (int i = tid; i < 8192; i += 512) { const int b = i >> 10, k = i & 1023; const float x = c[i]; cact[k * 8 + b] = x / (1.0f + __expf(-x)); }
        __syncthreads();
        for (int task = blockIdx.x; task < 288; task += G) {
            const int idx = task * 128 + (tid & 127), kq = tid >> 7, l = idx / 9216, n = idx - l * 9216;
            const float* aw = p->in[12] + (size_t)l * 1024 * 9216 + n;
            float a[8];
#pragma unroll
            for (int b = 0; b < 8; ++b) a[b] = 0.f;
#pragma unroll 8
            for (int k = kq * 256; k < kq * 256 + 256; ++k) { const float w = aw[(size_t)k * 9216]; const f32x4 c0 = *(const LAS f32x4*)(cact + k * 8), c1 = *(const LAS f32x4*)(cact + k * 8 + 4);
                a[0] += c0[0] * w; a[1] += c0[1] * w; a[2] += c0[2] * w; a[3] += c0[3] * w; a[4] += c1[0] * w; a[5] += c1[1] * w; a[6] += c1[2] * w; a[7] += c1[3] * w; }
#pragma unroll
            for (int b = 0; b < 8; ++b) red[(kq * 8 + b) * 128 + (tid & 127)] = a[b];
            __syncthreads();
            if (kq == 0) { const float bias = p->in[13][idx]; float* mod = (float*)(ws + WS_MOD);
#pragma unroll
                for (int b = 0; b < 8; ++b) mod[((size_t)l * 8 + b) * 9216 + n] = ((red[b * 128 + tid] + red[(8 + b) * 128 + tid]) + (red[(16 + b) * 128 + tid] + red[(24 + b) * 128 + tid])) + bias; }
            __syncthreads();
        }
    }
    if (blockIdx.x == 72 % G) {
        const float* lg = p->in[5]; float* lb = (float*)(ws + WS_LB);
        for (int k = tid; k < 1024; k += 512) { const float a0 = lg[k], a1 = lg[1024 + k], a2 = lg[2048 + k], a3 = lg[3072 + k]; const float mx = fmaxf(fmaxf(a0, a1), fmaxf(a2, a3));
            const float e0 = __expf(a0 - mx), e1 = __expf(a1 - mx), e2 = __expf(a2 - mx), e3 = __expf(a3 - mx), inv = 1.0f / (e0 + e1 + e2 + e3);
            lb[k] = 0.f; lb[1024 + k] = e1 * inv; lb[2048 + k] = (e1 + e2) * inv; lb[3072 + k] = (e1 + e2 + e3) * inv; }
    }
    { const float* wsrc = p->in[3]; bf16_t* wst = (bf16_t*)(ws + WS_WST);
      for (int i = blockIdx.x * 512 + tid; i < 4 * 8 * 128 * 128 / 2; i += G * 512) { const int e = 2 * i, s = e & 127, t = (e >> 7) & 127;
          const float v0 = s <= t ? wsrc[e] : 0.f, v1 = (s + 1) <= t ? wsrc[e + 1] : 0.f; ((unsigned*)wst)[i] = cvt_pk_bf16(v0, v1); } }
    LAS float* scr = (LAS float*)(lds + 32768 + wave * 8704);
    const int gw = blockIdx.x * 8 + wave, NGW = G * 8;
    constexpr int I_IN = 16 * 256, I_13 = 16 * 176, I_2 = 44 * 32, I_SQ = 16 * 32, I_LAYER = I_IN + 2 * I_13 + 2 * I_2 + 3 * I_SQ;
    for (int it = gw; it < NL * I_LAYER; it += NGW) {
        const int l = it / I_LAYER; int r = it - l * I_LAYER;
        if (r < I_IN) { transpose_item(p->in[2] + (size_t)l * 1024 * 8192, 1024, 8192, (bf16_t*)(ws + WS_WIN) + (size_t)l * 8192 * 1024, r, 0, scr, lane); continue; } r -= I_IN;
        if (r < 2 * I_13) { const int s = r / I_13; r -= s * I_13; transpose_item(p->in[9] + (size_t)(l * 2 + s) * 1024 * 5632, 1024, 5632, (bf16_t*)(ws + WS_W13) + (size_t)(l * 2 + s) * 5632 * 1024, r, 1, scr, lane); continue; } r -= 2 * I_13;
        if (r < 2 * I_2) { const int s = r / I_2; r -= s * I_2; transpose_item(p->in[10] + (size_t)(l * 2 + s) * FH * 1024, FH, 1024, (bf16_t*)(ws + WS_W2) + (size_t)(l * 2 + s) * 1024 * FH, r, 0, scr, lane); continue; } r -= 2 * I_2;
        const int m = r / I_SQ; r -= m * I_SQ;
        const float* src = (m == 0 ? p->in[6] : (m == 1 ? p->in[7] : p->in[8])) + (size_t)l * 1024 * 1024;
        bf16_t* dst = (bf16_t*)(ws + (m == 0 ? WS_WA : (m == 1 ? WS_WB : WS_WO))) + (size_t)l * 1024 * 1024;
        transpose_item(src, 1024, 1024, dst, r, 0, scr, lane);
    }
}

template <bool FINAL> __device__ __forceinline__ void norm_phase(const float* hin, bf16_t* hn, float* fout, const float* nw, const float* modl  , int sub) {
    const int tid = opaque_tid(), lane = tid & 63, gw = blockIdx.x * 8 + (tid >> 6), NGW = gridDim.x * 8;
    f32x4 w4[4];
#pragma unroll
    for (int j = 0; j < 4; ++j) w4[j] = *(const f32x4*)(nw + 4 * lane + 256 * j);
    for (int row = gw; row < NT; row += NGW) {
        const float* xr = hin + (size_t)row * DM + 4 * lane;
        f32x4 v[4]; float s = 0.f;
#pragma unroll
        for (int j = 0; j < 4; ++j) { v[j] = *(const f32x4*)(xr + 256 * j); s += (v[j][0] * v[j][0] + v[j][1] * v[j][1]) + (v[j][2] * v[j][2] + v[j][3] * v[j][3]); }
        const float rstd = rsqrtf(wave_sum(s) * (1.0f / DM) + 1e-6f);
        if (FINAL) {
#pragma unroll
            for (int j = 0; j < 4; ++j) *(f32x4*)(fout + (size_t)row * DM + 4 * lane + 256 * j) = v[j] * rstd * w4[j];
        } else {
            const float* sh = modl + (size_t)(row >> 13) * 9216 + (3 * sub) * 1024 + 4 * lane; const float* sc = sh + 1024;
#pragma unroll
            for (int j = 0; j < 4; ++j) { const f32x4 a = *(const f32x4*)(sc + 256 * j), b = *(const f32x4*)(sh + 256 * j); const f32x4 o = v[j] * rstd * w4[j] * (a + 1.0f) + b;
                u32x2 w; w.x = cvt_pk_bf16(o[0], o[1]); w.y = cvt_pk_bf16(o[2], o[3]); *(u32x2*)(hn + (size_t)row * DM + 4 * lane + 256 * j) = w; }
        }
    }
}

__device__ __forceinline__ int tr64_off(int row, int col) { return row * 128 + ((((col >> 3) ^ (row ^ (row >> 3))) & 7) << 4) + ((col & 7) << 1); }
__device__ __forceinline__ int tr128_off(int row, int col) { return row * 256 + ((((col >> 3) ^ (row ^ (row >> 3))) & 15) << 4) + ((col & 7) << 1); }
constexpr int H_LF = 0, H_P = 0  , H_TOT = 32768, H_VEC = 34816, H_SS = 36864, H_QP = 38912, H_KP = 56320, H_KT = 73728, H_VT = 90112, H_ST = 106496, H_END = 141312;
static_assert(H_END <= LDS_BYTES, "LDS");
#define MFMA16(a, b, c) __builtin_amdgcn_mfma_f32_16x16x32_bf16((a), (b), (c), 0, 0, 0)

template <bool PRE> __device__ __forceinline__ void hgrn_seq(LAS unsigned char* lds, const bf16_t* __restrict__ Qb, const float* __restrict__ Fb, const bf16_t* __restrict__ Ib, const bf16_t* OGb, bf16_t* OUTb, size_t row_base, int colbase, int c0, int nch, float* Ubuf, float* Dbuf, int item0, int nprev) {
    const int tid = opaque_tid(), lane = tid & 63, w = __builtin_amdgcn_readfirstlane(tid >> 6), q4 = lane >> 4, l15 = lane & 15;
    const int pt = tid >> 4, pc8 = (tid & 15) * 8;
    LAS float* Lf = (LAS float*)(lds + H_LF); LAS float* Ltot = (LAS float*)(lds + H_TOT); LAS float* Lvec = (LAS float*)(lds + H_VEC); LAS float* Lss = (LAS float*)(lds + H_SS);
    f32x4 S[8];
#pragma unroll
    for (int i = 0; i < 8; ++i) S[i] = (f32x4){0.f, 0.f, 0.f, 0.f};
    if (!PRE) { for (int j = 0; j < nprev; ++j) { const float* Uj = Ubuf + (size_t)(item0 + j) * 16384; const f32x4 dj = *(const f32x4*)(Dbuf + (size_t)(item0 + j) * 128 + 16 * w + 4 * q4);
#pragma unroll
            for (int vt = 0; vt < 8; ++vt) S[vt] = S[vt] * dj + *(const f32x4*)(Uj + (vt * 512 + tid) * 4); } }
    float dacc = 1.0f;
    u32x4 rq[2], rv[2]; f32x4 rf[2][2];
#define HG_LOAD(c) do { _Pragma("unroll") for (int i_ = 0; i_ < 2; ++i_) { const size_t go_ = (row_base + (size_t)(c) * 64 + pt + 32 * i_) * 1024 + colbase + pc8; \
        if (!PRE) rq[i_] = *(const u32x4*)(Qb + go_); rv[i_] = *(const u32x4*)(Ib + go_); rf[i_][0] = *(const f32x4*)(Fb + go_); rf[i_][1] = *(const f32x4*)(Fb + go_ + 4); } } while (0)
    HG_LOAD(c0);
    for (int c = c0; c < c0 + nch; ++c) {
        u32x2 rog[4];
        if (!PRE) {
#pragma unroll
        for (int ti = 0; ti < 4; ++ti) rog[ti] = *(const u32x2*)(OGb + (row_base + (size_t)c * 64 + 16 * ti + l15) * 1024 + colbase + 16 * w + 4 * q4); }
#pragma unroll
        for (int i = 0; i < 2; ++i) { *(LAS f32x4*)(Lf + (pt + 32 * i) * 128 + pc8) = rf[i][0]; *(LAS f32x4*)(Lf + (pt + 32 * i) * 128 + pc8 + 4) = rf[i][1]; }
        __syncthreads();
        { const int k = tid & 127, seg = tid >> 7; float run = 0.f;
#pragma unroll
          for (int i = 0; i < 16; ++i) { const int idx = (16 * seg + i) * 128 + k; run += Lf[idx]; Lf[idx] = run; }
          Ltot[seg * 128 + k] = run; }
        __syncthreads();
        { const int k = tid & 127, seg = tid >> 7; const float t0 = Ltot[k], t1 = Ltot[128 + k], t2 = Ltot[256 + k], t3 = Ltot[384 + k];
          const float off = seg == 0 ? 0.f : (seg == 1 ? t0 : (seg == 2 ? t0 + t1 : t0 + t1 + t2));
          if (seg > 0) {
#pragma unroll
              for (int i = 0; i < 16; ++i) { const int idx = (16 * seg + i) * 128 + k; Lf[idx] += off; } }
          else { const float b31 = t0 + t1, b63 = b31 + t2 + t3; Lvec[k] = __expf(b31); Lvec[128 + k] = __expf(b63); Lvec[256 + k] = __expf(b63 - b31); Lvec[384 + k] = b31; } }
        __syncthreads();
#pragma unroll
        for (int i = 0; i < 2; ++i) { const int t = pt + 32 * i;
            const f32x4 b0 = *(const LAS f32x4*)(Lf + t * 128 + pc8), b1 = *(const LAS f32x4*)(Lf + t * 128 + pc8 + 4), r0 = *(const LAS f32x4*)(Lvec + 384 + pc8), r1 = *(const LAS f32x4*)(Lvec + 384 + pc8 + 4);
            unsigned qw[4] = {0u, 0u, 0u, 0u}; if (!PRE) { qw[0] = rq[i].x; qw[1] = rq[i].y; qw[2] = rq[i].z; qw[3] = rq[i].w; } const unsigned vw[4] = {rv[i].x, rv[i].y, rv[i].z, rv[i].w};
            float qp[8], kp[8];
#pragma unroll
            for (int j = 0; j < 8; ++j) { const float bb = j < 4 ? b0[j & 3] : b1[j & 3], rr = j < 4 ? r0[j & 3] : r1[j & 3], lf = j < 4 ? rf[i][0][j & 3] : rf[i][1][j & 3];
                const float d = fminf(fmaxf(bb - rr, -80.f), 80.f);
                if (!PRE) { const float qv = (j & 1) ? bf_hi(qw[j >> 1]) : bf_lo(qw[j >> 1]); qp[j] = qv * __expf(d); } else qp[j] = 0.f;
                kp[j] = (1.0f - __expf(lf)) * __expf(-d); }
            u32x4 wq, wk; wq.x = cvt_pk_bf16(qp[0], qp[1]); wq.y = cvt_pk_bf16(qp[2], qp[3]); wq.z = cvt_pk_bf16(qp[4], qp[5]); wq.w = cvt_pk_bf16(qp[6], qp[7]);
            wk.x = cvt_pk_bf16(kp[0], kp[1]); wk.y = cvt_pk_bf16(kp[2], kp[3]); wk.z = cvt_pk_bf16(kp[4], kp[5]); wk.w = cvt_pk_bf16(kp[6], kp[7]);
            if (!PRE) { *(LAS u32x4*)(lds + H_QP + t * 272 + pc8 * 2) = wq; *(LAS u32x4*)(lds + H_KP + t * 272 + pc8 * 2) = wk; }
            const unsigned kw[4] = {wk.x, wk.y, wk.z, wk.w};
#pragma unroll
            for (int j = 0; j < 8; ++j) { const unsigned short kk = (unsigned short)((j & 1) ? (kw[j >> 1] >> 16) : (kw[j >> 1] & 0xffffu)), vv = (unsigned short)((j & 1) ? (vw[j >> 1] >> 16) : (vw[j >> 1] & 0xffffu));
                *(LAS unsigned short*)(lds + H_KT + tr64_off(pc8 + j, t)) = kk; *(LAS unsigned short*)(lds + H_VT + tr64_off(pc8 + j, t)) = vv; } }
        if (PRE) { if (tid < 128) dacc *= Lvec[128 + tid]; }
        if (!PRE) { const f32x4 e4 = *(const LAS f32x4*)(Lvec + 16 * w + 4 * q4);
#pragma unroll
          for (int vt = 0; vt < 8; ++vt) { const f32x4 sv = S[vt] * e4; u32x2 o; o.x = cvt_pk_bf16(sv[0], sv[1]); o.y = cvt_pk_bf16(sv[2], sv[3]);
              *(LAS u32x2*)(lds + H_ST + (16 * vt + l15) * 272 + (16 * w + 4 * q4) * 2) = o; } }
        if (c + 1 < c0 + nch) HG_LOAD(c + 1);
        __syncthreads();
        f32x4 oT[4];
        if (!PRE) {
        { const int ti = w >> 1;
#pragma unroll
          for (int sj = 0; sj < 2; ++sj) { const int si = 2 * (w & 1) + sj; f32x4 a4 = (f32x4){0.f, 0.f, 0.f, 0.f};
              if (si <= ti) {
#pragma unroll
                  for (int kb = 0; kb < 4; ++kb) { const bf16x8 a = *(const LAS bf16x8*)(lds + H_KP + (16 * si + l15) * 272 + kb * 64 + q4 * 16), b = *(const LAS bf16x8*)(lds + H_QP + (16 * ti + l15) * 272 + kb * 64 + q4 * 16); a4 = MFMA16(a, b, a4); }
                  const int t = 16 * ti + l15, s0 = 16 * si + 4 * q4;
#pragma unroll
                  for (int r = 0; r < 4; ++r) a4[r] = (s0 + r <= t) ? a4[r] : 0.f; }
              u32x2 o; o.x = cvt_pk_bf16(a4[0], a4[1]); o.y = cvt_pk_bf16(a4[2], a4[3]);
              *(LAS u32x2*)(lds + H_P + (16 * ti + l15) * 144 + (16 * si + 4 * q4) * 2) = o; } }
#pragma unroll
        for (int ti = 0; ti < 4; ++ti) oT[ti] = (f32x4){0.f, 0.f, 0.f, 0.f};
#pragma unroll
        for (int kb = 0; kb < 4; ++kb) { const bf16x8 a = *(const LAS bf16x8*)(lds + H_ST + (16 * w + l15) * 272 + kb * 64 + q4 * 16);
#pragma unroll
            for (int ti = 0; ti < 4; ++ti) { const bf16x8 b = *(const LAS bf16x8*)(lds + H_QP + (16 * ti + l15) * 272 + kb * 64 + q4 * 16); oT[ti] = MFMA16(a, b, oT[ti]); } }
        __syncthreads();
        }
        { f32x4 U[8];
#pragma unroll
          for (int vt = 0; vt < 8; ++vt) U[vt] = (f32x4){0.f, 0.f, 0.f, 0.f};
#pragma unroll
          for (int kb = 0; kb < 2; ++kb) { const bf16x8 av = *(const LAS bf16x8*)(lds + H_VT + tr64_off(16 * w + l15, 32 * kb + 8 * q4)), ak = *(const LAS bf16x8*)(lds + H_KT + tr64_off(16 * w + l15, 32 * kb + 8 * q4));
#pragma unroll
              for (int ti = 0; ti < 4; ++ti) { if (!PRE) { const bf16x8 b = *(const LAS bf16x8*)(lds + H_P + (16 * ti + l15) * 144 + (32 * kb + 8 * q4) * 2); oT[ti] = MFMA16(av, b, oT[ti]); } }
#pragma unroll
              for (int vt = 0; vt < 8; ++vt) { const bf16x8 b = *(const LAS bf16x8*)(lds + H_VT + tr64_off(16 * vt + l15, 32 * kb + 8 * q4)); U[vt] = MFMA16(ak, b, U[vt]); } }
          const f32x4 d4 = *(const LAS f32x4*)(Lvec + 128 + 16 * w + 4 * q4), c4 = *(const LAS f32x4*)(Lvec + 256 + 16 * w + 4 * q4);
#pragma unroll
          for (int vt = 0; vt < 8; ++vt) S[vt] = S[vt] * d4 + U[vt] * c4; }
        if (!PRE) {
#pragma unroll
        for (int ti = 0; ti < 4; ++ti) { float ss = (oT[ti][0] * oT[ti][0] + oT[ti][1] * oT[ti][1]) + (oT[ti][2] * oT[ti][2] + oT[ti][3] * oT[ti][3]); ss += __shfl_xor(ss, 16); ss += __shfl_xor(ss, 32);
            if (q4 == 0) Lss[w * 64 + 16 * ti + l15] = ss; }
        __syncthreads();
#pragma unroll
        for (int ti = 0; ti < 4; ++ti) { const int t = 16 * ti + l15; float tot = 0.f;
#pragma unroll
            for (int ww = 0; ww < 8; ++ww) tot += Lss[ww * 64 + t];
            const float rs = rsqrtf(tot * (1.0f / 128.0f) + 1e-6f);
            u32x2 o; o.x = cvt_pk_bf16(oT[ti][0] * rs * bf_lo(rog[ti].x), oT[ti][1] * rs * bf_hi(rog[ti].x)); o.y = cvt_pk_bf16(oT[ti][2] * rs * bf_lo(rog[ti].y), oT[ti][3] * rs * bf_hi(rog[ti].y));
            *(u32x2*)(OUTb + (row_base + (size_t)c * 64 + t) * 1024 + colbase + 16 * w + 4 * q4) = o; }
        }
    }
    if (PRE) { float* Uo = Ubuf + (size_t)item0 * 16384;
#pragma unroll
        for (int vt = 0; vt < 8; ++vt) *(f32x4*)(Uo + (vt * 512 + tid) * 4) = S[vt];
        if (tid < 128) Dbuf[(size_t)item0 * 128 + tid] = dacc; }
    __syncthreads();
#undef HG_LOAD
}

__device__ __forceinline__ void gmlp_item(LAS unsigned char* lds, const bf16_t* __restrict__ Vb, const bf16_t* Ub, bf16_t* Ob, const bf16_t* __restrict__ Wt  , const float* __restrict__ bias  , size_t row0, int col0, int tid) {
     const int lane = tid & 63, w = __builtin_amdgcn_readfirstlane(tid >> 6), q4 = lane >> 4, l15 = lane & 15;
    const int ps = tid >> 4, pc8 = (tid & 15) * 8, nkb = (w >> 1) + 1;
    bf16x8 wf[4];
#pragma unroll
    for (int kb = 0; kb < 4; ++kb) if (kb < nkb) wf[kb] = *(const bf16x8*)(Wt + (16 * w + l15) * 128 + kb * 32 + q4 * 8);
#pragma unroll
    for (int i = 0; i < 4; ++i) { const int s = ps + 32 * i; const u32x4 raw = *(const u32x4*)(Vb + (row0 + s) * 1024 + col0 + pc8);
        float x[8] = {bf_lo(raw.x), bf_hi(raw.x), bf_lo(raw.y), bf_hi(raw.y), bf_lo(raw.z), bf_hi(raw.z), bf_lo(raw.w), bf_hi(raw.w)};
        float sm = ((x[0] + x[1]) + (x[2] + x[3])) + ((x[4] + x[5]) + (x[6] + x[7]));
        sm += __shfl_xor(sm, 1); sm += __shfl_xor(sm, 2); sm += __shfl_xor(sm, 4); sm += __shfl_xor(sm, 8);
        const float mu = sm * (1.0f / 128.0f); float vs = 0.f;
#pragma unroll
        for (int j = 0; j < 8; ++j) { x[j] -= mu; vs += x[j] * x[j]; }
        vs += __shfl_xor(vs, 1); vs += __shfl_xor(vs, 2); vs += __shfl_xor(vs, 4); vs += __shfl_xor(vs, 8);
        const float rstd = rsqrtf(vs * (1.0f / 128.0f) + 1e-6f);
#pragma unroll
        for (int j = 0; j < 4; ++j) { const unsigned pk = cvt_pk_bf16(x[2 * j] * rstd, x[2 * j + 1] * rstd);
            *(LAS unsigned short*)(lds + tr128_off(pc8 + 2 * j, s)) = (unsigned short)(pk & 0xffffu); *(LAS unsigned short*)(lds + tr128_off(pc8 + 2 * j + 1, s)) = (unsigned short)(pk >> 16); } }
    __syncthreads();
    f32x4 acc[8];
#pragma unroll
    for (int ct = 0; ct < 8; ++ct) acc[ct] = (f32x4){0.f, 0.f, 0.f, 0.f};
#pragma unroll
    for (int kb = 0; kb < 4; ++kb) if (kb < nkb) {
#pragma unroll
        for (int ct = 0; ct < 8; ++ct) { const bf16x8 a = *(const LAS bf16x8*)(lds + tr128_off(16 * ct + l15, 32 * kb + 8 * q4)); acc[ct] = MFMA16(a, wf[kb], acc[ct]); } }
    const int t = 16 * w + l15; const float bt = bias[t];
#pragma unroll
    for (int ct = 0; ct < 8; ++ct) { const size_t uo = (row0 + t) * 1024 + col0 + 16 * ct + 4 * q4; const u32x2 uu = *(const u32x2*)(Ub + uo);
        u32x2 o; o.x = cvt_pk_bf16(bf_lo(uu.x) * (acc[ct][0] + bt), bf_hi(uu.x) * (acc[ct][1] + bt)); o.y = cvt_pk_bf16(bf_lo(uu.y) * (acc[ct][2] + bt), bf_hi(uu.y) * (acc[ct][3] + bt));
        *(u32x2*)(Ob + uo) = o; }
    __syncthreads();
}

#define XB_TMO      128
#define XB_XCNT(j)  (256  + 64 * (j))
#define XB_XSUB(j)  (1280 + 64 * (j))
#define XB_XGEN(j)  (2304 + 64 * (j))
#define XB_TOP      3328
#define XB_TOPGEN   3392
#define XCD_BAR_WORDS 3456
#define XB_SPIN_CAP (1u << 18)

__device__ __forceinline__ unsigned xb_ld(unsigned* p)              { return __hip_atomic_load(p, __ATOMIC_RELAXED, __HIP_MEMORY_SCOPE_AGENT); }
__device__ __forceinline__ unsigned xb_add(unsigned* p, unsigned v) { return __hip_atomic_fetch_add(p, v, __ATOMIC_RELAXED, __HIP_MEMORY_SCOPE_AGENT); }
__device__ __forceinline__ unsigned xb_xcc_id() { return (unsigned)__builtin_amdgcn_s_getreg((3 << 11) | 20) & 0xFu; }
#define XB_SPIN(cond, bar) do { unsigned _sp = 0; while (cond) { __builtin_amdgcn_s_sleep(1); \
    if ((++_sp & 255u) == 0u) { if (xb_ld(&(bar)[XB_TMO])) break; if (_sp > XB_SPIN_CAP) { atomicAdd(&(bar)[XB_TMO], 1u); break; } } } } while (0)

struct XcdBarrier {
    unsigned* bar; unsigned x;
    volatile LAS unsigned* st;
};

__device__ __forceinline__ XcdBarrier xcd_barrier_post(unsigned* bar, volatile LAS unsigned* st) {
    XcdBarrier b; b.bar = bar; b.x = xb_xcc_id(); b.st = st;
    if (threadIdx.x == 0) (void)xb_add(&bar[XB_XCNT(b.x)], 1u);
    return b;
}
__device__ __forceinline__ void xcd_barrier_complete(unsigned* bar, unsigned x, unsigned& nloc, unsigned& nx) {
    const unsigned G = gridDim.x * gridDim.y * gridDim.z;
    unsigned sum, cnt, mine, sp = 0u;
    for (;;) {
        sum = 0u; cnt = 0u; mine = 0u;
#pragma unroll
        for (unsigned j = 0; j < 16; ++j) { const unsigned c = xb_ld(&bar[XB_XCNT(j)]); sum += c; cnt += (c > 0u) ? 1u : 0u; mine = (j == x) ? c : mine; }
        if (sum == G) break;
        __builtin_amdgcn_s_sleep(1);
        if ((++sp & 255u) == 0u) { if (xb_ld(&bar[XB_TMO])) break; if (sp > XB_SPIN_CAP) { atomicAdd(&bar[XB_TMO], 1u); break; } }
    }
    nloc = mine > 0u ? mine : 1u; nx = cnt > 0u ? cnt : 1u;
}

__device__ __forceinline__ void xcd_barrier(const XcdBarrier& b) {
    asm volatile("s_waitcnt vmcnt(0)" ::: "memory");
    __syncthreads();
    if (threadIdx.x == 0) {
        unsigned* bar = b.bar;
        __builtin_amdgcn_s_waitcnt(0);
        unsigned nloc = b.st[0], nx = b.st[1];
        if (nloc == 0u) { xcd_barrier_complete(bar, b.x, nloc, nx); b.st[0] = nloc; b.st[1] = nx; }
        const unsigned old = xb_add(&bar[XB_XSUB(b.x)], 1u);
        const unsigned gen = old / nloc;
        if (old + 1u == (gen + 1u) * nloc) {
            __builtin_amdgcn_fence(__ATOMIC_RELEASE, "agent");
            asm volatile("s_waitcnt vmcnt(0)" ::: "memory");
            const unsigned og = xb_add(&bar[XB_TOP], 1u);
            const unsigned tg = og / nx;
            if (og + 1u == (tg + 1u) * nx) xb_add(&bar[XB_TOPGEN], 1u);
            else XB_SPIN(xb_ld(&bar[XB_TOPGEN]) == tg, bar);
            __builtin_amdgcn_fence(__ATOMIC_ACQUIRE, "agent");
            xb_add(&bar[XB_XGEN(b.x)], 1u);
            asm volatile("s_waitcnt vmcnt(0)" ::: "memory");
        } else {
            XB_SPIN(xb_ld(&bar[XB_XGEN(b.x)]) == gen, bar);
            __builtin_amdgcn_fence(__ATOMIC_ACQUIRE, "agent");
            asm volatile("s_waitcnt vmcnt(0)" ::: "memory");
        }
    }
    __syncthreads();
}


__device__ __forceinline__ void flat_barrier(unsigned* bar, unsigned round) {
    asm volatile("s_waitcnt vmcnt(0)" ::: "memory");
    __syncthreads();
    if (threadIdx.x == 0) {
        __builtin_amdgcn_fence(__ATOMIC_RELEASE, "agent");
        asm volatile("s_waitcnt vmcnt(0)" ::: "memory");
        const unsigned G = gridDim.x, old = __hip_atomic_fetch_add(bar + 64, 1u, __ATOMIC_RELAXED, __HIP_MEMORY_SCOPE_AGENT);
        if (old + 1u == round * G) __hip_atomic_store(bar + 128, round, __ATOMIC_RELAXED, __HIP_MEMORY_SCOPE_AGENT);
        else { unsigned sp = 0; while (__hip_atomic_load(bar + 128, __ATOMIC_RELAXED, __HIP_MEMORY_SCOPE_AGENT) < round) { __builtin_amdgcn_s_sleep(2); if (++sp > (1u << 22)) break; } }
        __builtin_amdgcn_fence(__ATOMIC_ACQUIRE, "agent");
        asm volatile("s_waitcnt vmcnt(0)" ::: "memory");
    }
    __syncthreads();
}
constexpr int HSEG = 8, HCH = SEQ / 64 / HSEG;
#ifndef PHMASK
#define PHMASK 0xffff
#endif
__global__ void __launch_bounds__(512, 2) mk_fwd(Params p_arg) {
    extern __shared__ __attribute__((aligned(16))) unsigned char lds_raw[];
    LAS unsigned char* lds = (LAS unsigned char*)lds_raw;
    int pc = 0;
    { if (threadIdx.x == 0) { *(LAS u32x4*)(lds + XB_ST_OFF) = (u32x4){0u, 0u, 0u, 0u}; } __syncthreads();
      KP pp0 = (KP)__builtin_amdgcn_kernarg_segment_ptr(); if (blockIdx.x == 0) { unsigned* bar0 = (unsigned*)pp0->ws; for (int i = threadIdx.x; i < XCD_BAR_WORDS; i += 512) __hip_atomic_store(bar0 + i, 0u, __ATOMIC_RELAXED, __HIP_MEMORY_SCOPE_AGENT); } }
#define GETP KP pp = (KP)__builtin_amdgcn_kernarg_segment_ptr(); asm volatile("" : "+s"(pp))
#ifdef MK_TIME
    LAS unsigned long long* tacc = (LAS unsigned long long*)(lds + 143360); const bool timer = (blockIdx.x == 0 && threadIdx.x == 0); unsigned long long tph0 = 0, tph1 = 0; int tcls = 0;
    if (timer) { for (int i = 0; i < 16; ++i) tacc[i] = 0ull; }
#define T_BEGIN(c) if (timer) { tph0 = __builtin_amdgcn_s_memrealtime(); tcls = (c); }
#define T_MID if (timer) { tph1 = __builtin_amdgcn_s_memrealtime(); tacc[tcls] += tph1 - tph0; }
#define T_END if (timer) { tacc[15] += __builtin_amdgcn_s_memrealtime() - tph1; }
#else
#define T_BEGIN(c)
#define T_MID
#define T_END
#endif
#ifndef MK_DUP
#define MK_DUP 0
#endif
#define PH_BEGIN(bit, cls) { GETP; T_BEGIN(cls) if (pc >= pp->ph_lo && pc < pp->ph_hi && (PHMASK & (bit))) for (int rep_ = 0; rep_ < (((MK_DUP) & (bit)) ? 2 : 1); ++rep_) {
#define PH_END } } { GETP; T_MID ++pc; if (pc > pp->ph_lo && pc < pp->ph_hi) { if (pc == 1) { cg::this_grid().sync(); (void)xcd_barrier_post((unsigned*)pp->ws, (volatile LAS unsigned*)(lds + XB_ST_OFF)); } else { XcdBarrier xb_; xb_.bar = (unsigned*)pp->ws; xb_.x = xb_xcc_id(); xb_.st = (volatile LAS unsigned*)(lds + XB_ST_OFF); xcd_barrier(xb_); } } T_END }

    PH_BEGIN(1, 0) prologue_phase(pp, lds); PH_END

    for (int blk = 0; blk < 3 * NL; ++blk) {
        const int l = blk / 3, kind = blk - 3 * l;
        PH_BEGIN(2, 1) unsigned char* ws = pp->ws; const float* hin = (blk == 0) ? pp->in[0] : pp->out;
            norm_phase<false>(hin, (bf16_t*)(ws + WS_HN), nullptr, pp->in[11] + (size_t)(l * 3 + kind) * 1024, (const float*)(ws + WS_MOD) + (size_t)l * 8 * 9216, kind); PH_END
        if (kind != 1) {
            const int s = kind >> 1;
            PH_BEGIN(4, 2) unsigned char* ws = pp->ws;
                pg8::Gemm g{(const bf16_t*)(ws + WS_HN), (const bf16_t*)(ws + WS_W13) + (size_t)(l * 2 + s) * 5632 * 1024, NT, 5632, 1024}; pg8::StaticOrder S; S.init(NT, 5632, (int)gridDim.x, (int)blockIdx.x);
                pg8::EpiSwiGLU E{(bf16_t*)(ws + WS_BIG)}; pg8::gemm_phase<pg8::EpiSwiGLU, pg8::StaticOrder, false>(lds, g, S, E, nullptr); PH_END
            PH_BEGIN(8, 3) unsigned char* ws = pp->ws; const float* hin = (blk == 0) ? pp->in[0] : pp->out;
                pg8::Gemm g{(const bf16_t*)(ws + WS_BIG), (const bf16_t*)(ws + WS_W2) + (size_t)(l * 2 + s) * 1024 * FH, NT, 1024, FH}; pg8::StaticOrder S; S.init(NT, 1024, (int)gridDim.x, (int)blockIdx.x);
                pg8::EpiResid E{hin, pp->out, (const float*)(ws + WS_MOD) + (size_t)l * 8 * 9216 + (3 * kind + 2) * 1024, 0.5f}; pg8::gemm_phase<pg8::EpiResid, pg8::StaticOrder, false>(lds, g, S, E, nullptr); PH_END
        } else {
            for (int half = 0; half < 2; ++half) {
                PH_BEGIN(16, 4) unsigned char* ws = pp->ws;
                    pg8::Gemm g{(const bf16_t*)(ws + WS_HN) + (size_t)half * TH * 1024, (const bf16_t*)(ws + WS_WIN) + (size_t)l * 8192 * 1024, TH, 8192, 1024}; pg8::StaticOrder S; S.init(TH, 8192, (int)gridDim.x, (int)blockIdx.x);
                    pg8::EpiInproj E{(bf16_t*)(ws + WS_U), (bf16_t*)(ws + WS_V), (bf16_t*)(ws + WS_Q), (float*)(ws + WS_F), (bf16_t*)(ws + WS_I), (bf16_t*)(ws + WS_OG), (bf16_t*)(ws + WS_GA), (bf16_t*)(ws + WS_GB), (const float*)(ws + WS_LB) + l * 1024};
                    pg8::gemm_phase<pg8::EpiInproj, pg8::StaticOrder, false>(lds, g, S, E, nullptr); PH_END
                PH_BEGIN(32, 5) unsigned char* ws = pp->ws; const int G = (int)gridDim.x;
                    for (int it = (int)blockIdx.x; it < 32 * (HSEG - 1); it += G) { const int sq = it / (HSEG - 1), sg = it - sq * (HSEG - 1);
                        hgrn_seq<true>(lds, nullptr, (const float*)(ws + WS_F), (const bf16_t*)(ws + WS_I), nullptr, nullptr, (size_t)(sq >> 3) * SEQ, (sq & 7) * 128, sg * HCH, HCH, (float*)(ws + WS_HU), (float*)(ws + WS_HD), sq * HSEG + sg, 0); }
                    { const bf16_t* wst = (const bf16_t*)(ws + WS_WST) + (size_t)l * 8 * 128 * 128; const float* gb = pp->in[4] + (size_t)l * 8 * 128; const int tid = opaque_tid();
                        for (int it = (int)blockIdx.x; it < 4 * 64 * 8; it += G) { const int g8 = it & 7, ch = (it >> 3) & 63, bl = it >> 9;
                            gmlp_item(lds, (const bf16_t*)(ws + WS_V), (const bf16_t*)(ws + WS_U), (bf16_t*)(ws + ((MK_DUP & 32) && rep_ == 0 ? WS_END : WS_U)), wst + g8 * 128 * 128, gb + g8 * 128, (size_t)bl * SEQ + ch * 128, g8 * 128, tid); } }
                PH_END
                PH_BEGIN(64, 6) unsigned char* ws = pp->ws; const int G = (int)gridDim.x;
                    for (int it = (int)blockIdx.x; it < 32 * HSEG; it += G) { const int sq = it / HSEG, sg = it - sq * HSEG;
                        hgrn_seq<false>(lds, (const bf16_t*)(ws + WS_Q), (const float*)(ws + WS_F), (const bf16_t*)(ws + WS_I), (const bf16_t*)(ws + WS_OG), (bf16_t*)(ws + ((MK_DUP & 64) && rep_ == 0 ? WS_END : WS_OG)), (size_t)(sq >> 3) * SEQ, (sq & 7) * 128, sg * HCH, HCH, (float*)(ws + WS_HU), (float*)(ws + WS_HD), sq * HSEG, sg); }
                PH_END
                PH_BEGIN(128, 7) unsigned char* ws = pp->ws;
                    pg8::Gemm g{(const bf16_t*)(ws + WS_U), (const bf16_t*)(ws + WS_WA) + (size_t)l * 1024 * 1024, TH, 1024, 1024}; pg8::StaticOrder S; S.init(TH, 1024, (int)gridDim.x, (int)blockIdx.x);
                    pg8::EpiBranch<0> E{(const bf16_t*)(ws + WS_GA), nullptr, (bf16_t*)(ws + WS_V)}; pg8::gemm_phase<pg8::EpiBranch<0>, pg8::StaticOrder, false>(lds, g, S, E, nullptr); PH_END
                PH_BEGIN(256, 8) unsigned char* ws = pp->ws;
                    pg8::Gemm g{(const bf16_t*)(ws + WS_OG), (const bf16_t*)(ws + WS_WB) + (size_t)l * 1024 * 1024, TH, 1024, 1024}; pg8::StaticOrder S; S.init(TH, 1024, (int)gridDim.x, (int)blockIdx.x);
                    pg8::EpiBranch<1> E{(const bf16_t*)(ws + WS_GB), (const bf16_t*)(ws + WS_V), (bf16_t*)(ws + WS_Q)}; pg8::gemm_phase<pg8::EpiBranch<1>, pg8::StaticOrder, false>(lds, g, S, E, nullptr); PH_END
                PH_BEGIN(512, 9) unsigned char* ws = pp->ws; float* hh = pp->out + (size_t)half * TH * 1024;
                    pg8::Gemm g{(const bf16_t*)(ws + WS_Q), (const bf16_t*)(ws + WS_WO) + (size_t)l * 1024 * 1024, TH, 1024, 1024}; pg8::StaticOrder S; S.init(TH, 1024, (int)gridDim.x, (int)blockIdx.x);
                    pg8::EpiResid E{hh, hh, (const float*)(ws + WS_MOD) + (size_t)l * 8 * 9216 + (size_t)(half * 4) * 9216 + 5 * 1024, 1.0f}; pg8::gemm_phase<pg8::EpiResid, pg8::StaticOrder, false>(lds, g, S, E, nullptr); PH_END
            }
        }
    }
    PH_BEGIN(1024, 10) norm_phase<true>(pp->out, nullptr, pp->out, pp->in[14], nullptr, 0); PH_END
#ifdef MK_TIME
    __syncthreads(); asm volatile("s_waitcnt vmcnt(0)" ::: "memory");
    if (timer) { GETP; unsigned long long a = 0, b = 0; for (int i = 0; i < 16; ++i) { if ((MK_TA >> i) & 1) a += tacc[i]; if ((MK_TB >> i) & 1) b += tacc[i]; }
        const float V = (float)a * 0.01f; int n = (int)((float)b * 0.01f / 20.0f); if (n < 1) n = 1; if (n > 1024) n = 1024;
        float* o = pp->out; for (int i = 0; i < n; ++i) o[i] = V; }
#endif
}
constexpr int N_PHASES = 1 + NL * (3 + 4 + 12) + 1;

extern "C" void kernel_launch(void* const* d_in, const int* in_sizes, int n_in, void* d_out, int out_size, void* d_ws, size_t ws_size, hipStream_t stream) {
    static int grid = 0;
    if (grid == 0) {
        if (n_in != 15 || out_size != NT * DM || ws_size < WS_END) { fprintf(stderr, "kernel_launch: unexpected shapes (n_in %d, out %d, ws %zu < %zu)\n", n_in, out_size, ws_size, (size_t)WS_END); grid = -1; return; }
        int dev = 0, cus = 0, per_cu = 0;
        hipGetDevice(&dev); hipDeviceGetAttribute(&cus, hipDeviceAttributeMultiprocessorCount, dev);
        if (hipFuncSetAttribute((const void*)mk_fwd, hipFuncAttributeMaxDynamicSharedMemorySize, LDS_BYTES) != hipSuccess) { fprintf(stderr, "kernel_launch: hipFuncSetAttribute failed\n"); grid = -1; return; }
        if (hipOccupancyMaxActiveBlocksPerMultiprocessor(&per_cu, (const void*)mk_fwd, 512, LDS_BYTES) != hipSuccess || per_cu < 1) { fprintf(stderr, "kernel_launch: occupancy query says %d\n", per_cu); per_cu = 1; }
        (void)hipGetLastError();
        grid = cus * 1;
    }
    if (grid < 0) return;
    Params p{};
    for (int i = 0; i < 15; ++i) p.in[i] = (const float*)d_in[i];
    p.out = (float*)d_out; p.ws = (unsigned char*)d_ws;
#if MK_COOP
    p.ph_lo = 0; p.ph_hi = N_PHASES;
    void* args[] = {&p};
    hipError_t e = hipLaunchCooperativeKernel((const void*)mk_fwd, dim3(grid), dim3(512), args, LDS_BYTES, stream);
    if (e != hipSuccess) fprintf(stderr, "cooperative launch failed: %s (grid %d)\n", hipGetErrorString(e), grid);
#else
    for (int i = 0; i < N_PHASES; ++i) { p.ph_lo = i; p.ph_hi = i + 1; hipLaunchKernelGGL(mk_fwd, dim3(grid), dim3(512), LDS_BYTES, stream, p); }
#endif
}
```

```cpp
#include <hip/hip_runtime.h>
#include <hip/hip_cooperative_groups.h>
#include <cstdio>
namespace cg = cooperative_groups;
#ifndef MK_COOP
#define MK_COOP 1
#endif
namespace pg8 {
#define PG8_LAS __attribute__((address_space(3)))
typedef unsigned short bf16_t;
typedef short bf16x8 __attribute__((ext_vector_type(8)));
typedef float f32x4 __attribute__((ext_vector_type(4)));
typedef unsigned u32x4 __attribute__((ext_vector_type(4)));
constexpr int BM = 256, BK = 64, HALF = 128, HTB = HALF * BK * 2  , STAGE_BYTES = 8 * HTB, NXCD = 8, WGM = 8;

__host__ __device__ __forceinline__ int lds_byte(int r, int c) { const int st = (r >> 4) * 2 + (c >> 5), rr = r & 15, cc = c & 31, ob = rr * 64 + cc * 2; return st * 1024 + (ob ^ (((ob >> 9) & 1) << 5)); }
__host__ __device__ __forceinline__ void stage_rc(int b, int& R, int& C) { const int st = b / 1024, sb = b % 1024, swz = sb ^ (((sb >> 9) & 1) << 5); R = (st >> 1) * 16 + swz / 64; C = (st & 1) * 32 + (swz % 64) / 2; }
__host__ __device__ __forceinline__ int perm32(int rho) { const int n = rho >> 4, i = rho & 15; return 8 * (i >> 2) + 4 * n + (i & 3); }

struct Unit { int pm, pn, part; };
struct Gemm { const bf16_t* A; const bf16_t* Bt; int M, N, K; };

struct StaticOrder {
    int nM, nN, nwg, G, c;
    __host__ __device__ void init(int M, int N, int G_, int c_) { nM = M / BM; nN = N / BM; nwg = nM * nN; G = G_; c = c_; }
    __host__ __device__ bool next(int i, Unit& u) const {
        const long L = (long)i * G + c; if (L >= nwg) return false;
        int wgid = (int)L; { const int q = nwg / NXCD, r = nwg % NXCD, xcd = wgid % NXCD, off = wgid / NXCD; wgid = (xcd < r ? xcd * (q + 1) : r * (q + 1) + (xcd - r) * q) + off; }
        const int nig = WGM * nN, gid = wgid / nig, fm = gid * WGM, gsz = (nM - fm) < WGM ? (nM - fm) : WGM;
        u.pm = fm + ((wgid % nig) % gsz); u.pn = (wgid % nig) / gsz; u.part = 0; return true;
    }
    __device__ __forceinline__ void a_ready(const Unit&) const {}
    __device__ __forceinline__ void done(const Unit&) const {}
    __device__ __forceinline__ const char* a_ptr(const Gemm& g, const Unit& u, size_t tstep) const { return (const char*)g.A + (size_t)u.pm * tstep; }
    __device__ __forceinline__ const char* b_ptr(const Gemm& g, const Unit& u, size_t tstep) const { return (const char*)g.Bt + (size_t)u.pn * tstep; }
};
__device__ __forceinline__ int opaque_tid() { int t = threadIdx.x; asm volatile("" : "+v"(t)); return t; }
typedef __bf16 bf16x2_t __attribute__((ext_vector_type(2)));
typedef float f32x2_t __attribute__((ext_vector_type(2)));
__device__ __forceinline__ unsigned cvt_pk_bf16(float lo, float hi) { const f32x2_t v = {lo, hi}; const bf16x2_t b = __builtin_convertvector(v, bf16x2_t); return __builtin_bit_cast(unsigned, b); }
__device__ __forceinline__ float bf_lo(unsigned w) { return __uint_as_float(w << 16); }
__device__ __forceinline__ float bf_hi(unsigned w) { return __uint_as_float(w & 0xffff0000u); }
template <int ACT> __device__ __forceinline__ float actf(float x) {
    if (ACT == 0) return x;
    if (ACT == 1) { const float u = 1.5957691216f * (x + 0.044715f * x * x * x); return x * __builtin_amdgcn_rcpf(1.0f + __expf(-u)); }
    if (ACT == 2) return x * __builtin_amdgcn_rcpf(1.0f + __expf(-x));
    return __builtin_amdgcn_rcpf(1.0f + __expf(-x));
}
struct EpiSwiGLU {
    static constexpr bool PERM = true, AFTER_DRAIN = false, TWO_PART = false;
    bf16_t* O;
    __device__ __forceinline__ void operator()(const f32x4 (&acc)[2][2][4][2], const Unit& u, int wr, int wc, int fr, int fq) const {
        const int row0 = u.pm * BM + wr * 64 + fr, col0 = u.pn * HALF + wc * 32 + 8 * fq;
#pragma unroll
        for (int ai = 0; ai < 2; ++ai)
#pragma unroll
            for (int m = 0; m < 4; ++m) {
                const f32x4 a0 = acc[ai][0][m][0], a1 = acc[ai][0][m][1], b0 = acc[ai][1][m][0], b1 = acc[ai][1][m][1];
                float v[8];
#pragma unroll
                for (int j = 0; j < 4; ++j) { v[j] = actf<2>(a0[j]) * b0[j]; v[4 + j] = actf<2>(a1[j]) * b1[j]; }
                u32x4 w; w.x = cvt_pk_bf16(v[0], v[1]); w.y = cvt_pk_bf16(v[2], v[3]); w.z = cvt_pk_bf16(v[4], v[5]); w.w = cvt_pk_bf16(v[6], v[7]);
                *(u32x4*)(O + (size_t)(row0 + ai * HALF + m * 16) * 2816 + col0) = w;
            }
    }
};
struct EpiResid {
    static constexpr bool PERM = false, AFTER_DRAIN = false, TWO_PART = false;
    const float* hin; float* hout; const float* gmod; float scale;
    __device__ __forceinline__ void operator()(const f32x4 (&acc)[2][2][4][2], const Unit& u, int wr, int wc, int fr, int fq) const {
        const int row0 = u.pm * BM + wr * 64 + fr, col0 = u.pn * BM + wc * 32 + 4 * fq;
        const float* gp = gmod + (size_t)((u.pm * BM) >> 13) * 9216 + col0;
        f32x4 cf[2][2];
#pragma unroll
        for (int bj = 0; bj < 2; ++bj)
#pragma unroll
            for (int n = 0; n < 2; ++n) { const f32x4 g = *(const f32x4*)(gp + bj * HALF + n * 16); cf[bj][n] = (g + 1.0f) * scale; }
#pragma unroll
        for (int ai = 0; ai < 2; ++ai) {
            f32x4 hv[4][2][2];
#pragma unroll
            for (int m = 0; m < 4; ++m) { const size_t off = (size_t)(row0 + ai * HALF + m * 16) * 1024 + col0;
#pragma unroll
                for (int bj = 0; bj < 2; ++bj)
#pragma unroll
                    for (int n = 0; n < 2; ++n) hv[m][bj][n] = *(const f32x4*)(hin + off + bj * HALF + n * 16); }
#pragma unroll
            for (int m = 0; m < 4; ++m) { const size_t off = (size_t)(row0 + ai * HALF + m * 16) * 1024 + col0;
#pragma unroll
                for (int bj = 0; bj < 2; ++bj)
#pragma unroll
                    for (int n = 0; n < 2; ++n) *(f32x4*)(hout + off + bj * HALF + n * 16) = hv[m][bj][n] + cf[bj][n] * acc[ai][bj][m][n]; }
            asm volatile("" ::: "memory"); }
    }
};
struct EpiInproj {
    static constexpr bool PERM = true, AFTER_DRAIN = false, TWO_PART = false;
    bf16_t* U; bf16_t* V; bf16_t* Q; float* F; bf16_t* I; bf16_t* OG; bf16_t* GA; bf16_t* GB; const float* lb;
    template <int ACT> __device__ __forceinline__ void st16(const f32x4 (&acc)[2][2][4][2], bf16_t* dst, int row0, int colg) const {
#pragma unroll
        for (int ai = 0; ai < 2; ++ai)
#pragma unroll
            for (int m = 0; m < 4; ++m)
#pragma unroll
                for (int bj = 0; bj < 2; ++bj) { const f32x4 v0 = acc[ai][bj][m][0], v1 = acc[ai][bj][m][1];
                    u32x4 w; w.x = cvt_pk_bf16(actf<ACT>(v0[0]), actf<ACT>(v0[1])); w.y = cvt_pk_bf16(actf<ACT>(v0[2]), actf<ACT>(v0[3]));
                    w.z = cvt_pk_bf16(actf<ACT>(v1[0]), actf<ACT>(v1[1])); w.w = cvt_pk_bf16(actf<ACT>(v1[2]), actf<ACT>(v1[3]));
                    *(u32x4*)(dst + (size_t)(row0 + ai * HALF + m * 16) * 1024 + colg + bj * HALF) = w; }
    }
    __device__ __forceinline__ void operator()(const f32x4 (&acc)[2][2][4][2], const Unit& u, int wr, int wc, int fr, int fq) const {
        const int grp = u.pn >> 2, colg = (u.pn & 3) * BM + wc * 32 + 8 * fq, row0 = u.pm * BM + wr * 64 + fr;
        if (grp == 3) {
#pragma unroll
            for (int bj = 0; bj < 2; ++bj) { const f32x4 l0 = *(const f32x4*)(lb + colg + bj * HALF), l1 = *(const f32x4*)(lb + colg + bj * HALF + 4);
#pragma unroll
                for (int ai = 0; ai < 2; ++ai)
#pragma unroll
                    for (int m = 0; m < 4; ++m) { const f32x4 v0 = acc[ai][bj][m][0], v1 = acc[ai][bj][m][1]; f32x4 o0, o1;
#pragma unroll
                        for (int j = 0; j < 4; ++j) { o0[j] = __logf(fmaxf(l0[j] + (1.0f - l0[j]) * actf<3>(v0[j]), 1e-30f)); o1[j] = __logf(fmaxf(l1[j] + (1.0f - l1[j]) * actf<3>(v1[j]), 1e-30f)); }
                        float* d = F + (size_t)(row0 + ai * HALF + m * 16) * 1024 + colg + bj * HALF; *(f32x4*)d = o0; *(f32x4*)(d + 4) = o1; } }
        } else if (grp < 2) st16<1>(acc, grp == 0 ? U : V, row0, colg);
        else if (grp == 2) st16<2>(acc, Q, row0, colg);
        else if (grp == 4) st16<0>(acc, I, row0, colg);
        else st16<3>(acc, grp == 5 ? OG : (grp == 6 ? GA : GB), row0, colg);
    }
};
template <int MODE> struct EpiBranch {
    static constexpr bool PERM = true, AFTER_DRAIN = false, TWO_PART = false;
    const bf16_t* G; const bf16_t* P; bf16_t* O;
    __device__ __forceinline__ void operator()(const f32x4 (&acc)[2][2][4][2], const Unit& u, int wr, int wc, int fr, int fq) const {
        const int row0 = u.pm * BM + wr * 64 + fr, col0 = u.pn * BM + wc * 32 + 8 * fq;
#pragma unroll
        for (int ai = 0; ai < 2; ++ai)
#pragma unroll
            for (int m = 0; m < 4; ++m)
#pragma unroll
                for (int bj = 0; bj < 2; ++bj) { const size_t off = (size_t)(row0 + ai * HALF + m * 16) * 1024 + col0 + bj * HALF;
                    const u32x4 g = *(const u32x4*)(G + off); const f32x4 v0 = acc[ai][bj][m][0], v1 = acc[ai][bj][m][1];
                    float r[8] = { bf_lo(g.x) * v0[0], bf_hi(g.x) * v0[1], bf_lo(g.y) * v0[2], bf_hi(g.y) * v0[3], bf_lo(g.z) * v1[0], bf_hi(g.z) * v1[1], bf_lo(g.w) * v1[2], bf_hi(g.w) * v1[3] };
                    if (MODE == 1) { const u32x4 p = *(const u32x4*)(P + off);
                        r[0] += bf_lo(p.x); r[1] += bf_hi(p.x); r[2] += bf_lo(p.y); r[3] += bf_hi(p.y); r[4] += bf_lo(p.z); r[5] += bf_hi(p.z); r[6] += bf_lo(p.w); r[7] += bf_hi(p.w); }
                    u32x4 w; w.x = cvt_pk_bf16(r[0], r[1]); w.y = cvt_pk_bf16(r[2], r[3]); w.z = cvt_pk_bf16(r[4], r[5]); w.w = cvt_pk_bf16(r[6], r[7]);
                    *(u32x4*)(O + off) = w; }
    }
};

struct EpiBranchFused {
    static constexpr bool PERM = true, AFTER_DRAIN = false, TWO_PART = true;
    const bf16_t* GA; const bf16_t* GB; bf16_t* O;
    __device__ __forceinline__ void mid(f32x4 (&acc)[2][2][4][2], const Unit& u, int wr, int wc, int fr, int fq) const {
        const int row0 = u.pm * BM + wr * 64 + fr, col0 = u.pn * BM + wc * 32 + 8 * fq;
#pragma unroll
        for (int ai = 0; ai < 2; ++ai)
#pragma unroll
            for (int m = 0; m < 4; ++m)
#pragma unroll
                for (int bj = 0; bj < 2; ++bj) { const size_t off = (size_t)(row0 + ai * HALF + m * 16) * 1024 + col0 + bj * HALF;
                    const u32x4 a = *(const u32x4*)(GA + off), b = *(const u32x4*)(GB + off);
                    const float ra[8] = {bf_lo(a.x), bf_hi(a.x), bf_lo(a.y), bf_hi(a.y), bf_lo(a.z), bf_hi(a.z), bf_lo(a.w), bf_hi(a.w)}, rb[8] = {bf_lo(b.x), bf_hi(b.x), bf_lo(b.y), bf_hi(b.y), bf_lo(b.z), bf_hi(b.z), bf_lo(b.w), bf_hi(b.w)};
#pragma unroll
                    for (int j = 0; j < 4; ++j) { acc[ai][bj][m][0][j] *= ra[j] / fmaxf(rb[j], 1e-6f); acc[ai][bj][m][1][j] *= ra[4 + j] / fmaxf(rb[4 + j], 1e-6f); } }
    }
    __device__ __forceinline__ void operator()(const f32x4 (&acc)[2][2][4][2], const Unit& u, int wr, int wc, int fr, int fq) const {
        const int row0 = u.pm * BM + wr * 64 + fr, col0 = u.pn * BM + wc * 32 + 8 * fq;
#pragma unroll
        for (int ai = 0; ai < 2; ++ai)
#pragma unroll
            for (int m = 0; m < 4; ++m)
#pragma unroll
                for (int bj = 0; bj < 2; ++bj) { const size_t off = (size_t)(row0 + ai * HALF + m * 16) * 1024 + col0 + bj * HALF;
                    const u32x4 b = *(const u32x4*)(GB + off); const f32x4 v0 = acc[ai][bj][m][0], v1 = acc[ai][bj][m][1];
                    const float rb[8] = {bf_lo(b.x), bf_hi(b.x), bf_lo(b.y), bf_hi(b.y), bf_lo(b.z), bf_hi(b.z), bf_lo(b.w), bf_hi(b.w)};
                    u32x4 w; w.x = cvt_pk_bf16(fmaxf(rb[0], 1e-6f) * v0[0], fmaxf(rb[1], 1e-6f) * v0[1]); w.y = cvt_pk_bf16(fmaxf(rb[2], 1e-6f) * v0[2], fmaxf(rb[3], 1e-6f) * v0[3]);
                    w.z = cvt_pk_bf16(fmaxf(rb[4], 1e-6f) * v1[0], fmaxf(rb[5], 1e-6f) * v1[1]); w.w = cvt_pk_bf16(fmaxf(rb[6], 1e-6f) * v1[2], fmaxf(rb[7], 1e-6f) * v1[3]);
                    *(u32x4*)(O + off) = w; }
    }
};
struct BranchOrder : StaticOrder {
    const bf16_t* A2; const bf16_t* Bt2;
    __device__ __forceinline__ bool next(int i, Unit& u) const { const bool ok = StaticOrder::next(i >> 1, u); u.part = i & 1; return ok; }
    __device__ __forceinline__ const char* a_ptr(const Gemm& g, const Unit& u, size_t tstep) const { return (const char*)(u.part ? A2 : g.A) + (size_t)u.pm * tstep; }
    __device__ __forceinline__ const char* b_ptr(const Gemm& g, const Unit& u, size_t tstep) const { return (const char*)(u.part ? Bt2 : g.Bt) + (size_t)u.pn * tstep; }
};
struct SplitAOrder : StaticOrder {
    const bf16_t* A1;
    __device__ __forceinline__ const char* a_ptr(const Gemm& g, const Unit& u, size_t tstep) const { return u.pm < 128 ? (const char*)g.A + (size_t)u.pm * tstep : (const char*)A1 + (size_t)(u.pm - 128) * tstep; }
};

template <class Epi, class Sched, bool STAMP = false>
__device__ __forceinline__ void gemm_phase(PG8_LAS unsigned char* lds, const Gemm g, const Sched& S, const Epi& E, unsigned long long* stamps) {
    const int tid = opaque_tid(), wid = __builtin_amdgcn_readfirstlane(tid >> 6), lane = tid & 63, wr = wid >> 2, wc = wid & 3, fr = lane & 15, fq = lane >> 4;
    const int K = g.K, nt = K / BK;
    int ts_lo = 0, ts_hi = 0, nts = 0; const unsigned long long rt_entry = STAMP ? (unsigned long long)wall_clock64() : 0ull;
#define PG8_STAMP() do { if (STAMP && wid == 0 && nts < 64) { const unsigned long long _c = (unsigned long long)clock64(); \
        ts_lo = (lane == nts) ? (int)(unsigned)_c : ts_lo; ts_hi = (lane == nts) ? (int)(unsigned)(_c >> 32) : ts_hi; ++nts; } } while (0)
    PG8_STAMP();
    unsigned voffA[2], voffB[2];
#pragma unroll
    for (int i = 0; i < 2; ++i) { int R, C; stage_rc(tid * 16 + i * 8192, R, C); const int Rb = Epi::PERM ? ((R & ~31) + perm32(R & 31)) : R;
        voffA[i] = (unsigned)(R * K + C) * 2u; voffB[i] = (unsigned)(Rb * K + C) * 2u; }
    const size_t kstep = (size_t)(BK * 2);
    const size_t hstep = (size_t)HALF * K * 2;
    const size_t tstep = 2 * hstep;
    const unsigned ldsw = (unsigned)wid * 1024u;
    const int aoff = lds_byte(wr * 64 + fr, fq * 8), boff = lds_byte(wc * 32 + fr, fq * 8);
#define PG8_SA(b, h) (((b) * 2 + (h)) * HTB)
#define PG8_SB(b, h) ((4 + (b) * 2 + (h)) * HTB)
#define PG8_STAGE(bufoff, gbase, voff) do { _Pragma("unroll") for (int _i = 0; _i < 2; ++_i) \
        __builtin_amdgcn_global_load_lds((const unsigned*)((const char*)(gbase) + (voff)[_i]), (PG8_LAS unsigned*)(lds + (bufoff) + ldsw + _i * 8192), 16, 0, 0); } while (0)
#define PG8_LDA(dst, b, h) do { _Pragma("unroll") for (int m = 0; m < 4; ++m) _Pragma("unroll") for (int k = 0; k < 2; ++k) dst[m][k] = *(const PG8_LAS bf16x8*)(lds + PG8_SA(b, h) + aoff + m * 2048 + k * 1024); } while (0)
#define PG8_LDB(dst, b, h) do { _Pragma("unroll") for (int n = 0; n < 2; ++n) _Pragma("unroll") for (int k = 0; k < 2; ++k) dst[n][k] = *(const PG8_LAS bf16x8*)(lds + PG8_SB(b, h) + boff + n * 2048 + k * 1024); } while (0)
#define PG8_MMA(ai, bj, At, Bt) do { __builtin_amdgcn_s_setprio(1); _Pragma("unroll") for (int m = 0; m < 4; ++m) _Pragma("unroll") for (int n = 0; n < 2; ++n) _Pragma("unroll") for (int k = 0; k < 2; ++k) \
        acc[ai][bj][m][n] = __builtin_amdgcn_mfma_f32_16x16x32_bf16(Bt[n][k], At[m][k], acc[ai][bj][m][n], 0, 0, 0); __builtin_amdgcn_s_setprio(0); } while (0)
#define PG8_WAIT_V(n) asm volatile("s_waitcnt vmcnt(" #n ")" ::: "memory")
#define PG8_WAIT_L(n) asm volatile("s_waitcnt lgkmcnt(" #n ")" ::: "memory")
#define PG8_BAR __builtin_amdgcn_s_barrier()
#define PG8_SCHED __builtin_amdgcn_sched_barrier(0)
    Unit cur, nxt; int ui = 0;
    if (!S.next(0, cur)) return;
    f32x4 acc[2][2][4][2];
#pragma unroll
    for (int a = 0; a < 2; ++a)
#pragma unroll
        for (int b = 0; b < 2; ++b)
#pragma unroll
            for (int m = 0; m < 4; ++m)
#pragma unroll
                for (int n = 0; n < 2; ++n) acc[a][b][m][n] = (f32x4){0.f, 0.f, 0.f, 0.f};
    bf16x8 At[4][2], B0[2][2], B1[2][2];
    const char* cA = S.a_ptr(g, cur, tstep); const char* cB = S.b_ptr(g, cur, tstep);
    S.a_ready(cur);
    PG8_STAGE(PG8_SB(0, 0), cB, voffB); PG8_STAGE(PG8_SA(0, 0), cA, voffA); PG8_STAGE(PG8_SB(0, 1), cB + hstep, voffB); PG8_STAGE(PG8_SA(0, 1), cA + hstep, voffA);
    if (wr == 1) PG8_BAR;
    PG8_WAIT_V(4); PG8_BAR;
    PG8_STAGE(PG8_SB(1, 0), cB + kstep, voffB); PG8_STAGE(PG8_SA(1, 0), cA + kstep, voffA); PG8_STAGE(PG8_SB(1, 1), cB + hstep + kstep, voffB);
    PG8_WAIT_V(6); PG8_BAR;
    PG8_STAMP();
    for (;;) {
        const bool has_next = S.next(ui + 1, nxt);
        const char* nA = has_next ? S.a_ptr(g, nxt, tstep) : cA; const char* nB = has_next ? S.b_ptr(g, nxt, tstep) : cB;
        for (int t = 0; t < nt; t += 2) {
            const bool last = (t == nt - 2);
            const char* a1 = cA + (size_t)(t + 1) * kstep;
            const char* a2 = last ? nA : cA + (size_t)(t + 2) * kstep; const char* b2 = last ? nB : cB + (size_t)(t + 2) * kstep;
            const char* a3 = a2 + kstep; const char* b3 = b2 + kstep;
            if (last && has_next) S.a_ready(nxt);
            PG8_LDB(B0, 0, 0); PG8_SCHED; PG8_LDA(At, 0, 0); PG8_STAGE(PG8_SA(1, 1), a1 + hstep, voffA);
            PG8_WAIT_L(8); PG8_BAR; PG8_WAIT_L(0); PG8_MMA(0, 0, At, B0); PG8_BAR; PG8_SCHED;
            PG8_LDB(B1, 0, 1); PG8_STAGE(PG8_SB(0, 0), b2, voffB);
            PG8_BAR; PG8_WAIT_L(0); PG8_MMA(0, 1, At, B1); PG8_BAR;
            PG8_LDA(At, 0, 1); PG8_STAGE(PG8_SA(0, 0), a2, voffA);
            PG8_BAR; PG8_WAIT_L(0); PG8_MMA(1, 0, At, B0); PG8_BAR; PG8_SCHED;
            PG8_STAGE(PG8_SB(0, 1), b2 + hstep, voffB);
            PG8_WAIT_V(6); PG8_BAR; PG8_MMA(1, 1, At, B1); PG8_BAR;
            PG8_LDB(B0, 1, 0); PG8_SCHED; PG8_LDA(At, 1, 0); PG8_STAGE(PG8_SA(0, 1), a2 + hstep, voffA);
            PG8_WAIT_L(8); PG8_BAR; PG8_WAIT_L(0); PG8_MMA(0, 0, At, B0); PG8_BAR; PG8_SCHED;
            PG8_LDB(B1, 1, 1); PG8_STAGE(PG8_SB(1, 0), b3, voffB);
            PG8_BAR; PG8_WAIT_L(0); PG8_MMA(0, 1, At, B1); PG8_BAR;
            PG8_LDA(At, 1, 1); PG8_STAGE(PG8_SA(1, 0), a3, voffA);
            PG8_BAR; PG8_WAIT_L(0); PG8_MMA(1, 0, At, B0); PG8_BAR; PG8_SCHED;
            PG8_STAGE(PG8_SB(1, 1), b3 + hstep, voffB);
            PG8_WAIT_V(6); PG8_BAR; PG8_MMA(1, 1, At, B1); PG8_BAR;
        }
        PG8_STAMP();
        if constexpr (Epi::TWO_PART) { if (cur.part == 0) E.mid(acc, cur, wr, wc, fr, fq); else E(acc, cur, wr, wc, fr, fq); } else if constexpr (!Epi::AFTER_DRAIN) { E(acc, cur, wr, wc, fr, fq); S.done(cur); }
        PG8_STAMP();
        if (!has_next) break;
        bool keep_acc = false; if constexpr (Epi::TWO_PART) keep_acc = (cur.part == 0);
        if (!keep_acc)
#pragma unroll
        for (int a = 0; a < 2; ++a)
#pragma unroll
            for (int b = 0; b < 2; ++b)
#pragma unroll
                for (int m = 0; m < 4; ++m)
#pragma unroll
                    for (int n = 0; n < 2; ++n) acc[a][b][m][n] = (f32x4){0.f, 0.f, 0.f, 0.f};
        cur = nxt; cA = nA; cB = nB; ++ui;
    }
    PG8_WAIT_V(0);
    if (wr == 0) PG8_BAR;
    PG8_BAR;
    if constexpr (Epi::AFTER_DRAIN) { E.fused(acc, cur, wr, wc, fr, fq, lds, wid, lane); S.done(cur); }
    PG8_STAMP();
    if (STAMP && wid == 0) { stamps[lane] = lane < nts ? (((unsigned long long)(unsigned)ts_hi << 32) | (unsigned)ts_lo) : 0ull;
        if (lane == 62) stamps[62] = rt_entry; if (lane == 63) stamps[63] = (unsigned long long)wall_clock64(); }
#undef PG8_STAMP
#undef PG8_SA
#undef PG8_SB
#undef PG8_STAGE
#undef PG8_LDA
#undef PG8_LDB
#undef PG8_MMA
#undef PG8_WAIT_V
#undef PG8_WAIT_L
#undef PG8_BAR
#undef PG8_SCHED
}
}
using pg8::bf16_t; using pg8::bf16x8; using pg8::f32x4; using pg8::u32x4; using pg8::cvt_pk_bf16; using pg8::bf_lo; using pg8::bf_hi; using pg8::opaque_tid;
#define LAS __attribute__((address_space(3)))
typedef unsigned u32x2 __attribute__((ext_vector_type(2)));

constexpr int NT = 65536, DM = 1024, NL = 4, SEQ = 8192, FH = 2816, TH = 32768  ;
constexpr int LDS_BYTES = 144 * 1024, XB_ST_OFF = 143616;
constexpr size_t MiB = 1024ull * 1024ull;
constexpr size_t WS_MOD = 64 * 1024;
constexpr size_t WS_WST = 2 * MiB;
constexpr size_t WS_LB = 3 * MiB;
constexpr size_t WS_WIN = 4 * MiB;
constexpr size_t WS_W13 = 68 * MiB;
constexpr size_t WS_W2 = 156 * MiB;
constexpr size_t WS_WA = 200 * MiB, WS_WB = 208 * MiB, WS_WO = 216 * MiB;
constexpr size_t WS_HN = 224 * MiB;
constexpr size_t WS_BIG = 352 * MiB;
constexpr size_t ZB = 64 * MiB;
constexpr size_t WS_U = WS_BIG, WS_V = WS_BIG + ZB, WS_Q = WS_BIG + 2 * ZB, WS_F = WS_BIG + 3 * ZB  , WS_I = WS_BIG + 5 * ZB, WS_OG = WS_BIG + 6 * ZB, WS_GA = WS_BIG + 7 * ZB, WS_GB = WS_BIG + 8 * ZB;
constexpr size_t WS_HU = WS_BIG + 9 * ZB;
constexpr size_t WS_HD = WS_HU + 16 * MiB;
constexpr size_t WS_M0 = WS_HD + 1 * MiB;
constexpr size_t WS_END = WS_M0 + ZB;

struct Params { const float* in[15]; float* out; unsigned char* ws; int ph_lo, ph_hi; };
typedef const Params __attribute__((address_space(4))) * KP;

__device__ __forceinline__ float wave_sum(float v) {
#pragma unroll
    for (int o = 1; o < 64; o <<= 1) v += __shfl_xor(v, o);
    return v;
}

__device__ __forceinline__ void transpose_item(const float* __restrict__ W, int K, int N, bf16_t* __restrict__ WT, int item, int remap, LAS float* scr, int lane) {
    const int nblk = N / 32, kb = item / nblk, nb = item - kb * nblk, k0 = 64 * kb, n0 = 32 * nb;
    int drow0 = n0;
    if (remap) { const int bj = n0 / FH, nn = n0 - bj * FH; drow0 = (nn >> 7) * 256 + bj * 128 + (nn & 127); }
#pragma unroll 8
    for (int i = 0; i < 32; ++i) { const int kk = 2 * i + (lane >> 5); scr[kk * 33 + (lane & 31)] = W[(size_t)(k0 + kk) * N + n0 + (lane & 31)]; }
    asm volatile("s_waitcnt lgkmcnt(0)" ::: "memory");
    const int c = lane & 7;
#pragma unroll
    for (int j = 0; j < 4; ++j) { const int n = (lane >> 3) + 8 * j; const LAS float* s = scr + (8 * c) * 33 + n;
        u32x4 o; o.x = cvt_pk_bf16(s[0 * 33], s[1 * 33]); o.y = cvt_pk_bf16(s[2 * 33], s[3 * 33]); o.z = cvt_pk_bf16(s[4 * 33], s[5 * 33]); o.w = cvt_pk_bf16(s[6 * 33], s[7 * 33]);
        *(u32x4*)(WT + (size_t)(drow0 + n) * K + k0 + 8 * c) = o; }
    asm volatile("s_waitcnt lgkmcnt(0)" ::: "memory");
}

__device__ __forceinline__ void prologue_phase(KP p, LAS unsigned char* lds) {
    const int tid = opaque_tid(), lane = tid & 63, wave = tid >> 6, G = gridDim.x;
    unsigned char* ws = p->ws;
    {
        LAS float* cact = (LAS float*)lds;
        LAS float* red = (LAS float*)(lds + 32768);
        const float* c = p->in[1];
        for (int i = tid; i < 8192; i += 512) { const int b = i >> 10, k = i & 1023; const float x = c[i]; cact[k * 8 + b] = x / (1.0f + __expf(-x)); }
        __syncthreads();
        for (int task = blockIdx.x; task < 288; task += G) {
            const int idx = task * 128 + (tid & 127), kq = tid >> 7, l = idx / 9216, n = idx - l * 9216;
            const float* aw = p->in[12] + (size_t)l * 1024 * 9216 + n;
            float a[8];
#pragma unroll
            for (int b = 0; b < 8; ++b) a[b] = 0.f;
#pragma unroll 8
            for (int k = kq * 256; k < kq * 256 + 256; ++k) { const float w = aw[(size_t)k * 9216]; const f32x4 c0 = *(const LAS f32x4*)(cact + k * 8), c1 = *(const LAS f32x4*)(cact + k * 8 + 4);
                a[0] += c0[0] * w; a[1] += c0[1] * w; a[2] += c0[2] * w; a[3] += c0[3] * w; a[4] += c1[0] * w; a[5] += c1[1] * w; a[6] += c1[2] * w; a[7] += c1[3] * w; }
#pragma unroll
            for (int b = 0; b < 8; ++b) red[(kq * 8 + b) * 128 + (tid & 127)] = a[b];
            __syncthreads();
            if (kq == 0) { const float bias = p->in[13][idx]; float* mod = (float*)(ws + WS_MOD);
#pragma unroll
                for (int b = 0; b < 8; ++b) mod[((size_t)l * 8 + b) * 9216 + n] = ((red[b * 128 + tid] + red[(8 + b) * 128 + tid]) + (red[(16 + b) * 128 + tid] + red[(24 + b) * 128 + tid])) + bias; }
            __syncthreads();
        }
    }
    if (blockIdx.x == 72 % G) {
        const float* lg = p->in[5]; float* lb = (float*)(ws + WS_LB);
        for (int k = tid; k < 1024; k += 512) { const float a0 = lg[k], a1 = lg[1024 + k], a2 = lg[2048 + k], a3 = lg[3072 + k]; const float mx = fmaxf(fmaxf(a0, a1), fmaxf(a2, a3));
            const float e0 = __expf(a0 - mx), e1 = __expf(a1 - mx), e2 = __expf(a2 - mx), e3 = __expf(a3 - mx), inv = 1.0f / (e0 + e1 + e2 + e3);
            lb[k] = 0.f; lb[1024 + k] = e1 * inv; lb[2048 + k] = (e1 + e2) * inv; lb[3072 + k] = (e1 + e2 + e3) * inv; }
    }
    { const float* wsrc = p->in[3]; bf16_t* wst = (bf16_t*)(ws + WS_WST);
      for (int i = blockIdx.x * 512 + tid; i < 4 * 8 * 128 * 128 / 2; i += G * 512) { const int e = 2 * i, s = e & 127, t = (e >> 7) & 127;
          const float v0 = s <= t ? wsrc[e] : 0.f, v1 = (s + 1) <= t ? wsrc[e + 1] : 0.f; ((unsigned*)wst)[i] = cvt_pk_bf16(v0, v1); } }
    LAS float* scr = (LAS float*)(lds + 32768 + wave * 8704);
    const int gw = blockIdx.x * 8 + wave, NGW = G * 8;
    constexpr int I_IN = 16 * 256, I_13 = 16 * 176, I_2 = 44 * 32, I_SQ = 16 * 32, I_LAYER = I_IN + 2 * I_13 + 2 * I_2 + 3 * I_SQ;
    for (int it = gw; it < NL * I_LAYER; it += NGW) {
        const int l = it / I_LAYER; int r = it - l * I_LAYER;
        if (r < I_IN) { transpose_item(p->in[2] + (size_t)l * 1024 * 8192, 1024, 8192, (bf16_t*)(ws + WS_WIN) + (size_t)l * 8192 * 1024, r, 0, scr, lane); continue; } r -= I_IN;
        if (r < 2 * I_13) { const int s = r / I_13; r -= s * I_13; transpose_item(p->in[9] + (size_t)(l * 2 + s) * 1024 * 5632, 1024, 5632, (bf16_t*)(ws + WS_W13) + (size_t)(l * 2 + s) * 5632 * 1024, r, 1, scr, lane); continue; } r -= 2 * I_13;
        if (r < 2 * I_2) { const int s = r / I_2; r -= s * I_2; transpose_item(p->in[10] + (size_t)(l * 2 + s) * FH * 1024, FH, 1024, (bf16_t*)(ws + WS_W2) + (size_t)(l * 2 + s) * 1024 * FH, r, 0, scr, lane); continue; } r -= 2 * I_2;
        const int m = r / I_SQ; r -= m * I_SQ;
        const float* src = (m == 0 ? p->in[6] : (m == 1 ? p->in[7] : p->in[8])) + (size_t)l * 1024 * 1024;
        bf16_t* dst = (bf16_t*)(ws + (m == 0 ? WS_WA : (m == 1 ? WS_WB : WS_WO))) + (size_t)l * 1024 * 1024;
        transpose_item(src, 1024, 1024, dst, r, 0, scr, lane);
    }
}

template <bool FINAL> __device__ __forceinline__ void norm_phase(const float* hin, bf16_t* hn, float* fout, const float* nw, const float* modl  , int sub) {
    const int tid = opaque_tid(), lane = tid & 63, gw = blockIdx.x * 8 + (tid >> 6), NGW = gridDim.x * 8;
    f32x4 w4[4];
#pragma unroll
    for (int j = 0; j < 4; ++j) w4[j] = *(const f32x4*)(nw + 4 * lane + 256 * j);
    for (int row = gw; row < NT; row += NGW) {
        const float* xr = hin + (size_t)row * DM + 4 * lane;
        f32x4 v[4]; float s = 0.f;
#pragma unroll
        for (int j = 0; j < 4; ++j) { v[j] = *(const f32x4*)(xr + 256 * j); s += (v[j][0] * v[j][0] + v[j][1] * v[j][1]) + (v[j][2] * v[j][2] + v[j][3] * v[j][3]); }
        const float rstd = rsqrtf(wave_sum(s) * (1.0f / DM) + 1e-6f);
        if (FINAL) {
#pragma unroll
            for (int j = 0; j < 4; ++j) *(f32x4*)(fout + (size_t)row * DM + 4 * lane + 256 * j) = v[j] * rstd * w4[j];
        } else {
            const float* sh = modl + (size_t)(row >> 13) * 9216 + (3 * sub) * 1024 + 4 * lane; const float* sc = sh + 1024;
#pragma unroll
            for (int j = 0; j < 4; ++j) { const f32x4 a = *(const f32x4*)(sc + 256 * j), b = *(const f32x4*)(sh + 256 * j); const f32x4 o = v[j] * rstd * w4[j] * (a + 1.0f) + b;
                u32x2 w; w.x = cvt_pk_bf16(o[0], o[1]); w.y = cvt_pk_bf16(o[2], o[3]); *(u32x2*)(hn + (size_t)row * DM + 4 * lane + 256 * j) = w; }
        }
    }
}

__device__ __forceinline__ int tr64_off(int row, int col) { return row * 128 + ((((col >> 3) ^ (row ^ (row >> 3))) & 7) << 4) + ((col & 7) << 1); }
__device__ __forceinline__ int tr128_off(int row, int col) { return row * 256 + ((((col >> 3) ^ (row ^ (row >> 3))) & 15) << 4) + ((col & 7) << 1); }
constexpr int H_LF = 0, H_P = 0  , H_TOT = 32768, H_VEC = 34816, H_SS = 36864, H_QP = 38912, H_KP = 56320, H_KT = 73728, H_VT = 90112, H_ST = 106496, H_END = 141312;
static_assert(H_END <= LDS_BYTES, "LDS");
#define MFMA16(a, b, c) __builtin_amdgcn_mfma_f32_16x16x32_bf16((a), (b), (c), 0, 0, 0)

template <bool PRE> __device__ __forceinline__ void hgrn_seq(LAS unsigned char* lds, const bf16_t* __restrict__ Qb, const float* __restrict__ Fb, const bf16_t* __restrict__ Ib, const bf16_t* OGb, bf16_t* OUTb, size_t row_base, int colbase, int c0, int nch, float* Ubuf, float* Dbuf, int item0, int nprev) {
    const int tid = opaque_tid(), lane = tid & 63, w = __builtin_amdgcn_readfirstlane(tid >> 6), q4 = lane >> 4, l15 = lane & 15;
    const int pt = tid >> 4, pc8 = (tid & 15) * 8;
    LAS float* Lf = (LAS float*)(lds + H_LF); LAS float* Ltot = (LAS float*)(lds + H_TOT); LAS float* Lvec = (LAS float*)(lds + H_VEC); LAS float* Lss = (LAS float*)(lds + H_SS);
    f32x4 S[8];
#pragma unroll
    for (int i = 0; i < 8; ++i) S[i] = (f32x4){0.f, 0.f, 0.f, 0.f};
    if (!PRE) { for (int j = 0; j < nprev; ++j) { const float* Uj = Ubuf + (size_t)(item0 + j) * 16384; const f32x4 dj = *(const f32x4*)(Dbuf + (size_t)(item0 + j) * 128 + 16 * w + 4 * q4);
#pragma unroll
            for (int vt = 0; vt < 8; ++vt) S[vt] = S[vt] * dj + *(const f32x4*)(Uj + (vt * 512 + tid) * 4); } }
    float dacc = 1.0f;
    u32x4 rq[2], rv[2]; f32x4 rf[2][2];
#define HG_LOAD(c) do { _Pragma("unroll") for (int i_ = 0; i_ < 2; ++i_) { const size_t go_ = (row_base + (size_t)(c) * 64 + pt + 32 * i_) * 1024 + colbase + pc8; \
        if (!PRE) rq[i_] = *(const u32x4*)(Qb + go_); rv[i_] = *(const u32x4*)(Ib + go_); rf[i_][0] = *(const f32x4*)(Fb + go_); rf[i_][1] = *(const f32x4*)(Fb + go_ + 4); } } while (0)
    HG_LOAD(c0);
    for (int c = c0; c < c0 + nch; ++c) {
        u32x2 rog[4];
        if (!PRE) {
#pragma unroll
        for (int ti = 0; ti < 4; ++ti) rog[ti] = *(const u32x2*)(OGb + (row_base + (size_t)c * 64 + 16 * ti + l15) * 1024 + colbase + 16 * w + 4 * q4); }
#pragma unroll
        for (int i = 0; i < 2; ++i) { *(LAS f32x4*)(Lf + (pt + 32 * i) * 128 + pc8) = rf[i][0]; *(LAS f32x4*)(Lf + (pt + 32 * i) * 128 + pc8 + 4) = rf[i][1]; }
        __syncthreads();
        { const int k = tid & 127, seg = tid >> 7; float run = 0.f;
#pragma unroll
          for (int i = 0; i < 16; ++i) { const int idx = (16 * seg + i) * 128 + k; run += Lf[idx]; Lf[idx] = run; }
          Ltot[seg * 128 + k] = run; }
        __syncthreads();
        { const int k = tid & 127, seg = tid >> 7; const float t0 = Ltot[k], t1 = Ltot[128 + k], t2 = Ltot[256 + k], t3 = Ltot[384 + k];
          const float off = seg == 0 ? 0.f : (seg == 1 ? t0 : (seg == 2 ? t0 + t1 : t0 + t1 + t2));
          if (seg > 0) {
#pragma unroll
              for (int i = 0; i < 16; ++i) { const int idx = (16 * seg + i) * 128 + k; Lf[idx] += off; } }
          else { const float b31 = t0 + t1, b63 = b31 + t2 + t3; Lvec[k] = __expf(b31); Lvec[128 + k] = __expf(b63); Lvec[256 + k] = __expf(b63 - b31); Lvec[384 + k] = b31; } }
        __syncthreads();
#pragma unroll
        for (int i = 0; i < 2; ++i) { const int t = pt + 32 * i;
            const f32x4 b0 = *(const LAS f32x4*)(Lf + t * 128 + pc8), b1 = *(const LAS f32x4*)(Lf + t * 128 + pc8 + 4), r0 = *(const LAS f32x4*)(Lvec + 384 + pc8), r1 = *(const LAS f32x4*)(Lvec + 384 + pc8 + 4);
            unsigned qw[4] = {0u, 0u, 0u, 0u}; if (!PRE) { qw[0] = rq[i].x; qw[1] = rq[i].y; qw[2] = rq[i].z; qw[3] = rq[i].w; } const unsigned vw[4] = {rv[i].x, rv[i].y, rv[i].z, rv[i].w};
            float qp[8], kp[8];
#pragma unroll
            for (int j = 0; j < 8; ++j) { const float bb = j < 4 ? b0[j & 3] : b1[j & 3], rr = j < 4 ? r0[j & 3] : r1[j & 3], lf = j < 4 ? rf[i][0][j & 3] : rf[i][1][j & 3];
                const float d = fminf(fmaxf(bb - rr, -80.f), 80.f);
                if (!PRE) { const float qv = (j & 1) ? bf_hi(qw[j >> 1]) : bf_lo(qw[j >> 1]); qp[j] = qv * __expf(d); } else qp[j] = 0.f;
                kp[j] = (1.0f - __expf(lf)) * __expf(-d); }
            u32x4 wq, wk; wq.x = cvt_pk_bf16(qp[0], qp[1]); wq.y = cvt_pk_bf16(qp[2], qp[3]); wq.z = cvt_pk_bf16(qp[4], qp[5]); wq.w = cvt_pk_bf16(qp[6], qp[7]);
            wk.x = cvt_pk_bf16(kp[0], kp[1]); wk.y = cvt_pk_bf16(kp[2], kp[3]); wk.z = cvt_pk_bf16(kp[4], kp[5]); wk.w = cvt_pk_bf16(kp[6], kp[7]);
            if (!PRE) { *(LAS u32x4*)(lds + H_QP + t * 272 + pc8 * 2) = wq; *(LAS u32x4*)(lds + H_KP + t * 272 + pc8 * 2) = wk; }
            const unsigned kw[4] = {wk.x, wk.y, wk.z, wk.w};
#pragma unroll
            for (int j = 0; j < 8; ++j) { const unsigned short kk = (unsigned short)((j & 1) ? (kw[j >> 1] >> 16) : (kw[j >> 1] & 0xffffu)), vv = (unsigned short)((j & 1) ? (vw[j >> 1] >> 16) : (vw[j >> 1] & 0xffffu));
                *(LAS unsigned short*)(lds + H_KT + tr64_off(pc8 + j, t)) = kk; *(LAS unsigned short*)(lds + H_VT + tr64_off(pc8 + j, t)) = vv; } }
        if (PRE) { if (tid < 128) dacc *= Lvec[128 + tid]; }
        if (!PRE) { const f32x4 e4 = *(const LAS f32x4*)(Lvec + 16 * w + 4 * q4);
#pragma unroll
          for (int vt = 0; vt < 8; ++vt) { const f32x4 sv = S[vt] * e4; u32x2 o; o.x = cvt_pk_bf16(sv[0], sv[1]); o.y = cvt_pk_bf16(sv[2], sv[3]);
              *(LAS u32x2*)(lds + H_ST + (16 * vt + l15) * 272 + (16 * w + 4 * q4) * 2) = o; } }
        if (c + 1 < c0 + nch) HG_LOAD(c + 1);
        __syncthreads();
        f32x4 oT[4];
        if (!PRE) {
        { const int ti = w >> 1;
#pragma unroll
          for (int sj = 0; sj < 2; ++sj) { const int si = 2 * (w & 1) + sj; f32x4 a4 = (f32x4){0.f, 0.f, 0.f, 0.f};
              if (si <= ti) {
#pragma unroll
                  for (int kb = 0; kb < 4; ++kb) { const bf16x8 a = *(const LAS bf16x8*)(lds + H_KP + (16 * si + l15) * 272 + kb * 64 + q4 * 16), b = *(const LAS bf16x8*)(lds + H_QP + (16 * ti + l15) * 272 + kb * 64 + q4 * 16); a4 = MFMA16(a, b, a4); }
                  const int t = 16 * ti + l15, s0 = 16 * si + 4 * q4;
#pragma unroll
                  for (int r = 0; r < 4; ++r) a4[r] = (s0 + r <= t) ? a4[r] : 0.f; }
              u32x2 o; o.x = cvt_pk_bf16(a4[0], a4[1]); o.y = cvt_pk_bf16(a4[2], a4[3]);
              *(LAS u32x2*)(lds + H_P + (16 * ti + l15) * 144 + (16 * si + 4 * q4) * 2) = o; } }
#pragma unroll
        for (int ti = 0; ti < 4; ++ti) oT[ti] = (f32x4){0.f, 0.f, 0.f, 0.f};
#pragma unroll
        for (int kb = 0; kb < 4; ++kb) { const bf16x8 a = *(const LAS bf16x8*)(lds + H_ST + (16 * w + l15) * 272 + kb * 64 + q4 * 16);
#pragma unroll
            for (int ti = 0; ti < 4; ++ti) { const bf16x8 b = *(const LAS bf16x8*)(lds + H_QP + (16 * ti + l15) * 272 + kb * 64 + q4 * 16); oT[ti] = MFMA16(a, b, oT[ti]); } }
        __syncthreads();
        }
        { f32x4 U[8];
#pragma unroll
          for (int vt = 0; vt < 8; ++vt) U[vt] = (f32x4){0.f, 0.f, 0.f, 0.f};
#pragma unroll
          for (int kb = 0; kb < 2; ++kb) { const bf16x8 av = *(const LAS bf16x8*)(lds + H_VT + tr64_off(16 * w + l15, 32 * kb + 8 * q4)), ak = *(const LAS bf16x8*)(lds + H_KT + tr64_off(16 * w + l15, 32 * kb + 8 * q4));
#pragma unroll
              for (int ti = 0; ti < 4; ++ti) { if (!PRE) { const bf16x8 b = *(const LAS bf16x8*)(lds + H_P + (16 * ti + l15) * 144 + (32 * kb + 8 * q4) * 2); oT[ti] = MFMA16(av, b, oT[ti]); } }
#pragma unroll
              for (int vt = 0; vt < 8; ++vt) { const bf16x8 b = *(const LAS bf16x8*)(lds + H_VT + tr64_off(16 * vt + l15, 32 * kb + 8 * q4)); U[vt] = MFMA16(ak, b, U[vt]); } }
          const f32x4 d4 = *(const LAS f32x4*)(Lvec + 128 + 16 * w + 4 * q4), c4 = *(const LAS f32x4*)(Lvec + 256 + 16 * w + 4 * q4);
#pragma unroll
          for (int vt = 0; vt < 8; ++vt) S[vt] = S[vt] * d4 + U[vt] * c4; }
        if (!PRE) {
#pragma unroll
        for (int ti = 0; ti < 4; ++ti) { float ss = (oT[ti][0] * oT[ti][0] + oT[ti][1] * oT[ti][1]) + (oT[ti][2] * oT[ti][2] + oT[ti][3] * oT[ti][3]); ss += __shfl_xor(ss, 16); ss += __shfl_xor(ss, 32);
            if (q4 == 0) Lss[w * 64 + 16 * ti + l15] = ss; }
        __syncthreads();
#pragma unroll
        for (int ti = 0; ti < 4; ++ti) { const int t = 16 * ti + l15; float tot = 0.f;
#pragma unroll
            for (int ww = 0; ww < 8; ++ww) tot += Lss[ww * 64 + t];
            const float rs = rsqrtf(tot * (1.0f / 128.0f) + 1e-6f);
            u32x2 o; o.x = cvt_pk_bf16(oT[ti][0] * rs * bf_lo(rog[ti].x), oT[ti][1] * rs * bf_hi(rog[ti].x)); o.y = cvt_pk_bf16(oT[ti][2] * rs * bf_lo(rog[ti].y), oT[ti][3] * rs * bf_hi(rog[ti].y));
            *(u32x2*)(OUTb + (row_base + (size_t)c * 64 + t) * 1024 + colbase + 16 * w + 4 * q4) = o; }
        }
    }
    if (PRE) { float* Uo = Ubuf + (size_t)item0 * 16384;
#pragma unroll
        for (int vt = 0; vt < 8; ++vt) *(f32x4*)(Uo + (vt * 512 + tid) * 4) = S[vt];
        if (tid < 128) Dbuf[(size_t)item0 * 128 + tid] = dacc; }
    __syncthreads();
#undef HG_LOAD
}

__device__ __forceinline__ void gmlp_item(LAS unsigned char* lds, const bf16_t* __restrict__ Vb, const bf16_t* Ub, bf16_t* Ob, const bf16_t* __restrict__ Wt  , const float* __restrict__ bias  , size_t row0, int col0, int tid) {
     const int lane = tid & 63, w = __builtin_amdgcn_readfirstlane(tid >> 6), q4 = lane >> 4, l15 = lane & 15;
    const int ps = tid >> 4, pc8 = (tid & 15) * 8, nkb = (w >> 1) + 1;
    bf16x8 wf[4];
#pragma unroll
    for (int kb = 0; kb < 4; ++kb) if (kb < nkb) wf[kb] = *(const bf16x8*)(Wt + (16 * w + l15) * 128 + kb * 32 + q4 * 8);
#pragma unroll
    for (int i = 0; i < 4; ++i) { const int s = ps + 32 * i; const u32x4 raw = *(const u32x4*)(Vb + (row0 + s) * 1024 + col0 + pc8);
        float x[8] = {bf_lo(raw.x), bf_hi(raw.x), bf_lo(raw.y), bf_hi(raw.y), bf_lo(raw.z), bf_hi(raw.z), bf_lo(raw.w), bf_hi(raw.w)};
        float sm = ((x[0] + x[1]) + (x[2] + x[3])) + ((x[4] + x[5]) + (x[6] + x[7]));
        sm += __shfl_xor(sm, 1); sm += __shfl_xor(sm, 2); sm += __shfl_xor(sm, 4); sm += __shfl_xor(sm, 8);
        const float mu = sm * (1.0f / 128.0f); float vs = 0.f;
#pragma unroll
        for (int j = 0; j < 8; ++j) { x[j] -= mu; vs += x[j] * x[j]; }
        vs += __shfl_xor(vs, 1); vs += __shfl_xor(vs, 2); vs += __shfl_xor(vs, 4); vs += __shfl_xor(vs, 8);
        const float rstd = rsqrtf(vs * (1.0f / 128.0f) + 1e-6f);
#pragma unroll
        for (int j = 0; j < 4; ++j) { const unsigned pk = cvt_pk_bf16(x[2 * j] * rstd, x[2 * j + 1] * rstd);
            *(LAS unsigned short*)(lds + tr128_off(pc8 + 2 * j, s)) = (unsigned short)(pk & 0xffffu); *(LAS unsigned short*)(lds + tr128_off(pc8 + 2 * j + 1, s)) = (unsigned short)(pk >> 16); } }
    __syncthreads();
    f32x4 acc[8];
#pragma unroll
    for (int ct = 0; ct < 8; ++ct) acc[ct] = (f32x4){0.f, 0.f, 0.f, 0.f};
#pragma unroll
    for (int kb = 0; kb < 4; ++kb) if (kb < nkb) {
#pragma unroll
        for (int ct = 0; ct < 8; ++ct) { const bf16x8 a = *(const LAS bf16x8*)(lds + tr128_off(16 * ct + l15, 32 * kb + 8 * q4)); acc[ct] = MFMA16(a, wf[kb], acc[ct]); } }
    const int t = 16 * w + l15; const float bt = bias[t];
#pragma unroll
    for (int ct = 0; ct < 8; ++ct) { const size_t uo = (row0 + t) * 1024 + col0 + 16 * ct + 4 * q4; const u32x2 uu = *(const u32x2*)(Ub + uo);
        u32x2 o; o.x = cvt_pk_bf16(bf_lo(uu.x) * (acc[ct][0] + bt), bf_hi(uu.x) * (acc[ct][1] + bt)); o.y = cvt_pk_bf16(bf_lo(uu.y) * (acc[ct][2] + bt), bf_hi(uu.y) * (acc[ct][3] + bt));
        *(u32x2*)(Ob + uo) = o; }
    __syncthreads();
}

#define XB_TMO      128
#define XB_XCNT(j)  (256  + 64 * (j))
#define XB_XSUB(j)  (1280 + 64 * (j))
#define XB_XGEN(j)  (2304 + 64 * (j))
#define XB_TOP      3328
#define XB_TOPGEN   3392
#define XCD_BAR_WORDS 3456
#define XB_SPIN_CAP (1u << 18)

__device__ __forceinline__ unsigned xb_ld(unsigned* p)              { return __hip_atomic_load(p, __ATOMIC_RELAXED, __HIP_MEMORY_SCOPE_AGENT); }
__device__ __forceinline__ unsigned xb_add(unsigned* p, unsigned v) { return __hip_atomic_fetch_add(p, v, __ATOMIC_RELAXED, __HIP_MEMORY_SCOPE_AGENT); }
__device__ __forceinline__ unsigned xb_xcc_id() { return (unsigned)__builtin_amdgcn_s_getreg((3 << 11) | 20) & 0xFu; }
#define XB_SPIN(cond, bar) do { unsigned _sp = 0; while (cond) { __builtin_amdgcn_s_sleep(1); \
    if ((++_sp & 255u) == 0u) { if (xb_ld(&(bar)[XB_TMO])) break; if (_sp > XB_SPIN_CAP) { atomicAdd(&(bar)[XB_TMO], 1u); break; } } } } while (0)

struct XcdBarrier {
    unsigned* bar; unsigned x;
    volatile LAS unsigned* st;
};

__device__ __forceinline__ XcdBarrier xcd_barrier_post(unsigned* bar, volatile LAS unsigned* st) {
    XcdBarrier b; b.bar = bar; b.x = xb_xcc_id(); b.st = st;
    if (threadIdx.x == 0) (void)xb_add(&bar[XB_XCNT(b.x)], 1u);
    return b;
}
__device__ __forceinline__ void xcd_barrier_complete(unsigned* bar, unsigned x, unsigned& nloc, unsigned& nx) {
    const unsigned G = gridDim.x * gridDim.y * gridDim.z;
    unsigned sum, cnt, mine, sp = 0u;
    for (;;) {
        sum = 0u; cnt = 0u; mine = 0u;
#pragma unroll
        for (unsigned j = 0; j < 16; ++j) { const unsigned c = xb_ld(&bar[XB_XCNT(j)]); sum += c; cnt += (c > 0u) ? 1u : 0u; mine = (j == x) ? c : mine; }
        if (sum == G) break;
        __builtin_amdgcn_s_sleep(1);
        if ((++sp & 255u) == 0u) { if (xb_ld(&bar[XB_TMO])) break; if (sp > XB_SPIN_CAP) { atomicAdd(&bar[XB_TMO], 1u); break; } }
    }
    nloc = mine > 0u ? mine : 1u; nx = cnt > 0u ? cnt : 1u;
}

__device__ __forceinline__ void xcd_barrier(const XcdBarrier& b) {
    asm volatile("s_waitcnt vmcnt(0)" ::: "memory");
    __syncthreads();
    if (threadIdx.x == 0) {
        unsigned* bar = b.bar;
        __builtin_amdgcn_s_waitcnt(0);
        unsigned nloc = b.st[0], nx = b.st[1];
        if (nloc == 0u) { xcd_barrier_complete(bar, b.x, nloc, nx); b.st[0] = nloc; b.st[1] = nx; }
        const unsigned old = xb_add(&bar[XB_XSUB(b.x)], 1u);
        const unsigned gen = old / nloc;
        if (old + 1u == (gen + 1u) * nloc) {
            __builtin_amdgcn_fence(__ATOMIC_RELEASE, "agent");
            asm volatile("s_waitcnt vmcnt(0)" ::: "memory");
            const unsigned og = xb_add(&bar[XB_TOP], 1u);
            const unsigned tg = og / nx;
            if (og + 1u == (tg + 1u) * nx) xb_add(&bar[XB_TOPGEN], 1u);
            else XB_SPIN(xb_ld(&bar[XB_TOPGEN]) == tg, bar);
            __builtin_amdgcn_fence(__ATOMIC_ACQUIRE, "agent");
            xb_add(&bar[XB_XGEN(b.x)], 1u);
            asm volatile("s_waitcnt vmcnt(0)" ::: "memory");
        } else {
            XB_SPIN(xb_ld(&bar[XB_XGEN(b.x)]) == gen, bar);
            __builtin_amdgcn_fence(__ATOMIC_ACQUIRE, "agent");
            asm volatile("s_waitcnt vmcnt(0)" ::: "memory");
        }
    }
    __syncthreads();
}


__device__ __forceinline__ void flat_barrier(unsigned* bar, unsigned round) {
    asm volatile("s_waitcnt vmcnt(0)" ::: "memory");
    __syncthreads();
    if (threadIdx.x == 0) {
        __builtin_amdgcn_fence(__ATOMIC_RELEASE, "agent");
        asm volatile("s_waitcnt vmcnt(0)" ::: "memory");
        const unsigned G = gridDim.x, old = __hip_atomic_fetch_add(bar + 64, 1u, __ATOMIC_RELAXED, __HIP_MEMORY_SCOPE_AGENT);
        if (old + 1u == round * G) __hip_atomic_store(bar + 128, round, __ATOMIC_RELAXED, __HIP_MEMORY_SCOPE_AGENT);
        else { unsigned sp = 0; while (__hip_atomic_load(bar + 128, __ATOMIC_RELAXED, __HIP_MEMORY_SCOPE_AGENT) < round) { __builtin_amdgcn_s_sleep(2); if (++sp > (1u << 22)) break; } }
        __builtin_amdgcn_fence(__ATOMIC_ACQUIRE, "agent");
        asm volatile("s_waitcnt vmcnt(0)" ::: "memory");
    }
    __syncthreads();
}

__device__ __forceinline__ void stagger_start(unsigned ticks) {
    const unsigned g = (blockIdx.x >> 3) & 3u;
    if (g) { const unsigned long long t0 = __builtin_amdgcn_s_memrealtime(); while (__builtin_amdgcn_s_memrealtime() - t0 < (unsigned long long)(g * ticks)) __builtin_amdgcn_s_sleep(8); }
}
constexpr int HSEG = 8, HCH = SEQ / 64 / HSEG;
#ifndef PHMASK
#define PHMASK 0xffff
#endif
#ifndef MK_STAG_UP
#define MK_STAG_UP 700u
#endif
__global__ void __launch_bounds__(512, 2) mk_fwd(Params p_arg) {
    extern __shared__ __attribute__((aligned(16))) unsigned char lds_raw[];
    LAS unsigned char* lds = (LAS unsigned char*)lds_raw;
    int pc = 0;
    { if (threadIdx.x == 0) { *(LAS u32x4*)(lds + XB_ST_OFF) = (u32x4){0u, 0u, 0u, 0u}; } __syncthreads();
      KP pp0 = (KP)__builtin_amdgcn_kernarg_segment_ptr(); if (blockIdx.x == 0) { unsigned* bar0 = (unsigned*)pp0->ws; for (int i = threadIdx.x; i < XCD_BAR_WORDS; i += 512) __hip_atomic_store(bar0 + i, 0u, __ATOMIC_RELAXED, __HIP_MEMORY_SCOPE_AGENT); } }
#define GETP KP pp = (KP)__builtin_amdgcn_kernarg_segment_ptr(); asm volatile("" : "+s"(pp))
#ifdef MK_TIME
    LAS unsigned long long* tacc = (LAS unsigned long long*)(lds + 143360); const bool timer = (blockIdx.x == 0 && threadIdx.x == 0); unsigned long long tph0 = 0, tph1 = 0; int tcls = 0;
    if (timer) { for (int i = 0; i < 16; ++i) tacc[i] = 0ull; }
#define T_BEGIN(c) if (timer) { tph0 = __builtin_amdgcn_s_memrealtime(); tcls = (c); }
#define T_MID if (timer) { tph1 = __builtin_amdgcn_s_memrealtime(); tacc[tcls] += tph1 - tph0; }
#define T_END if (timer) { tacc[15] += __builtin_amdgcn_s_memrealtime() - tph1; }
#else
#define T_BEGIN(c)
#define T_MID
#define T_END
#endif
#ifndef MK_DUP
#define MK_DUP 0
#endif
#define PH_BEGIN(bit, cls) { GETP; T_BEGIN(cls) if (pc >= pp->ph_lo && pc < pp->ph_hi && (PHMASK & (bit))) for (int rep_ = 0; rep_ < (((MK_DUP) & (bit)) ? 2 : 1); ++rep_) {
#define PH_END } } { GETP; T_MID ++pc; if (pc > pp->ph_lo && pc < pp->ph_hi) { if (pc == 1) { cg::this_grid().sync(); (void)xcd_barrier_post((unsigned*)pp->ws, (volatile LAS unsigned*)(lds + XB_ST_OFF)); } else { XcdBarrier xb_; xb_.bar = (unsigned*)pp->ws; xb_.x = xb_xcc_id(); xb_.st = (volatile LAS unsigned*)(lds + XB_ST_OFF); xcd_barrier(xb_); } } T_END }

    PH_BEGIN(1, 0) prologue_phase(pp, lds); PH_END

    for (int blk = 0; blk < 3 * NL; ++blk) {
        const int l = blk / 3, kind = blk - 3 * l;
        PH_BEGIN(2, 1) unsigned char* ws = pp->ws; const float* hin = (blk == 0) ? pp->in[0] : pp->out;
            norm_phase<false>(hin, (bf16_t*)(ws + WS_HN), nullptr, pp->in[11] + (size_t)(l * 3 + kind) * 1024, (const float*)(ws + WS_MOD) + (size_t)l * 8 * 9216, kind); PH_END
        if (kind != 1) {
            const int s = kind >> 1;
            PH_BEGIN(4, 2) unsigned char* ws = pp->ws;
                pg8::Gemm g{(const bf16_t*)(ws + WS_HN), (const bf16_t*)(ws + WS_W13) + (size_t)(l * 2 + s) * 5632 * 1024, NT, 5632, 1024}; pg8::StaticOrder S; S.init(NT, 5632, (int)gridDim.x, (int)blockIdx.x);
                pg8::EpiSwiGLU E{(bf16_t*)(ws + WS_BIG)}; pg8::gemm_phase<pg8::EpiSwiGLU, pg8::StaticOrder, false>(lds, g, S, E, nullptr); PH_END
            PH_BEGIN(8, 3) unsigned char* ws = pp->ws; const float* hin = (blk == 0) ? pp->in[0] : pp->out;
                pg8::Gemm g{(const bf16_t*)(ws + WS_BIG), (const bf16_t*)(ws + WS_W2) + (size_t)(l * 2 + s) * 1024 * FH, NT, 1024, FH}; pg8::StaticOrder S; S.init(NT, 1024, (int)gridDim.x, (int)blockIdx.x);
                pg8::EpiResid E{hin, pp->out, (const float*)(ws + WS_MOD) + (size_t)l * 8 * 9216 + (3 * kind + 2) * 1024, 0.5f}; pg8::gemm_phase<pg8::EpiResid, pg8::StaticOrder, false>(lds, g, S, E, nullptr); PH_END
        } else {
            for (int half = 0; half < 2; ++half) {
                PH_BEGIN(16, 4) unsigned char* ws = pp->ws;
                    pg8::Gemm g{(const bf16_t*)(ws + WS_HN) + (size_t)half * TH * 1024, (const bf16_t*)(ws + WS_WIN) + (size_t)l * 8192 * 1024, TH, 8192, 1024}; pg8::StaticOrder S; S.init(TH, 8192, (int)gridDim.x, (int)blockIdx.x);
                    pg8::EpiInproj E{(bf16_t*)(ws + WS_U), (bf16_t*)(ws + WS_V), (bf16_t*)(ws + WS_Q), (float*)(ws + WS_F), (bf16_t*)(ws + WS_I), (bf16_t*)(ws + WS_OG), (bf16_t*)(ws + WS_GA), (bf16_t*)(ws + WS_GB), (const float*)(ws + WS_LB) + l * 1024};
                    pg8::gemm_phase<pg8::EpiInproj, pg8::StaticOrder, false>(lds, g, S, E, nullptr); PH_END
                PH_BEGIN(32, 5) unsigned char* ws = pp->ws; const int G = (int)gridDim.x;
                    for (int it = (int)blockIdx.x; it < 32 * (HSEG - 1); it += G) { const int sq = it / (HSEG - 1), sg = it - sq * (HSEG - 1);
                        hgrn_seq<true>(lds, nullptr, (const float*)(ws + WS_F), (const bf16_t*)(ws + WS_I), nullptr, nullptr, (size_t)(sq >> 3) * SEQ, (sq & 7) * 128, sg * HCH, HCH, (float*)(ws + WS_HU), (float*)(ws + WS_HD), sq * HSEG + sg, 0); }
                    { const bf16_t* wst = (const bf16_t*)(ws + WS_WST) + (size_t)l * 8 * 128 * 128; const float* gb = pp->in[4] + (size_t)l * 8 * 128; const int tid = opaque_tid();
                        for (int it = (int)blockIdx.x; it < 4 * 64 * 8; it += G) { const int g8 = it & 7, ch = (it >> 3) & 63, bl = it >> 9;
                            gmlp_item(lds, (const bf16_t*)(ws + WS_V), (const bf16_t*)(ws + WS_U), (bf16_t*)(ws + ((MK_DUP & 32) && rep_ == 0 ? WS_M0 : WS_U)), wst + g8 * 128 * 128, gb + g8 * 128, (size_t)bl * SEQ + ch * 128, g8 * 128, tid); } }
                PH_END
                PH_BEGIN(64, 6) unsigned char* ws = pp->ws; const int G = (int)gridDim.x;
                    for (int it = (int)blockIdx.x; it < 32 * HSEG; it += G) { const int sq = it / HSEG, sg = it - sq * HSEG;
                        hgrn_seq<false>(lds, (const bf16_t*)(ws + WS_Q), (const float*)(ws + WS_F), (const bf16_t*)(ws + WS_I), (const bf16_t*)(ws + WS_OG), (bf16_t*)(ws + ((MK_DUP & 64) && rep_ == 0 ? WS_M0 : WS_OG)), (size_t)(sq >> 3) * SEQ, (sq & 7) * 128, sg * HCH, HCH, (float*)(ws + WS_HU), (float*)(ws + WS_HD), sq * HSEG, sg); }
                PH_END
                PH_BEGIN(128, 7) unsigned char* ws = pp->ws;
                    pg8::Gemm g{(const bf16_t*)(ws + WS_U), (const bf16_t*)(ws + WS_WA) + (size_t)l * 1024 * 1024, TH, 1024, 1024}; pg8::BranchOrder S; S.init(TH, 1024, (int)gridDim.x, (int)blockIdx.x);
                    S.A2 = (const bf16_t*)(ws + WS_OG); S.Bt2 = (const bf16_t*)(ws + WS_WB) + (size_t)l * 1024 * 1024;
                    pg8::EpiBranchFused E{(const bf16_t*)(ws + WS_GA), (const bf16_t*)(ws + WS_GB), (bf16_t*)(ws + (half == 0 ? WS_M0 : WS_Q))}; pg8::gemm_phase<pg8::EpiBranchFused, pg8::BranchOrder, false>(lds, g, S, E, nullptr); PH_END
            }
            PH_BEGIN(512, 9) unsigned char* ws = pp->ws; float* hh = pp->out;
                pg8::Gemm g{(const bf16_t*)(ws + WS_M0), (const bf16_t*)(ws + WS_WO) + (size_t)l * 1024 * 1024, NT, 1024, 1024}; pg8::SplitAOrder S; S.init(NT, 1024, (int)gridDim.x, (int)blockIdx.x); S.A1 = (const bf16_t*)(ws + WS_Q);
                pg8::EpiResid E{hh, hh, (const float*)(ws + WS_MOD) + (size_t)l * 8 * 9216 + 5 * 1024, 1.0f}; pg8::gemm_phase<pg8::EpiResid, pg8::SplitAOrder, false>(lds, g, S, E, nullptr); PH_END
        }
    }
    PH_BEGIN(1024, 10) norm_phase<true>(pp->out, nullptr, pp->out, pp->in[14], nullptr, 0); PH_END
#ifdef MK_TIME
    __syncthreads(); asm volatile("s_waitcnt vmcnt(0)" ::: "memory");
    if (timer) { GETP; unsigned long long a = 0, b = 0; for (int i = 0; i < 16; ++i) { if ((MK_TA >> i) & 1) a += tacc[i]; if ((MK_TB >> i) & 1) b += tacc[i]; }
        const float V = (float)a * 0.01f; int n = (int)((float)b * 0.01f / 20.0f); if (n < 1) n = 1; if (n > 1024) n = 1024;
        float* o = pp->out; for (int i = 0; i < n; ++i) o[i] = V; }
#endif
}
constexpr int N_PHASES = 1 + NL * (3 + 10 + 3) + 1;

extern "C" void kernel_launch(void* const* d_in, const int* in_sizes, int n_in, void* d_out, int out_size, void* d_ws, size_t ws_size, hipStream_t stream) {
    static int grid = 0;
    if (grid == 0) {
        if (n_in != 15 || out_size != NT * DM || ws_size < WS_END) { fprintf(stderr, "kernel_launch: unexpected shapes (n_in %d, out %d, ws %zu < %zu)\n", n_in, out_size, ws_size, (size_t)WS_END); grid = -1; return; }
        int dev = 0, cus = 0, per_cu = 0;
        hipGetDevice(&dev); hipDeviceGetAttribute(&cus, hipDeviceAttributeMultiprocessorCount, dev);
        if (hipFuncSetAttribute((const void*)mk_fwd, hipFuncAttributeMaxDynamicSharedMemorySize, LDS_BYTES) != hipSuccess) { fprintf(stderr, "kernel_launch: hipFuncSetAttribute failed\n"); grid = -1; return; }
        if (hipOccupancyMaxActiveBlocksPerMultiprocessor(&per_cu, (const void*)mk_fwd, 512, LDS_BYTES) != hipSuccess || per_cu < 1) { fprintf(stderr, "kernel_launch: occupancy query says %d\n", per_cu); per_cu = 1; }
        (void)hipGetLastError();
        grid = cus * 1;
    }
    if (grid < 0) return;
    Params p{};
    for (int i = 0; i < 15; ++i) p.in[i] = (const float*)d_in[i];
    p.out = (float*)d_out; p.ws = (unsigned char*)d_ws;
#if MK_COOP
    p.ph_lo = 0; p.ph_hi = N_PHASES;
    void* args[] = {&p};
    hipError_t e = hipLaunchCooperativeKernel((const void*)mk_fwd, dim3(grid), dim3(512), args, LDS_BYTES, stream);
    if (e != hipSuccess) fprintf(stderr, "cooperative launch failed: %s (grid %d)\n", hipGetErrorString(e), grid);
#else
    for (int i = 0; i < N_PHASES; ++i) { p.ph_lo = i; p.ph_hi = i + 1; hipLaunchKernelGGL(mk_fwd, dim3(grid), dim3(512), LDS_BYTES, stream, p); }
#endif
}
```

```cpp
#include <hip/hip_runtime.h>
#include <hip/hip_cooperative_groups.h>
#include <cstdio>
namespace cg = cooperative_groups;
#ifndef MK_COOP
#define MK_COOP 1
#endif
namespace pg8 {
#define PG8_LAS __attribute__((address_space(3)))
typedef unsigned short bf16_t;
typedef short bf16x8 __attribute__((ext_vector_type(8)));
typedef float f32x4 __attribute__((ext_vector_type(4)));
typedef unsigned u32x4 __attribute__((ext_vector_type(4)));
constexpr int BM = 256, BK = 64, HALF = 128, HTB = HALF * BK * 2  , STAGE_BYTES = 8 * HTB, NXCD = 8, WGM = 8;

__host__ __device__ __forceinline__ int lds_byte(int r, int c) { const int st = (r >> 4) * 2 + (c >> 5), rr = r & 15, cc = c & 31, ob = rr * 64 + cc * 2; return st * 1024 + (ob ^ (((ob >> 9) & 1) << 5)); }
__host__ __device__ __forceinline__ void stage_rc(int b, int& R, int& C) { const int st = b / 1024, sb = b % 1024, swz = sb ^ (((sb >> 9) & 1) << 5); R = (st >> 1) * 16 + swz / 64; C = (st & 1) * 32 + (swz % 64) / 2; }
__host__ __device__ __forceinline__ int perm32(int rho) { const int n = rho >> 4, i = rho & 15; return 8 * (i >> 2) + 4 * n + (i & 3); }

struct Unit { int pm, pn, part; };
struct Gemm { const bf16_t* A; const bf16_t* Bt; int M, N, K; };

struct StaticOrder {
    int nM, nN, nwg, G, c;
    __host__ __device__ void init(int M, int N, int G_, int c_) { nM = M / BM; nN = N / BM; nwg = nM * nN; G = G_; c = c_; }
    __host__ __device__ bool next(int i, Unit& u) const {
        const long L = (long)i * G + c; if (L >= nwg) return false;
        int wgid = (int)L; { const int q = nwg / NXCD, r = nwg % NXCD, xcd = wgid % NXCD, off = wgid / NXCD; wgid = (xcd < r ? xcd * (q + 1) : r * (q + 1) + (xcd - r) * q) + off; }
        const int nig = WGM * nN, gid = wgid / nig, fm = gid * WGM, gsz = (nM - fm) < WGM ? (nM - fm) : WGM;
        u.pm = fm + ((wgid % nig) % gsz); u.pn = (wgid % nig) / gsz; u.part = 0; return true;
    }
    __device__ __forceinline__ void a_ready(const Unit&) const {}
    __device__ __forceinline__ void done(const Unit&) const {}
    __device__ __forceinline__ const char* a_ptr(const Gemm& g, const Unit& u, size_t tstep) const { return (const char*)g.A + (size_t)u.pm * tstep; }
    __device__ __forceinline__ const char* b_ptr(const Gemm& g, const Unit& u, size_t tstep) const { return (const char*)g.Bt + (size_t)u.pn * tstep; }
};
__device__ __forceinline__ int opaque_tid() { int t = threadIdx.x; asm volatile("" : "+v"(t)); return t; }
typedef __bf16 bf16x2_t __attribute__((ext_vector_type(2)));
typedef float f32x2_t __attribute__((ext_vector_type(2)));
__device__ __forceinline__ unsigned cvt_pk_bf16(float lo, float hi) { const f32x2_t v = {lo, hi}; const bf16x2_t b = __builtin_convertvector(v, bf16x2_t); return __builtin_bit_cast(unsigned, b); }
__device__ __forceinline__ float bf_lo(unsigned w) { return __uint_as_float(w << 16); }
__device__ __forceinline__ float bf_hi(unsigned w) { return __uint_as_float(w & 0xffff0000u); }
template <int ACT> __device__ __forceinline__ float actf(float x) {
    if (ACT == 0) return x;
    if (ACT == 1) { const float u = 1.5957691216f * (x + 0.044715f * x * x * x); return x * __builtin_amdgcn_rcpf(1.0f + __expf(-u)); }
    if (ACT == 2) return x * __builtin_amdgcn_rcpf(1.0f + __expf(-x));
    return __builtin_amdgcn_rcpf(1.0f + __expf(-x));
}
struct EpiSwiGLU {
    static constexpr bool PERM = true, AFTER_DRAIN = false, TWO_PART = false;
    bf16_t* O;
    __device__ __forceinline__ void operator()(const f32x4 (&acc)[2][2][4][2], const Unit& u, int wr, int wc, int fr, int fq) const {
        const int row0 = u.pm * BM + wr * 64 + fr, col0 = u.pn * HALF + wc * 32 + 8 * fq;
#pragma unroll
        for (int ai = 0; ai < 2; ++ai)
#pragma unroll
            for (int m = 0; m < 4; ++m) {
                const f32x4 a0 = acc[ai][0][m][0], a1 = acc[ai][0][m][1], b0 = acc[ai][1][m][0], b1 = acc[ai][1][m][1];
                float v[8];
#pragma unroll
                for (int j = 0; j < 4; ++j) { v[j] = actf<2>(a0[j]) * b0[j]; v[4 + j] = actf<2>(a1[j]) * b1[j]; }
                u32x4 w; w.x = cvt_pk_bf16(v[0], v[1]); w.y = cvt_pk_bf16(v[2], v[3]); w.z = cvt_pk_bf16(v[4], v[5]); w.w = cvt_pk_bf16(v[6], v[7]);
                *(u32x4*)(O + (size_t)(row0 + ai * HALF + m * 16) * 2816 + col0) = w;
            }
    }
};
struct EpiResid {
    static constexpr bool PERM = false, AFTER_DRAIN = false, TWO_PART = false;
    const float* hin; float* hout; const float* gmod; float scale;
    __device__ __forceinline__ void operator()(const f32x4 (&acc)[2][2][4][2], const Unit& u, int wr, int wc, int fr, int fq) const {
        const int row0 = u.pm * BM + wr * 64 + fr, col0 = u.pn * BM + wc * 32 + 4 * fq;
        const float* gp = gmod + (size_t)((u.pm * BM) >> 13) * 9216 + col0;
        f32x4 cf[2][2];
#pragma unroll
        for (int bj = 0; bj < 2; ++bj)
#pragma unroll
            for (int n = 0; n < 2; ++n) { const f32x4 g = *(const f32x4*)(gp + bj * HALF + n * 16); cf[bj][n] = (g + 1.0f) * scale; }
#pragma unroll
        for (int ai = 0; ai < 2; ++ai) {
            f32x4 hv[4][2][2];
#pragma unroll
            for (int m = 0; m < 4; ++m) { const size_t off = (size_t)(row0 + ai * HALF + m * 16) * 1024 + col0;
#pragma unroll
                for (int bj = 0; bj < 2; ++bj)
#pragma unroll
                    for (int n = 0; n < 2; ++n) hv[m][bj][n] = *(const f32x4*)(hin + off + bj * HALF + n * 16); }
#pragma unroll
            for (int m = 0; m < 4; ++m) { const size_t off = (size_t)(row0 + ai * HALF + m * 16) * 1024 + col0;
#pragma unroll
                for (int bj = 0; bj < 2; ++bj)
#pragma unroll
                    for (int n = 0; n < 2; ++n) *(f32x4*)(hout + off + bj * HALF + n * 16) = hv[m][bj][n] + cf[bj][n] * acc[ai][bj][m][n]; }
            asm volatile("" ::: "memory"); }
    }
};
struct EpiInproj {
    static constexpr bool PERM = true, AFTER_DRAIN = false, TWO_PART = false;
    bf16_t* U; bf16_t* V; bf16_t* Q; float* F; bf16_t* I; bf16_t* OG; bf16_t* GA; bf16_t* GB; const float* lb;
    template <int ACT> __device__ __forceinline__ void st16(const f32x4 (&acc)[2][2][4][2], bf16_t* dst, int row0, int colg) const {
#pragma unroll
        for (int ai = 0; ai < 2; ++ai)
#pragma unroll
            for (int m = 0; m < 4; ++m)
#pragma unroll
                for (int bj = 0; bj < 2; ++bj) { const f32x4 v0 = acc[ai][bj][m][0], v1 = acc[ai][bj][m][1];
                    u32x4 w; w.x = cvt_pk_bf16(actf<ACT>(v0[0]), actf<ACT>(v0[1])); w.y = cvt_pk_bf16(actf<ACT>(v0[2]), actf<ACT>(v0[3]));
                    w.z = cvt_pk_bf16(actf<ACT>(v1[0]), actf<ACT>(v1[1])); w.w = cvt_pk_bf16(actf<ACT>(v1[2]), actf<ACT>(v1[3]));
                    *(u32x4*)(dst + (size_t)(row0 + ai * HALF + m * 16) * 1024 + colg + bj * HALF) = w; }
    }
    __device__ __forceinline__ void operator()(const f32x4 (&acc)[2][2][4][2], const Unit& u, int wr, int wc, int fr, int fq) const {
        const int grp = u.pn >> 2, colg = (u.pn & 3) * BM + wc * 32 + 8 * fq, row0 = u.pm * BM + wr * 64 + fr;
        if (grp == 3) {
#pragma unroll
            for (int bj = 0; bj < 2; ++bj) { const f32x4 l0 = *(const f32x4*)(lb + colg + bj * HALF), l1 = *(const f32x4*)(lb + colg + bj * HALF + 4);
#pragma unroll
                for (int ai = 0; ai < 2; ++ai)
#pragma unroll
                    for (int m = 0; m < 4; ++m) { const f32x4 v0 = acc[ai][bj][m][0], v1 = acc[ai][bj][m][1]; f32x4 o0, o1;
#pragma unroll
                        for (int j = 0; j < 4; ++j) { o0[j] = __logf(fmaxf(l0[j] + (1.0f - l0[j]) * actf<3>(v0[j]), 1e-30f)); o1[j] = __logf(fmaxf(l1[j] + (1.0f - l1[j]) * actf<3>(v1[j]), 1e-30f)); }
                        float* d = F + (size_t)(row0 + ai * HALF + m * 16) * 1024 + colg + bj * HALF; *(f32x4*)d = o0; *(f32x4*)(d + 4) = o1; } }
        } else if (grp < 2) st16<1>(acc, grp == 0 ? U : V, row0, colg);
        else if (grp == 2) st16<2>(acc, Q, row0, colg);
        else if (grp == 4) st16<0>(acc, I, row0, colg);
        else st16<3>(acc, grp == 5 ? OG : (grp == 6 ? GA : GB), row0, colg);
    }
};
template <int MODE> struct EpiBranch {
    static constexpr bool PERM = true, AFTER_DRAIN = false, TWO_PART = false;
    const bf16_t* G; const bf16_t* P; bf16_t* O;
    __device__ __forceinline__ void operator()(const f32x4 (&acc)[2][2][4][2], const Unit& u, int wr, int wc, int fr, int fq) const {
        const int row0 = u.pm * BM + wr * 64 + fr, col0 = u.pn * BM + wc * 32 + 8 * fq;
#pragma unroll
        for (int ai = 0; ai < 2; ++ai)
#pragma unroll
            for (int m = 0; m < 4; ++m)
#pragma unroll
                for (int bj = 0; bj < 2; ++bj) { const size_t off = (size_t)(row0 + ai * HALF + m * 16) * 1024 + col0 + bj * HALF;
                    const u32x4 g = *(const u32x4*)(G + off); const f32x4 v0 = acc[ai][bj][m][0], v1 = acc[ai][bj][m][1];
                    float r[8] = { bf_lo(g.x) * v0[0], bf_hi(g.x) * v0[1], bf_lo(g.y) * v0[2], bf_hi(g.y) * v0[3], bf_lo(g.z) * v1[0], bf_hi(g.z) * v1[1], bf_lo(g.w) * v1[2], bf_hi(g.w) * v1[3] };
                    if (MODE == 1) { const u32x4 p = *(const u32x4*)(P + off);
                        r[0] += bf_lo(p.x); r[1] += bf_hi(p.x); r[2] += bf_lo(p.y); r[3] += bf_hi(p.y); r[4] += bf_lo(p.z); r[5] += bf_hi(p.z); r[6] += bf_lo(p.w); r[7] += bf_hi(p.w); }
                    u32x4 w; w.x = cvt_pk_bf16(r[0], r[1]); w.y = cvt_pk_bf16(r[2], r[3]); w.z = cvt_pk_bf16(r[4], r[5]); w.w = cvt_pk_bf16(r[6], r[7]);
                    *(u32x4*)(O + off) = w; }
    }
};

struct EpiBranchFused {
    static constexpr bool PERM = true, AFTER_DRAIN = false, TWO_PART = true;
    const bf16_t* GA; const bf16_t* GB; bf16_t* O;
    __device__ __forceinline__ void mid(f32x4 (&acc)[2][2][4][2], const Unit& u, int wr, int wc, int fr, int fq) const {
        const int row0 = u.pm * BM + wr * 64 + fr, col0 = u.pn * BM + wc * 32 + 8 * fq;
#pragma unroll
        for (int ai = 0; ai < 2; ++ai)
#pragma unroll
            for (int m = 0; m < 4; ++m)
#pragma unroll
                for (int bj = 0; bj < 2; ++bj) { const size_t off = (size_t)(row0 + ai * HALF + m * 16) * 1024 + col0 + bj * HALF;
                    const u32x4 a = *(const u32x4*)(GA + off), b = *(const u32x4*)(GB + off);
                    const float ra[8] = {bf_lo(a.x), bf_hi(a.x), bf_lo(a.y), bf_hi(a.y), bf_lo(a.z), bf_hi(a.z), bf_lo(a.w), bf_hi(a.w)}, rb[8] = {bf_lo(b.x), bf_hi(b.x), bf_lo(b.y), bf_hi(b.y), bf_lo(b.z), bf_hi(b.z), bf_lo(b.w), bf_hi(b.w)};
#pragma unroll
                    for (int j = 0; j < 4; ++j) { acc[ai][bj][m][0][j] *= ra[j] / fmaxf(rb[j], 1e-6f); acc[ai][bj][m][1][j] *= ra[4 + j] / fmaxf(rb[4 + j], 1e-6f); } }
    }
    __device__ __forceinline__ void operator()(const f32x4 (&acc)[2][2][4][2], const Unit& u, int wr, int wc, int fr, int fq) const {
        const int row0 = u.pm * BM + wr * 64 + fr, col0 = u.pn * BM + wc * 32 + 8 * fq;
#pragma unroll
        for (int ai = 0; ai < 2; ++ai)
#pragma unroll
            for (int m = 0; m < 4; ++m)
#pragma unroll
                for (int bj = 0; bj < 2; ++bj) { const size_t off = (size_t)(row0 + ai * HALF + m * 16) * 1024 + col0 + bj * HALF;
                    const u32x4 b = *(const u32x4*)(GB + off); const f32x4 v0 = acc[ai][bj][m][0], v1 = acc[ai][bj][m][1];
                    const float rb[8] = {bf_lo(b.x), bf_hi(b.x), bf_lo(b.y), bf_hi(b.y), bf_lo(b.z), bf_hi(b.z), bf_lo(b.w), bf_hi(b.w)};
                    u32x4 w; w.x = cvt_pk_bf16(fmaxf(rb[0], 1e-6f) * v0[0], fmaxf(rb[1], 1e-6f) * v0[1]); w.y = cvt_pk_bf16(fmaxf(rb[2], 1e-6f) * v0[2], fmaxf(rb[3], 1e-6f) * v0[3]);
                    w.z = cvt_pk_bf16(fmaxf(rb[4], 1e-6f) * v1[0], fmaxf(rb[5], 1e-6f) * v1[1]); w.w = cvt_pk_bf16(fmaxf(rb[6], 1e-6f) * v1[2], fmaxf(rb[7], 1e-6f) * v1[3]);
                    *(u32x4*)(O + off) = w; }
    }
};
struct BranchOrder : StaticOrder {
    const bf16_t* A2; const bf16_t* Bt2;
    __device__ __forceinline__ bool next(int i, Unit& u) const { const bool ok = StaticOrder::next(i >> 1, u); u.part = i & 1; return ok; }
    __device__ __forceinline__ const char* a_ptr(const Gemm& g, const Unit& u, size_t tstep) const { return (const char*)(u.part ? A2 : g.A) + (size_t)u.pm * tstep; }
    __device__ __forceinline__ const char* b_ptr(const Gemm& g, const Unit& u, size_t tstep) const { return (const char*)(u.part ? Bt2 : g.Bt) + (size_t)u.pn * tstep; }
};
struct SplitAOrder : StaticOrder {
    const bf16_t* A1;
    __device__ __forceinline__ const char* a_ptr(const Gemm& g, const Unit& u, size_t tstep) const { return u.pm < 128 ? (const char*)g.A + (size_t)u.pm * tstep : (const char*)A1 + (size_t)(u.pm - 128) * tstep; }
};

template <class Epi, class Sched, bool STAMP = false>
__device__ __forceinline__ void gemm_phase(PG8_LAS unsigned char* lds, const Gemm g, const Sched& S, const Epi& E, unsigned long long* stamps) {
    const int tid = opaque_tid(), wid = __builtin_amdgcn_readfirstlane(tid >> 6), lane = tid & 63, wr = wid >> 2, wc = wid & 3, fr = lane & 15, fq = lane >> 4;
    const int K = g.K, nt = K / BK;
    int ts_lo = 0, ts_hi = 0, nts = 0; const unsigned long long rt_entry = STAMP ? (unsigned long long)wall_clock64() : 0ull;
#define PG8_STAMP() do { if (STAMP && wid == 0 && nts < 64) { const unsigned long long _c = (unsigned long long)clock64(); \
        ts_lo = (lane == nts) ? (int)(unsigned)_c : ts_lo; ts_hi = (lane == nts) ? (int)(unsigned)(_c >> 32) : ts_hi; ++nts; } } while (0)
    PG8_STAMP();
    unsigned voffA[2], voffB[2];
#pragma unroll
    for (int i = 0; i < 2; ++i) { int R, C; stage_rc(tid * 16 + i * 8192, R, C); const int Rb = Epi::PERM ? ((R & ~31) + perm32(R & 31)) : R;
        voffA[i] = (unsigned)(R * K + C) * 2u; voffB[i] = (unsigned)(Rb * K + C) * 2u; }
    const size_t kstep = (size_t)(BK * 2);
    const size_t hstep = (size_t)HALF * K * 2;
    const size_t tstep = 2 * hstep;
    const unsigned ldsw = (unsigned)wid * 1024u;
    const int aoff = lds_byte(wr * 64 + fr, fq * 8), boff = lds_byte(wc * 32 + fr, fq * 8);
#define PG8_SA(b, h) (((b) * 2 + (h)) * HTB)
#define PG8_SB(b, h) ((4 + (b) * 2 + (h)) * HTB)
#define PG8_STAGE(bufoff, gbase, voff) do { _Pragma("unroll") for (int _i = 0; _i < 2; ++_i) \
        __builtin_amdgcn_global_load_lds((const unsigned*)((const char*)(gbase) + (voff)[_i]), (PG8_LAS unsigned*)(lds + (bufoff) + ldsw + _i * 8192), 16, 0, 0); } while (0)
#define PG8_LDA(dst, b, h) do { _Pragma("unroll") for (int m = 0; m < 4; ++m) _Pragma("unroll") for (int k = 0; k < 2; ++k) dst[m][k] = *(const PG8_LAS bf16x8*)(lds + PG8_SA(b, h) + aoff + m * 2048 + k * 1024); } while (0)
#define PG8_LDB(dst, b, h) do { _Pragma("unroll") for (int n = 0; n < 2; ++n) _Pragma("unroll") for (int k = 0; k < 2; ++k) dst[n][k] = *(const PG8_LAS bf16x8*)(lds + PG8_SB(b, h) + boff + n * 2048 + k * 1024); } while (0)
#define PG8_MMA(ai, bj, At, Bt) do { __builtin_amdgcn_s_setprio(1); _Pragma("unroll") for (int m = 0; m < 4; ++m) _Pragma("unroll") for (int n = 0; n < 2; ++n) _Pragma("unroll") for (int k = 0; k < 2; ++k) \
        acc[ai][bj][m][n] = __builtin_amdgcn_mfma_f32_16x16x32_bf16(Bt[n][k], At[m][k], acc[ai][bj][m][n], 0, 0, 0); __builtin_amdgcn_s_setprio(0); } while (0)
#define PG8_WAIT_V(n) asm volatile("s_waitcnt vmcnt(" #n ")" ::: "memory")
#define PG8_WAIT_L(n) asm volatile("s_waitcnt lgkmcnt(" #n ")" ::: "memory")
#define PG8_BAR __builtin_amdgcn_s_barrier()
#define PG8_SCHED __builtin_amdgcn_sched_barrier(0)
    Unit cur, nxt; int ui = 0;
    if (!S.next(0, cur)) return;
    f32x4 acc[2][2][4][2];
#pragma unroll
    for (int a = 0; a < 2; ++a)
#pragma unroll
        for (int b = 0; b < 2; ++b)
#pragma unroll
            for (int m = 0; m < 4; ++m)
#pragma unroll
                for (int n = 0; n < 2; ++n) acc[a][b][m][n] = (f32x4){0.f, 0.f, 0.f, 0.f};
    bf16x8 At[4][2], B0[2][2], B1[2][2];
    const char* cA = S.a_ptr(g, cur, tstep); const char* cB = S.b_ptr(g, cur, tstep);
    S.a_ready(cur);
    PG8_STAGE(PG8_SB(0, 0), cB, voffB); PG8_STAGE(PG8_SA(0, 0), cA, voffA); PG8_STAGE(PG8_SB(0, 1), cB + hstep, voffB); PG8_STAGE(PG8_SA(0, 1), cA + hstep, voffA);
    if (wr == 1) PG8_BAR;
    PG8_WAIT_V(4); PG8_BAR;
    PG8_STAGE(PG8_SB(1, 0), cB + kstep, voffB); PG8_STAGE(PG8_SA(1, 0), cA + kstep, voffA); PG8_STAGE(PG8_SB(1, 1), cB + hstep + kstep, voffB);
    PG8_WAIT_V(6); PG8_BAR;
    PG8_STAMP();
    for (;;) {
        const bool has_next = S.next(ui + 1, nxt);
        const char* nA = has_next ? S.a_ptr(g, nxt, tstep) : cA; const char* nB = has_next ? S.b_ptr(g, nxt, tstep) : cB;
        for (int t = 0; t < nt; t += 2) {
            const bool last = (t == nt - 2);
            const char* a1 = cA + (size_t)(t + 1) * kstep;
            const char* a2 = last ? nA : cA + (size_t)(t + 2) * kstep; const char* b2 = last ? nB : cB + (size_t)(t + 2) * kstep;
            const char* a3 = a2 + kstep; const char* b3 = b2 + kstep;
            if (last && has_next) S.a_ready(nxt);
            PG8_LDB(B0, 0, 0); PG8_SCHED; PG8_LDA(At, 0, 0); PG8_STAGE(PG8_SA(1, 1), a1 + hstep, voffA);
            PG8_WAIT_L(8); PG8_BAR; PG8_WAIT_L(0); PG8_MMA(0, 0, At, B0); PG8_BAR; PG8_SCHED;
            PG8_LDB(B1, 0, 1); PG8_STAGE(PG8_SB(0, 0), b2, voffB);
            PG8_BAR; PG8_WAIT_L(0); PG8_MMA(0, 1, At, B1); PG8_BAR;
            PG8_LDA(At, 0, 1); PG8_STAGE(PG8_SA(0, 0), a2, voffA);
            PG8_BAR; PG8_WAIT_L(0); PG8_MMA(1, 0, At, B0); PG8_BAR; PG8_SCHED;
            PG8_STAGE(PG8_SB(0, 1), b2 + hstep, voffB);
            PG8_WAIT_V(6); PG8_BAR; PG8_MMA(1, 1, At, B1); PG8_BAR;
            PG8_LDB(B0, 1, 0); PG8_SCHED; PG8_LDA(At, 1, 0); PG8_STAGE(PG8_SA(0, 1), a2 + hstep, voffA);
            PG8_WAIT_L(8); PG8_BAR; PG8_WAIT_L(0); PG8_MMA(0, 0, At, B0); PG8_BAR; PG8_SCHED;
            PG8_LDB(B1, 1, 1); PG8_STAGE(PG8_SB(1, 0), b3, voffB);
            PG8_BAR; PG8_WAIT_L(0); PG8_MMA(0, 1, At, B1); PG8_BAR;
            PG8_LDA(At, 1, 1); PG8_STAGE(PG8_SA(1, 0), a3, voffA);
            PG8_BAR; PG8_WAIT_L(0); PG8_MMA(1, 0, At, B0); PG8_BAR; PG8_SCHED;
            PG8_STAGE(PG8_SB(1, 1), b3 + hstep, voffB);
            PG8_WAIT_V(6); PG8_BAR; PG8_MMA(1, 1, At, B1); PG8_BAR;
        }
        PG8_STAMP();
        if constexpr (Epi::TWO_PART) { if (cur.part == 0) E.mid(acc, cur, wr, wc, fr, fq); else E(acc, cur, wr, wc, fr, fq); } else if constexpr (!Epi::AFTER_DRAIN) { E(acc, cur, wr, wc, fr, fq); S.done(cur); }
        PG8_STAMP();
        if (!has_next) break;
        bool keep_acc = false; if constexpr (Epi::TWO_PART) keep_acc = (cur.part == 0);
        if (!keep_acc)
#pragma unroll
        for (int a = 0; a < 2; ++a)
#pragma unroll
            for (int b = 0; b < 2; ++b)
#pragma unroll
                for (int m = 0; m < 4; ++m)
#pragma unroll
                    for (int n = 0; n < 2; ++n) acc[a][b][m][n] = (f32x4){0.f, 0.f, 0.f, 0.f};
        cur = nxt; cA = nA; cB = nB; ++ui;
    }
    PG8_WAIT_V(0);
    if (wr == 0) PG8_BAR;
    PG8_BAR;
    if constexpr (Epi::AFTER_DRAIN) { E.fused(acc, cur, wr, wc, fr, fq, lds, wid, lane); S.done(cur); }
    PG8_STAMP();
    if (STAMP && wid == 0) { stamps[lane] = lane < nts ? (((unsigned long long)(unsigned)ts_hi << 32) | (unsigned)ts_lo) : 0ull;
        if (lane == 62) stamps[62] = rt_entry; if (lane == 63) stamps[63] = (unsigned long long)wall_clock64(); }
#undef PG8_STAMP
#undef PG8_SA
#undef PG8_SB
#undef PG8_STAGE
#undef PG8_LDA
#undef PG8_LDB
#undef PG8_MMA
#undef PG8_WAIT_V
#undef PG8_WAIT_L
#undef PG8_BAR
#undef PG8_SCHED
}
}
using pg8::bf16_t; using pg8::bf16x8; using pg8::f32x4; using pg8::u32x4; using pg8::cvt_pk_bf16; using pg8::bf_lo; using pg8::bf_hi; using pg8::opaque_tid;
#define LAS __attribute__((address_space(3)))
typedef unsigned u32x2 __attribute__((ext_vector_type(2)));

constexpr int NT = 65536, DM = 1024, NL = 4, SEQ = 8192, FH = 2816, TH = 32768  ;
constexpr int LDS_BYTES = 144 * 1024, XB_ST_OFF = 143616;
constexpr size_t MiB = 1024ull * 1024ull;
constexpr size_t WS_MOD = 64 * 1024;
constexpr size_t WS_WST = 2 * MiB;
constexpr size_t WS_LB = 3 * MiB;
constexpr size_t WS_WIN = 4 * MiB;
constexpr size_t WS_W13 = 68 * MiB;
constexpr size_t WS_W2 = 156 * MiB;
constexpr size_t WS_WA = 200 * MiB, WS_WB = 208 * MiB, WS_WO = 216 * MiB;
constexpr size_t WS_HN = 224 * MiB;
constexpr size_t WS_BIG = 352 * MiB;
constexpr size_t ZB = 64 * MiB;
constexpr size_t WS_U = WS_BIG, WS_V = WS_BIG + ZB, WS_Q = WS_BIG + 2 * ZB, WS_F = WS_BIG + 3 * ZB  , WS_I = WS_BIG + 5 * ZB, WS_OG = WS_BIG + 6 * ZB, WS_GA = WS_BIG + 7 * ZB, WS_GB = WS_BIG + 8 * ZB;
constexpr size_t WS_HU = WS_BIG + 9 * ZB;
constexpr size_t WS_HD = WS_HU + 16 * MiB;
constexpr size_t WS_M0 = WS_HD + 1 * MiB;
constexpr size_t WS_END = WS_M0 + ZB;

struct Params { const float* in[15]; float* out; unsigned char* ws; int ph_lo, ph_hi; };
typedef const Params __attribute__((address_space(4))) * KP;

__device__ __forceinline__ float wave_sum(float v) {
#pragma unroll
    for (int o = 1; o < 64; o <<= 1) v += __shfl_xor(v, o);
    return v;
}

__device__ __forceinline__ void transpose_item(const float* __restrict__ W, int K, int N, bf16_t* __restrict__ WT, int item, int remap, LAS float* scr, int lane) {
    const int nblk = N / 32, kb = item / nblk, nb = item - kb * nblk, k0 = 64 * kb, n0 = 32 * nb;
    int drow0 = n0;
    if (remap) { const int bj = n0 / FH, nn = n0 - bj * FH; drow0 = (nn >> 7) * 256 + bj * 128 + (nn & 127); }
#pragma unroll 8
    for (int i = 0; i < 32; ++i) { const int kk = 2 * i + (lane >> 5); scr[kk * 33 + (lane & 31)] = W[(size_t)(k0 + kk) * N + n0 + (lane & 31)]; }
    asm volatile("s_waitcnt lgkmcnt(0)" ::: "memory");
    const int c = lane & 7;
#pragma unroll
    for (int j = 0; j < 4; ++j) { const int n = (lane >> 3) + 8 * j; const LAS float* s = scr + (8 * c) * 33 + n;
        u32x4 o; o.x = cvt_pk_bf16(s[0 * 33], s[1 * 33]); o.y = cvt_pk_bf16(s[2 * 33], s[3 * 33]); o.z = cvt_pk_bf16(s[4 * 33], s[5 * 33]); o.w = cvt_pk_bf16(s[6 * 33], s[7 * 33]);
        *(u32x4*)(WT + (size_t)(drow0 + n) * K + k0 + 8 * c) = o; }
    asm volatile("s_waitcnt lgkmcnt(0)" ::: "memory");
}

__device__ __forceinline__ void prologue_phase(KP p, LAS unsigned char* lds) {
    const int tid = opaque_tid(), lane = tid & 63, wave = tid >> 6, G = gridDim.x;
    unsigned char* ws = p->ws;
    {
        LAS float* cact = (LAS float*)lds;
        LAS float* red = (LAS float*)(lds + 32768);
        const float* c = p->in[1];
        for (int i = tid; i < 8192; i += 512) { const int b = i >> 10, k = i & 1023; const float x = c[i]; cact[k * 8 + b] = x / (1.0f + __expf(-x)); }
        __syncthreads();
        for (int task = blockIdx.x; task < 288; task += G) {
            const int idx = task * 128 + (tid & 127), kq = tid >> 7, l = idx / 9216, n = idx - l * 9216;
            const float* aw = p->in[12] + (size_t)l * 1024 * 9216 + n;
            float a[8];
#pragma unroll
            for (int b = 0; b < 8; ++b) a[b] = 0.f;
#pragma unroll 8
            for (int k = kq * 256; k < kq * 256 + 256; ++k) { const float w = aw[(size_t)k * 9216]; const f32x4 c0 = *(const LAS f32x4*)(cact + k * 8), c1 = *(const LAS f32x4*)(cact + k * 8 + 4);
                a[0] += c0[0] * w; a[1] += c0[1] * w; a[2] += c0[2] * w; a[3] += c0[3] * w; a[4] += c1[0] * w; a[5] += c1[1] * w; a[6] += c1[2] * w; a[7] += c1[3] * w; }
#pragma unroll
            for (int b = 0; b < 8; ++b) red[(kq * 8 + b) * 128 + (tid & 127)] = a[b];
            __syncthreads();
            if (kq == 0) { const float bias = p->in[13][idx]; float* mod = (float*)(ws + WS_MOD);
#pragma unroll
                for (int b = 0; b < 8; ++b) mod[((size_t)l * 8 + b) * 9216 + n] = ((red[b * 128 + tid] + red[(8 + b) * 128 + tid]) + (red[(16 + b) * 128 + tid] + red[(24 + b) * 128 + tid])) + bias; }
            __syncthreads();
        }
    }
    if (blockIdx.x == 72 % G) {
        const float* lg = p->in[5]; float* lb = (float*)(ws + WS_LB);
        for (int k = tid; k < 1024; k += 512) { const float a0 = lg[k], a1 = lg[1024 + k], a2 = lg[2048 + k], a3 = lg[3072 + k]; const float mx = fmaxf(fmaxf(a0, a1), fmaxf(a2, a3));
            const float e0 = __expf(a0 - mx), e1 = __expf(a1 - mx), e2 = __expf(a2 - mx), e3 = __expf(a3 - mx), inv = 1.0f / (e0 + e1 + e2 + e3);
            lb[k] = 0.f; lb[1024 + k] = e1 * inv; lb[2048 + k] = (e1 + e2) * inv; lb[3072 + k] = (e1 + e2 + e3) * inv; }
    }
    { const float* wsrc = p->in[3]; bf16_t* wst = (bf16_t*)(ws + WS_WST);
      for (int i = blockIdx.x * 512 + tid; i < 4 * 8 * 128 * 128 / 2; i += G * 512) { const int e = 2 * i, s = e & 127, t = (e >> 7) & 127;
          const float v0 = s <= t ? wsrc[e] : 0.f, v1 = (s + 1) <= t ? wsrc[e + 1] : 0.f; ((unsigned*)wst)[i] = cvt_pk_bf16(v0, v1); } }
    LAS float* scr = (LAS float*)(lds + 32768 + wave * 8704);
    const int gw = blockIdx.x * 8 + wave, NGW = G * 8;
    constexpr int I_IN = 16 * 256, I_13 = 16 * 176, I_2 = 44 * 32, I_SQ = 16 * 32, I_LAYER = I_IN + 2 * I_13 + 2 * I_2 + 3 * I_SQ;
    for (int it = gw; it < NL * I_LAYER; it += NGW) {
        const int l = it / I_LAYER; int r = it - l * I_LAYER;
        if (r < I_IN) { transpose_item(p->in[2] + (size_t)l * 1024 * 8192, 1024, 8192, (bf16_t*)(ws + WS_WIN) + (size_t)l * 8192 * 1024, r, 0, scr, lane); continue; } r -= I_IN;
        if (r < 2 * I_13) { const int s = r / I_13; r -= s * I_13; transpose_item(p->in[9] + (size_t)(l * 2 + s) * 1024 * 5632, 1024, 5632, (bf16_t*)(ws + WS_W13) + (size_t)(l * 2 + s) * 5632 * 1024, r, 1, scr, lane); continue; } r -= 2 * I_13;
        if (r < 2 * I_2) { const int s = r / I_2; r -= s * I_2; transpose_item(p->in[10] + (size_t)(l * 2 + s) * FH * 1024, FH, 1024, (bf16_t*)(ws + WS_W2) + (size_t)(l * 2 + s) * 1024 * FH, r, 0, scr, lane); continue; } r -= 2 * I_2;
        const int m = r / I_SQ; r -= m * I_SQ;
        const float* src = (m == 0 ? p->in[6] : (m == 1 ? p->in[7] : p->in[8])) + (size_t)l * 1024 * 1024;
        bf16_t* dst = (bf16_t*)(ws + (m == 0 ? WS_WA : (m == 1 ? WS_WB : WS_WO))) + (size_t)l * 1024 * 1024;
        transpose_item(src, 1024, 1024, dst, r, 0, scr, lane);
    }
}

template <bool FINAL> __device__ __forceinline__ void norm_phase(const float* hin, bf16_t* hn, float* fout, const float* nw, const float* modl  , int sub) {
    const int tid = opaque_tid(), lane = tid & 63, gw = blockIdx.x * 8 + (tid >> 6), NGW = gridDim.x * 8;
    f32x4 w4[4];
#pragma unroll
    for (int j = 0; j < 4; ++j) w4[j] = *(const f32x4*)(nw + 4 * lane + 256 * j);
    for (int row = gw; row < NT; row += NGW) {
        const float* xr = hin + (size_t)row * DM + 4 * lane;
        f32x4 v[4]; float s = 0.f;
#pragma unroll
        for (int j = 0; j < 4; ++j) { v[j] = *(const f32x4*)(xr + 256 * j); s += (v[j][0] * v[j][0] + v[j][1] * v[j][1]) + (v[j][2] * v[j][2] + v[j][3] * v[j][3]); }
        const float rstd = rsqrtf(wave_sum(s) * (1.0f / DM) + 1e-6f);
        if (FINAL) {
#pragma unroll
            for (int j = 0; j < 4; ++j) *(f32x4*)(fout + (size_t)row * DM + 4 * lane + 256 * j) = v[j] * rstd * w4[j];
        } else {
            const float* sh = modl + (size_t)(row >> 13) * 9216 + (3 * sub) * 1024 + 4 * lane; const float* sc = sh + 1024;
#pragma unroll
            for (int j = 0; j < 4; ++j) { const f32x4 a = *(const f32x4*)(sc + 256 * j), b = *(const f32x4*)(sh + 256 * j); const f32x4 o = v[j] * rstd * w4[j] * (a + 1.0f) + b;
                u32x2 w; w.x = cvt_pk_bf16(o[0], o[1]); w.y = cvt_pk_bf16(o[2], o[3]); *(u32x2*)(hn + (size_t)row * DM + 4 * lane + 256 * j) = w; }
        }
    }
}

__device__ __forceinline__ int tr64_off(int row, int col) { return row * 128 + ((((col >> 3) ^ (row ^ (row >> 3))) & 7) << 4) + ((col & 7) << 1); }
__device__ __forceinline__ int tr128_off(int row, int col) { return row * 256 + ((((col >> 3) ^ (row ^ (row >> 3))) & 15) << 4) + ((col & 7) << 1); }
constexpr int H_LF = 0, H_P = 0  , H_TOT = 32768, H_VEC = 34816, H_SS = 36864, H_QP = 38912, H_KP = 56320, H_KT = 73728, H_VT = 90112, H_ST = 106496, H_END = 141312;
static_assert(H_END <= LDS_BYTES, "LDS");
#define MFMA16(a, b, c) __builtin_amdgcn_mfma_f32_16x16x32_bf16((a), (b), (c), 0, 0, 0)

template <bool PRE> __device__ __forceinline__ void hgrn_seq(LAS unsigned char* lds, const bf16_t* __restrict__ Qb, const float* __restrict__ Fb, const bf16_t* __restrict__ Ib, const bf16_t* OGb, bf16_t* OUTb, size_t row_base, int colbase, int c0, int nch, float* Ubuf, float* Dbuf, int item0, int nprev) {
    const int tid = opaque_tid(), lane = tid & 63, w = __builtin_amdgcn_readfirstlane(tid >> 6), q4 = lane >> 4, l15 = lane & 15;
    const int pt = tid >> 4, pc8 = (tid & 15) * 8;
    LAS float* Lf = (LAS float*)(lds + H_LF); LAS float* Ltot = (LAS float*)(lds + H_TOT); LAS float* Lvec = (LAS float*)(lds + H_VEC); LAS float* Lss = (LAS float*)(lds + H_SS);
    f32x4 S[8];
#pragma unroll
    for (int i = 0; i < 8; ++i) S[i] = (f32x4){0.f, 0.f, 0.f, 0.f};
    if (!PRE) { for (int j = 0; j < nprev; ++j) { const float* Uj = Ubuf + (size_t)(item0 + j) * 16384; const f32x4 dj = *(const f32x4*)(Dbuf + (size_t)(item0 + j) * 128 + 16 * w + 4 * q4);
#pragma unroll
            for (int vt = 0; vt < 8; ++vt) S[vt] = S[vt] * dj + *(const f32x4*)(Uj + (vt * 512 + tid) * 4); } }
    float dacc = 1.0f;
    u32x4 rq[2], rv[2]; f32x4 rf[2][2];
#define HG_LOAD(c) do { _Pragma("unroll") for (int i_ = 0; i_ < 2; ++i_) { const size_t go_ = (row_base + (size_t)(c) * 64 + pt + 32 * i_) * 1024 + colbase + pc8; \
        if (!PRE) rq[i_] = *(const u32x4*)(Qb + go_); rv[i_] = *(const u32x4*)(Ib + go_); rf[i_][0] = *(const f32x4*)(Fb + go_); rf[i_][1] = *(const f32x4*)(Fb + go_ + 4); } } while (0)
    HG_LOAD(c0);
    for (int c = c0; c < c0 + nch; ++c) {
        u32x2 rog[4];
        if (!PRE) {
#pragma unroll
        for (int ti = 0; ti < 4; ++ti) rog[ti] = *(const u32x2*)(OGb + (row_base + (size_t)c * 64 + 16 * ti + l15) * 1024 + colbase + 16 * w + 4 * q4); }
#pragma unroll
        for (int i = 0; i < 2; ++i) { *(LAS f32x4*)(Lf + (pt + 32 * i) * 128 + pc8) = rf[i][0]; *(LAS f32x4*)(Lf + (pt + 32 * i) * 128 + pc8 + 4) = rf[i][1]; }
        __syncthreads();
        { const int k = tid & 127, seg = tid >> 7; float run = 0.f;
#pragma unroll
          for (int i = 0; i < 16; ++i) { const int idx = (16 * seg + i) * 128 + k; run += Lf[idx]; Lf[idx] = run; }
          Ltot[seg * 128 + k] = run; }
        __syncthreads();
        { const int k = tid & 127, seg = tid >> 7; const float t0 = Ltot[k], t1 = Ltot[128 + k], t2 = Ltot[256 + k], t3 = Ltot[384 + k];
          const float off = seg == 0 ? 0.f : (seg == 1 ? t0 : (seg == 2 ? t0 + t1 : t0 + t1 + t2));
          if (seg > 0) {
#pragma unroll
              for (int i = 0; i < 16; ++i) { const int idx = (16 * seg + i) * 128 + k; Lf[idx] += off; } }
          else { const float b31 = t0 + t1, b63 = b31 + t2 + t3; Lvec[k] = __expf(b31); Lvec[128 + k] = __expf(b63); Lvec[256 + k] = __expf(b63 - b31); Lvec[384 + k] = b31; } }
        __syncthreads();
#pragma unroll
        for (int i = 0; i < 2; ++i) { const int t = pt + 32 * i;
            const f32x4 b0 = *(const LAS f32x4*)(Lf + t * 128 + pc8), b1 = *(const LAS f32x4*)(Lf + t * 128 + pc8 + 4), r0 = *(const LAS f32x4*)(Lvec + 384 + pc8), r1 = *(const LAS f32x4*)(Lvec + 384 + pc8 + 4);
            unsigned qw[4] = {0u, 0u, 0u, 0u}; if (!PRE) { qw[0] = rq[i].x; qw[1] = rq[i].y; qw[2] = rq[i].z; qw[3] = rq[i].w; } const unsigned vw[4] = {rv[i].x, rv[i].y, rv[i].z, rv[i].w};
            float qp[8], kp[8];
#pragma unroll
            for (int j = 0; j < 8; ++j) { const float bb = j < 4 ? b0[j & 3] : b1[j & 3], rr = j < 4 ? r0[j & 3] : r1[j & 3], lf = j < 4 ? rf[i][0][j & 3] : rf[i][1][j & 3];
                const float d = fminf(fmaxf(bb - rr, -80.f), 80.f);
                if (!PRE) { const float qv = (j & 1) ? bf_hi(qw[j >> 1]) : bf_lo(qw[j >> 1]); qp[j] = qv * __expf(d); } else qp[j] = 0.f;
                kp[j] = (1.0f - __expf(lf)) * __expf(-d); }
            u32x4 wq, wk; wq.x = cvt_pk_bf16(qp[0], qp[1]); wq.y = cvt_pk_bf16(qp[2], qp[3]); wq.z = cvt_pk_bf16(qp[4], qp[5]); wq.w = cvt_pk_bf16(qp[6], qp[7]);
            wk.x = cvt_pk_bf16(kp[0], kp[1]); wk.y = cvt_pk_bf16(kp[2], kp[3]); wk.z = cvt_pk_bf16(kp[4], kp[5]); wk.w = cvt_pk_bf16(kp[6], kp[7]);
            if (!PRE) { *(LAS u32x4*)(lds + H_QP + t * 272 + pc8 * 2) = wq; *(LAS u32x4*)(lds + H_KP + t * 272 + pc8 * 2) = wk; }
            const unsigned kw[4] = {wk.x, wk.y, wk.z, wk.w};
#pragma unroll
            for (int j = 0; j < 8; ++j) { const unsigned short kk = (unsigned short)((j & 1) ? (kw[j >> 1] >> 16) : (kw[j >> 1] & 0xffffu)), vv = (unsigned short)((j & 1) ? (vw[j >> 1] >> 16) : (vw[j >> 1] & 0xffffu));
                *(LAS unsigned short*)(lds + H_KT + tr64_off(pc8 + j, t)) = kk; *(LAS unsigned short*)(lds + H_VT + tr64_off(pc8 + j, t)) = vv; } }
        if (PRE) { if (tid < 128) dacc *= Lvec[128 + tid]; }
        if (!PRE) { const f32x4 e4 = *(const LAS f32x4*)(Lvec + 16 * w + 4 * q4);
#pragma unroll
          for (int vt = 0; vt < 8; ++vt) { const f32x4 sv = S[vt] * e4; u32x2 o; o.x = cvt_pk_bf16(sv[0], sv[1]); o.y = cvt_pk_bf16(sv[2], sv[3]);
              *(LAS u32x2*)(lds + H_ST + (16 * vt + l15) * 272 + (16 * w + 4 * q4) * 2) = o; } }
        if (c + 1 < c0 + nch) HG_LOAD(c + 1);
        __syncthreads();
        f32x4 oT[4];
        if (!PRE) {
        { const int ti = w >> 1;
#pragma unroll
          for (int sj = 0; sj < 2; ++sj) { const int si = 2 * (w & 1) + sj; f32x4 a4 = (f32x4){0.f, 0.f, 0.f, 0.f};
              if (si <= ti) {
#pragma unroll
                  for (int kb = 0; kb < 4; ++kb) { const bf16x8 a = *(const LAS bf16x8*)(lds + H_KP + (16 * si + l15) * 272 + kb * 64 + q4 * 16), b = *(const LAS bf16x8*)(lds + H_QP + (16 * ti + l15) * 272 + kb * 64 + q4 * 16); a4 = MFMA16(a, b, a4); }
                  const int t = 16 * ti + l15, s0 = 16 * si + 4 * q4;
#pragma unroll
                  for (int r = 0; r < 4; ++r) a4[r] = (s0 + r <= t) ? a4[r] : 0.f; }
              u32x2 o; o.x = cvt_pk_bf16(a4[0], a4[1]); o.y = cvt_pk_bf16(a4[2], a4[3]);
              *(LAS u32x2*)(lds + H_P + (16 * ti + l15) * 144 + (16 * si + 4 * q4) * 2) = o; } }
#pragma unroll
        for (int ti = 0; ti < 4; ++ti) oT[ti] = (f32x4){0.f, 0.f, 0.f, 0.f};
#pragma unroll
        for (int kb = 0; kb < 4; ++kb) { const bf16x8 a = *(const LAS bf16x8*)(lds + H_ST + (16 * w + l15) * 272 + kb * 64 + q4 * 16);
#pragma unroll
            for (int ti = 0; ti < 4; ++ti) { const bf16x8 b = *(const LAS bf16x8*)(lds + H_QP + (16 * ti + l15) * 272 + kb * 64 + q4 * 16); oT[ti] = MFMA16(a, b, oT[ti]); } }
        __syncthreads();
        }
        { f32x4 U[8];
#pragma unroll
          for (int vt = 0; vt < 8; ++vt) U[vt] = (f32x4){0.f, 0.f, 0.f, 0.f};
#pragma unroll
          for (int kb = 0; kb < 2; ++kb) { const bf16x8 av = *(const LAS bf16x8*)(lds + H_VT + tr64_off(16 * w + l15, 32 * kb + 8 * q4)), ak = *(const LAS bf16x8*)(lds + H_KT + tr64_off(16 * w + l15, 32 * kb + 8 * q4));
#pragma unroll
              for (int ti = 0; ti < 4; ++ti) { if (!PRE) { const bf16x8 b = *(const LAS bf16x8*)(lds + H_P + (16 * ti + l15) * 144 + (32 * kb + 8 * q4) * 2); oT[ti] = MFMA16(av, b, oT[ti]); } }
#pragma unroll
              for (int vt = 0; vt < 8; ++vt) { const bf16x8 b = *(const LAS bf16x8*)(lds + H_VT + tr64_off(16 * vt + l15, 32 * kb + 8 * q4)); U[vt] = MFMA16(ak, b, U[vt]); } }
          const f32x4 d4 = *(const LAS f32x4*)(Lvec + 128 + 16 * w + 4 * q4), c4 = *(const LAS f32x4*)(Lvec + 256 + 16 * w + 4 * q4);
#pragma unroll
          for (int vt = 0; vt < 8; ++vt) S[vt] = S[vt] * d4 + U[vt] * c4; }
        if (!PRE) {
#pragma unroll
        for (int ti = 0; ti < 4; ++ti) { float ss = (oT[ti][0] * oT[ti][0] + oT[ti][1] * oT[ti][1]) + (oT[ti][2] * oT[ti][2] + oT[ti][3] * oT[ti][3]); ss += __shfl_xor(ss, 16); ss += __shfl_xor(ss, 32);
            if (q4 == 0) Lss[w * 64 + 16 * ti + l15] = ss; }
        __syncthreads();
#pragma unroll
        for (int ti = 0; ti < 4; ++ti) { const int t = 16 * ti + l15; float tot = 0.f;
#pragma unroll
            for (int ww = 0; ww < 8; ++ww) tot += Lss[ww * 64 + t];
            const float rs = rsqrtf(tot * (1.0f / 128.0f) + 1e-6f);
            u32x2 o; o.x = cvt_pk_bf16(oT[ti][0] * rs * bf_lo(rog[ti].x), oT[ti][1] * rs * bf_hi(rog[ti].x)); o.y = cvt_pk_bf16(oT[ti][2] * rs * bf_lo(rog[ti].y), oT[ti][3] * rs * bf_hi(rog[ti].y));
            *(u32x2*)(OUTb + (row_base + (size_t)c * 64 + t) * 1024 + colbase + 16 * w + 4 * q4) = o; }
        }
    }
    if (PRE) { float* Uo = Ubuf + (size_t)item0 * 16384;
#pragma unroll
        for (int vt = 0; vt < 8; ++vt) *(f32x4*)(Uo + (vt * 512 + tid) * 4) = S[vt];
        if (tid < 128) Dbuf[(size_t)item0 * 128 + tid] = dacc; }
    __syncthreads();
#undef HG_LOAD
}

__device__ __forceinline__ void gmlp_loop(LAS unsigned char* lds, const bf16_t* __restrict__ Vb, const bf16_t* Ub, bf16_t* Ob, const bf16_t* __restrict__ wst  , const float* __restrict__ gbias  , int first, int stride, int nitems) {
    const int tid = opaque_tid(), lane = tid & 63, w = __builtin_amdgcn_readfirstlane(tid >> 6), q4 = lane >> 4, l15 = lane & 15;
    const int ps = tid >> 4, pc8 = (tid & 15) * 8, nkb = (w >> 1) + 1, t = 16 * w + l15;
    int it = first; if (it >= nitems) return;
    u32x4 rv[4]; u32x2 ru[8]; bf16x8 wf[4]; float bt;
#define GM_DEC(i_) const int g8_ = (i_) & 7; const size_t row0_ = (size_t)((i_) >> 9) * SEQ + (size_t)(((i_) >> 3) & 63) * 128; const int col0_ = g8_ * 128;
#define GM_LOADV(i_) do { GM_DEC(i_) _Pragma("unroll") for (int i = 0; i < 4; ++i) rv[i] = *(const u32x4*)(Vb + (row0_ + ps + 32 * i) * 1024 + col0_ + pc8); \
        _Pragma("unroll") for (int kb = 0; kb < 4; ++kb) if (kb < nkb) wf[kb] = *(const bf16x8*)(wst + (size_t)g8_ * 16384 + (16 * w + l15) * 128 + kb * 32 + q4 * 8); } while (0)
#define GM_LOADU(i_) do { GM_DEC(i_) bt = gbias[g8_ * 128 + t]; _Pragma("unroll") for (int ct = 0; ct < 8; ++ct) ru[ct] = *(const u32x2*)(Ub + (row0_ + t) * 1024 + col0_ + 16 * ct + 4 * q4); } while (0)
    GM_LOADV(it); GM_LOADU(it);
    for (;;) {
#pragma unroll
        for (int i = 0; i < 4; ++i) { const int s = ps + 32 * i; const u32x4 raw = rv[i];
            float x[8] = {bf_lo(raw.x), bf_hi(raw.x), bf_lo(raw.y), bf_hi(raw.y), bf_lo(raw.z), bf_hi(raw.z), bf_lo(raw.w), bf_hi(raw.w)};
            float sm = ((x[0] + x[1]) + (x[2] + x[3])) + ((x[4] + x[5]) + (x[6] + x[7]));
            sm += __shfl_xor(sm, 1); sm += __shfl_xor(sm, 2); sm += __shfl_xor(sm, 4); sm += __shfl_xor(sm, 8);
            const float mu = sm * (1.0f / 128.0f); float vs = 0.f;
#pragma unroll
            for (int j = 0; j < 8; ++j) { x[j] -= mu; vs += x[j] * x[j]; }
            vs += __shfl_xor(vs, 1); vs += __shfl_xor(vs, 2); vs += __shfl_xor(vs, 4); vs += __shfl_xor(vs, 8);
            const float rstd = rsqrtf(vs * (1.0f / 128.0f) + 1e-6f);
#pragma unroll
            for (int j = 0; j < 4; ++j) { const unsigned pk = cvt_pk_bf16(x[2 * j] * rstd, x[2 * j + 1] * rstd);
                *(LAS unsigned short*)(lds + tr128_off(pc8 + 2 * j, s)) = (unsigned short)(pk & 0xffffu); *(LAS unsigned short*)(lds + tr128_off(pc8 + 2 * j + 1, s)) = (unsigned short)(pk >> 16); } }
        bf16x8 wc[4];
#pragma unroll
        for (int kb = 0; kb < 4; ++kb) wc[kb] = wf[kb];
        const int nxt = it + stride; const bool more = nxt < nitems;
        if (more) GM_LOADV(nxt);
        __syncthreads();
        f32x4 acc[8];
#pragma unroll
        for (int ct = 0; ct < 8; ++ct) acc[ct] = (f32x4){0.f, 0.f, 0.f, 0.f};
#pragma unroll
        for (int kb = 0; kb < 4; ++kb) if (kb < nkb) {
#pragma unroll
            for (int ct = 0; ct < 8; ++ct) { const bf16x8 a = *(const LAS bf16x8*)(lds + tr128_off(16 * ct + l15, 32 * kb + 8 * q4)); acc[ct] = MFMA16(a, wc[kb], acc[ct]); } }
        { GM_DEC(it)
#pragma unroll
          for (int ct = 0; ct < 8; ++ct) { const u32x2 uu = ru[ct];
              u32x2 o; o.x = cvt_pk_bf16(bf_lo(uu.x) * (acc[ct][0] + bt), bf_hi(uu.x) * (acc[ct][1] + bt)); o.y = cvt_pk_bf16(bf_lo(uu.y) * (acc[ct][2] + bt), bf_hi(uu.y) * (acc[ct][3] + bt));
              *(u32x2*)(Ob + (row0_ + t) * 1024 + col0_ + 16 * ct + 4 * q4) = o; } }
        if (!more) break;
        GM_LOADU(nxt);
        __syncthreads();
        it = nxt;
    }
    __syncthreads();
#undef GM_DEC
#undef GM_LOADV
#undef GM_LOADU
}

#define XB_TMO      128
#define XB_XCNT(j)  (256  + 64 * (j))
#define XB_XSUB(j)  (1280 + 64 * (j))
#define XB_XGEN(j)  (2304 + 64 * (j))
#define XB_TOP      3328
#define XB_TOPGEN   3392
#define XCD_BAR_WORDS 3456
#define XB_SPIN_CAP (1u << 18)

__device__ __forceinline__ unsigned xb_ld(unsigned* p)              { return __hip_atomic_load(p, __ATOMIC_RELAXED, __HIP_MEMORY_SCOPE_AGENT); }
__device__ __forceinline__ unsigned xb_add(unsigned* p, unsigned v) { return __hip_atomic_fetch_add(p, v, __ATOMIC_RELAXED, __HIP_MEMORY_SCOPE_AGENT); }
__device__ __forceinline__ unsigned xb_xcc_id() { return (unsigned)__builtin_amdgcn_s_getreg((3 << 11) | 20) & 0xFu; }
#define XB_SPIN(cond, bar) do { unsigned _sp = 0; while (cond) { __builtin_amdgcn_s_sleep(1); \
    if ((++_sp & 255u) == 0u) { if (xb_ld(&(bar)[XB_TMO])) break; if (_sp > XB_SPIN_CAP) { atomicAdd(&(bar)[XB_TMO], 1u); break; } } } } while (0)

struct XcdBarrier {
    unsigned* bar; unsigned x;
    volatile LAS unsigned* st;
};

__device__ __forceinline__ XcdBarrier xcd_barrier_post(unsigned* bar, volatile LAS unsigned* st) {
    XcdBarrier b; b.bar = bar; b.x = xb_xcc_id(); b.st = st;
    if (threadIdx.x == 0) (void)xb_add(&bar[XB_XCNT(b.x)], 1u);
    return b;
}
__device__ __forceinline__ void xcd_barrier_complete(unsigned* bar, unsigned x, unsigned& nloc, unsigned& nx) {
    const unsigned G = gridDim.x * gridDim.y * gridDim.z;
    unsigned sum, cnt, mine, sp = 0u;
    for (;;) {
        sum = 0u; cnt = 0u; mine = 0u;
#pragma unroll
        for (unsigned j = 0; j < 16; ++j) { const unsigned c = xb_ld(&bar[XB_XCNT(j)]); sum += c; cnt += (c > 0u) ? 1u : 0u; mine = (j == x) ? c : mine; }
        if (sum == G) break;
        __builtin_amdgcn_s_sleep(1);
        if ((++sp & 255u) == 0u) { if (xb_ld(&bar[XB_TMO])) break; if (sp > XB_SPIN_CAP) { atomicAdd(&bar[XB_TMO], 1u); break; } }
    }
    nloc = mine > 0u ? mine : 1u; nx = cnt > 0u ? cnt : 1u;
}

__device__ __forceinline__ void xcd_barrier(const XcdBarrier& b) {
    asm volatile("s_waitcnt vmcnt(0)" ::: "memory");
    __syncthreads();
    if (threadIdx.x == 0) {
        unsigned* bar = b.bar;
        __builtin_amdgcn_s_waitcnt(0);
        unsigned nloc = b.st[0], nx = b.st[1];
        if (nloc == 0u) { xcd_barrier_complete(bar, b.x, nloc, nx); b.st[0] = nloc; b.st[1] = nx; }
        const unsigned old = xb_add(&bar[XB_XSUB(b.x)], 1u);
        const unsigned gen = old / nloc;
        if (old + 1u == (gen + 1u) * nloc) {
            __builtin_amdgcn_fence(__ATOMIC_RELEASE, "agent");
            asm volatile("s_waitcnt vmcnt(0)" ::: "memory");
            const unsigned og = xb_add(&bar[XB_TOP], 1u);
            const unsigned tg = og / nx;
            if (og + 1u == (tg + 1u) * nx) xb_add(&bar[XB_TOPGEN], 1u);
            else XB_SPIN(xb_ld(&bar[XB_TOPGEN]) == tg, bar);
            __builtin_amdgcn_fence(__ATOMIC_ACQUIRE, "agent");
            xb_add(&bar[XB_XGEN(b.x)], 1u);
            asm volatile("s_waitcnt vmcnt(0)" ::: "memory");
        } else {
            XB_SPIN(xb_ld(&bar[XB_XGEN(b.x)]) == gen, bar);
            __builtin_amdgcn_fence(__ATOMIC_ACQUIRE, "agent");
            asm volatile("s_waitcnt vmcnt(0)" ::: "memory");
        }
    }
    __syncthreads();
}


__device__ __forceinline__ void flat_barrier(unsigned* bar, unsigned round) {
    asm volatile("s_waitcnt vmcnt(0)" ::: "memory");
    __syncthreads();
    if (threadIdx.x == 0) {
        __builtin_amdgcn_fence(__ATOMIC_RELEASE, "agent");
        asm volatile("s_waitcnt vmcnt(0)" ::: "memory");
        const unsigned G = gridDim.x, old = __hip_atomic_fetch_add(bar + 64, 1u, __ATOMIC_RELAXED, __HIP_MEMORY_SCOPE_AGENT);
        if (old + 1u == round * G) __hip_atomic_store(bar + 128, round, __ATOMIC_RELAXED, __HIP_MEMORY_SCOPE_AGENT);
        else { unsigned sp = 0; while (__hip_atomic_load(bar + 128, __ATOMIC_RELAXED, __HIP_MEMORY_SCOPE_AGENT) < round) { __builtin_amdgcn_s_sleep(2); if (++sp > (1u << 22)) break; } }
        __builtin_amdgcn_fence(__ATOMIC_ACQUIRE, "agent");
        asm volatile("s_waitcnt vmcnt(0)" ::: "memory");
    }
    __syncthreads();
}

__device__ __forceinline__ void stagger_start(unsigned ticks) {
    const unsigned g = (blockIdx.x >> 3) & 3u;
    if (g) { const unsigned long long t0 = __builtin_amdgcn_s_memrealtime(); while (__builtin_amdgcn_s_memrealtime() - t0 < (unsigned long long)(g * ticks)) __builtin_amdgcn_s_sleep(8); }
}
constexpr int HSEG = 8, HCH = SEQ / 64 / HSEG;
#ifndef PHMASK
#define PHMASK 0xffff
#endif
#ifndef MK_STAG_UP
#define MK_STAG_UP 700u
#endif
__global__ void __launch_bounds__(512, 2) mk_fwd(Params p_arg) {
    extern __shared__ __attribute__((aligned(16))) unsigned char lds_raw[];
    LAS unsigned char* lds = (LAS unsigned char*)lds_raw;
    int pc = 0;
    { if (threadIdx.x == 0) { *(LAS u32x4*)(lds + XB_ST_OFF) = (u32x4){0u, 0u, 0u, 0u}; } __syncthreads();
      KP pp0 = (KP)__builtin_amdgcn_kernarg_segment_ptr(); if (blockIdx.x == 0) { unsigned* bar0 = (unsigned*)pp0->ws; for (int i = threadIdx.x; i < XCD_BAR_WORDS; i += 512) __hip_atomic_store(bar0 + i, 0u, __ATOMIC_RELAXED, __HIP_MEMORY_SCOPE_AGENT); } }
#define GETP KP pp = (KP)__builtin_amdgcn_kernarg_segment_ptr(); asm volatile("" : "+s"(pp))
#ifdef MK_TIME
    LAS unsigned long long* tacc = (LAS unsigned long long*)(lds + 143360); const bool timer = (blockIdx.x == 0 && threadIdx.x == 0); unsigned long long tph0 = 0, tph1 = 0; int tcls = 0;
    if (timer) { for (int i = 0; i < 16; ++i) tacc[i] = 0ull; }
#define T_BEGIN(c) if (timer) { tph0 = __builtin_amdgcn_s_memrealtime(); tcls = (c); }
#define T_MID if (timer) { tph1 = __builtin_amdgcn_s_memrealtime(); tacc[tcls] += tph1 - tph0; }
#define T_END if (timer) { tacc[15] += __builtin_amdgcn_s_memrealtime() - tph1; }
#else
#define T_BEGIN(c)
#define T_MID
#define T_END
#endif
#ifndef MK_DUP
#define MK_DUP 0
#endif
#define PH_BEGIN(bit, cls) { GETP; T_BEGIN(cls) if (pc >= pp->ph_lo && pc < pp->ph_hi && (PHMASK & (bit))) for (int rep_ = 0; rep_ < (((MK_DUP) & (bit)) ? 2 : 1); ++rep_) {
#define PH_END } } { GETP; T_MID ++pc; if (pc > pp->ph_lo && pc < pp->ph_hi) { if (pc == 1) { cg::this_grid().sync(); (void)xcd_barrier_post((unsigned*)pp->ws, (volatile LAS unsigned*)(lds + XB_ST_OFF)); } else { XcdBarrier xb_; xb_.bar = (unsigned*)pp->ws; xb_.x = xb_xcc_id(); xb_.st = (volatile LAS unsigned*)(lds + XB_ST_OFF); xcd_barrier(xb_); } } T_END }

    PH_BEGIN(1, 0) prologue_phase(pp, lds); PH_END

    for (int blk = 0; blk < 3 * NL; ++blk) {
        const int l = blk / 3, kind = blk - 3 * l;
        PH_BEGIN(2, 1) unsigned char* ws = pp->ws; const float* hin = (blk == 0) ? pp->in[0] : pp->out;
            norm_phase<false>(hin, (bf16_t*)(ws + WS_HN), nullptr, pp->in[11] + (size_t)(l * 3 + kind) * 1024, (const float*)(ws + WS_MOD) + (size_t)l * 8 * 9216, kind); PH_END
        if (kind != 1) {
            const int s = kind >> 1;
            PH_BEGIN(4, 2) unsigned char* ws = pp->ws;
                pg8::Gemm g{(const bf16_t*)(ws + WS_HN), (const bf16_t*)(ws + WS_W13) + (size_t)(l * 2 + s) * 5632 * 1024, NT, 5632, 1024}; pg8::StaticOrder S; S.init(NT, 5632, (int)gridDim.x, (int)blockIdx.x);
                pg8::EpiSwiGLU E{(bf16_t*)(ws + WS_BIG)}; pg8::gemm_phase<pg8::EpiSwiGLU, pg8::StaticOrder, false>(lds, g, S, E, nullptr); PH_END
            PH_BEGIN(8, 3) unsigned char* ws = pp->ws; const float* hin = (blk == 0) ? pp->in[0] : pp->out;
                pg8::Gemm g{(const bf16_t*)(ws + WS_BIG), (const bf16_t*)(ws + WS_W2) + (size_t)(l * 2 + s) * 1024 * FH, NT, 1024, FH}; pg8::StaticOrder S; S.init(NT, 1024, (int)gridDim.x, (int)blockIdx.x);
                pg8::EpiResid E{hin, pp->out, (const float*)(ws + WS_MOD) + (size_t)l * 8 * 9216 + (3 * kind + 2) * 1024, 0.5f}; pg8::gemm_phase<pg8::EpiResid, pg8::StaticOrder, false>(lds, g, S, E, nullptr); PH_END
        } else {
            for (int half = 0; half < 2; ++half) {
                PH_BEGIN(16, 4) unsigned char* ws = pp->ws;
                    pg8::Gemm g{(const bf16_t*)(ws + WS_HN) + (size_t)half * TH * 1024, (const bf16_t*)(ws + WS_WIN) + (size_t)l * 8192 * 1024, TH, 8192, 1024}; pg8::StaticOrder S; S.init(TH, 8192, (int)gridDim.x, (int)blockIdx.x);
                    pg8::EpiInproj E{(bf16_t*)(ws + WS_U), (bf16_t*)(ws + WS_V), (bf16_t*)(ws + WS_Q), (float*)(ws + WS_F), (bf16_t*)(ws + WS_I), (bf16_t*)(ws + WS_OG), (bf16_t*)(ws + WS_GA), (bf16_t*)(ws + WS_GB), (const float*)(ws + WS_LB) + l * 1024};
                    pg8::gemm_phase<pg8::EpiInproj, pg8::StaticOrder, false>(lds, g, S, E, nullptr); PH_END
                PH_BEGIN(32, 5) unsigned char* ws = pp->ws; const int G = (int)gridDim.x;
                    for (int it = (int)blockIdx.x; it < 32 * (HSEG - 1); it += G) { const int sq = it / (HSEG - 1), sg = it - sq * (HSEG - 1);
                        hgrn_seq<true>(lds, nullptr, (const float*)(ws + WS_F), (const bf16_t*)(ws + WS_I), nullptr, nullptr, (size_t)(sq >> 3) * SEQ, (sq & 7) * 128, sg * HCH, HCH, (float*)(ws + WS_HU), (float*)(ws + WS_HD), sq * HSEG + sg, 0); }
                    gmlp_loop(lds, (const bf16_t*)(ws + WS_V), (const bf16_t*)(ws + WS_U), (bf16_t*)(ws + WS_U), (const bf16_t*)(ws + WS_WST) + (size_t)l * 8 * 128 * 128, pp->in[4] + (size_t)l * 8 * 128, (int)blockIdx.x, G, 4 * 64 * 8);
                PH_END
                PH_BEGIN(64, 6) unsigned char* ws = pp->ws; const int G = (int)gridDim.x;
                    for (int it = (int)blockIdx.x; it < 32 * HSEG; it += G) { const int sq = it / HSEG, sg = it - sq * HSEG;
                        hgrn_seq<false>(lds, (const bf16_t*)(ws + WS_Q), (const float*)(ws + WS_F), (const bf16_t*)(ws + WS_I), (const bf16_t*)(ws + WS_OG), (bf16_t*)(ws + ((MK_DUP & 64) && rep_ == 0 ? WS_M0 : WS_OG)), (size_t)(sq >> 3) * SEQ, (sq & 7) * 128, sg * HCH, HCH, (float*)(ws + WS_HU), (float*)(ws + WS_HD), sq * HSEG, sg); }
                PH_END
                PH_BEGIN(128, 7) unsigned char* ws = pp->ws;
                    pg8::Gemm g{(const bf16_t*)(ws + WS_U), (const bf16_t*)(ws + WS_WA) + (size_t)l * 1024 * 1024, TH, 1024, 1024}; pg8::BranchOrder S; S.init(TH, 1024, (int)gridDim.x, (int)blockIdx.x);
                    S.A2 = (const bf16_t*)(ws + WS_OG); S.Bt2 = (const bf16_t*)(ws + WS_WB) + (size_t)l * 1024 * 1024;
                    pg8::EpiBranchFused E{(const bf16_t*)(ws + WS_GA), (const bf16_t*)(ws + WS_GB), (bf16_t*)(ws + (half == 0 ? WS_M0 : WS_Q))}; pg8::gemm_phase<pg8::EpiBranchFused, pg8::BranchOrder, false>(lds, g, S, E, nullptr); PH_END
            }
            PH_BEGIN(512, 9) unsigned char* ws = pp->ws; float* hh = pp->out;
                pg8::Gemm g{(const bf16_t*)(ws + WS_M0), (const bf16_t*)(ws + WS_WO) + (size_t)l * 1024 * 1024, NT, 1024, 1024}; pg8::SplitAOrder S; S.init(NT, 1024, (int)gridDim.x, (int)blockIdx.x); S.A1 = (const bf16_t*)(ws + WS_Q);
                pg8::EpiResid E{hh, hh, (const float*)(ws + WS_MOD) + (size_t)l * 8 * 9216 + 5 * 1024, 1.0f}; pg8::gemm_phase<pg8::EpiResid, pg8::SplitAOrder, false>(lds, g, S, E, nullptr); PH_END
        }
    }
    PH_BEGIN(1024, 10) norm_phase<true>(pp->out, nullptr, pp->out, pp->in[14], nullptr, 0); PH_END
#ifdef MK_TIME
    __syncthreads(); asm volatile("s_waitcnt vmcnt(0)" ::: "memory");
    if (timer) { GETP; unsigned long long a = 0, b = 0; for (int i = 0; i < 16; ++i) { if ((MK_TA >> i) & 1) a += tacc[i]; if ((MK_TB >> i) & 1) b += tacc[i]; }
        const float V = (float)a * 0.01f; int n = (int)((float)b * 0.01f / 20.0f); if (n < 1) n = 1; if (n > 1024) n = 1024;
        float* o = pp->out; for (int i = 0; i < n; ++i) o[i] = V; }
#endif
}
constexpr int N_PHASES = 1 + NL * (3 + 10 + 3) + 1;

extern "C" void kernel_launch(void* const* d_in, const int* in_sizes, int n_in, void* d_out, int out_size, void* d_ws, size_t ws_size, hipStream_t stream) {
    static int grid = 0;
    if (grid == 0) {
        if (n_in != 15 || out_size != NT * DM || ws_size < WS_END) { fprintf(stderr, "kernel_launch: unexpected shapes (n_in %d, out %d, ws %zu < %zu)\n", n_in, out_size, ws_size, (size_t)WS_END); grid = -1; return; }
        int dev = 0, cus = 0, per_cu = 0;
        hipGetDevice(&dev); hipDeviceGetAttribute(&cus, hipDeviceAttributeMultiprocessorCount, dev);
        if (hipFuncSetAttribute((const void*)mk_fwd, hipFuncAttributeMaxDynamicSharedMemorySize, LDS_BYTES) != hipSuccess) { fprintf(stderr, "kernel_launch: hipFuncSetAttribute failed\n"); grid = -1; return; }
        if (hipOccupancyMaxActiveBlocksPerMultiprocessor(&per_cu, (const void*)mk_fwd, 512, LDS_BYTES) != hipSuccess || per_cu < 1) { fprintf(stderr, "kernel_launch: occupancy query says %d\n", per_cu); per_cu = 1; }
        (void)hipGetLastError();
        grid = cus * 1;
    }
    if (grid < 0) return;
    Params p{};
    for (int i = 0; i < 15; ++i) p.in[i] = (const float*)d_in[i];
    p.out = (float*)d_out; p.ws = (unsigned char*)d_ws;
#if MK_COOP
    p.ph_lo = 0; p.ph_hi = N_PHASES;
    void* args[] = {&p};
    hipError_t e = hipLaunchCooperativeKernel((const void*)mk_fwd, dim3(grid), dim3(512), args, LDS_BYTES, stream);
    if (e != hipSuccess) fprintf(stderr, "cooperative launch failed: %s (grid %d)\n", hipGetErrorString(e), grid);
#else
    for (int i = 0; i < N_PHASES; ++i) { p.ph_lo = i; p.ph_hi = i + 1; hipLaunchKernelGGL(mk_fwd, dim3(grid), dim3(512), LDS_BYTES, stream, p); }
#endif
}
```

```cpp
#include <hip/hip_runtime.h>
#include <hip/hip_cooperative_groups.h>
#include <cstdio>
namespace cg = cooperative_groups;
#ifndef MK_COOP
#define MK_COOP 1
#endif
namespace pg8 {
#define PG8_LAS __attribute__((address_space(3)))
typedef unsigned short bf16_t;
typedef short bf16x8 __attribute__((ext_vector_type(8)));
typedef float f32x4 __attribute__((ext_vector_type(4)));
typedef unsigned u32x4 __attribute__((ext_vector_type(4)));
constexpr int BM = 256, BK = 64, HALF = 128, HTB = HALF * BK * 2  , STAGE_BYTES = 8 * HTB, NXCD = 8, WGM = 8;

__host__ __device__ __forceinline__ int lds_byte(int r, int c) { const int st = (r >> 4) * 2 + (c >> 5), rr = r & 15, cc = c & 31, ob = rr * 64 + cc * 2; return st * 1024 + (ob ^ (((ob >> 9) & 1) << 5)); }
__host__ __device__ __forceinline__ void stage_rc(int b, int& R, int& C) { const int st = b / 1024, sb = b % 1024, swz = sb ^ (((sb >> 9) & 1) << 5); R = (st >> 1) * 16 + swz / 64; C = (st & 1) * 32 + (swz % 64) / 2; }
__host__ __device__ __forceinline__ int perm32(int rho) { const int n = rho >> 4, i = rho & 15; return 8 * (i >> 2) + 4 * n + (i & 3); }

struct Unit { int pm, pn, part; };
struct Gemm { const bf16_t* A; const bf16_t* Bt; int M, N, K; };

struct StaticOrder {
    int nM, nN, nwg, G, c;
    __host__ __device__ void init(int M, int N, int G_, int c_) { nM = M / BM; nN = N / BM; nwg = nM * nN; G = G_; c = c_; }
    __host__ __device__ bool next(int i, Unit& u) const {
        const long L = (long)i * G + c; if (L >= nwg) return false;
        int wgid = (int)L; { const int q = nwg / NXCD, r = nwg % NXCD, xcd = wgid % NXCD, off = wgid / NXCD; wgid = (xcd < r ? xcd * (q + 1) : r * (q + 1) + (xcd - r) * q) + off; }
        const int nig = WGM * nN, gid = wgid / nig, fm = gid * WGM, gsz = (nM - fm) < WGM ? (nM - fm) : WGM;
        u.pm = fm + ((wgid % nig) % gsz); u.pn = (wgid % nig) / gsz; u.part = 0; return true;
    }
    __device__ __forceinline__ void a_ready(const Unit&) const {}
    __device__ __forceinline__ void done(const Unit&) const {}
    __device__ __forceinline__ const char* a_ptr(const Gemm& g, const Unit& u, size_t tstep) const { return (const char*)g.A + (size_t)u.pm * tstep; }
    __device__ __forceinline__ const char* b_ptr(const Gemm& g, const Unit& u, size_t tstep) const { return (const char*)g.Bt + (size_t)u.pn * tstep; }
};
__device__ __forceinline__ int opaque_tid() { int t = threadIdx.x; asm volatile("" : "+v"(t)); return t; }
typedef __bf16 bf16x2_t __attribute__((ext_vector_type(2)));
typedef float f32x2_t __attribute__((ext_vector_type(2)));
__device__ __forceinline__ unsigned cvt_pk_bf16(float lo, float hi) { const f32x2_t v = {lo, hi}; const bf16x2_t b = __builtin_convertvector(v, bf16x2_t); return __builtin_bit_cast(unsigned, b); }
__device__ __forceinline__ float bf_lo(unsigned w) { return __uint_as_float(w << 16); }
__device__ __forceinline__ float bf_hi(unsigned w) { return __uint_as_float(w & 0xffff0000u); }
template <int ACT> __device__ __forceinline__ float actf(float x) {
    if (ACT == 0) return x;
    if (ACT == 1) { const float u = 1.5957691216f * (x + 0.044715f * x * x * x); return x * __builtin_amdgcn_rcpf(1.0f + __expf(-u)); }
    if (ACT == 2) return x * __builtin_amdgcn_rcpf(1.0f + __expf(-x));
    return __builtin_amdgcn_rcpf(1.0f + __expf(-x));
}
struct EpiSwiGLU {
    static constexpr bool PERM = true, AFTER_DRAIN = false, TWO_PART = false;
    bf16_t* O;
    __device__ __forceinline__ void operator()(const f32x4 (&acc)[2][2][4][2], const Unit& u, int wr, int wc, int fr, int fq) const {
        const int row0 = u.pm * BM + wr * 64 + fr, col0 = u.pn * HALF + wc * 32 + 8 * fq;
#pragma unroll
        for (int ai = 0; ai < 2; ++ai)
#pragma unroll
            for (int m = 0; m < 4; ++m) {
                const f32x4 a0 = acc[ai][0][m][0], a1 = acc[ai][0][m][1], b0 = acc[ai][1][m][0], b1 = acc[ai][1][m][1];
                float v[8];
#pragma unroll
                for (int j = 0; j < 4; ++j) { v[j] = actf<2>(a0[j]) * b0[j]; v[4 + j] = actf<2>(a1[j]) * b1[j]; }
                u32x4 w; w.x = cvt_pk_bf16(v[0], v[1]); w.y = cvt_pk_bf16(v[2], v[3]); w.z = cvt_pk_bf16(v[4], v[5]); w.w = cvt_pk_bf16(v[6], v[7]);
                *(u32x4*)(O + (size_t)(row0 + ai * HALF + m * 16) * 2816 + col0) = w;
            }
    }
};
struct EpiResid {
    static constexpr bool PERM = false, AFTER_DRAIN = false, TWO_PART = false;
    const float* hin; float* hout; const float* gmod; float scale;
    __device__ __forceinline__ void operator()(const f32x4 (&acc)[2][2][4][2], const Unit& u, int wr, int wc, int fr, int fq) const {
        const int row0 = u.pm * BM + wr * 64 + fr, col0 = u.pn * BM + wc * 32 + 4 * fq;
        const float* gp = gmod + (size_t)((u.pm * BM) >> 13) * 9216 + col0;
        f32x4 cf[2][2];
#pragma unroll
        for (int bj = 0; bj < 2; ++bj)
#pragma unroll
            for (int n = 0; n < 2; ++n) { const f32x4 g = *(const f32x4*)(gp + bj * HALF + n * 16); cf[bj][n] = (g + 1.0f) * scale; }
#pragma unroll
        for (int ai = 0; ai < 2; ++ai) {
            f32x4 hv[4][2][2];
#pragma unroll
            for (int m = 0; m < 4; ++m) { const size_t off = (size_t)(row0 + ai * HALF + m * 16) * 1024 + col0;
#pragma unroll
                for (int bj = 0; bj < 2; ++bj)
#pragma unroll
                    for (int n = 0; n < 2; ++n) hv[m][bj][n] = *(const f32x4*)(hin + off + bj * HALF + n * 16); }
#pragma unroll
            for (int m = 0; m < 4; ++m) { const size_t off = (size_t)(row0 + ai * HALF + m * 16) * 1024 + col0;
#pragma unroll
                for (int bj = 0; bj < 2; ++bj)
#pragma unroll
                    for (int n = 0; n < 2; ++n) *(f32x4*)(hout + off + bj * HALF + n * 16) = hv[m][bj][n] + cf[bj][n] * acc[ai][bj][m][n]; }
            asm volatile("" ::: "memory"); }
    }
};
struct EpiInproj {
    static constexpr bool PERM = true, AFTER_DRAIN = false, TWO_PART = false;
    bf16_t* U; bf16_t* V; bf16_t* Q; float* F; bf16_t* I; bf16_t* OG; bf16_t* GA; bf16_t* GB; const float* lb;
    template <int ACT> __device__ __forceinline__ void st16(const f32x4 (&acc)[2][2][4][2], bf16_t* dst, int row0, int colg) const {
#pragma unroll
        for (int ai = 0; ai < 2; ++ai)
#pragma unroll
            for (int m = 0; m < 4; ++m)
#pragma unroll
                for (int bj = 0; bj < 2; ++bj) { const f32x4 v0 = acc[ai][bj][m][0], v1 = acc[ai][bj][m][1];
                    u32x4 w; w.x = cvt_pk_bf16(actf<ACT>(v0[0]), actf<ACT>(v0[1])); w.y = cvt_pk_bf16(actf<ACT>(v0[2]), actf<ACT>(v0[3]));
                    w.z = cvt_pk_bf16(actf<ACT>(v1[0]), actf<ACT>(v1[1])); w.w = cvt_pk_bf16(actf<ACT>(v1[2]), actf<ACT>(v1[3]));
                    *(u32x4*)(dst + (size_t)(row0 + ai * HALF + m * 16) * 1024 + colg + bj * HALF) = w; }
    }
    __device__ __forceinline__ void operator()(const f32x4 (&acc)[2][2][4][2], const Unit& u, int wr, int wc, int fr, int fq) const {
        const int grp = u.pn >> 2, colg = (u.pn & 3) * BM + wc * 32 + 8 * fq, row0 = u.pm * BM + wr * 64 + fr;
        if (grp == 3) {
#pragma unroll
            for (int bj = 0; bj < 2; ++bj) { const f32x4 l0 = *(const f32x4*)(lb + colg + bj * HALF), l1 = *(const f32x4*)(lb + colg + bj * HALF + 4);
#pragma unroll
                for (int ai = 0; ai < 2; ++ai)
#pragma unroll
                    for (int m = 0; m < 4; ++m) { const f32x4 v0 = acc[ai][bj][m][0], v1 = acc[ai][bj][m][1]; f32x4 o0, o1;
#pragma unroll
                        for (int j = 0; j < 4; ++j) { o0[j] = __logf(fmaxf(l0[j] + (1.0f - l0[j]) * actf<3>(v0[j]), 1e-30f)); o1[j] = __logf(fmaxf(l1[j] + (1.0f - l1[j]) * actf<3>(v1[j]), 1e-30f)); }
                        float* d = F + (size_t)(row0 + ai * HALF + m * 16) * 1024 + colg + bj * HALF; *(f32x4*)d = o0; *(f32x4*)(d + 4) = o1; } }
        } else if (grp < 2) st16<1>(acc, grp == 0 ? U : V, row0, colg);
        else if (grp == 2) st16<2>(acc, Q, row0, colg);
        else if (grp == 4) st16<0>(acc, I, row0, colg);
        else st16<3>(acc, grp == 5 ? OG : (grp == 6 ? GA : GB), row0, colg);
    }
};
template <int MODE> struct EpiBranch {
    static constexpr bool PERM = true, AFTER_DRAIN = false, TWO_PART = false;
    const bf16_t* G; const bf16_t* P; bf16_t* O;
    __device__ __forceinline__ void operator()(const f32x4 (&acc)[2][2][4][2], const Unit& u, int wr, int wc, int fr, int fq) const {
        const int row0 = u.pm * BM + wr * 64 + fr, col0 = u.pn * BM + wc * 32 + 8 * fq;
#pragma unroll
        for (int ai = 0; ai < 2; ++ai)
#pragma unroll
            for (int m = 0; m < 4; ++m)
#pragma unroll
                for (int bj = 0; bj < 2; ++bj) { const size_t off = (size_t)(row0 + ai * HALF + m * 16) * 1024 + col0 + bj * HALF;
                    const u32x4 g = *(const u32x4*)(G + off); const f32x4 v0 = acc[ai][bj][m][0], v1 = acc[ai][bj][m][1];
                    float r[8] = { bf_lo(g.x) * v0[0], bf_hi(g.x) * v0[1], bf_lo(g.y) * v0[2], bf_hi(g.y) * v0[3], bf_lo(g.z) * v1[0], bf_hi(g.z) * v1[1], bf_lo(g.w) * v1[2], bf_hi(g.w) * v1[3] };
                    if (MODE == 1) { const u32x4 p = *(const u32x4*)(P + off);
                        r[0] += bf_lo(p.x); r[1] += bf_hi(p.x); r[2] += bf_lo(p.y); r[3] += bf_hi(p.y); r[4] += bf_lo(p.z); r[5] += bf_hi(p.z); r[6] += bf_lo(p.w); r[7] += bf_hi(p.w); }
                    u32x4 w; w.x = cvt_pk_bf16(r[0], r[1]); w.y = cvt_pk_bf16(r[2], r[3]); w.z = cvt_pk_bf16(r[4], r[5]); w.w = cvt_pk_bf16(r[6], r[7]);
                    *(u32x4*)(O + off) = w; }
    }
};

struct EpiBranchFused {
    static constexpr bool PERM = true, AFTER_DRAIN = false, TWO_PART = true;
    const bf16_t* GA; const bf16_t* GB; bf16_t* O;
    __device__ __forceinline__ void mid(f32x4 (&acc)[2][2][4][2], const Unit& u, int wr, int wc, int fr, int fq) const {
        const int row0 = u.pm * BM + wr * 64 + fr, col0 = u.pn * BM + wc * 32 + 8 * fq;
#pragma unroll
        for (int ai = 0; ai < 2; ++ai)
#pragma unroll
            for (int m = 0; m < 4; ++m)
#pragma unroll
                for (int bj = 0; bj < 2; ++bj) { const size_t off = (size_t)(row0 + ai * HALF + m * 16) * 1024 + col0 + bj * HALF;
                    const u32x4 a = *(const u32x4*)(GA + off), b = *(const u32x4*)(GB + off);
                    const float ra[8] = {bf_lo(a.x), bf_hi(a.x), bf_lo(a.y), bf_hi(a.y), bf_lo(a.z), bf_hi(a.z), bf_lo(a.w), bf_hi(a.w)}, rb[8] = {bf_lo(b.x), bf_hi(b.x), bf_lo(b.y), bf_hi(b.y), bf_lo(b.z), bf_hi(b.z), bf_lo(b.w), bf_hi(b.w)};
#pragma unroll
                    for (int j = 0; j < 4; ++j) { acc[ai][bj][m][0][j] *= ra[j] / fmaxf(rb[j], 1e-6f); acc[ai][bj][m][1][j] *= ra[4 + j] / fmaxf(rb[4 + j], 1e-6f); } }
    }
    __device__ __forceinline__ void operator()(const f32x4 (&acc)[2][2][4][2], const Unit& u, int wr, int wc, int fr, int fq) const {
        const int row0 = u.pm * BM + wr * 64 + fr, col0 = u.pn * BM + wc * 32 + 8 * fq;
#pragma unroll
        for (int ai = 0; ai < 2; ++ai)
#pragma unroll
            for (int m = 0; m < 4; ++m)
#pragma unroll
                for (int bj = 0; bj < 2; ++bj) { const size_t off = (size_t)(row0 + ai * HALF + m * 16) * 1024 + col0 + bj * HALF;
                    const u32x4 b = *(const u32x4*)(GB + off); const f32x4 v0 = acc[ai][bj][m][0], v1 = acc[ai][bj][m][1];
                    const float rb[8] = {bf_lo(b.x), bf_hi(b.x), bf_lo(b.y), bf_hi(b.y), bf_lo(b.z), bf_hi(b.z), bf_lo(b.w), bf_hi(b.w)};
                    u32x4 w; w.x = cvt_pk_bf16(fmaxf(rb[0], 1e-6f) * v0[0], fmaxf(rb[1], 1e-6f) * v0[1]); w.y = cvt_pk_bf16(fmaxf(rb[2], 1e-6f) * v0[2], fmaxf(rb[3], 1e-6f) * v0[3]);
                    w.z = cvt_pk_bf16(fmaxf(rb[4], 1e-6f) * v1[0], fmaxf(rb[5], 1e-6f) * v1[1]); w.w = cvt_pk_bf16(fmaxf(rb[6], 1e-6f) * v1[2], fmaxf(rb[7], 1e-6f) * v1[3]);
                    *(u32x4*)(O + off) = w; }
    }
};
struct BranchOrder : StaticOrder {
    const bf16_t* A2; const bf16_t* Bt2;
    __device__ __forceinline__ bool next(int i, Unit& u) const { const bool ok = StaticOrder::next(i >> 1, u); u.part = i & 1; return ok; }
    __device__ __forceinline__ const char* a_ptr(const Gemm& g, const Unit& u, size_t tstep) const { return (const char*)(u.part ? A2 : g.A) + (size_t)u.pm * tstep; }
    __device__ __forceinline__ const char* b_ptr(const Gemm& g, const Unit& u, size_t tstep) const { return (const char*)(u.part ? Bt2 : g.Bt) + (size_t)u.pn * tstep; }
};
struct SplitAOrder : StaticOrder {
    const bf16_t* A1;
    __device__ __forceinline__ const char* a_ptr(const Gemm& g, const Unit& u, size_t tstep) const { return u.pm < 128 ? (const char*)g.A + (size_t)u.pm * tstep : (const char*)A1 + (size_t)(u.pm - 128) * tstep; }
};

template <class Epi, class Sched, bool STAMP = false>
__device__ __forceinline__ void gemm_phase(PG8_LAS unsigned char* lds, const Gemm g, const Sched& S, const Epi& E, unsigned long long* stamps) {
    const int tid = opaque_tid(), wid = __builtin_amdgcn_readfirstlane(tid >> 6), lane = tid & 63, wr = wid >> 2, wc = wid & 3, fr = lane & 15, fq = lane >> 4;
    const int K = g.K, nt = K / BK;
    int ts_lo = 0, ts_hi = 0, nts = 0; const unsigned long long rt_entry = STAMP ? (unsigned long long)wall_clock64() : 0ull;
#define PG8_STAMP() do { if (STAMP && wid == 0 && nts < 64) { const unsigned long long _c = (unsigned long long)clock64(); \
        ts_lo = (lane == nts) ? (int)(unsigned)_c : ts_lo; ts_hi = (lane == nts) ? (int)(unsigned)(_c >> 32) : ts_hi; ++nts; } } while (0)
    PG8_STAMP();
    unsigned voffA[2], voffB[2];
#pragma unroll
    for (int i = 0; i < 2; ++i) { int R, C; stage_rc(tid * 16 + i * 8192, R, C); const int Rb = Epi::PERM ? ((R & ~31) + perm32(R & 31)) : R;
        voffA[i] = (unsigned)(R * K + C) * 2u; voffB[i] = (unsigned)(Rb * K + C) * 2u; }
    const size_t kstep = (size_t)(BK * 2);
    const size_t hstep = (size_t)HALF * K * 2;
    const size_t tstep = 2 * hstep;
    const unsigned ldsw = (unsigned)wid * 1024u;
    const int aoff = lds_byte(wr * 64 + fr, fq * 8), boff = lds_byte(wc * 32 + fr, fq * 8);
#define PG8_SA(b, h) (((b) * 2 + (h)) * HTB)
#define PG8_SB(b, h) ((4 + (b) * 2 + (h)) * HTB)
#define PG8_STAGE(bufoff, gbase, voff) do { _Pragma("unroll") for (int _i = 0; _i < 2; ++_i) \
        __builtin_amdgcn_global_load_lds((const unsigned*)((const char*)(gbase) + (voff)[_i]), (PG8_LAS unsigned*)(lds + (bufoff) + ldsw + _i * 8192), 16, 0, 0); } while (0)
#define PG8_LDA(dst, b, h) do { _Pragma("unroll") for (int m = 0; m < 4; ++m) _Pragma("unroll") for (int k = 0; k < 2; ++k) dst[m][k] = *(const PG8_LAS bf16x8*)(lds + PG8_SA(b, h) + aoff + m * 2048 + k * 1024); } while (0)
#define PG8_LDB(dst, b, h) do { _Pragma("unroll") for (int n = 0; n < 2; ++n) _Pragma("unroll") for (int k = 0; k < 2; ++k) dst[n][k] = *(const PG8_LAS bf16x8*)(lds + PG8_SB(b, h) + boff + n * 2048 + k * 1024); } while (0)
#define PG8_MMA(ai, bj, At, Bt) do { __builtin_amdgcn_s_setprio(1); _Pragma("unroll") for (int m = 0; m < 4; ++m) _Pragma("unroll") for (int n = 0; n < 2; ++n) _Pragma("unroll") for (int k = 0; k < 2; ++k) \
        acc[ai][bj][m][n] = __builtin_amdgcn_mfma_f32_16x16x32_bf16(Bt[n][k], At[m][k], acc[ai][bj][m][n], 0, 0, 0); __builtin_amdgcn_s_setprio(0); } while (0)
#define PG8_WAIT_V(n) asm volatile("s_waitcnt vmcnt(" #n ")" ::: "memory")
#define PG8_WAIT_L(n) asm volatile("s_waitcnt lgkmcnt(" #n ")" ::: "memory")
#define PG8_BAR __builtin_amdgcn_s_barrier()
#define PG8_SCHED __builtin_amdgcn_sched_barrier(0)
    Unit cur, nxt; int ui = 0;
    if (!S.next(0, cur)) return;
    f32x4 acc[2][2][4][2];
#pragma unroll
    for (int a = 0; a < 2; ++a)
#pragma unroll
        for (int b = 0; b < 2; ++b)
#pragma unroll
            for (int m = 0; m < 4; ++m)
#pragma unroll
                for (int n = 0; n < 2; ++n) acc[a][b][m][n] = (f32x4){0.f, 0.f, 0.f, 0.f};
    bf16x8 At[4][2], B0[2][2], B1[2][2];
    const char* cA = S.a_ptr(g, cur, tstep); const char* cB = S.b_ptr(g, cur, tstep);
    S.a_ready(cur);
    PG8_STAGE(PG8_SB(0, 0), cB, voffB); PG8_STAGE(PG8_SA(0, 0), cA, voffA); PG8_STAGE(PG8_SB(0, 1), cB + hstep, voffB); PG8_STAGE(PG8_SA(0, 1), cA + hstep, voffA);
    if (wr == 1) PG8_BAR;
    PG8_WAIT_V(4); PG8_BAR;
    PG8_STAGE(PG8_SB(1, 0), cB + kstep, voffB); PG8_STAGE(PG8_SA(1, 0), cA + kstep, voffA); PG8_STAGE(PG8_SB(1, 1), cB + hstep + kstep, voffB);
    PG8_WAIT_V(6); PG8_BAR;
    PG8_STAMP();
    for (;;) {
        const bool has_next = S.next(ui + 1, nxt);
        const char* nA = has_next ? S.a_ptr(g, nxt, tstep) : cA; const char* nB = has_next ? S.b_ptr(g, nxt, tstep) : cB;
        for (int t = 0; t < nt; t += 2) {
            const bool last = (t == nt - 2);
            const char* a1 = cA + (size_t)(t + 1) * kstep;
            const char* a2 = last ? nA : cA + (size_t)(t + 2) * kstep; const char* b2 = last ? nB : cB + (size_t)(t + 2) * kstep;
            const char* a3 = a2 + kstep; const char* b3 = b2 + kstep;
            if (last && has_next) S.a_ready(nxt);
            PG8_LDB(B0, 0, 0); PG8_SCHED; PG8_LDA(At, 0, 0); PG8_STAGE(PG8_SA(1, 1), a1 + hstep, voffA);
            PG8_WAIT_L(8); PG8_BAR; PG8_WAIT_L(0); PG8_MMA(0, 0, At, B0); PG8_BAR; PG8_SCHED;
            PG8_LDB(B1, 0, 1); PG8_STAGE(PG8_SB(0, 0), b2, voffB);
            PG8_BAR; PG8_WAIT_L(0); PG8_MMA(0, 1, At, B1); PG8_BAR;
            PG8_LDA(At, 0, 1); PG8_STAGE(PG8_SA(0, 0), a2, voffA);
            PG8_BAR; PG8_WAIT_L(0); PG8_MMA(1, 0, At, B0); PG8_BAR; PG8_SCHED;
            PG8_STAGE(PG8_SB(0, 1), b2 + hstep, voffB);
            PG8_WAIT_V(6); PG8_BAR; PG8_MMA(1, 1, At, B1); PG8_BAR;
            PG8_LDB(B0, 1, 0); PG8_SCHED; PG8_LDA(At, 1, 0); PG8_STAGE(PG8_SA(0, 1), a2 + hstep, voffA);
            PG8_WAIT_L(8); PG8_BAR; PG8_WAIT_L(0); PG8_MMA(0, 0, At, B0); PG8_BAR; PG8_SCHED;
            PG8_LDB(B1, 1, 1); PG8_STAGE(PG8_SB(1, 0), b3, voffB);
            PG8_BAR; PG8_WAIT_L(0); PG8_MMA(0, 1, At, B1); PG8_BAR;
            PG8_LDA(At, 1, 1); PG8_STAGE(PG8_SA(1, 0), a3, voffA);
            PG8_BAR; PG8_WAIT_L(0); PG8_MMA(1, 0, At, B0); PG8_BAR; PG8_SCHED;
            PG8_STAGE(PG8_SB(1, 1), b3 + hstep, voffB);
            PG8_WAIT_V(6); PG8_BAR; PG8_MMA(1, 1, At, B1); PG8_BAR;
        }
        PG8_STAMP();
        if constexpr (Epi::TWO_PART) { if (cur.part == 0) E.mid(acc, cur, wr, wc, fr, fq); else E(acc, cur, wr, wc, fr, fq); } else if constexpr (!Epi::AFTER_DRAIN) { E(acc, cur, wr, wc, fr, fq); S.done(cur); }
        PG8_STAMP();
        if (!has_next) break;
        bool keep_acc = false; if constexpr (Epi::TWO_PART) keep_acc = (cur.part == 0);
        if (!keep_acc)
#pragma unroll
        for (int a = 0; a < 2; ++a)
#pragma unroll
            for (int b = 0; b < 2; ++b)
#pragma unroll
                for (int m = 0; m < 4; ++m)
#pragma unroll
                    for (int n = 0; n < 2; ++n) acc[a][b][m][n] = (f32x4){0.f, 0.f, 0.f, 0.f};
        cur = nxt; cA = nA; cB = nB; ++ui;
    }
    PG8_WAIT_V(0);
    if (wr == 0) PG8_BAR;
    PG8_BAR;
    if constexpr (Epi::AFTER_DRAIN) { E.fused(acc, cur, wr, wc, fr, fq, lds, wid, lane); S.done(cur); }
    PG8_STAMP();
    if (STAMP && wid == 0) { stamps[lane] = lane < nts ? (((unsigned long long)(unsigned)ts_hi << 32) | (unsigned)ts_lo) : 0ull;
        if (lane == 62) stamps[62] = rt_entry; if (lane == 63) stamps[63] = (unsigned long long)wall_clock64(); }
#undef PG8_STAMP
#undef PG8_SA
#undef PG8_SB
#undef PG8_STAGE
#undef PG8_LDA
#undef PG8_LDB
#undef PG8_MMA
#undef PG8_WAIT_V
#undef PG8_WAIT_L
#undef PG8_BAR
#undef PG8_SCHED
}
}
using pg8::bf16_t; using pg8::bf16x8; using pg8::f32x4; using pg8::u32x4; using pg8::cvt_pk_bf16; using pg8::bf_lo; using pg8::bf_hi; using pg8::opaque_tid;
#define LAS __attribute__((address_space(3)))
typedef unsigned u32x2 __attribute__((ext_vector_type(2)));

constexpr int NT = 65536, DM = 1024, NL = 4, SEQ = 8192, FH = 2816, TH = 32768  ;
constexpr int LDS_BYTES = 144 * 1024, XB_ST_OFF = 143616;
constexpr size_t MiB = 1024ull * 1024ull;
constexpr size_t WS_MOD = 64 * 1024;
constexpr size_t WS_WST = 2 * MiB;
constexpr size_t WS_LB = 3 * MiB;
constexpr size_t WS_WIN = 4 * MiB;
constexpr size_t WS_W13 = 68 * MiB;
constexpr size_t WS_W2 = 156 * MiB;
constexpr size_t WS_WA = 200 * MiB, WS_WB = 208 * MiB, WS_WO = 216 * MiB;
constexpr size_t WS_HN = 224 * MiB;
constexpr size_t WS_BIG = 352 * MiB;
constexpr size_t ZB = 64 * MiB;
constexpr size_t WS_U = WS_BIG, WS_V = WS_BIG + ZB, WS_Q = WS_BIG + 2 * ZB, WS_F = WS_BIG + 3 * ZB  , WS_I = WS_BIG + 5 * ZB, WS_OG = WS_BIG + 6 * ZB, WS_GA = WS_BIG + 7 * ZB, WS_GB = WS_BIG + 8 * ZB;
constexpr size_t WS_HU = WS_BIG + 9 * ZB;
constexpr size_t WS_HD = WS_HU + 16 * MiB;
constexpr size_t WS_M0 = WS_HD + 1 * MiB;
constexpr size_t WS_END = WS_M0 + ZB;

struct Params { const float* in[15]; float* out; unsigned char* ws; int ph_lo, ph_hi; };
typedef const Params __attribute__((address_space(4))) * KP;

__device__ __forceinline__ float wave_sum(float v) {
#pragma unroll
    for (int o = 1; o < 64; o <<= 1) v += __shfl_xor(v, o);
    return v;
}

__device__ __forceinline__ void transpose_item(const float* __restrict__ W, int K, int N, bf16_t* __restrict__ WT, int item, int remap, LAS float* scr, int lane) {
    const int nblk = N / 32, kb = item / nblk, nb = item - kb * nblk, k0 = 64 * kb, n0 = 32 * nb;
    int drow0 = n0;
    if (remap) { const int bj = n0 / FH, nn = n0 - bj * FH; drow0 = (nn >> 7) * 256 + bj * 128 + (nn & 127); }
#pragma unroll 8
    for (int i = 0; i < 32; ++i) { const int kk = 2 * i + (lane >> 5); scr[kk * 33 + (lane & 31)] = W[(size_t)(k0 + kk) * N + n0 + (lane & 31)]; }
    asm volatile("s_waitcnt lgkmcnt(0)" ::: "memory");
    const int c = lane & 7;
#pragma unroll
    for (int j = 0; j < 4; ++j) { const int n = (lane >> 3) + 8 * j; const LAS float* s = scr + (8 * c) * 33 + n;
        u32x4 o; o.x = cvt_pk_bf16(s[0 * 33], s[1 * 33]); o.y = cvt_pk_bf16(s[2 * 33], s[3 * 33]); o.z = cvt_pk_bf16(s[4 * 33], s[5 * 33]); o.w = cvt_pk_bf16(s[6 * 33], s[7 * 33]);
        *(u32x4*)(WT + (size_t)(drow0 + n) * K + k0 + 8 * c) = o; }
    asm volatile("s_waitcnt lgkmcnt(0)" ::: "memory");
}

__device__ __forceinline__ void prologue_phase(KP p, LAS unsigned char* lds) {
    const int tid = opaque_tid(), lane = tid & 63, wave = tid >> 6, G = gridDim.x;
    unsigned char* ws = p->ws;
    {
        LAS float* cact = (LAS float*)lds;
        LAS float* red = (LAS float*)(lds + 32768);
        const float* c = p->in[1];
        for (int i = tid; i < 8192; i += 512) { const int b = i >> 10, k = i & 1023; const float x = c[i]; cact[k * 8 + b] = x / (1.0f + __expf(-x)); }
        __syncthreads();
        for (int task = blockIdx.x; task < 288; task += G) {
            const int idx = task * 128 + (tid & 127), kq = tid >> 7, l = idx / 9216, n = idx - l * 9216;
            const float* aw = p->in[12] + (size_t)l * 1024 * 9216 + n;
            float a[8];
#pragma unroll
            for (int b = 0; b < 8; ++b) a[b] = 0.f;
#pragma unroll 8
            for (int k = kq * 256; k < kq * 256 + 256; ++k) { const float w = aw[(size_t)k * 9216]; const f32x4 c0 = *(const LAS f32x4*)(cact + k * 8), c1 = *(const LAS f32x4*)(cact + k * 8 + 4);
                a[0] += c0[0] * w; a[1] += c0[1] * w; a[2] += c0[2] * w; a[3] += c0[3] * w; a[4] += c1[0] * w; a[5] += c1[1] * w; a[6] += c1[2] * w; a[7] += c1[3] * w; }
#pragma unroll
            for (int b = 0; b < 8; ++b) red[(kq * 8 + b) * 128 + (tid & 127)] = a[b];
            __syncthreads();
            if (kq == 0) { const float bias = p->in[13][idx]; float* mod = (float*)(ws + WS_MOD);
#pragma unroll
                for (int b = 0; b < 8; ++b) mod[((size_t)l * 8 + b) * 9216 + n] = ((red[b * 128 + tid] + red[(8 + b) * 128 + tid]) + (red[(16 + b) * 128 + tid] + red[(24 + b) * 128 + tid])) + bias; }
            __syncthreads();
        }
    }
    if (blockIdx.x == 72 % G) {
        const float* lg = p->in[5]; float* lb = (float*)(ws + WS_LB);
        for (int k = tid; k < 1024; k += 512) { const float a0 = lg[k], a1 = lg[1024 + k], a2 = lg[2048 + k], a3 = lg[3072 + k]; const float mx = fmaxf(fmaxf(a0, a1), fmaxf(a2, a3));
            const float e0 = __expf(a0 - mx), e1 = __expf(a1 - mx), e2 = __expf(a2 - mx), e3 = __expf(a3 - mx), inv = 1.0f / (e0 + e1 + e2 + e3);
            lb[k] = 0.f; lb[1024 + k] = e1 * inv; lb[2048 + k] = (e1 + e2) * inv; lb[3072 + k] = (e1 + e2 + e3) * inv; }
    }
    { const float* wsrc = p->in[3]; bf16_t* wst = (bf16_t*)(ws + WS_WST);
      for (int i = blockIdx.x * 512 + tid; i < 4 * 8 * 128 * 128 / 2; i += G * 512) { const int e = 2 * i, s = e & 127, t = (e >> 7) & 127;
          const float v0 = s <= t ? wsrc[e] : 0.f, v1 = (s + 1) <= t ? wsrc[e + 1] : 0.f; ((unsigned*)wst)[i] = cvt_pk_bf16(v0, v1); } }
    LAS float* scr = (LAS float*)(lds + 32768 + wave * 8704);
    const int gw = blockIdx.x * 8 + wave, NGW = G * 8;
    constexpr int I_IN = 16 * 256, I_13 = 16 * 176, I_2 = 44 * 32, I_SQ = 16 * 32, I_LAYER = I_IN + 2 * I_13 + 2 * I_2 + 3 * I_SQ;
    for (int it = gw; it < NL * I_LAYER; it += NGW) {
        const int l = it / I_LAYER; int r = it - l * I_LAYER;
        if (r < I_IN) { transpose_item(p->in[2] + (size_t)l * 1024 * 8192, 1024, 8192, (bf16_t*)(ws + WS_WIN) + (size_t)l * 8192 * 1024, r, 0, scr, lane); continue; } r -= I_IN;
        if (r < 2 * I_13) { const int s = r / I_13; r -= s * I_13; transpose_item(p->in[9] + (size_t)(l * 2 + s) * 1024 * 5632, 1024, 5632, (bf16_t*)(ws + WS_W13) + (size_t)(l * 2 + s) * 5632 * 1024, r, 1, scr, lane); continue; } r -= 2 * I_13;
        if (r < 2 * I_2) { const int s = r / I_2; r -= s * I_2; transpose_item(p->in[10] + (size_t)(l * 2 + s) * FH * 1024, FH, 1024, (bf16_t*)(ws + WS_W2) + (size_t)(l * 2 + s) * 1024 * FH, r, 0, scr, lane); continue; } r -= 2 * I_2;
        const int m = r / I_SQ; r -= m * I_SQ;
        const float* src = (m == 0 ? p->in[6] : (m == 1 ? p->in[7] : p->in[8])) + (size_t)l * 1024 * 1024;
        bf16_t* dst = (bf16_t*)(ws + (m == 0 ? WS_WA : (m == 1 ? WS_WB : WS_WO))) + (size_t)l * 1024 * 1024;
        transpose_item(src, 1024, 1024, dst, r, 0, scr, lane);
    }
}

template <bool FINAL> __device__ __forceinline__ void norm_phase(const float* hin, bf16_t* hn, float* fout, const float* nw, const float* modl  , int sub) {
    const int tid = opaque_tid(), lane = tid & 63, gw = blockIdx.x * 8 + (tid >> 6), NGW = gridDim.x * 8;
    f32x4 w4[4];
#pragma unroll
    for (int j = 0; j < 4; ++j) w4[j] = *(const f32x4*)(nw + 4 * lane + 256 * j);
    for (int row = gw; row < NT; row += NGW) {
        const float* xr = hin + (size_t)row * DM + 4 * lane;
        f32x4 v[4]; float s = 0.f;
#pragma unroll
        for (int j = 0; j < 4; ++j) { v[j] = *(const f32x4*)(xr + 256 * j); s += (v[j][0] * v[j][0] + v[j][1] * v[j][1]) + (v[j][2] * v[j][2] + v[j][3] * v[j][3]); }
        const float rstd = rsqrtf(wave_sum(s) * (1.0f / DM) + 1e-6f);
        if (FINAL) {
#pragma unroll
            for (int j = 0; j < 4; ++j) *(f32x4*)(fout + (size_t)row * DM + 4 * lane + 256 * j) = v[j] * rstd * w4[j];
        } else {
            const float* sh = modl + (size_t)(row >> 13) * 9216 + (3 * sub) * 1024 + 4 * lane; const float* sc = sh + 1024;
#pragma unroll
            for (int j = 0; j < 4; ++j) { const f32x4 a = *(const f32x4*)(sc + 256 * j), b = *(const f32x4*)(sh + 256 * j); const f32x4 o = v[j] * rstd * w4[j] * (a + 1.0f) + b;
                u32x2 w; w.x = cvt_pk_bf16(o[0], o[1]); w.y = cvt_pk_bf16(o[2], o[3]); *(u32x2*)(hn + (size_t)row * DM + 4 * lane + 256 * j) = w; }
        }
    }
}

__device__ __forceinline__ int tr64_off(int row, int col) { return row * 128 + ((((col >> 3) ^ (row ^ (row >> 3))) & 7) << 4) + ((col & 7) << 1); }
__device__ __forceinline__ int tr128_off(int row, int col) { return row * 256 + ((((col >> 3) ^ (row ^ (row >> 3))) & 15) << 4) + ((col & 7) << 1); }
constexpr int H_LF = 0, H_P = 0  , H_TOT = 32768, H_VEC = 34816, H_SS = 36864, H_QP = 38912, H_KP = 56320, H_KT = 73728, H_VT = 90112, H_ST = 106496, H_END = 141312;
static_assert(H_END <= LDS_BYTES, "LDS");
#define MFMA16(a, b, c) __builtin_amdgcn_mfma_f32_16x16x32_bf16((a), (b), (c), 0, 0, 0)

template <bool PRE> __device__ __forceinline__ void hgrn_seq(LAS unsigned char* lds, const bf16_t* __restrict__ Qb, const float* __restrict__ Fb, const bf16_t* __restrict__ Ib, const bf16_t* OGb, bf16_t* OUTb, size_t row_base, int colbase, int c0, int nch, float* Ubuf, float* Dbuf, int item0, int nprev) {
    const int tid = opaque_tid(), lane = tid & 63, w = __builtin_amdgcn_readfirstlane(tid >> 6), q4 = lane >> 4, l15 = lane & 15;
    const int pt = tid >> 4, pc8 = (tid & 15) * 8;
    const int sk = tid & 127, sseg = tid >> 7;
    LAS float* Lf = (LAS float*)(lds + H_LF); LAS float* Ltot = (LAS float*)(lds + H_TOT); LAS float* Lss = (LAS float*)(lds + H_SS);
    f32x4 S[8];
#pragma unroll
    for (int i = 0; i < 8; ++i) S[i] = (f32x4){0.f, 0.f, 0.f, 0.f};
    if (!PRE) { for (int j = 0; j < nprev; ++j) { const float* Uj = Ubuf + (size_t)(item0 + j) * 16384; const f32x4 dj = *(const f32x4*)(Dbuf + (size_t)(item0 + j) * 128 + 16 * w + 4 * q4);
#pragma unroll
            for (int vt = 0; vt < 8; ++vt) S[vt] = S[vt] * dj + *(const f32x4*)(Uj + (vt * 512 + tid) * 4); } }
    float dacc = 1.0f;
    u32x4 rq[2], rv[2]; float rfc[16];
#define HG_LOADF(c) do { const float* fp_ = Fb + (row_base + (size_t)(c) * 64 + 16 * sseg) * 1024 + colbase + sk; _Pragma("unroll") for (int i_ = 0; i_ < 16; ++i_) rfc[i_] = fp_[(size_t)i_ * 1024]; } while (0)
#define HG_LOADQV(c) do { _Pragma("unroll") for (int i_ = 0; i_ < 2; ++i_) { const size_t go_ = (row_base + (size_t)(c) * 64 + pt + 32 * i_) * 1024 + colbase + pc8; \
        if (!PRE) rq[i_] = *(const u32x4*)(Qb + go_); rv[i_] = *(const u32x4*)(Ib + go_); } } while (0)
    HG_LOADF(c0); HG_LOADQV(c0);
    for (int c = c0; c < c0 + nch; ++c) {
        u32x2 rog[4];
        if (!PRE) {
#pragma unroll
        for (int ti = 0; ti < 4; ++ti) rog[ti] = *(const u32x2*)(OGb + (row_base + (size_t)c * 64 + 16 * ti + l15) * 1024 + colbase + 16 * w + 4 * q4); }
        { float run = 0.f;
#pragma unroll
          for (int i = 0; i < 16; ++i) { run += rfc[i]; Lf[(16 * sseg + i) * 128 + sk] = run; }
          Ltot[sseg * 128 + sk] = run; }
        if (c + 1 < c0 + nch) HG_LOADF(c + 1);
        __syncthreads();
        f32x4 e4, d4, c4;
        { const int kk = 16 * w + 4 * q4; const f32x4 a0 = *(const LAS f32x4*)(Ltot + kk), a1 = *(const LAS f32x4*)(Ltot + 128 + kk), a2 = *(const LAS f32x4*)(Ltot + 256 + kk), a3 = *(const LAS f32x4*)(Ltot + 384 + kk);
          const f32x4 b31 = a0 + a1, b63 = b31 + (a2 + a3);
#pragma unroll
          for (int r = 0; r < 4; ++r) { e4[r] = __expf(b31[r]); d4[r] = __expf(b63[r]); c4[r] = __expf(b63[r] - b31[r]); } }
        if (PRE) { if (tid < 128) dacc *= __expf((Ltot[tid] + Ltot[128 + tid]) + (Ltot[256 + tid] + Ltot[384 + tid])); }
        { f32x4 tv[4][2];
#pragma unroll
          for (int sg = 0; sg < 4; ++sg) { tv[sg][0] = *(const LAS f32x4*)(Ltot + sg * 128 + pc8); tv[sg][1] = *(const LAS f32x4*)(Ltot + sg * 128 + pc8 + 4); }
#pragma unroll
          for (int i = 0; i < 2; ++i) { const int t = pt + 32 * i; const bool hi = (pt >> 4) != 0;
            f32x4 off[2], ref[2];
#pragma unroll
            for (int h = 0; h < 2; ++h) { ref[h] = tv[0][h] + tv[1][h];
                if (i == 0) off[h] = hi ? tv[0][h] : (f32x4){0.f, 0.f, 0.f, 0.f}; else off[h] = hi ? ref[h] + tv[2][h] : ref[h]; }
            const f32x4 b0 = *(const LAS f32x4*)(Lf + t * 128 + pc8), b1 = *(const LAS f32x4*)(Lf + t * 128 + pc8 + 4);
            f32x4 p0 = (f32x4){0.f, 0.f, 0.f, 0.f}, p1 = p0;
            if (t & 15) { p0 = *(const LAS f32x4*)(Lf + (t - 1) * 128 + pc8); p1 = *(const LAS f32x4*)(Lf + (t - 1) * 128 + pc8 + 4); }
            unsigned qw[4] = {0u, 0u, 0u, 0u}; if (!PRE) { qw[0] = rq[i].x; qw[1] = rq[i].y; qw[2] = rq[i].z; qw[3] = rq[i].w; } const unsigned vw[4] = {rv[i].x, rv[i].y, rv[i].z, rv[i].w};
            float qp[8], kp[8];
#pragma unroll
            for (int j = 0; j < 8; ++j) { const float bl = j < 4 ? b0[j & 3] : b1[j & 3], pl = j < 4 ? p0[j & 3] : p1[j & 3], of = j < 4 ? off[0][j & 3] : off[1][j & 3], rr = j < 4 ? ref[0][j & 3] : ref[1][j & 3];
                const float lf = bl - pl, d = fminf(fmaxf((bl + of) - rr, -80.f), 80.f);
                if (!PRE) { const float qv = (j & 1) ? bf_hi(qw[j >> 1]) : bf_lo(qw[j >> 1]); qp[j] = qv * __expf(d); } else qp[j] = 0.f;
                kp[j] = (1.0f - __expf(lf)) * __expf(-d); }
            u32x4 wq, wk; wq.x = cvt_pk_bf16(qp[0], qp[1]); wq.y = cvt_pk_bf16(qp[2], qp[3]); wq.z = cvt_pk_bf16(qp[4], qp[5]); wq.w = cvt_pk_bf16(qp[6], qp[7]);
            wk.x = cvt_pk_bf16(kp[0], kp[1]); wk.y = cvt_pk_bf16(kp[2], kp[3]); wk.z = cvt_pk_bf16(kp[4], kp[5]); wk.w = cvt_pk_bf16(kp[6], kp[7]);
            if (!PRE) { *(LAS u32x4*)(lds + H_QP + t * 272 + pc8 * 2) = wq; *(LAS u32x4*)(lds + H_KP + t * 272 + pc8 * 2) = wk; }
            const unsigned kw[4] = {wk.x, wk.y, wk.z, wk.w};
#pragma unroll
            for (int j = 0; j < 8; ++j) { const unsigned short kk = (unsigned short)((j & 1) ? (kw[j >> 1] >> 16) : (kw[j >> 1] & 0xffffu)), vv = (unsigned short)((j & 1) ? (vw[j >> 1] >> 16) : (vw[j >> 1] & 0xffffu));
                *(LAS unsigned short*)(lds + H_KT + tr64_off(pc8 + j, t)) = kk; *(LAS unsigned short*)(lds + H_VT + tr64_off(pc8 + j, t)) = vv; } } }
        if (!PRE) {
#pragma unroll
          for (int vt = 0; vt < 8; ++vt) { const f32x4 sv = S[vt] * e4; u32x2 o; o.x = cvt_pk_bf16(sv[0], sv[1]); o.y = cvt_pk_bf16(sv[2], sv[3]);
              *(LAS u32x2*)(lds + H_ST + (16 * vt + l15) * 272 + (16 * w + 4 * q4) * 2) = o; } }
        if (c + 1 < c0 + nch) HG_LOADQV(c + 1);
        __syncthreads();
        f32x4 oT[4];
        if (!PRE) {
        { const int ti = w >> 1;
#pragma unroll
          for (int sj = 0; sj < 2; ++sj) { const int si = 2 * (w & 1) + sj; f32x4 a4 = (f32x4){0.f, 0.f, 0.f, 0.f};
              if (si <= ti) {
#pragma unroll
                  for (int kb = 0; kb < 4; ++kb) { const bf16x8 a = *(const LAS bf16x8*)(lds + H_KP + (16 * si + l15) * 272 + kb * 64 + q4 * 16), b = *(const LAS bf16x8*)(lds + H_QP + (16 * ti + l15) * 272 + kb * 64 + q4 * 16); a4 = MFMA16(a, b, a4); }
                  const int t = 16 * ti + l15, s0 = 16 * si + 4 * q4;
#pragma unroll
                  for (int r = 0; r < 4; ++r) a4[r] = (s0 + r <= t) ? a4[r] : 0.f; }
              u32x2 o; o.x = cvt_pk_bf16(a4[0], a4[1]); o.y = cvt_pk_bf16(a4[2], a4[3]);
              *(LAS u32x2*)(lds + H_P + (16 * ti + l15) * 144 + (16 * si + 4 * q4) * 2) = o; } }
#pragma unroll
        for (int ti = 0; ti < 4; ++ti) oT[ti] = (f32x4){0.f, 0.f, 0.f, 0.f};
#pragma unroll
        for (int kb = 0; kb < 4; ++kb) { const bf16x8 a = *(const LAS bf16x8*)(lds + H_ST + (16 * w + l15) * 272 + kb * 64 + q4 * 16);
#pragma unroll
            for (int ti = 0; ti < 4; ++ti) { const bf16x8 b = *(const LAS bf16x8*)(lds + H_QP + (16 * ti + l15) * 272 + kb * 64 + q4 * 16); oT[ti] = MFMA16(a, b, oT[ti]); } }
        __syncthreads();
        }
        { f32x4 U[8];
#pragma unroll
          for (int vt = 0; vt < 8; ++vt) U[vt] = (f32x4){0.f, 0.f, 0.f, 0.f};
#pragma unroll
          for (int kb = 0; kb < 2; ++kb) { const bf16x8 av = *(const LAS bf16x8*)(lds + H_VT + tr64_off(16 * w + l15, 32 * kb + 8 * q4)), ak = *(const LAS bf16x8*)(lds + H_KT + tr64_off(16 * w + l15, 32 * kb + 8 * q4));
#pragma unroll
              for (int ti = 0; ti < 4; ++ti) { if (!PRE && (kb == 0 || ti >= 2)) { const bf16x8 b = *(const LAS bf16x8*)(lds + H_P + (16 * ti + l15) * 144 + (32 * kb + 8 * q4) * 2); oT[ti] = MFMA16(av, b, oT[ti]); } }
#pragma unroll
              for (int vt = 0; vt < 8; ++vt) { const bf16x8 b = *(const LAS bf16x8*)(lds + H_VT + tr64_off(16 * vt + l15, 32 * kb + 8 * q4)); U[vt] = MFMA16(ak, b, U[vt]); } }
#pragma unroll
          for (int vt = 0; vt < 8; ++vt) S[vt] = S[vt] * d4 + U[vt] * c4; }
        if (!PRE) {
#pragma unroll
        for (int ti = 0; ti < 4; ++ti) { float ss = (oT[ti][0] * oT[ti][0] + oT[ti][1] * oT[ti][1]) + (oT[ti][2] * oT[ti][2] + oT[ti][3] * oT[ti][3]); ss += __shfl_xor(ss, 16); ss += __shfl_xor(ss, 32);
            if (q4 == 0) Lss[w * 64 + 16 * ti + l15] = ss; }
        __syncthreads();
#pragma unroll
        for (int ti = 0; ti < 4; ++ti) { const int t = 16 * ti + l15; float tot = 0.f;
#pragma unroll
            for (int ww = 0; ww < 8; ++ww) tot += Lss[ww * 64 + t];
            const float rs = rsqrtf(tot * (1.0f / 128.0f) + 1e-6f);
            u32x2 o; o.x = cvt_pk_bf16(oT[ti][0] * rs * bf_lo(rog[ti].x), oT[ti][1] * rs * bf_hi(rog[ti].x)); o.y = cvt_pk_bf16(oT[ti][2] * rs * bf_lo(rog[ti].y), oT[ti][3] * rs * bf_hi(rog[ti].y));
            *(u32x2*)(OUTb + (row_base + (size_t)c * 64 + t) * 1024 + colbase + 16 * w + 4 * q4) = o; }
        }
    }
    if (PRE) { float* Uo = Ubuf + (size_t)item0 * 16384;
#pragma unroll
        for (int vt = 0; vt < 8; ++vt) *(f32x4*)(Uo + (vt * 512 + tid) * 4) = S[vt];
        if (tid < 128) Dbuf[(size_t)item0 * 128 + tid] = dacc; }
    __syncthreads();
#undef HG_LOADF
#undef HG_LOADQV
}

__device__ __forceinline__ void gmlp_loop(LAS unsigned char* lds, const bf16_t* __restrict__ Vb, const bf16_t* Ub, bf16_t* Ob, const bf16_t* __restrict__ wst  , const float* __restrict__ gbias  , int first, int stride, int nitems) {
    const int tid = opaque_tid(), lane = tid & 63, w = __builtin_amdgcn_readfirstlane(tid >> 6), q4 = lane >> 4, l15 = lane & 15;
    const int ps = tid >> 4, pc8 = (tid & 15) * 8, nkb = (w >> 1) + 1, t = 16 * w + l15;
    int it = first; if (it >= nitems) return;
    u32x4 rv[4]; u32x2 ru[8]; bf16x8 wf[4]; float bt;
#define GM_DEC(i_) const int g8_ = (i_) & 7; const size_t row0_ = (size_t)((i_) >> 9) * SEQ + (size_t)(((i_) >> 3) & 63) * 128; const int col0_ = g8_ * 128;
#define GM_LOADV(i_) do { GM_DEC(i_) _Pragma("unroll") for (int i = 0; i < 4; ++i) rv[i] = *(const u32x4*)(Vb + (row0_ + ps + 32 * i) * 1024 + col0_ + pc8); \
        _Pragma("unroll") for (int kb = 0; kb < 4; ++kb) if (kb < nkb) wf[kb] = *(const bf16x8*)(wst + (size_t)g8_ * 16384 + (16 * w + l15) * 128 + kb * 32 + q4 * 8); } while (0)
#define GM_LOADU(i_) do { GM_DEC(i_) bt = gbias[g8_ * 128 + t]; _Pragma("unroll") for (int ct = 0; ct < 8; ++ct) ru[ct] = *(const u32x2*)(Ub + (row0_ + t) * 1024 + col0_ + 16 * ct + 4 * q4); } while (0)
    GM_LOADV(it); GM_LOADU(it);
    for (;;) {
#pragma unroll
        for (int i = 0; i < 4; ++i) { const int s = ps + 32 * i; const u32x4 raw = rv[i];
            float x[8] = {bf_lo(raw.x), bf_hi(raw.x), bf_lo(raw.y), bf_hi(raw.y), bf_lo(raw.z), bf_hi(raw.z), bf_lo(raw.w), bf_hi(raw.w)};
            float sm = ((x[0] + x[1]) + (x[2] + x[3])) + ((x[4] + x[5]) + (x[6] + x[7]));
            sm += __shfl_xor(sm, 1); sm += __shfl_xor(sm, 2); sm += __shfl_xor(sm, 4); sm += __shfl_xor(sm, 8);
            const float mu = sm * (1.0f / 128.0f); float vs = 0.f;
#pragma unroll
            for (int j = 0; j < 8; ++j) { x[j] -= mu; vs += x[j] * x[j]; }
            vs += __shfl_xor(vs, 1); vs += __shfl_xor(vs, 2); vs += __shfl_xor(vs, 4); vs += __shfl_xor(vs, 8);
            const float rstd = rsqrtf(vs * (1.0f / 128.0f) + 1e-6f);
#pragma unroll
            for (int j = 0; j < 4; ++j) { const unsigned pk = cvt_pk_bf16(x[2 * j] * rstd, x[2 * j + 1] * rstd);
                *(LAS unsigned short*)(lds + tr128_off(pc8 + 2 * j, s)) = (unsigned short)(pk & 0xffffu); *(LAS unsigned short*)(lds + tr128_off(pc8 + 2 * j + 1, s)) = (unsigned short)(pk >> 16); } }
        bf16x8 wc[4];
#pragma unroll
        for (int kb = 0; kb < 4; ++kb) wc[kb] = wf[kb];
        const int nxt = it + stride; const bool more = nxt < nitems;
        if (more) GM_LOADV(nxt);
        __syncthreads();
        f32x4 acc[8];
#pragma unroll
        for (int ct = 0; ct < 8; ++ct) acc[ct] = (f32x4){0.f, 0.f, 0.f, 0.f};
#pragma unroll
        for (int kb = 0; kb < 4; ++kb) if (kb < nkb) {
#pragma unroll
            for (int ct = 0; ct < 8; ++ct) { const bf16x8 a = *(const LAS bf16x8*)(lds + tr128_off(16 * ct + l15, 32 * kb + 8 * q4)); acc[ct] = MFMA16(a, wc[kb], acc[ct]); } }
        { GM_DEC(it)
#pragma unroll
          for (int ct = 0; ct < 8; ++ct) { const u32x2 uu = ru[ct];
              u32x2 o; o.x = cvt_pk_bf16(bf_lo(uu.x) * (acc[ct][0] + bt), bf_hi(uu.x) * (acc[ct][1] + bt)); o.y = cvt_pk_bf16(bf_lo(uu.y) * (acc[ct][2] + bt), bf_hi(uu.y) * (acc[ct][3] + bt));
              *(u32x2*)(Ob + (row0_ + t) * 1024 + col0_ + 16 * ct + 4 * q4) = o; } }
        if (!more) break;
        GM_LOADU(nxt);
        __syncthreads();
        it = nxt;
    }
    __syncthreads();
#undef GM_DEC
#undef GM_LOADV
#undef GM_LOADU
}

#define XB_TMO      128
#define XB_XCNT(j)  (256  + 64 * (j))
#define XB_XSUB(j)  (1280 + 64 * (j))
#define XB_XGEN(j)  (2304 + 64 * (j))
#define XB_TOP      3328
#define XB_TOPGEN   3392
#define XCD_BAR_WORDS 3456
#define XB_SPIN_CAP (1u << 18)

__device__ __forceinline__ unsigned xb_ld(unsigned* p)              { return __hip_atomic_load(p, __ATOMIC_RELAXED, __HIP_MEMORY_SCOPE_AGENT); }
__device__ __forceinline__ unsigned xb_add(unsigned* p, unsigned v) { return __hip_atomic_fetch_add(p, v, __ATOMIC_RELAXED, __HIP_MEMORY_SCOPE_AGENT); }
__device__ __forceinline__ unsigned xb_xcc_id() { return (unsigned)__builtin_amdgcn_s_getreg((3 << 11) | 20) & 0xFu; }
#define XB_SPIN(cond, bar) do { unsigned _sp = 0; while (cond) { __builtin_amdgcn_s_sleep(1); \
    if ((++_sp & 255u) == 0u) { if (xb_ld(&(bar)[XB_TMO])) break; if (_sp > XB_SPIN_CAP) { atomicAdd(&(bar)[XB_TMO], 1u); break; } } } } while (0)

struct XcdBarrier {
    unsigned* bar; unsigned x;
    volatile LAS unsigned* st;
};

__device__ __forceinline__ XcdBarrier xcd_barrier_post(unsigned* bar, volatile LAS unsigned* st) {
    XcdBarrier b; b.bar = bar; b.x = xb_xcc_id(); b.st = st;
    if (threadIdx.x == 0) (void)xb_add(&bar[XB_XCNT(b.x)], 1u);
    return b;
}
__device__ __forceinline__ void xcd_barrier_complete(unsigned* bar, unsigned x, unsigned& nloc, unsigned& nx) {
    const unsigned G = gridDim.x * gridDim.y * gridDim.z;
    unsigned sum, cnt, mine, sp = 0u;
    for (;;) {
        sum = 0u; cnt = 0u; mine = 0u;
#pragma unroll
        for (unsigned j = 0; j < 16; ++j) { const unsigned c = xb_ld(&bar[XB_XCNT(j)]); sum += c; cnt += (c > 0u) ? 1u : 0u; mine = (j == x) ? c : mine; }
        if (sum == G) break;
        __builtin_amdgcn_s_sleep(1);
        if ((++sp & 255u) == 0u) { if (xb_ld(&bar[XB_TMO])) break; if (sp > XB_SPIN_CAP) { atomicAdd(&bar[XB_TMO], 1u); break; } }
    }
    nloc = mine > 0u ? mine : 1u; nx = cnt > 0u ? cnt : 1u;
}

__device__ __forceinline__ void xcd_barrier(const XcdBarrier& b) {
    asm volatile("s_waitcnt vmcnt(0)" ::: "memory");
    __syncthreads();
    if (threadIdx.x == 0) {
        unsigned* bar = b.bar;
        __builtin_amdgcn_s_waitcnt(0);
        unsigned nloc = b.st[0], nx = b.st[1];
        if (nloc == 0u) { xcd_barrier_complete(bar, b.x, nloc, nx); b.st[0] = nloc; b.st[1] = nx; }
        const unsigned old = xb_add(&bar[XB_XSUB(b.x)], 1u);
        const unsigned gen = old / nloc;
        if (old + 1u == (gen + 1u) * nloc) {
            __builtin_amdgcn_fence(__ATOMIC_RELEASE, "agent");
            asm volatile("s_waitcnt vmcnt(0)" ::: "memory");
            const unsigned og = xb_add(&bar[XB_TOP], 1u);
            const unsigned tg = og / nx;
            if (og + 1u == (tg + 1u) * nx) xb_add(&bar[XB_TOPGEN], 1u);
            else XB_SPIN(xb_ld(&bar[XB_TOPGEN]) == tg, bar);
            __builtin_amdgcn_fence(__ATOMIC_ACQUIRE, "agent");
            xb_add(&bar[XB_XGEN(b.x)], 1u);
            asm volatile("s_waitcnt vmcnt(0)" ::: "memory");
        } else {
            XB_SPIN(xb_ld(&bar[XB_XGEN(b.x)]) == gen, bar);
            __builtin_amdgcn_fence(__ATOMIC_ACQUIRE, "agent");
            asm volatile("s_waitcnt vmcnt(0)" ::: "memory");
        }
    }
    __syncthreads();
}


__device__ __forceinline__ void flat_barrier(unsigned* bar, unsigned round) {
    asm volatile("s_waitcnt vmcnt(0)" ::: "memory");
    __syncthreads();
    if (threadIdx.x == 0) {
        __builtin_amdgcn_fence(__ATOMIC_RELEASE, "agent");
        asm volatile("s_waitcnt vmcnt(0)" ::: "memory");
        const unsigned G = gridDim.x, old = __hip_atomic_fetch_add(bar + 64, 1u, __ATOMIC_RELAXED, __HIP_MEMORY_SCOPE_AGENT);
        if (old + 1u == round * G) __hip_atomic_store(bar + 128, round, __ATOMIC_RELAXED, __HIP_MEMORY_SCOPE_AGENT);
        else { unsigned sp = 0; while (__hip_atomic_load(bar + 128, __ATOMIC_RELAXED, __HIP_MEMORY_SCOPE_AGENT) < round) { __builtin_amdgcn_s_sleep(2); if (++sp > (1u << 22)) break; } }
        __builtin_amdgcn_fence(__ATOMIC_ACQUIRE, "agent");
        asm volatile("s_waitcnt vmcnt(0)" ::: "memory");
    }
    __syncthreads();
}

__device__ __forceinline__ void stagger_start(unsigned ticks) {
    const unsigned g = (blockIdx.x >> 3) & 3u;
    if (g) { const unsigned long long t0 = __builtin_amdgcn_s_memrealtime(); while (__builtin_amdgcn_s_memrealtime() - t0 < (unsigned long long)(g * ticks)) __builtin_amdgcn_s_sleep(8); }
}
constexpr int HSEG = 8, HCH = SEQ / 64 / HSEG;
#ifndef PHMASK
#define PHMASK 0xffff
#endif
#ifndef MK_STAG_UP
#define MK_STAG_UP 700u
#endif
__global__ void __launch_bounds__(512, 2) mk_fwd(Params p_arg) {
    extern __shared__ __attribute__((aligned(16))) unsigned char lds_raw[];
    LAS unsigned char* lds = (LAS unsigned char*)lds_raw;
    int pc = 0;
    { if (threadIdx.x == 0) { *(LAS u32x4*)(lds + XB_ST_OFF) = (u32x4){0u, 0u, 0u, 0u}; } __syncthreads();
      KP pp0 = (KP)__builtin_amdgcn_kernarg_segment_ptr(); if (blockIdx.x == 0) { unsigned* bar0 = (unsigned*)pp0->ws; for (int i = threadIdx.x; i < XCD_BAR_WORDS; i += 512) __hip_atomic_store(bar0 + i, 0u, __ATOMIC_RELAXED, __HIP_MEMORY_SCOPE_AGENT); } }
#define GETP KP pp = (KP)__builtin_amdgcn_kernarg_segment_ptr(); asm volatile("" : "+s"(pp))
#ifdef MK_TIME
    LAS unsigned long long* tacc = (LAS unsigned long long*)(lds + 143360); const bool timer = (blockIdx.x == 0 && threadIdx.x == 0); unsigned long long tph0 = 0, tph1 = 0; int tcls = 0;
    if (timer) { for (int i = 0; i < 16; ++i) tacc[i] = 0ull; }
#define T_BEGIN(c) if (timer) { tph0 = __builtin_amdgcn_s_memrealtime(); tcls = (c); }
#define T_MID if (timer) { tph1 = __builtin_amdgcn_s_memrealtime(); tacc[tcls] += tph1 - tph0; }
#define T_END if (timer) { tacc[15] += __builtin_amdgcn_s_memrealtime() - tph1; }
#else
#define T_BEGIN(c)
#define T_MID
#define T_END
#endif
#ifndef MK_DUP
#define MK_DUP 0
#endif
#define PH_BEGIN(bit, cls) { GETP; T_BEGIN(cls) if (pc >= pp->ph_lo && pc < pp->ph_hi && (PHMASK & (bit))) for (int rep_ = 0; rep_ < (((MK_DUP) & (bit)) ? 2 : 1); ++rep_) {
#define PH_END } } { GETP; T_MID ++pc; if (pc > pp->ph_lo && pc < pp->ph_hi) { if (pc == 1) { cg::this_grid().sync(); (void)xcd_barrier_post((unsigned*)pp->ws, (volatile LAS unsigned*)(lds + XB_ST_OFF)); } else { XcdBarrier xb_; xb_.bar = (unsigned*)pp->ws; xb_.x = xb_xcc_id(); xb_.st = (volatile LAS unsigned*)(lds + XB_ST_OFF); xcd_barrier(xb_); } } T_END }

    PH_BEGIN(1, 0) prologue_phase(pp, lds); PH_END

    for (int blk = 0; blk < 3 * NL; ++blk) {
        const int l = blk / 3, kind = blk - 3 * l;
        PH_BEGIN(2, 1) unsigned char* ws = pp->ws; const float* hin = (blk == 0) ? pp->in[0] : pp->out;
            norm_phase<false>(hin, (bf16_t*)(ws + WS_HN), nullptr, pp->in[11] + (size_t)(l * 3 + kind) * 1024, (const float*)(ws + WS_MOD) + (size_t)l * 8 * 9216, kind); PH_END
        if (kind != 1) {
            const int s = kind >> 1;
            PH_BEGIN(4, 2) unsigned char* ws = pp->ws;
                pg8::Gemm g{(const bf16_t*)(ws + WS_HN), (const bf16_t*)(ws + WS_W13) + (size_t)(l * 2 + s) * 5632 * 1024, NT, 5632, 1024}; pg8::StaticOrder S; S.init(NT, 5632, (int)gridDim.x, (int)blockIdx.x);
                pg8::EpiSwiGLU E{(bf16_t*)(ws + WS_BIG)}; pg8::gemm_phase<pg8::EpiSwiGLU, pg8::StaticOrder, false>(lds, g, S, E, nullptr); PH_END
            PH_BEGIN(8, 3) unsigned char* ws = pp->ws; const float* hin = (blk == 0) ? pp->in[0] : pp->out;
                pg8::Gemm g{(const bf16_t*)(ws + WS_BIG), (const bf16_t*)(ws + WS_W2) + (size_t)(l * 2 + s) * 1024 * FH, NT, 1024, FH}; pg8::StaticOrder S; S.init(NT, 1024, (int)gridDim.x, (int)blockIdx.x);
                pg8::EpiResid E{hin, pp->out, (const float*)(ws + WS_MOD) + (size_t)l * 8 * 9216 + (3 * kind + 2) * 1024, 0.5f}; pg8::gemm_phase<pg8::EpiResid, pg8::StaticOrder, false>(lds, g, S, E, nullptr); PH_END
        } else {
            for (int half = 0; half < 2; ++half) {
                PH_BEGIN(16, 4) unsigned char* ws = pp->ws;
                    pg8::Gemm g{(const bf16_t*)(ws + WS_HN) + (size_t)half * TH * 1024, (const bf16_t*)(ws + WS_WIN) + (size_t)l * 8192 * 1024, TH, 8192, 1024}; pg8::StaticOrder S; S.init(TH, 8192, (int)gridDim.x, (int)blockIdx.x);
                    pg8::EpiInproj E{(bf16_t*)(ws + WS_U), (bf16_t*)(ws + WS_V), (bf16_t*)(ws + WS_Q), (float*)(ws + WS_F), (bf16_t*)(ws + WS_I), (bf16_t*)(ws + WS_OG), (bf16_t*)(ws + WS_GA), (bf16_t*)(ws + WS_GB), (const float*)(ws + WS_LB) + l * 1024};
                    pg8::gemm_phase<pg8::EpiInproj, pg8::StaticOrder, false>(lds, g, S, E, nullptr); PH_END
                PH_BEGIN(32, 5) unsigned char* ws = pp->ws; const int G = (int)gridDim.x;
                    for (int it = (int)blockIdx.x; it < 32 * (HSEG - 1); it += G) { const int sq = it / (HSEG - 1), sg = it - sq * (HSEG - 1);
                        hgrn_seq<true>(lds, nullptr, (const float*)(ws + WS_F), (const bf16_t*)(ws + WS_I), nullptr, nullptr, (size_t)(sq >> 3) * SEQ, (sq & 7) * 128, sg * HCH, HCH, (float*)(ws + WS_HU), (float*)(ws + WS_HD), sq * HSEG + sg, 0); }
                    gmlp_loop(lds, (const bf16_t*)(ws + WS_V), (const bf16_t*)(ws + WS_U), (bf16_t*)(ws + WS_U), (const bf16_t*)(ws + WS_WST) + (size_t)l * 8 * 128 * 128, pp->in[4] + (size_t)l * 8 * 128, (int)blockIdx.x, G, 4 * 64 * 8);
                PH_END
                PH_BEGIN(64, 6) unsigned char* ws = pp->ws; const int G = (int)gridDim.x;
                    for (int it = (int)blockIdx.x; it < 32 * HSEG; it += G) { const int sq = it / HSEG, sg = it - sq * HSEG;
                        hgrn_seq<false>(lds, (const bf16_t*)(ws + WS_Q), (const float*)(ws + WS_F), (const bf16_t*)(ws + WS_I), (const bf16_t*)(ws + WS_OG), (bf16_t*)(ws + ((MK_DUP & 64) && rep_ == 0 ? WS_M0 : WS_OG)), (size_t)(sq >> 3) * SEQ, (sq & 7) * 128, sg * HCH, HCH, (float*)(ws + WS_HU), (float*)(ws + WS_HD), sq * HSEG, sg); }
                PH_END
                PH_BEGIN(128, 7) unsigned char* ws = pp->ws;
                    pg8::Gemm g{(const bf16_t*)(ws + WS_U), (const bf16_t*)(ws + WS_WA) + (size_t)l * 1024 * 1024, TH, 1024, 1024}; pg8::BranchOrder S; S.init(TH, 1024, (int)gridDim.x, (int)blockIdx.x);
                    S.A2 = (const bf16_t*)(ws + WS_OG); S.Bt2 = (const bf16_t*)(ws + WS_WB) + (size_t)l * 1024 * 1024;
                    pg8::EpiBranchFused E{(const bf16_t*)(ws + WS_GA), (const bf16_t*)(ws + WS_GB), (bf16_t*)(ws + (half == 0 ? WS_M0 : WS_Q))}; pg8::gemm_phase<pg8::EpiBranchFused, pg8::BranchOrder, false>(lds, g, S, E, nullptr); PH_END
            }
            PH_BEGIN(512, 9) unsigned char* ws = pp->ws; float* hh = pp->out;
                pg8::Gemm g{(const bf16_t*)(ws + WS_M0), (const bf16_t*)(ws + WS_WO) + (size_t)l * 1024 * 1024, NT, 1024, 1024}; pg8::SplitAOrder S; S.init(NT, 1024, (int)gridDim.x, (int)blockIdx.x); S.A1 = (const bf16_t*)(ws + WS_Q);
                pg8::EpiResid E{hh, hh, (const float*)(ws + WS_MOD) + (size_t)l * 8 * 9216 + 5 * 1024, 1.0f}; pg8::gemm_phase<pg8::EpiResid, pg8::SplitAOrder, false>(lds, g, S, E, nullptr); PH_END
        }
    }
    PH_BEGIN(1024, 10) norm_phase<true>(pp->out, nullptr, pp->out, pp->in[14], nullptr, 0); PH_END
#ifdef MK_TIME
    __syncthreads(); asm volatile("s_waitcnt vmcnt(0)" ::: "memory");
    if (timer) { GETP; unsigned long long a = 0, b = 0; for (int i = 0; i < 16; ++i) { if ((MK_TA >> i) & 1) a += tacc[i]; if ((MK_TB >> i) & 1) b += tacc[i]; }
        const float V = (float)a * 0.01f; int n = (int)((float)b * 0.01f / 20.0f); if (n < 1) n = 1; if (n > 1024) n = 1024;
        float* o = pp->out; for (int i = 0; i < n; ++i) o[i] = V; }
#endif
}
constexpr int N_PHASES = 1 + NL * (3 + 10 + 3) + 1;

extern "C" void kernel_launch(void* const* d_in, const int* in_sizes, int n_in, void* d_out, int out_size, void* d_ws, size_t ws_size, hipStream_t stream) {
    static int grid = 0;
    if (grid == 0) {
        if (n_in != 15 || out_size != NT * DM || ws_size < WS_END) { fprintf(stderr, "kernel_launch: unexpected shapes (n_in %d, out %d, ws %zu < %zu)\n", n_in, out_size, ws_size, (size_t)WS_END); grid = -1; return; }
        int dev = 0, cus = 0, per_cu = 0;
        hipGetDevice(&dev); hipDeviceGetAttribute(&cus, hipDeviceAttributeMultiprocessorCount, dev);
        if (hipFuncSetAttribute((const void*)mk_fwd, hipFuncAttributeMaxDynamicSharedMemorySize, LDS_BYTES) != hipSuccess) { fprintf(stderr, "kernel_launch: hipFuncSetAttribute failed\n"); grid = -1; return; }
        if (hipOccupancyMaxActiveBlocksPerMultiprocessor(&per_cu, (const void*)mk_fwd, 512, LDS_BYTES) != hipSuccess || per_cu < 1) { fprintf(stderr, "kernel_launch: occupancy query says %d\n", per_cu); per_cu = 1; }
        (void)hipGetLastError();
        grid = cus * 1;
    }
    if (grid < 0) return;
    Params p{};
    for (int i = 0; i < 15; ++i) p.in[i] = (const float*)d_in[i];
    p.out = (float*)d_out; p.ws = (unsigned char*)d_ws;
#if MK_COOP
    p.ph_lo = 0; p.ph_hi = N_PHASES;
    void* args[] = {&p};
    hipError_t e = hipLaunchCooperativeKernel((const void*)mk_fwd, dim3(grid), dim3(512), args, LDS_BYTES, stream);
    if (e != hipSuccess) fprintf(stderr, "cooperative launch failed: %s (grid %d)\n", hipGetErrorString(e), grid);
#else
    for (int i = 0; i < N_PHASES; ++i) { p.ph_lo = i; p.ph_hi = i + 1; hipLaunchKernelGGL(mk_fwd, dim3(grid), dim3(512), LDS_BYTES, stream, p); }
#endif
}
```

```cpp
#include <hip/hip_runtime.h>
#include <hip/hip_cooperative_groups.h>
#include <cstdio>
namespace cg = cooperative_groups;
#ifndef MK_COOP
#define MK_COOP 1
#endif
namespace pg8 {
#define PG8_LAS __attribute__((address_space(3)))
typedef unsigned short bf16_t;
typedef short bf16x8 __attribute__((ext_vector_type(8)));
typedef float f32x4 __attribute__((ext_vector_type(4)));
typedef unsigned u32x4 __attribute__((ext_vector_type(4)));
constexpr int BM = 256, BK = 64, HALF = 128, HTB = HALF * BK * 2  , STAGE_BYTES = 8 * HTB, NXCD = 8, WGM = 8;

__host__ __device__ __forceinline__ int lds_byte(int r, int c) { const int st = (r >> 4) * 2 + (c >> 5), rr = r & 15, cc = c & 31, ob = rr * 64 + cc * 2; return st * 1024 + (ob ^ (((ob >> 9) & 1) << 5)); }
__host__ __device__ __forceinline__ void stage_rc(int b, int& R, int& C) { const int st = b / 1024, sb = b % 1024, swz = sb ^ (((sb >> 9) & 1) << 5); R = (st >> 1) * 16 + swz / 64; C = (st & 1) * 32 + (swz % 64) / 2; }
__host__ __device__ __forceinline__ int perm32(int rho) { const int n = rho >> 4, i = rho & 15; return 8 * (i >> 2) + 4 * n + (i & 3); }

struct Unit { int pm, pn, part; };
struct Gemm { const bf16_t* A; const bf16_t* Bt; int M, N, K; };

struct StaticOrder {
    int nM, nN, nwg, G, c;
    __host__ __device__ void init(int M, int N, int G_, int c_) { nM = M / BM; nN = N / BM; nwg = nM * nN; G = G_; c = c_; }
    __host__ __device__ bool next(int i, Unit& u) const {
        const long L = (long)i * G + c; if (L >= nwg) return false;
        int wgid = (int)L; { const int q = nwg / NXCD, r = nwg % NXCD, xcd = wgid % NXCD, off = wgid / NXCD; wgid = (xcd < r ? xcd * (q + 1) : r * (q + 1) + (xcd - r) * q) + off; }
        const int nig = WGM * nN, gid = wgid / nig, fm = gid * WGM, gsz = (nM - fm) < WGM ? (nM - fm) : WGM;
        u.pm = fm + ((wgid % nig) % gsz); u.pn = (wgid % nig) / gsz; u.part = 0; return true;
    }
    __device__ __forceinline__ void a_ready(const Unit&) const {}
    __device__ __forceinline__ void done(const Unit&) const {}
    __device__ __forceinline__ const char* a_ptr(const Gemm& g, const Unit& u, size_t tstep) const { return (const char*)g.A + (size_t)u.pm * tstep; }
    __device__ __forceinline__ const char* b_ptr(const Gemm& g, const Unit& u, size_t tstep) const { return (const char*)g.Bt + (size_t)u.pn * tstep; }
};
__device__ __forceinline__ int opaque_tid() { int t = threadIdx.x; asm volatile("" : "+v"(t)); return t; }
typedef __bf16 bf16x2_t __attribute__((ext_vector_type(2)));
typedef float f32x2_t __attribute__((ext_vector_type(2)));
__device__ __forceinline__ unsigned cvt_pk_bf16(float lo, float hi) { const f32x2_t v = {lo, hi}; const bf16x2_t b = __builtin_convertvector(v, bf16x2_t); return __builtin_bit_cast(unsigned, b); }
__device__ __forceinline__ float bf_lo(unsigned w) { return __uint_as_float(w << 16); }
__device__ __forceinline__ float bf_hi(unsigned w) { return __uint_as_float(w & 0xffff0000u); }
template <int ACT> __device__ __forceinline__ float actf(float x) {
    if (ACT == 0) return x;
    if (ACT == 1) { const float u = 1.5957691216f * (x + 0.044715f * x * x * x); return x * __builtin_amdgcn_rcpf(1.0f + __expf(-u)); }
    if (ACT == 2) return x * __builtin_amdgcn_rcpf(1.0f + __expf(-x));
    return __builtin_amdgcn_rcpf(1.0f + __expf(-x));
}
template <int ACT> __device__ __forceinline__ void act8(float (&v)[8]) {
    if (ACT == 0) return;
    float a[8];
#pragma unroll
    for (int j = 0; j < 8; ++j) a[j] = (ACT == 1) ? -1.5957691216f * (v[j] + 0.044715f * v[j] * v[j] * v[j]) : -v[j];
#pragma unroll
    for (int j = 0; j < 8; ++j) a[j] = __expf(a[j]);
#pragma unroll
    for (int j = 0; j < 8; ++j) a[j] = 1.0f + a[j];
#pragma unroll
    for (int j = 0; j < 8; ++j) a[j] = __builtin_amdgcn_rcpf(a[j]);
#pragma unroll
    for (int j = 0; j < 8; ++j) v[j] = (ACT == 3) ? a[j] : v[j] * a[j];
}
struct EpiSwiGLU {
    static constexpr bool PERM = true, AFTER_DRAIN = false, TWO_PART = false;
    bf16_t* O;
    __device__ __forceinline__ void operator()(const f32x4 (&acc)[2][2][4][2], const Unit& u, int wr, int wc, int fr, int fq) const {
        const int row0 = u.pm * BM + wr * 64 + fr, col0 = u.pn * HALF + wc * 32 + 8 * fq;
#pragma unroll
        for (int ai = 0; ai < 2; ++ai)
#pragma unroll
            for (int m = 0; m < 4; ++m) {
                const f32x4 a0 = acc[ai][0][m][0], a1 = acc[ai][0][m][1], b0 = acc[ai][1][m][0], b1 = acc[ai][1][m][1];
                float v[8] = {a0[0], a0[1], a0[2], a0[3], a1[0], a1[1], a1[2], a1[3]};
                act8<2>(v);
#pragma unroll
                for (int j = 0; j < 4; ++j) { v[j] *= b0[j]; v[4 + j] *= b1[j]; }
                u32x4 w; w.x = cvt_pk_bf16(v[0], v[1]); w.y = cvt_pk_bf16(v[2], v[3]); w.z = cvt_pk_bf16(v[4], v[5]); w.w = cvt_pk_bf16(v[6], v[7]);
                *(u32x4*)(O + (size_t)(row0 + ai * HALF + m * 16) * 2816 + col0) = w;
            }
    }
};
struct EpiResid {
    static constexpr bool PERM = false, AFTER_DRAIN = false, TWO_PART = false;
    const float* hin; float* hout; const float* gmod; float scale;
    __device__ __forceinline__ void operator()(const f32x4 (&acc)[2][2][4][2], const Unit& u, int wr, int wc, int fr, int fq) const {
        const int row0 = u.pm * BM + wr * 64 + fr, col0 = u.pn * BM + wc * 32 + 4 * fq;
        const float* gp = gmod + (size_t)((u.pm * BM) >> 13) * 9216 + col0;
        f32x4 cf[2][2];
#pragma unroll
        for (int bj = 0; bj < 2; ++bj)
#pragma unroll
            for (int n = 0; n < 2; ++n) { const f32x4 g = *(const f32x4*)(gp + bj * HALF + n * 16); cf[bj][n] = (g + 1.0f) * scale; }
#pragma unroll
        for (int ai = 0; ai < 2; ++ai) {
            f32x4 hv[4][2][2];
#pragma unroll
            for (int m = 0; m < 4; ++m) { const size_t off = (size_t)(row0 + ai * HALF + m * 16) * 1024 + col0;
#pragma unroll
                for (int bj = 0; bj < 2; ++bj)
#pragma unroll
                    for (int n = 0; n < 2; ++n) hv[m][bj][n] = *(const f32x4*)(hin + off + bj * HALF + n * 16); }
#pragma unroll
            for (int m = 0; m < 4; ++m) { const size_t off = (size_t)(row0 + ai * HALF + m * 16) * 1024 + col0;
#pragma unroll
                for (int bj = 0; bj < 2; ++bj)
#pragma unroll
                    for (int n = 0; n < 2; ++n) *(f32x4*)(hout + off + bj * HALF + n * 16) = hv[m][bj][n] + cf[bj][n] * acc[ai][bj][m][n]; }
            asm volatile("" ::: "memory"); }
    }
};
struct EpiInproj {
    static constexpr bool PERM = true, AFTER_DRAIN = false, TWO_PART = false;
    bf16_t* U; bf16_t* V; bf16_t* Q; float* F; bf16_t* I; bf16_t* OG; bf16_t* GA; bf16_t* GB; const float* lb;
    template <int ACT> __device__ __forceinline__ void st16(const f32x4 (&acc)[2][2][4][2], bf16_t* dst, int row0, int colg) const {
#pragma unroll
        for (int ai = 0; ai < 2; ++ai)
#pragma unroll
            for (int m = 0; m < 4; ++m)
#pragma unroll
                for (int bj = 0; bj < 2; ++bj) { const f32x4 v0 = acc[ai][bj][m][0], v1 = acc[ai][bj][m][1];
                    float v[8] = {v0[0], v0[1], v0[2], v0[3], v1[0], v1[1], v1[2], v1[3]};
                    act8<ACT>(v);
                    u32x4 w; w.x = cvt_pk_bf16(v[0], v[1]); w.y = cvt_pk_bf16(v[2], v[3]); w.z = cvt_pk_bf16(v[4], v[5]); w.w = cvt_pk_bf16(v[6], v[7]);
                    *(u32x4*)(dst + (size_t)(row0 + ai * HALF + m * 16) * 1024 + colg + bj * HALF) = w; }
    }
    __device__ __forceinline__ void operator()(const f32x4 (&acc)[2][2][4][2], const Unit& u, int wr, int wc, int fr, int fq) const {
        const int grp = u.pn >> 2, colg = (u.pn & 3) * BM + wc * 32 + 8 * fq, row0 = u.pm * BM + wr * 64 + fr;
        if (grp == 3) {
#pragma unroll
            for (int bj = 0; bj < 2; ++bj) { const f32x4 l0 = *(const f32x4*)(lb + colg + bj * HALF), l1 = *(const f32x4*)(lb + colg + bj * HALF + 4);
#pragma unroll
                for (int ai = 0; ai < 2; ++ai)
#pragma unroll
                    for (int m = 0; m < 4; ++m) { const f32x4 v0 = acc[ai][bj][m][0], v1 = acc[ai][bj][m][1]; f32x4 o0, o1;
#pragma unroll
                        for (int j = 0; j < 4; ++j) { o0[j] = __logf(fmaxf(l0[j] + (1.0f - l0[j]) * actf<3>(v0[j]), 1e-30f)); o1[j] = __logf(fmaxf(l1[j] + (1.0f - l1[j]) * actf<3>(v1[j]), 1e-30f)); }
                        float* d = F + (size_t)(row0 + ai * HALF + m * 16) * 1024 + colg + bj * HALF; *(f32x4*)d = o0; *(f32x4*)(d + 4) = o1; } }
        } else if (grp < 2) st16<1>(acc, grp == 0 ? U : V, row0, colg);
        else if (grp == 2) st16<2>(acc, Q, row0, colg);
        else if (grp == 4) st16<0>(acc, I, row0, colg);
        else st16<3>(acc, grp == 5 ? OG : (grp == 6 ? GA : GB), row0, colg);
    }
};
template <int MODE> struct EpiBranch {
    static constexpr bool PERM = true, AFTER_DRAIN = false, TWO_PART = false;
    const bf16_t* G; const bf16_t* P; bf16_t* O;
    __device__ __forceinline__ void operator()(const f32x4 (&acc)[2][2][4][2], const Unit& u, int wr, int wc, int fr, int fq) const {
        const int row0 = u.pm * BM + wr * 64 + fr, col0 = u.pn * BM + wc * 32 + 8 * fq;
#pragma unroll
        for (int ai = 0; ai < 2; ++ai)
#pragma unroll
            for (int m = 0; m < 4; ++m)
#pragma unroll
                for (int bj = 0; bj < 2; ++bj) { const size_t off = (size_t)(row0 + ai * HALF + m * 16) * 1024 + col0 + bj * HALF;
                    const u32x4 g = *(const u32x4*)(G + off); const f32x4 v0 = acc[ai][bj][m][0], v1 = acc[ai][bj][m][1];
                    float r[8] = { bf_lo(g.x) * v0[0], bf_hi(g.x) * v0[1], bf_lo(g.y) * v0[2], bf_hi(g.y) * v0[3], bf_lo(g.z) * v1[0], bf_hi(g.z) * v1[1], bf_lo(g.w) * v1[2], bf_hi(g.w) * v1[3] };
                    if (MODE == 1) { const u32x4 p = *(const u32x4*)(P + off);
                        r[0] += bf_lo(p.x); r[1] += bf_hi(p.x); r[2] += bf_lo(p.y); r[3] += bf_hi(p.y); r[4] += bf_lo(p.z); r[5] += bf_hi(p.z); r[6] += bf_lo(p.w); r[7] += bf_hi(p.w); }
                    u32x4 w; w.x = cvt_pk_bf16(r[0], r[1]); w.y = cvt_pk_bf16(r[2], r[3]); w.z = cvt_pk_bf16(r[4], r[5]); w.w = cvt_pk_bf16(r[6], r[7]);
                    *(u32x4*)(O + off) = w; }
    }
};

struct EpiBranchFused {
    static constexpr bool PERM = true, AFTER_DRAIN = false, TWO_PART = true;
    const bf16_t* GA; const bf16_t* GB; bf16_t* O;
    __device__ __forceinline__ void mid(f32x4 (&acc)[2][2][4][2], const Unit& u, int wr, int wc, int fr, int fq) const {
        const int row0 = u.pm * BM + wr * 64 + fr, col0 = u.pn * BM + wc * 32 + 8 * fq;
#pragma unroll
        for (int ai = 0; ai < 2; ++ai)
#pragma unroll
            for (int m = 0; m < 4; ++m)
#pragma unroll
                for (int bj = 0; bj < 2; ++bj) { const size_t off = (size_t)(row0 + ai * HALF + m * 16) * 1024 + col0 + bj * HALF;
                    const u32x4 a = *(const u32x4*)(GA + off), b = *(const u32x4*)(GB + off);
                    const float ra[8] = {bf_lo(a.x), bf_hi(a.x), bf_lo(a.y), bf_hi(a.y), bf_lo(a.z), bf_hi(a.z), bf_lo(a.w), bf_hi(a.w)}, rb[8] = {bf_lo(b.x), bf_hi(b.x), bf_lo(b.y), bf_hi(b.y), bf_lo(b.z), bf_hi(b.z), bf_lo(b.w), bf_hi(b.w)};
#pragma unroll
                    for (int j = 0; j < 4; ++j) { acc[ai][bj][m][0][j] *= ra[j] * __builtin_amdgcn_rcpf(fmaxf(rb[j], 1e-6f)); acc[ai][bj][m][1][j] *= ra[4 + j] * __builtin_amdgcn_rcpf(fmaxf(rb[4 + j], 1e-6f)); } }
    }
    __device__ __forceinline__ void operator()(const f32x4 (&acc)[2][2][4][2], const Unit& u, int wr, int wc, int fr, int fq) const {
        const int row0 = u.pm * BM + wr * 64 + fr, col0 = u.pn * BM + wc * 32 + 8 * fq;
#pragma unroll
        for (int ai = 0; ai < 2; ++ai)
#pragma unroll
            for (int m = 0; m < 4; ++m)
#pragma unroll
                for (int bj = 0; bj < 2; ++bj) { const size_t off = (size_t)(row0 + ai * HALF + m * 16) * 1024 + col0 + bj * HALF;
                    const u32x4 b = *(const u32x4*)(GB + off); const f32x4 v0 = acc[ai][bj][m][0], v1 = acc[ai][bj][m][1];
                    const float rb[8] = {bf_lo(b.x), bf_hi(b.x), bf_lo(b.y), bf_hi(b.y), bf_lo(b.z), bf_hi(b.z), bf_lo(b.w), bf_hi(b.w)};
                    u32x4 w; w.x = cvt_pk_bf16(fmaxf(rb[0], 1e-6f) * v0[0], fmaxf(rb[1], 1e-6f) * v0[1]); w.y = cvt_pk_bf16(fmaxf(rb[2], 1e-6f) * v0[2], fmaxf(rb[3], 1e-6f) * v0[3]);
                    w.z = cvt_pk_bf16(fmaxf(rb[4], 1e-6f) * v1[0], fmaxf(rb[5], 1e-6f) * v1[1]); w.w = cvt_pk_bf16(fmaxf(rb[6], 1e-6f) * v1[2], fmaxf(rb[7], 1e-6f) * v1[3]);
                    *(u32x4*)(O + off) = w; }
    }
};
struct BranchOrder : StaticOrder {
    const bf16_t* A2; const bf16_t* Bt2;
    __device__ __forceinline__ bool next(int i, Unit& u) const { const bool ok = StaticOrder::next(i >> 1, u); u.part = i & 1; return ok; }
    __device__ __forceinline__ const char* a_ptr(const Gemm& g, const Unit& u, size_t tstep) const { return (const char*)(u.part ? A2 : g.A) + (size_t)u.pm * tstep; }
    __device__ __forceinline__ const char* b_ptr(const Gemm& g, const Unit& u, size_t tstep) const { return (const char*)(u.part ? Bt2 : g.Bt) + (size_t)u.pn * tstep; }
};
struct SplitAOrder : StaticOrder {
    const bf16_t* A1;
    __device__ __forceinline__ const char* a_ptr(const Gemm& g, const Unit& u, size_t tstep) const { return u.pm < 128 ? (const char*)g.A + (size_t)u.pm * tstep : (const char*)A1 + (size_t)(u.pm - 128) * tstep; }
};

template <class Epi, class Sched, bool STAMP = false>
__device__ __forceinline__ void gemm_phase(PG8_LAS unsigned char* lds, const Gemm g, const Sched& S, const Epi& E, unsigned long long* stamps) {
    const int tid = opaque_tid(), wid = __builtin_amdgcn_readfirstlane(tid >> 6), lane = tid & 63, wr = wid >> 2, wc = wid & 3, fr = lane & 15, fq = lane >> 4;
    const int K = g.K, nt = K / BK;
    int ts_lo = 0, ts_hi = 0, nts = 0; const unsigned long long rt_entry = STAMP ? (unsigned long long)wall_clock64() : 0ull;
#define PG8_STAMP() do { if (STAMP && wid == 0 && nts < 64) { const unsigned long long _c = (unsigned long long)clock64(); \
        ts_lo = (lane == nts) ? (int)(unsigned)_c : ts_lo; ts_hi = (lane == nts) ? (int)(unsigned)(_c >> 32) : ts_hi; ++nts; } } while (0)
    PG8_STAMP();
    unsigned voffA[2], voffB[2];
#pragma unroll
    for (int i = 0; i < 2; ++i) { int R, C; stage_rc(tid * 16 + i * 8192, R, C); const int Rb = Epi::PERM ? ((R & ~31) + perm32(R & 31)) : R;
        voffA[i] = (unsigned)(R * K + C) * 2u; voffB[i] = (unsigned)(Rb * K + C) * 2u; }
    const size_t kstep = (size_t)(BK * 2);
    const size_t hstep = (size_t)HALF * K * 2;
    const size_t tstep = 2 * hstep;
    const unsigned ldsw = (unsigned)wid * 1024u;
    const int aoff = lds_byte(wr * 64 + fr, fq * 8), boff = lds_byte(wc * 32 + fr, fq * 8);
#define PG8_SA(b, h) (((b) * 2 + (h)) * HTB)
#define PG8_SB(b, h) ((4 + (b) * 2 + (h)) * HTB)
#define PG8_STAGE(bufoff, gbase, voff) do { _Pragma("unroll") for (int _i = 0; _i < 2; ++_i) \
        __builtin_amdgcn_global_load_lds((const unsigned*)((const char*)(gbase) + (voff)[_i]), (PG8_LAS unsigned*)(lds + (bufoff) + ldsw + _i * 8192), 16, 0, 0); } while (0)
#define PG8_LDA(dst, b, h) do { _Pragma("unroll") for (int m = 0; m < 4; ++m) _Pragma("unroll") for (int k = 0; k < 2; ++k) dst[m][k] = *(const PG8_LAS bf16x8*)(lds + PG8_SA(b, h) + aoff + m * 2048 + k * 1024); } while (0)
#define PG8_LDB(dst, b, h) do { _Pragma("unroll") for (int n = 0; n < 2; ++n) _Pragma("unroll") for (int k = 0; k < 2; ++k) dst[n][k] = *(const PG8_LAS bf16x8*)(lds + PG8_SB(b, h) + boff + n * 2048 + k * 1024); } while (0)
#define PG8_MMA(ai, bj, At, Bt) do { __builtin_amdgcn_s_setprio(1); _Pragma("unroll") for (int m = 0; m < 4; ++m) _Pragma("unroll") for (int n = 0; n < 2; ++n) _Pragma("unroll") for (int k = 0; k < 2; ++k) \
        acc[ai][bj][m][n] = __builtin_amdgcn_mfma_f32_16x16x32_bf16(Bt[n][k], At[m][k], acc[ai][bj][m][n], 0, 0, 0); __builtin_amdgcn_s_setprio(0); } while (0)
#define PG8_WAIT_V(n) asm volatile("s_waitcnt vmcnt(" #n ")" ::: "memory")
#define PG8_WAIT_L(n) asm volatile("s_waitcnt lgkmcnt(" #n ")" ::: "memory")
#define PG8_BAR __builtin_amdgcn_s_barrier()
#define PG8_SCHED __builtin_amdgcn_sched_barrier(0)
    Unit cur, nxt; int ui = 0;
    if (!S.next(0, cur)) return;
    f32x4 acc[2][2][4][2];
#pragma unroll
    for (int a = 0; a < 2; ++a)
#pragma unroll
        for (int b = 0; b < 2; ++b)
#pragma unroll
            for (int m = 0; m < 4; ++m)
#pragma unroll
                for (int n = 0; n < 2; ++n) acc[a][b][m][n] = (f32x4){0.f, 0.f, 0.f, 0.f};
    bf16x8 At[4][2], B0[2][2], B1[2][2];
    const char* cA = S.a_ptr(g, cur, tstep); const char* cB = S.b_ptr(g, cur, tstep);
    S.a_ready(cur);
    PG8_STAGE(PG8_SB(0, 0), cB, voffB); PG8_STAGE(PG8_SA(0, 0), cA, voffA); PG8_STAGE(PG8_SB(0, 1), cB + hstep, voffB); PG8_STAGE(PG8_SA(0, 1), cA + hstep, voffA);
    if (wr == 1) PG8_BAR;
    PG8_WAIT_V(4); PG8_BAR;
    PG8_STAGE(PG8_SB(1, 0), cB + kstep, voffB); PG8_STAGE(PG8_SA(1, 0), cA + kstep, voffA); PG8_STAGE(PG8_SB(1, 1), cB + hstep + kstep, voffB);
    PG8_WAIT_V(6); PG8_BAR;
    PG8_STAMP();
    for (;;) {
        const bool has_next = S.next(ui + 1, nxt);
        const char* nA = has_next ? S.a_ptr(g, nxt, tstep) : cA; const char* nB = has_next ? S.b_ptr(g, nxt, tstep) : cB;
        for (int t = 0; t < nt; t += 2) {
            const bool last = (t == nt - 2);
            const char* a1 = cA + (size_t)(t + 1) * kstep;
            const char* a2 = last ? nA : cA + (size_t)(t + 2) * kstep; const char* b2 = last ? nB : cB + (size_t)(t + 2) * kstep;
            const char* a3 = a2 + kstep; const char* b3 = b2 + kstep;
            if (last && has_next) S.a_ready(nxt);
            PG8_LDB(B0, 0, 0); PG8_SCHED; PG8_LDA(At, 0, 0); PG8_STAGE(PG8_SA(1, 1), a1 + hstep, voffA);
            PG8_WAIT_L(8); PG8_BAR; PG8_WAIT_L(0); PG8_MMA(0, 0, At, B0); PG8_BAR; PG8_SCHED;
            PG8_LDB(B1, 0, 1); PG8_STAGE(PG8_SB(0, 0), b2, voffB);
            PG8_BAR; PG8_WAIT_L(0); PG8_MMA(0, 1, At, B1); PG8_BAR;
            PG8_LDA(At, 0, 1); PG8_STAGE(PG8_SA(0, 0), a2, voffA);
            PG8_BAR; PG8_WAIT_L(0); PG8_MMA(1, 0, At, B0); PG8_BAR; PG8_SCHED;
            PG8_STAGE(PG8_SB(0, 1), b2 + hstep, voffB);
            PG8_WAIT_V(6); PG8_BAR; PG8_MMA(1, 1, At, B1); PG8_BAR;
            PG8_LDB(B0, 1, 0); PG8_SCHED; PG8_LDA(At, 1, 0); PG8_STAGE(PG8_SA(0, 1), a2 + hstep, voffA);
            PG8_WAIT_L(8); PG8_BAR; PG8_WAIT_L(0); PG8_MMA(0, 0, At, B0); PG8_BAR; PG8_SCHED;
            PG8_LDB(B1, 1, 1); PG8_STAGE(PG8_SB(1, 0), b3, voffB);
            PG8_BAR; PG8_WAIT_L(0); PG8_MMA(0, 1, At, B1); PG8_BAR;
            PG8_LDA(At, 1, 1); PG8_STAGE(PG8_SA(1, 0), a3, voffA);
            PG8_BAR; PG8_WAIT_L(0); PG8_MMA(1, 0, At, B0); PG8_BAR; PG8_SCHED;
            PG8_STAGE(PG8_SB(1, 1), b3 + hstep, voffB);
            PG8_WAIT_V(6); PG8_BAR; PG8_MMA(1, 1, At, B1); PG8_BAR;
        }
        PG8_STAMP();
        if constexpr (Epi::TWO_PART) { if (cur.part == 0) E.mid(acc, cur, wr, wc, fr, fq); else E(acc, cur, wr, wc, fr, fq); } else if constexpr (!Epi::AFTER_DRAIN) { E(acc, cur, wr, wc, fr, fq); S.done(cur); }
        PG8_STAMP();
        if (!has_next) break;
        bool keep_acc = false; if constexpr (Epi::TWO_PART) keep_acc = (cur.part == 0);
        if (!keep_acc)
#pragma unroll
        for (int a = 0; a < 2; ++a)
#pragma unroll
            for (int b = 0; b < 2; ++b)
#pragma unroll
                for (int m = 0; m < 4; ++m)
#pragma unroll
                    for (int n = 0; n < 2; ++n) acc[a][b][m][n] = (f32x4){0.f, 0.f, 0.f, 0.f};
        cur = nxt; cA = nA; cB = nB; ++ui;
    }
    PG8_WAIT_V(0);
    if (wr == 0) PG8_BAR;
    PG8_BAR;
    if constexpr (Epi::AFTER_DRAIN) { E.fused(acc, cur, wr, wc, fr, fq, lds, wid, lane); S.done(cur); }
    PG8_STAMP();
    if (STAMP && wid == 0) { stamps[lane] = lane < nts ? (((unsigned long long)(unsigned)ts_hi << 32) | (unsigned)ts_lo) : 0ull;
        if (lane == 62) stamps[62] = rt_entry; if (lane == 63) stamps[63] = (unsigned long long)wall_clock64(); }
#undef PG8_STAMP
#undef PG8_SA
#undef PG8_SB
#undef PG8_STAGE
#undef PG8_LDA
#undef PG8_LDB
#undef PG8_MMA
#undef PG8_WAIT_V
#undef PG8_WAIT_L
#undef PG8_BAR
#undef PG8_SCHED
}
}
using pg8::bf16_t; using pg8::bf16x8; using pg8::f32x4; using pg8::u32x4; using pg8::cvt_pk_bf16; using pg8::bf_lo; using pg8::bf_hi; using pg8::opaque_tid;
#define LAS __attribute__((address_space(3)))
typedef unsigned u32x2 __attribute__((ext_vector_type(2)));

constexpr int NT = 65536, DM = 1024, NL = 4, SEQ = 8192, FH = 2816, TH = 32768  ;
constexpr int LDS_BYTES = 144 * 1024, XB_ST_OFF = 143616;
constexpr size_t MiB = 1024ull * 1024ull;
constexpr size_t WS_MOD = 64 * 1024;
constexpr size_t WS_WST = 2 * MiB;
constexpr size_t WS_LB = 3 * MiB;
constexpr size_t WS_WIN = 4 * MiB;
constexpr size_t WS_W13 = 68 * MiB;
constexpr size_t WS_W2 = 156 * MiB;
constexpr size_t WS_WA = 200 * MiB, WS_WB = 208 * MiB, WS_WO = 216 * MiB;
constexpr size_t WS_HN = 224 * MiB;
constexpr size_t WS_BIG = 352 * MiB;
constexpr size_t ZB = 64 * MiB;
constexpr size_t WS_U = WS_BIG, WS_V = WS_BIG + ZB, WS_Q = WS_BIG + 2 * ZB, WS_F = WS_BIG + 3 * ZB  , WS_I = WS_BIG + 5 * ZB, WS_OG = WS_BIG + 6 * ZB, WS_GA = WS_BIG + 7 * ZB, WS_GB = WS_BIG + 8 * ZB;
constexpr size_t WS_HU = WS_BIG + 9 * ZB;
constexpr size_t WS_HD = WS_HU + 16 * MiB;
constexpr size_t WS_M0 = WS_HD + 1 * MiB;
constexpr size_t WS_END = WS_M0 + ZB;

struct Params { const float* in[15]; float* out; unsigned char* ws; int ph_lo, ph_hi; };
typedef const Params __attribute__((address_space(4))) * KP;

__device__ __forceinline__ float wave_sum(float v) {
#pragma unroll
    for (int o = 1; o < 64; o <<= 1) v += __shfl_xor(v, o);
    return v;
}

__device__ __forceinline__ void transpose_item(const float* __restrict__ W, int K, int N, bf16_t* __restrict__ WT, int item, int remap, LAS float* scr, int lane) {
    const int nblk = N / 32, kb = item / nblk, nb = item - kb * nblk, k0 = 64 * kb, n0 = 32 * nb;
    int drow0 = n0;
    if (remap) { const int bj = n0 / FH, nn = n0 - bj * FH; drow0 = (nn >> 7) * 256 + bj * 128 + (nn & 127); }
#pragma unroll 8
    for (int i = 0; i < 32; ++i) { const int kk = 2 * i + (lane >> 5); scr[kk * 33 + (lane & 31)] = W[(size_t)(k0 + kk) * N + n0 + (lane & 31)]; }
    asm volatile("s_waitcnt lgkmcnt(0)" ::: "memory");
    const int c = lane & 7;
#pragma unroll
    for (int j = 0; j < 4; ++j) { const int n = (lane >> 3) + 8 * j; const LAS float* s = scr + (8 * c) * 33 + n;
        u32x4 o; o.x = cvt_pk_bf16(s[0 * 33], s[1 * 33]); o.y = cvt_pk_bf16(s[2 * 33], s[3 * 33]); o.z = cvt_pk_bf16(s[4 * 33], s[5 * 33]); o.w = cvt_pk_bf16(s[6 * 33], s[7 * 33]);
        *(u32x4*)(WT + (size_t)(drow0 + n) * K + k0 + 8 * c) = o; }
    asm volatile("s_waitcnt lgkmcnt(0)" ::: "memory");
}

__device__ __forceinline__ void prologue_phase(KP p, LAS unsigned char* lds) {
    const int tid = opaque_tid(), lane = tid & 63, wave = tid >> 6, G = gridDim.x;
    unsigned char* ws = p->ws;
    {
        LAS float* cact = (LAS float*)lds;
        LAS float* red = (LAS float*)(lds + 32768);
        const float* c = p->in[1];
        for (int i = tid; i < 8192; i += 512) { const int b = i >> 10, k = i & 1023; const float x = c[i]; cact[k * 8 + b] = x / (1.0f + __expf(-x)); }
        __syncthreads();
        for (int task = blockIdx.x; task < 288; task += G) {
            const int idx = task * 128 + (tid & 127), kq = tid >> 7, l = idx / 9216, n = idx - l * 9216;
            const float* aw = p->in[12] + (size_t)l * 1024 * 9216 + n;
            float a[8];
#pragma unroll
            for (int b = 0; b < 8; ++b) a[b] = 0.f;
#pragma unroll 8
            for (int k = kq * 256; k < kq * 256 + 256; ++k) { const float w = aw[(size_t)k * 9216]; const f32x4 c0 = *(const LAS f32x4*)(cact + k * 8), c1 = *(const LAS f32x4*)(cact + k * 8 + 4);
                a[0] += c0[0] * w; a[1] += c0[1] * w; a[2] += c0[2] * w; a[3] += c0[3] * w; a[4] += c1[0] * w; a[5] += c1[1] * w; a[6] += c1[2] * w; a[7] += c1[3] * w; }
#pragma unroll
            for (int b = 0; b < 8; ++b) red[(kq * 8 + b) * 128 + (tid & 127)] = a[b];
            __syncthreads();
            if (kq == 0) { const float bias = p->in[13][idx]; float* mod = (float*)(ws + WS_MOD);
#pragma unroll
                for (int b = 0; b < 8; ++b) mod[((size_t)l * 8 + b) * 9216 + n] = ((red[b * 128 + tid] + red[(8 + b) * 128 + tid]) + (red[(16 + b) * 128 + tid] + red[(24 + b) * 128 + tid])) + bias; }
            __syncthreads();
        }
    }
    if (blockIdx.x == 72 % G) {
        const float* lg = p->in[5]; float* lb = (float*)(ws + WS_LB);
        for (int k = tid; k < 1024; k += 512) { const float a0 = lg[k], a1 = lg[1024 + k], a2 = lg[2048 + k], a3 = lg[3072 + k]; const float mx = fmaxf(fmaxf(a0, a1), fmaxf(a2, a3));
            const float e0 = __expf(a0 - mx), e1 = __expf(a1 - mx), e2 = __expf(a2 - mx), e3 = __expf(a3 - mx), inv = 1.0f / (e0 + e1 + e2 + e3);
            lb[k] = 0.f; lb[1024 + k] = e1 * inv; lb[2048 + k] = (e1 + e2) * inv; lb[3072 + k] = (e1 + e2 + e3) * inv; }
    }
    { const float* wsrc = p->in[3]; bf16_t* wst = (bf16_t*)(ws + WS_WST);
      for (int i = blockIdx.x * 512 + tid; i < 4 * 8 * 128 * 128 / 2; i += G * 512) { const int e = 2 * i, s = e & 127, t = (e >> 7) & 127;
          const float v0 = s <= t ? wsrc[e] : 0.f, v1 = (s + 1) <= t ? wsrc[e + 1] : 0.f; ((unsigned*)wst)[i] = cvt_pk_bf16(v0, v1); } }
    LAS float* scr = (LAS float*)(lds + 32768 + wave * 8704);
    const int gw = blockIdx.x * 8 + wave, NGW = G * 8;
    constexpr int I_IN = 16 * 256, I_13 = 16 * 176, I_2 = 44 * 32, I_SQ = 16 * 32, I_LAYER = I_IN + 2 * I_13 + 2 * I_2 + 3 * I_SQ;
    for (int it = gw; it < NL * I_LAYER; it += NGW) {
        const int l = it / I_LAYER; int r = it - l * I_LAYER;
        if (r < I_IN) { transpose_item(p->in[2] + (size_t)l * 1024 * 8192, 1024, 8192, (bf16_t*)(ws + WS_WIN) + (size_t)l * 8192 * 1024, r, 0, scr, lane); continue; } r -= I_IN;
        if (r < 2 * I_13) { const int s = r / I_13; r -= s * I_13; transpose_item(p->in[9] + (size_t)(l * 2 + s) * 1024 * 5632, 1024, 5632, (bf16_t*)(ws + WS_W13) + (size_t)(l * 2 + s) * 5632 * 1024, r, 1, scr, lane); continue; } r -= 2 * I_13;
        if (r < 2 * I_2) { const int s = r / I_2; r -= s * I_2; transpose_item(p->in[10] + (size_t)(l * 2 + s) * FH * 1024, FH, 1024, (bf16_t*)(ws + WS_W2) + (size_t)(l * 2 + s) * 1024 * FH, r, 0, scr, lane); continue; } r -= 2 * I_2;
        const int m = r / I_SQ; r -= m * I_SQ;
        const float* src = (m == 0 ? p->in[6] : (m == 1 ? p->in[7] : p->in[8])) + (size_t)l * 1024 * 1024;
        bf16_t* dst = (bf16_t*)(ws + (m == 0 ? WS_WA : (m == 1 ? WS_WB : WS_WO))) + (size_t)l * 1024 * 1024;
        transpose_item(src, 1024, 1024, dst, r, 0, scr, lane);
    }
}

template <bool FINAL> __device__ __forceinline__ void norm_phase(const float* hin, bf16_t* hn, float* fout, const float* nw, const float* modl  , int sub) {
    const int tid = opaque_tid(), lane = tid & 63, gw = blockIdx.x * 8 + (tid >> 6), NGW = gridDim.x * 8;
    f32x4 w4[4];
#pragma unroll
    for (int j = 0; j < 4; ++j) w4[j] = *(const f32x4*)(nw + 4 * lane + 256 * j);
    for (int row = gw; row < NT; row += NGW) {
        const float* xr = hin + (size_t)row * DM + 4 * lane;
        f32x4 v[4]; float s = 0.f;
#pragma unroll
        for (int j = 0; j < 4; ++j) { v[j] = *(const f32x4*)(xr + 256 * j); s += (v[j][0] * v[j][0] + v[j][1] * v[j][1]) + (v[j][2] * v[j][2] + v[j][3] * v[j][3]); }
        const float rstd = rsqrtf(wave_sum(s) * (1.0f / DM) + 1e-6f);
        if (FINAL) {
#pragma unroll
            for (int j = 0; j < 4; ++j) *(f32x4*)(fout + (size_t)row * DM + 4 * lane + 256 * j) = v[j] * rstd * w4[j];
        } else {
            const float* sh = modl + (size_t)(row >> 13) * 9216 + (3 * sub) * 1024 + 4 * lane; const float* sc = sh + 1024;
#pragma unroll
            for (int j = 0; j < 4; ++j) { const f32x4 a = *(const f32x4*)(sc + 256 * j), b = *(const f32x4*)(sh + 256 * j); const f32x4 o = v[j] * rstd * w4[j] * (a + 1.0f) + b;
                u32x2 w; w.x = cvt_pk_bf16(o[0], o[1]); w.y = cvt_pk_bf16(o[2], o[3]); *(u32x2*)(hn + (size_t)row * DM + 4 * lane + 256 * j) = w; }
        }
    }
}

__device__ __forceinline__ int tr64_off(int row, int col) { return row * 128 + ((((col >> 3) ^ (row ^ (row >> 3))) & 7) << 4) + ((col & 7) << 1); }
__device__ __forceinline__ int tr128_off(int row, int col) { return row * 256 + ((((col >> 3) ^ (row ^ (row >> 3))) & 15) << 4) + ((col & 7) << 1); }
constexpr int H_LF = 0, H_P = 0  , H_TOT = 32768, H_VEC = 34816, H_SS = 36864, H_QP = 38912, H_KP = 56320, H_KT = 73728, H_VT = 90112, H_ST = 106496, H_END = 141312;
static_assert(H_END <= LDS_BYTES, "LDS");
#define MFMA16(a, b, c) __builtin_amdgcn_mfma_f32_16x16x32_bf16((a), (b), (c), 0, 0, 0)

template <bool PRE> __device__ __forceinline__ void hgrn_seq(LAS unsigned char* lds, const bf16_t* __restrict__ Qb, const float* __restrict__ Fb, const bf16_t* __restrict__ Ib, const bf16_t* OGb, bf16_t* OUTb, size_t row_base, int colbase, int c0, int nch, float* Ubuf, float* Dbuf, int item0, int nprev) {
    const int tid = opaque_tid(), lane = tid & 63, w = __builtin_amdgcn_readfirstlane(tid >> 6), q4 = lane >> 4, l15 = lane & 15;
    const int pt = tid >> 4, pc8 = (tid & 15) * 8;
    const int sk = tid & 127, sseg = tid >> 7;
    LAS float* Lf = (LAS float*)(lds + H_LF); LAS float* Ltot = (LAS float*)(lds + H_TOT); LAS float* Lss = (LAS float*)(lds + H_SS);
    f32x4 S[8];
#pragma unroll
    for (int i = 0; i < 8; ++i) S[i] = (f32x4){0.f, 0.f, 0.f, 0.f};
    if (!PRE) { for (int j = 0; j < nprev; ++j) { const float* Uj = Ubuf + (size_t)(item0 + j) * 16384; const f32x4 dj = *(const f32x4*)(Dbuf + (size_t)(item0 + j) * 128 + 16 * w + 4 * q4);
#pragma unroll
            for (int vt = 0; vt < 8; ++vt) S[vt] = S[vt] * dj + *(const f32x4*)(Uj + (vt * 512 + tid) * 4); } }
    float dacc = 1.0f;
    u32x4 rq[2], rv[2]; float rfc[16];
#define HG_LOADF(c) do { const float* fp_ = Fb + (row_base + (size_t)(c) * 64 + 16 * sseg) * 1024 + colbase + sk; _Pragma("unroll") for (int i_ = 0; i_ < 16; ++i_) rfc[i_] = fp_[(size_t)i_ * 1024]; } while (0)
#define HG_LOADQV(c) do { _Pragma("unroll") for (int i_ = 0; i_ < 2; ++i_) { const size_t go_ = (row_base + (size_t)(c) * 64 + pt + 32 * i_) * 1024 + colbase + pc8; \
        if (!PRE) rq[i_] = *(const u32x4*)(Qb + go_); rv[i_] = *(const u32x4*)(Ib + go_); } } while (0)
    HG_LOADF(c0); HG_LOADQV(c0);
    for (int c = c0; c < c0 + nch; ++c) {
        u32x2 rog[4];
        if (!PRE) {
#pragma unroll
        for (int ti = 0; ti < 4; ++ti) rog[ti] = *(const u32x2*)(OGb + (row_base + (size_t)c * 64 + 16 * ti + l15) * 1024 + colbase + 16 * w + 4 * q4); }
        { float run = 0.f;
#pragma unroll
          for (int i = 0; i < 16; ++i) { run += rfc[i]; Lf[(16 * sseg + i) * 128 + sk] = run; }
          Ltot[sseg * 128 + sk] = run; }
        if (c + 1 < c0 + nch) HG_LOADF(c + 1);
        __syncthreads();
        f32x4 e4, d4, c4;
        { const int kk = 16 * w + 4 * q4; const f32x4 a0 = *(const LAS f32x4*)(Ltot + kk), a1 = *(const LAS f32x4*)(Ltot + 128 + kk), a2 = *(const LAS f32x4*)(Ltot + 256 + kk), a3 = *(const LAS f32x4*)(Ltot + 384 + kk);
          const f32x4 b31 = a0 + a1, b63 = b31 + (a2 + a3);
#pragma unroll
          for (int r = 0; r < 4; ++r) { e4[r] = __expf(b31[r]); d4[r] = __expf(b63[r]); c4[r] = __expf(b63[r] - b31[r]); } }
        if (PRE) { if (tid < 128) dacc *= __expf((Ltot[tid] + Ltot[128 + tid]) + (Ltot[256 + tid] + Ltot[384 + tid])); }
        { f32x4 tv[4][2];
#pragma unroll
          for (int sg = 0; sg < 4; ++sg) { tv[sg][0] = *(const LAS f32x4*)(Ltot + sg * 128 + pc8); tv[sg][1] = *(const LAS f32x4*)(Ltot + sg * 128 + pc8 + 4); }
#pragma unroll
          for (int i = 0; i < 2; ++i) { const int t = pt + 32 * i; const bool hi = (pt >> 4) != 0;
            f32x4 off[2], ref[2];
#pragma unroll
            for (int h = 0; h < 2; ++h) { ref[h] = tv[0][h] + tv[1][h];
                if (i == 0) off[h] = hi ? tv[0][h] : (f32x4){0.f, 0.f, 0.f, 0.f}; else off[h] = hi ? ref[h] + tv[2][h] : ref[h]; }
            const f32x4 b0 = *(const LAS f32x4*)(Lf + t * 128 + pc8), b1 = *(const LAS f32x4*)(Lf + t * 128 + pc8 + 4);
            f32x4 p0 = (f32x4){0.f, 0.f, 0.f, 0.f}, p1 = p0;
            if (t & 15) { p0 = *(const LAS f32x4*)(Lf + (t - 1) * 128 + pc8); p1 = *(const LAS f32x4*)(Lf + (t - 1) * 128 + pc8 + 4); }
            unsigned qw[4] = {0u, 0u, 0u, 0u}; if (!PRE) { qw[0] = rq[i].x; qw[1] = rq[i].y; qw[2] = rq[i].z; qw[3] = rq[i].w; } const unsigned vw[4] = {rv[i].x, rv[i].y, rv[i].z, rv[i].w};
            float qp[8], kp[8];
#pragma unroll
            for (int j = 0; j < 8; ++j) { const float bl = j < 4 ? b0[j & 3] : b1[j & 3], pl = j < 4 ? p0[j & 3] : p1[j & 3], of = j < 4 ? off[0][j & 3] : off[1][j & 3], rr = j < 4 ? ref[0][j & 3] : ref[1][j & 3];
                const float lf = bl - pl, d = fminf(fmaxf((bl + of) - rr, -80.f), 80.f);
                if (!PRE) { const float qv = (j & 1) ? bf_hi(qw[j >> 1]) : bf_lo(qw[j >> 1]); qp[j] = qv * __expf(d); } else qp[j] = 0.f;
                kp[j] = (1.0f - __expf(lf)) * __expf(-d); }
            u32x4 wq, wk; wq.x = cvt_pk_bf16(qp[0], qp[1]); wq.y = cvt_pk_bf16(qp[2], qp[3]); wq.z = cvt_pk_bf16(qp[4], qp[5]); wq.w = cvt_pk_bf16(qp[6], qp[7]);
            wk.x = cvt_pk_bf16(kp[0], kp[1]); wk.y = cvt_pk_bf16(kp[2], kp[3]); wk.z = cvt_pk_bf16(kp[4], kp[5]); wk.w = cvt_pk_bf16(kp[6], kp[7]);
            if (!PRE) { *(LAS u32x4*)(lds + H_QP + t * 272 + pc8 * 2) = wq; *(LAS u32x4*)(lds + H_KP + t * 272 + pc8 * 2) = wk; }
            const unsigned kw[4] = {wk.x, wk.y, wk.z, wk.w};
#pragma unroll
            for (int j = 0; j < 8; ++j) { const unsigned short kk = (unsigned short)((j & 1) ? (kw[j >> 1] >> 16) : (kw[j >> 1] & 0xffffu)), vv = (unsigned short)((j & 1) ? (vw[j >> 1] >> 16) : (vw[j >> 1] & 0xffffu));
                *(LAS unsigned short*)(lds + H_KT + tr64_off(pc8 + j, t)) = kk; *(LAS unsigned short*)(lds + H_VT + tr64_off(pc8 + j, t)) = vv; } } }
        if (!PRE) {
#pragma unroll
          for (int vt = 0; vt < 8; ++vt) { const f32x4 sv = S[vt] * e4; u32x2 o; o.x = cvt_pk_bf16(sv[0], sv[1]); o.y = cvt_pk_bf16(sv[2], sv[3]);
              *(LAS u32x2*)(lds + H_ST + (16 * vt + l15) * 272 + (16 * w + 4 * q4) * 2) = o; } }
        if (c + 1 < c0 + nch) HG_LOADQV(c + 1);
        __syncthreads();
        f32x4 oT[4];
        if (!PRE) {
        { const int ti = w >> 1;
#pragma unroll
          for (int sj = 0; sj < 2; ++sj) { const int si = 2 * (w & 1) + sj; f32x4 a4 = (f32x4){0.f, 0.f, 0.f, 0.f};
              if (si <= ti) {
#pragma unroll
                  for (int kb = 0; kb < 4; ++kb) { const bf16x8 a = *(const LAS bf16x8*)(lds + H_KP + (16 * si + l15) * 272 + kb * 64 + q4 * 16), b = *(const LAS bf16x8*)(lds + H_QP + (16 * ti + l15) * 272 + kb * 64 + q4 * 16); a4 = MFMA16(a, b, a4); }
                  const int t = 16 * ti + l15, s0 = 16 * si + 4 * q4;
#pragma unroll
                  for (int r = 0; r < 4; ++r) a4[r] = (s0 + r <= t) ? a4[r] : 0.f; }
              u32x2 o; o.x = cvt_pk_bf16(a4[0], a4[1]); o.y = cvt_pk_bf16(a4[2], a4[3]);
              *(LAS u32x2*)(lds + H_P + (16 * ti + l15) * 144 + (16 * si + 4 * q4) * 2) = o; } }
#pragma unroll
        for (int ti = 0; ti < 4; ++ti) oT[ti] = (f32x4){0.f, 0.f, 0.f, 0.f};
#pragma unroll
        for (int kb = 0; kb < 4; ++kb) { const bf16x8 a = *(const LAS bf16x8*)(lds + H_ST + (16 * w + l15) * 272 + kb * 64 + q4 * 16);
#pragma unroll
            for (int ti = 0; ti < 4; ++ti) { const bf16x8 b = *(const LAS bf16x8*)(lds + H_QP + (16 * ti + l15) * 272 + kb * 64 + q4 * 16); oT[ti] = MFMA16(a, b, oT[ti]); } }
        __syncthreads();
        }
        { f32x4 U[8];
#pragma unroll
          for (int vt = 0; vt < 8; ++vt) U[vt] = (f32x4){0.f, 0.f, 0.f, 0.f};
#pragma unroll
          for (int kb = 0; kb < 2; ++kb) { const bf16x8 av = *(const LAS bf16x8*)(lds + H_VT + tr64_off(16 * w + l15, 32 * kb + 8 * q4)), ak = *(const LAS bf16x8*)(lds + H_KT + tr64_off(16 * w + l15, 32 * kb + 8 * q4));
#pragma unroll
              for (int ti = 0; ti < 4; ++ti) { if (!PRE && (kb == 0 || ti >= 2)) { const bf16x8 b = *(const LAS bf16x8*)(lds + H_P + (16 * ti + l15) * 144 + (32 * kb + 8 * q4) * 2); oT[ti] = MFMA16(av, b, oT[ti]); } }
#pragma unroll
              for (int vt = 0; vt < 8; ++vt) { const bf16x8 b = *(const LAS bf16x8*)(lds + H_VT + tr64_off(16 * vt + l15, 32 * kb + 8 * q4)); U[vt] = MFMA16(ak, b, U[vt]); } }
#pragma unroll
          for (int vt = 0; vt < 8; ++vt) S[vt] = S[vt] * d4 + U[vt] * c4; }
        if (!PRE) {
#pragma unroll
        for (int ti = 0; ti < 4; ++ti) { float ss = (oT[ti][0] * oT[ti][0] + oT[ti][1] * oT[ti][1]) + (oT[ti][2] * oT[ti][2] + oT[ti][3] * oT[ti][3]); ss += __shfl_xor(ss, 16); ss += __shfl_xor(ss, 32);
            if (q4 == 0) Lss[(16 * ti + l15) * 8 + w] = ss; }
        __syncthreads();
#pragma unroll
        for (int ti = 0; ti < 4; ++ti) { const int t = 16 * ti + l15; const f32x4 s0 = *(const LAS f32x4*)(Lss + t * 8), s1 = *(const LAS f32x4*)(Lss + t * 8 + 4);
            const float tot = ((s0[0] + s0[1]) + (s0[2] + s0[3])) + ((s1[0] + s1[1]) + (s1[2] + s1[3]));
            const float rs = rsqrtf(tot * (1.0f / 128.0f) + 1e-6f);
            u32x2 o; o.x = cvt_pk_bf16(oT[ti][0] * rs * bf_lo(rog[ti].x), oT[ti][1] * rs * bf_hi(rog[ti].x)); o.y = cvt_pk_bf16(oT[ti][2] * rs * bf_lo(rog[ti].y), oT[ti][3] * rs * bf_hi(rog[ti].y));
            *(u32x2*)(OUTb + (row_base + (size_t)c * 64 + t) * 1024 + colbase + 16 * w + 4 * q4) = o; }
        }
    }
    if (PRE) { float* Uo = Ubuf + (size_t)item0 * 16384;
#pragma unroll
        for (int vt = 0; vt < 8; ++vt) *(f32x4*)(Uo + (vt * 512 + tid) * 4) = S[vt];
        if (tid < 128) Dbuf[(size_t)item0 * 128 + tid] = dacc; }
    __syncthreads();
#undef HG_LOADF
#undef HG_LOADQV
}

__device__ __forceinline__ void gmlp_loop(LAS unsigned char* lds, const bf16_t* __restrict__ Vb, const bf16_t* Ub, bf16_t* Ob, const bf16_t* __restrict__ wst  , const float* __restrict__ gbias  , int first, int stride, int nitems) {
    const int tid = opaque_tid(), lane = tid & 63, w = __builtin_amdgcn_readfirstlane(tid >> 6), q4 = lane >> 4, l15 = lane & 15;
    const int ps = tid >> 4, pc8 = (tid & 15) * 8, nkb = (w >> 1) + 1, t = 16 * w + l15;
    int it = first; if (it >= nitems) return;
    u32x4 rv[4]; u32x2 ru[8]; bf16x8 wf[4]; float bt;
#define GM_DEC(i_) const int g8_ = (i_) & 7; const size_t row0_ = (size_t)((i_) >> 9) * SEQ + (size_t)(((i_) >> 3) & 63) * 128; const int col0_ = g8_ * 128;
#define GM_LOADV(i_) do { GM_DEC(i_) _Pragma("unroll") for (int i = 0; i < 4; ++i) rv[i] = *(const u32x4*)(Vb + (row0_ + ps + 32 * i) * 1024 + col0_ + pc8); \
        _Pragma("unroll") for (int kb = 0; kb < 4; ++kb) if (kb < nkb) wf[kb] = *(const bf16x8*)(wst + (size_t)g8_ * 16384 + (16 * w + l15) * 128 + kb * 32 + q4 * 8); } while (0)
#define GM_LOADU(i_) do { GM_DEC(i_) bt = gbias[g8_ * 128 + t]; _Pragma("unroll") for (int ct = 0; ct < 8; ++ct) ru[ct] = *(const u32x2*)(Ub + (row0_ + t) * 1024 + col0_ + 16 * ct + 4 * q4); } while (0)
    GM_LOADV(it); GM_LOADU(it);
    for (;;) {
#pragma unroll
        for (int i = 0; i < 4; ++i) { const int s = ps + 32 * i; const u32x4 raw = rv[i];
            float x[8] = {bf_lo(raw.x), bf_hi(raw.x), bf_lo(raw.y), bf_hi(raw.y), bf_lo(raw.z), bf_hi(raw.z), bf_lo(raw.w), bf_hi(raw.w)};
            float sm = ((x[0] + x[1]) + (x[2] + x[3])) + ((x[4] + x[5]) + (x[6] + x[7]));
            sm += __shfl_xor(sm, 1); sm += __shfl_xor(sm, 2); sm += __shfl_xor(sm, 4); sm += __shfl_xor(sm, 8);
            const float mu = sm * (1.0f / 128.0f); float vs = 0.f;
#pragma unroll
            for (int j = 0; j < 8; ++j) { x[j] -= mu; vs += x[j] * x[j]; }
            vs += __shfl_xor(vs, 1); vs += __shfl_xor(vs, 2); vs += __shfl_xor(vs, 4); vs += __shfl_xor(vs, 8);
            const float rstd = rsqrtf(vs * (1.0f / 128.0f) + 1e-6f);
#pragma unroll
            for (int j = 0; j < 4; ++j) { const unsigned pk = cvt_pk_bf16(x[2 * j] * rstd, x[2 * j + 1] * rstd);
                *(LAS unsigned short*)(lds + tr128_off(pc8 + 2 * j, s)) = (unsigned short)(pk & 0xffffu); *(LAS unsigned short*)(lds + tr128_off(pc8 + 2 * j + 1, s)) = (unsigned short)(pk >> 16); } }
        bf16x8 wc[4];
#pragma unroll
        for (int kb = 0; kb < 4; ++kb) wc[kb] = wf[kb];
        const int nxt = it + stride; const bool more = nxt < nitems;
        if (more) GM_LOADV(nxt);
        __syncthreads();
        f32x4 acc[8];
#pragma unroll
        for (int ct = 0; ct < 8; ++ct) acc[ct] = (f32x4){0.f, 0.f, 0.f, 0.f};
#pragma unroll
        for (int kb = 0; kb < 4; ++kb) if (kb < nkb) {
#pragma unroll
            for (int ct = 0; ct < 8; ++ct) { const bf16x8 a = *(const LAS bf16x8*)(lds + tr128_off(16 * ct + l15, 32 * kb + 8 * q4)); acc[ct] = MFMA16(a, wc[kb], acc[ct]); } }
        { GM_DEC(it)
#pragma unroll
          for (int ct = 0; ct < 8; ++ct) { const u32x2 uu = ru[ct];
              u32x2 o; o.x = cvt_pk_bf16(bf_lo(uu.x) * (acc[ct][0] + bt), bf_hi(uu.x) * (acc[ct][1] + bt)); o.y = cvt_pk_bf16(bf_lo(uu.y) * (acc[ct][2] + bt), bf_hi(uu.y) * (acc[ct][3] + bt));
              *(u32x2*)(Ob + (row0_ + t) * 1024 + col0_ + 16 * ct + 4 * q4) = o; } }
        if (!more) break;
        GM_LOADU(nxt);
        __syncthreads();
        it = nxt;
    }
    __syncthreads();
#undef GM_DEC
#undef GM_LOADV
#undef GM_LOADU
}

#define XB_TMO      128
#define XB_XCNT(j)  (256  + 64 * (j))
#define XB_XSUB(j)  (1280 + 64 * (j))
#define XB_XGEN(j)  (2304 + 64 * (j))
#define XB_TOP      3328
#define XB_TOPGEN   3392
#define XCD_BAR_WORDS 3456
#define XB_SPIN_CAP (1u << 18)

__device__ __forceinline__ unsigned xb_ld(unsigned* p)              { return __hip_atomic_load(p, __ATOMIC_RELAXED, __HIP_MEMORY_SCOPE_AGENT); }
__device__ __forceinline__ unsigned xb_add(unsigned* p, unsigned v) { return __hip_atomic_fetch_add(p, v, __ATOMIC_RELAXED, __HIP_MEMORY_SCOPE_AGENT); }
__device__ __forceinline__ unsigned xb_xcc_id() { return (unsigned)__builtin_amdgcn_s_getreg((3 << 11) | 20) & 0xFu; }
#define XB_SPIN(cond, bar) do { unsigned _sp = 0; while (cond) { __builtin_amdgcn_s_sleep(1); \
    if ((++_sp & 255u) == 0u) { if (xb_ld(&(bar)[XB_TMO])) break; if (_sp > XB_SPIN_CAP) { atomicAdd(&(bar)[XB_TMO], 1u); break; } } } } while (0)

struct XcdBarrier {
    unsigned* bar; unsigned x;
    volatile LAS unsigned* st;
};

__device__ __forceinline__ XcdBarrier xcd_barrier_post(unsigned* bar, volatile LAS unsigned* st) {
    XcdBarrier b; b.bar = bar; b.x = xb_xcc_id(); b.st = st;
    if (threadIdx.x == 0) (void)xb_add(&bar[XB_XCNT(b.x)], 1u);
    return b;
}
__device__ __forceinline__ void xcd_barrier_complete(unsigned* bar, unsigned x, unsigned& nloc, unsigned& nx) {
    const unsigned G = gridDim.x * gridDim.y * gridDim.z;
    unsigned sum, cnt, mine, sp = 0u;
    for (;;) {
        sum = 0u; cnt = 0u; mine = 0u;
#pragma unroll
        for (unsigned j = 0; j < 16; ++j) { const unsigned c = xb_ld(&bar[XB_XCNT(j)]); sum += c; cnt += (c > 0u) ? 1u : 0u; mine = (j == x) ? c : mine; }
        if (sum == G) break;
        __builtin_amdgcn_s_sleep(1);
        if ((++sp & 255u) == 0u) { if (xb_ld(&bar[XB_TMO])) break; if (sp > XB_SPIN_CAP) { atomicAdd(&bar[XB_TMO], 1u); break; } }
    }
    nloc = mine > 0u ? mine : 1u; nx = cnt > 0u ? cnt : 1u;
}

__device__ __forceinline__ void xcd_barrier(const XcdBarrier& b) {
    asm volatile("s_waitcnt vmcnt(0)" ::: "memory");
    __syncthreads();
    if (threadIdx.x == 0) {
        unsigned* bar = b.bar;
        __builtin_amdgcn_s_waitcnt(0);
        unsigned nloc = b.st[0], nx = b.st[1];
        if (nloc == 0u) { xcd_barrier_complete(bar, b.x, nloc, nx); b.st[0] = nloc; b.st[1] = nx; }
        const unsigned old = xb_add(&bar[XB_XSUB(b.x)], 1u);
        const unsigned gen = old / nloc;
        if (old + 1u == (gen + 1u) * nloc) {
            __builtin_amdgcn_fence(__ATOMIC_RELEASE, "agent");
            asm volatile("s_waitcnt vmcnt(0)" ::: "memory");
            const unsigned og = xb_add(&bar[XB_TOP], 1u);
            const unsigned tg = og / nx;
            if (og + 1u == (tg + 1u) * nx) xb_add(&bar[XB_TOPGEN], 1u);
            else XB_SPIN(xb_ld(&bar[XB_TOPGEN]) == tg, bar);
            __builtin_amdgcn_fence(__ATOMIC_ACQUIRE, "agent");
            xb_add(&bar[XB_XGEN(b.x)], 1u);
            asm volatile("s_waitcnt vmcnt(0)" ::: "memory");
        } else {
            XB_SPIN(xb_ld(&bar[XB_XGEN(b.x)]) == gen, bar);
            __builtin_amdgcn_fence(__ATOMIC_ACQUIRE, "agent");
            asm volatile("s_waitcnt vmcnt(0)" ::: "memory");
        }
    }
    __syncthreads();
}


__device__ __forceinline__ void flat_barrier(unsigned* bar, unsigned round) {
    asm volatile("s_waitcnt vmcnt(0)" ::: "memory");
    __syncthreads();
    if (threadIdx.x == 0) {
        __builtin_amdgcn_fence(__ATOMIC_RELEASE, "agent");
        asm volatile("s_waitcnt vmcnt(0)" ::: "memory");
        const unsigned G = gridDim.x, old = __hip_atomic_fetch_add(bar + 64, 1u, __ATOMIC_RELAXED, __HIP_MEMORY_SCOPE_AGENT);
        if (old + 1u == round * G) __hip_atomic_store(bar + 128, round, __ATOMIC_RELAXED, __HIP_MEMORY_SCOPE_AGENT);
        else { unsigned sp = 0; while (__hip_atomic_load(bar + 128, __ATOMIC_RELAXED, __HIP_MEMORY_SCOPE_AGENT) < round) { __builtin_amdgcn_s_sleep(2); if (++sp > (1u << 22)) break; } }
        __builtin_amdgcn_fence(__ATOMIC_ACQUIRE, "agent");
        asm volatile("s_waitcnt vmcnt(0)" ::: "memory");
    }
    __syncthreads();
}

__device__ __forceinline__ void stagger_start(unsigned ticks) {
    const unsigned g = (blockIdx.x >> 3) & 3u;
    if (g) { const unsigned long long t0 = __builtin_amdgcn_s_memrealtime(); while (__builtin_amdgcn_s_memrealtime() - t0 < (unsigned long long)(g * ticks)) __builtin_amdgcn_s_sleep(8); }
}
constexpr int HSEG = 8, HCH = SEQ / 64 / HSEG;
#ifndef PHMASK
#define PHMASK 0xffff
#endif
#ifndef MK_STAG_UP
#define MK_STAG_UP 700u
#endif
__global__ void __launch_bounds__(512, 2) mk_fwd(Params p_arg) {
    extern __shared__ __attribute__((aligned(16))) unsigned char lds_raw[];
    LAS unsigned char* lds = (LAS unsigned char*)lds_raw;
    int pc = 0;
    { if (threadIdx.x == 0) { *(LAS u32x4*)(lds + XB_ST_OFF) = (u32x4){0u, 0u, 0u, 0u}; } __syncthreads();
      KP pp0 = (KP)__builtin_amdgcn_kernarg_segment_ptr(); if (blockIdx.x == 0) { unsigned* bar0 = (unsigned*)pp0->ws; for (int i = threadIdx.x; i < XCD_BAR_WORDS; i += 512) __hip_atomic_store(bar0 + i, 0u, __ATOMIC_RELAXED, __HIP_MEMORY_SCOPE_AGENT); } }
#define GETP KP pp = (KP)__builtin_amdgcn_kernarg_segment_ptr(); asm volatile("" : "+s"(pp))
#ifdef MK_TIME
    LAS unsigned long long* tacc = (LAS unsigned long long*)(lds + 143360); const bool timer = (blockIdx.x == 0 && threadIdx.x == 0); unsigned long long tph0 = 0, tph1 = 0; int tcls = 0;
    if (timer) { for (int i = 0; i < 16; ++i) tacc[i] = 0ull; }
#define T_BEGIN(c) if (timer) { tph0 = __builtin_amdgcn_s_memrealtime(); tcls = (c); }
#define T_MID if (timer) { tph1 = __builtin_amdgcn_s_memrealtime(); tacc[tcls] += tph1 - tph0; }
#define T_END if (timer) { tacc[15] += __builtin_amdgcn_s_memrealtime() - tph1; }
#else
#define T_BEGIN(c)
#define T_MID
#define T_END
#endif
#ifndef MK_DUP
#define MK_DUP 0
#endif
#define PH_BEGIN(bit, cls) { GETP; T_BEGIN(cls) if (pc >= pp->ph_lo && pc < pp->ph_hi && (PHMASK & (bit))) for (int rep_ = 0; rep_ < (((MK_DUP) & (bit)) ? 2 : 1); ++rep_) {
#define PH_END } } { GETP; T_MID ++pc; if (pc > pp->ph_lo && pc < pp->ph_hi) { if (pc == 1) { cg::this_grid().sync(); (void)xcd_barrier_post((unsigned*)pp->ws, (volatile LAS unsigned*)(lds + XB_ST_OFF)); } else { XcdBarrier xb_; xb_.bar = (unsigned*)pp->ws; xb_.x = xb_xcc_id(); xb_.st = (volatile LAS unsigned*)(lds + XB_ST_OFF); xcd_barrier(xb_); } } T_END }

    PH_BEGIN(1, 0) prologue_phase(pp, lds); PH_END

    for (int blk = 0; blk < 3 * NL; ++blk) {
        const int l = blk / 3, kind = blk - 3 * l;
        PH_BEGIN(2, 1) unsigned char* ws = pp->ws; const float* hin = (blk == 0) ? pp->in[0] : pp->out;
            norm_phase<false>(hin, (bf16_t*)(ws + WS_HN), nullptr, pp->in[11] + (size_t)(l * 3 + kind) * 1024, (const float*)(ws + WS_MOD) + (size_t)l * 8 * 9216, kind); PH_END
        if (kind != 1) {
            const int s = kind >> 1;
            PH_BEGIN(4, 2) unsigned char* ws = pp->ws;
                pg8::Gemm g{(const bf16_t*)(ws + WS_HN), (const bf16_t*)(ws + WS_W13) + (size_t)(l * 2 + s) * 5632 * 1024, NT, 5632, 1024}; pg8::StaticOrder S; S.init(NT, 5632, (int)gridDim.x, (int)blockIdx.x);
                pg8::EpiSwiGLU E{(bf16_t*)(ws + WS_BIG)}; pg8::gemm_phase<pg8::EpiSwiGLU, pg8::StaticOrder, false>(lds, g, S, E, nullptr); PH_END
            PH_BEGIN(8, 3) unsigned char* ws = pp->ws; const float* hin = (blk == 0) ? pp->in[0] : pp->out;
                pg8::Gemm g{(const bf16_t*)(ws + WS_BIG), (const bf16_t*)(ws + WS_W2) + (size_t)(l * 2 + s) * 1024 * FH, NT, 1024, FH}; pg8::StaticOrder S; S.init(NT, 1024, (int)gridDim.x, (int)blockIdx.x);
                pg8::EpiResid E{hin, pp->out, (const float*)(ws + WS_MOD) + (size_t)l * 8 * 9216 + (3 * kind + 2) * 1024, 0.5f}; pg8::gemm_phase<pg8::EpiResid, pg8::StaticOrder, false>(lds, g, S, E, nullptr); PH_END
        } else {
            for (int half = 0; half < 2; ++half) {
                PH_BEGIN(16, 4) unsigned char* ws = pp->ws;
                    pg8::Gemm g{(const bf16_t*)(ws + WS_HN) + (size_t)half * TH * 1024, (const bf16_t*)(ws + WS_WIN) + (size_t)l * 8192 * 1024, TH, 8192, 1024}; pg8::StaticOrder S; S.init(TH, 8192, (int)gridDim.x, (int)blockIdx.x);
                    pg8::EpiInproj E{(bf16_t*)(ws + WS_U), (bf16_t*)(ws + WS_V), (bf16_t*)(ws + WS_Q), (float*)(ws + WS_F), (bf16_t*)(ws + WS_I), (bf16_t*)(ws + WS_OG), (bf16_t*)(ws + WS_GA), (bf16_t*)(ws + WS_GB), (const float*)(ws + WS_LB) + l * 1024};
                    pg8::gemm_phase<pg8::EpiInproj, pg8::StaticOrder, false>(lds, g, S, E, nullptr); PH_END
                PH_BEGIN(32, 5) unsigned char* ws = pp->ws; const int G = (int)gridDim.x;
                    for (int it = (int)blockIdx.x; it < 32 * (HSEG - 1); it += G) { const int sq = it / (HSEG - 1), sg = it - sq * (HSEG - 1);
                        hgrn_seq<true>(lds, nullptr, (const float*)(ws + WS_F), (const bf16_t*)(ws + WS_I), nullptr, nullptr, (size_t)(sq >> 3) * SEQ, (sq & 7) * 128, sg * HCH, HCH, (float*)(ws + WS_HU), (float*)(ws + WS_HD), sq * HSEG + sg, 0); }
                    gmlp_loop(lds, (const bf16_t*)(ws + WS_V), (const bf16_t*)(ws + WS_U), (bf16_t*)(ws + WS_U), (const bf16_t*)(ws + WS_WST) + (size_t)l * 8 * 128 * 128, pp->in[4] + (size_t)l * 8 * 128, (int)blockIdx.x, G, 4 * 64 * 8);
                PH_END
                PH_BEGIN(64, 6) unsigned char* ws = pp->ws; const int G = (int)gridDim.x;
                    for (int it = (int)blockIdx.x; it < 32 * HSEG; it += G) { const int sq = it / HSEG, sg = it - sq * HSEG;
                        hgrn_seq<false>(lds, (const bf16_t*)(ws + WS_Q), (const float*)(ws + WS_F), (const bf16_t*)(ws + WS_I), (const bf16_t*)(ws + WS_OG), (bf16_t*)(ws + ((MK_DUP & 64) && rep_ == 0 ? WS_M0 : WS_OG)), (size_t)(sq >> 3) * SEQ, (sq & 7) * 128, sg * HCH, HCH, (float*)(ws + WS_HU), (float*)(ws + WS_HD), sq * HSEG, sg); }
                PH_END
                PH_BEGIN(128, 7) unsigned char* ws = pp->ws;
                    pg8::Gemm g{(const bf16_t*)(ws + WS_U), (const bf16_t*)(ws + WS_WA) + (size_t)l * 1024 * 1024, TH, 1024, 1024}; pg8::BranchOrder S; S.init(TH, 1024, (int)gridDim.x, (int)blockIdx.x);
                    S.A2 = (const bf16_t*)(ws + WS_OG); S.Bt2 = (const bf16_t*)(ws + WS_WB) + (size_t)l * 1024 * 1024;
                    pg8::EpiBranchFused E{(const bf16_t*)(ws + WS_GA), (const bf16_t*)(ws + WS_GB), (bf16_t*)(ws + (half == 0 ? WS_M0 : WS_Q))}; pg8::gemm_phase<pg8::EpiBranchFused, pg8::BranchOrder, false>(lds, g, S, E, nullptr); PH_END
            }
            PH_BEGIN(512, 9) unsigned char* ws = pp->ws; float* hh = pp->out;
                pg8::Gemm g{(const bf16_t*)(ws + WS_M0), (const bf16_t*)(ws + WS_WO) + (size_t)l * 1024 * 1024, NT, 1024, 1024}; pg8::SplitAOrder S; S.init(NT, 1024, (int)gridDim.x, (int)blockIdx.x); S.A1 = (const bf16_t*)(ws + WS_Q);
                pg8::EpiResid E{hh, hh, (const float*)(ws + WS_MOD) + (size_t)l * 8 * 9216 + 5 * 1024, 1.0f}; pg8::gemm_phase<pg8::EpiResid, pg8::SplitAOrder, false>(lds, g, S, E, nullptr); PH_END
        }
    }
    PH_BEGIN(1024, 10) norm_phase<true>(pp->out, nullptr, pp->out, pp->in[14], nullptr, 0); PH_END
#ifdef MK_TIME
    __syncthreads(); asm volatile("s_waitcnt vmcnt(0)" ::: "memory");
    if (timer) { GETP; unsigned long long a = 0, b = 0; for (int i = 0; i < 16; ++i) { if ((MK_TA >> i) & 1) a += tacc[i]; if ((MK_TB >> i) & 1) b += tacc[i]; }
        const float V = (float)a * 0.01f; int n = (int)((float)b * 0.01f / 20.0f); if (n < 1) n = 1; if (n > 1024) n = 1024;
        float* o = pp->out; for (int i = 0; i < n; ++i) o[i] = V; }
#endif
}
constexpr int N_PHASES = 1 + NL * (3 + 10 + 3) + 1;

extern "C" void kernel_launch(void* const* d_in, const int* in_sizes, int n_in, void* d_out, int out_size, void* d_ws, size_t ws_size, hipStream_t stream) {
    static int grid = 0;
    if (grid == 0) {
        if (n_in != 15 || out_size != NT * DM || ws_size < WS_END) { fprintf(stderr, "kernel_launch: unexpected shapes (n_in %d, out %d, ws %zu < %zu)\n", n_in, out_size, ws_size, (size_t)WS_END); grid = -1; return; }
        int dev = 0, cus = 0, per_cu = 0;
        hipGetDevice(&dev); hipDeviceGetAttribute(&cus, hipDeviceAttributeMultiprocessorCount, dev);
        if (hipFuncSetAttribute((const void*)mk_fwd, hipFuncAttributeMaxDynamicSharedMemorySize, LDS_BYTES) != hipSuccess) { fprintf(stderr, "kernel_launch: hipFuncSetAttribute failed\n"); grid = -1; return; }
        if (hipOccupancyMaxActiveBlocksPerMultiprocessor(&per_cu, (const void*)mk_fwd, 512, LDS_BYTES) != hipSuccess || per_cu < 1) { fprintf(stderr, "kernel_launch: occupancy query says %d\n", per_cu); per_cu = 1; }
        (void)hipGetLastError();
        grid = cus * 1;
    }
    if (grid < 0) return;
    Params p{};
    for (int i = 0; i < 15; ++i) p.in[i] = (const float*)d_in[i];
    p.out = (float*)d_out; p.ws = (unsigned char*)d_ws;
#if MK_COOP
    p.ph_lo = 0; p.ph_hi = N_PHASES;
    void* args[] = {&p};
    hipError_t e = hipLaunchCooperativeKernel((const void*)mk_fwd, dim3(grid), dim3(512), args, LDS_BYTES, stream);
    if (e != hipSuccess) fprintf(stderr, "cooperative launch failed: %s (grid %d)\n", hipGetErrorString(e), grid);
#else
    for (int i = 0; i < N_PHASES; ++i) { p.ph_lo = i; p.ph_hi = i + 1; hipLaunchKernelGGL(mk_fwd, dim3(grid), dim3(512), LDS_BYTES, stream, p); }
#endif
}
```

```cpp
#include <hip/hip_runtime.h>
#include <hip/hip_cooperative_groups.h>
#include <cstdio>
namespace cg = cooperative_groups;
#ifndef MK_COOP
#define MK_COOP 1
#endif
namespace pg8 {
#define PG8_LAS __attribute__((address_space(3)))
typedef unsigned short bf16_t;
typedef short bf16x8 __attribute__((ext_vector_type(8)));
typedef float f32x4 __attribute__((ext_vector_type(4)));
typedef unsigned u32x4 __attribute__((ext_vector_type(4)));
constexpr int BM = 256, BK = 64, HALF = 128, HTB = HALF * BK * 2  , STAGE_BYTES = 8 * HTB, NXCD = 8, WGM = 8;

__host__ __device__ __forceinline__ int lds_byte(int r, int c) { const int st = (r >> 4) * 2 + (c >> 5), rr = r & 15, cc = c & 31, ob = rr * 64 + cc * 2; return st * 1024 + (ob ^ (((ob >> 9) & 1) << 5)); }
__host__ __device__ __forceinline__ void stage_rc(int b, int& R, int& C) { const int st = b / 1024, sb = b % 1024, swz = sb ^ (((sb >> 9) & 1) << 5); R = (st >> 1) * 16 + swz / 64; C = (st & 1) * 32 + (swz % 64) / 2; }
__host__ __device__ __forceinline__ int perm32(int rho) { const int n = rho >> 4, i = rho & 15; return 8 * (i >> 2) + 4 * n + (i & 3); }

struct Unit { int pm, pn, part; };
struct Gemm { const bf16_t* A; const bf16_t* Bt; int M, N, K; };

struct StaticOrder {
    int nM, nN, nwg, G, c;
    __host__ __device__ void init(int M, int N, int G_, int c_) { nM = M / BM; nN = N / BM; nwg = nM * nN; G = G_; c = c_; }
    __host__ __device__ bool next(int i, Unit& u) const {
        const long L = (long)i * G + c; if (L >= nwg) return false;
        int wgid = (int)L; { const int q = nwg / NXCD, r = nwg % NXCD, xcd = wgid % NXCD, off = wgid / NXCD; wgid = (xcd < r ? xcd * (q + 1) : r * (q + 1) + (xcd - r) * q) + off; }
        const int nig = WGM * nN, gid = wgid / nig, fm = gid * WGM, gsz = (nM - fm) < WGM ? (nM - fm) : WGM;
        u.pm = fm + ((wgid % nig) % gsz); u.pn = (wgid % nig) / gsz; u.part = 0; return true;
    }
    __device__ __forceinline__ void a_ready(const Unit&) const {}
    __device__ __forceinline__ void done(const Unit&) const {}
    __device__ __forceinline__ const char* a_ptr(const Gemm& g, const Unit& u, size_t tstep) const { return (const char*)g.A + (size_t)u.pm * tstep; }
    __device__ __forceinline__ const char* b_ptr(const Gemm& g, const Unit& u, size_t tstep) const { return (const char*)g.Bt + (size_t)u.pn * tstep; }
};
__device__ __forceinline__ int opaque_tid() { int t = threadIdx.x; asm volatile("" : "+v"(t)); return t; }
typedef __bf16 bf16x2_t __attribute__((ext_vector_type(2)));
typedef float f32x2_t __attribute__((ext_vector_type(2)));
__device__ __forceinline__ unsigned cvt_pk_bf16(float lo, float hi) { const f32x2_t v = {lo, hi}; const bf16x2_t b = __builtin_convertvector(v, bf16x2_t); return __builtin_bit_cast(unsigned, b); }
__device__ __forceinline__ float bf_lo(unsigned w) { return __uint_as_float(w << 16); }
__device__ __forceinline__ float bf_hi(unsigned w) { return __uint_as_float(w & 0xffff0000u); }
template <int ACT> __device__ __forceinline__ float actf(float x) {
    if (ACT == 0) return x;
    if (ACT == 1) { const float u = 1.5957691216f * (x + 0.044715f * x * x * x); return x * __builtin_amdgcn_rcpf(1.0f + __expf(-u)); }
    if (ACT == 2) return x * __builtin_amdgcn_rcpf(1.0f + __expf(-x));
    return __builtin_amdgcn_rcpf(1.0f + __expf(-x));
}
template <int ACT> __device__ __forceinline__ void act8(float (&v)[8]) {
    if (ACT == 0) return;
    float a[8];
#pragma unroll
    for (int j = 0; j < 8; ++j) a[j] = (ACT == 1) ? -1.5957691216f * (v[j] + 0.044715f * v[j] * v[j] * v[j]) : -v[j];
#pragma unroll
    for (int j = 0; j < 8; ++j) a[j] = __expf(a[j]);
#pragma unroll
    for (int j = 0; j < 8; ++j) a[j] = 1.0f + a[j];
#pragma unroll
    for (int j = 0; j < 8; ++j) a[j] = __builtin_amdgcn_rcpf(a[j]);
#pragma unroll
    for (int j = 0; j < 8; ++j) v[j] = (ACT == 3) ? a[j] : v[j] * a[j];
}
struct EpiSwiGLU {
    static constexpr bool PERM = true, AFTER_DRAIN = false, TWO_PART = false;
    bf16_t* O;
    __device__ __forceinline__ void operator()(const f32x4 (&acc)[2][2][4][2], const Unit& u, int wr, int wc, int fr, int fq) const {
        const int row0 = u.pm * BM + wr * 64 + fr, col0 = u.pn * HALF + wc * 32 + 8 * fq;
#pragma unroll
        for (int ai = 0; ai < 2; ++ai)
#pragma unroll
            for (int m = 0; m < 4; ++m) {
                const f32x4 a0 = acc[ai][0][m][0], a1 = acc[ai][0][m][1], b0 = acc[ai][1][m][0], b1 = acc[ai][1][m][1];
                float v[8] = {a0[0], a0[1], a0[2], a0[3], a1[0], a1[1], a1[2], a1[3]};
                act8<2>(v);
#pragma unroll
                for (int j = 0; j < 4; ++j) { v[j] *= b0[j]; v[4 + j] *= b1[j]; }
                u32x4 w; w.x = cvt_pk_bf16(v[0], v[1]); w.y = cvt_pk_bf16(v[2], v[3]); w.z = cvt_pk_bf16(v[4], v[5]); w.w = cvt_pk_bf16(v[6], v[7]);
                *(u32x4*)(O + (size_t)(row0 + ai * HALF + m * 16) * 2816 + col0) = w;
            }
    }
};
struct EpiResid {
    static constexpr bool PERM = false, AFTER_DRAIN = false, TWO_PART = false;
    const float* hin; float* hout; const float* gmod; float scale;
    __device__ __forceinline__ void operator()(const f32x4 (&acc)[2][2][4][2], const Unit& u, int wr, int wc, int fr, int fq) const {
        const int row0 = u.pm * BM + wr * 64 + fr, col0 = u.pn * BM + wc * 32 + 4 * fq;
        const float* gp = gmod + (size_t)((u.pm * BM) >> 13) * 9216 + col0;
        f32x4 cf[2][2];
#pragma unroll
        for (int bj = 0; bj < 2; ++bj)
#pragma unroll
            for (int n = 0; n < 2; ++n) { const f32x4 g = *(const f32x4*)(gp + bj * HALF + n * 16); cf[bj][n] = (g + 1.0f) * scale; }
#pragma unroll
        for (int ai = 0; ai < 2; ++ai) {
            f32x4 hv[4][2][2];
#pragma unroll
            for (int m = 0; m < 4; ++m) { const size_t off = (size_t)(row0 + ai * HALF + m * 16) * 1024 + col0;
#pragma unroll
                for (int bj = 0; bj < 2; ++bj)
#pragma unroll
                    for (int n = 0; n < 2; ++n) hv[m][bj][n] = *(const f32x4*)(hin + off + bj * HALF + n * 16); }
#pragma unroll
            for (int m = 0; m < 4; ++m) { const size_t off = (size_t)(row0 + ai * HALF + m * 16) * 1024 + col0;
#pragma unroll
                for (int bj = 0; bj < 2; ++bj)
#pragma unroll
                    for (int n = 0; n < 2; ++n) *(f32x4*)(hout + off + bj * HALF + n * 16) = hv[m][bj][n] + cf[bj][n] * acc[ai][bj][m][n]; }
            asm volatile("" ::: "memory"); }
    }
};
struct EpiInproj {
    static constexpr bool PERM = true, AFTER_DRAIN = false, TWO_PART = false;
    bf16_t* U; bf16_t* V; bf16_t* Q; float* F; bf16_t* I; bf16_t* OG; bf16_t* GA; bf16_t* GB; const float* lb;
    template <int ACT> __device__ __forceinline__ void st16(const f32x4 (&acc)[2][2][4][2], bf16_t* dst, int row0, int colg) const {
#pragma unroll
        for (int ai = 0; ai < 2; ++ai)
#pragma unroll
            for (int m = 0; m < 4; ++m)
#pragma unroll
                for (int bj = 0; bj < 2; ++bj) { const f32x4 v0 = acc[ai][bj][m][0], v1 = acc[ai][bj][m][1];
                    float v[8] = {v0[0], v0[1], v0[2], v0[3], v1[0], v1[1], v1[2], v1[3]};
                    act8<ACT>(v);
                    u32x4 w; w.x = cvt_pk_bf16(v[0], v[1]); w.y = cvt_pk_bf16(v[2], v[3]); w.z = cvt_pk_bf16(v[4], v[5]); w.w = cvt_pk_bf16(v[6], v[7]);
                    *(u32x4*)(dst + (size_t)(row0 + ai * HALF + m * 16) * 1024 + colg + bj * HALF) = w; }
    }
    __device__ __forceinline__ void operator()(const f32x4 (&acc)[2][2][4][2], const Unit& u, int wr, int wc, int fr, int fq) const {
        const int grp = u.pn >> 2, colg = (u.pn & 3) * BM + wc * 32 + 8 * fq, row0 = u.pm * BM + wr * 64 + fr;
        if (grp == 3) {
#pragma unroll
            for (int bj = 0; bj < 2; ++bj) { const f32x4 l0 = *(const f32x4*)(lb + colg + bj * HALF), l1 = *(const f32x4*)(lb + colg + bj * HALF + 4);
#pragma unroll
                for (int ai = 0; ai < 2; ++ai)
#pragma unroll
                    for (int m = 0; m < 4; ++m) { const f32x4 v0 = acc[ai][bj][m][0], v1 = acc[ai][bj][m][1]; f32x4 o0, o1;
#pragma unroll
                        for (int j = 0; j < 4; ++j) { o0[j] = __logf(fmaxf(l0[j] + (1.0f - l0[j]) * actf<3>(v0[j]), 1e-30f)); o1[j] = __logf(fmaxf(l1[j] + (1.0f - l1[j]) * actf<3>(v1[j]), 1e-30f)); }
                        float* d = F + (size_t)(row0 + ai * HALF + m * 16) * 1024 + colg + bj * HALF; *(f32x4*)d = o0; *(f32x4*)(d + 4) = o1; } }
        } else if (grp < 2) st16<1>(acc, grp == 0 ? U : V, row0, colg);
        else if (grp == 2) st16<2>(acc, Q, row0, colg);
        else if (grp == 4) st16<0>(acc, I, row0, colg);
        else st16<3>(acc, grp == 5 ? OG : (grp == 6 ? GA : GB), row0, colg);
    }
};
template <int MODE> struct EpiBranch {
    static constexpr bool PERM = true, AFTER_DRAIN = false, TWO_PART = false;
    const bf16_t* G; const bf16_t* P; bf16_t* O;
    __device__ __forceinline__ void operator()(const f32x4 (&acc)[2][2][4][2], const Unit& u, int wr, int wc, int fr, int fq) const {
        const int row0 = u.pm * BM + wr * 64 + fr, col0 = u.pn * BM + wc * 32 + 8 * fq;
#pragma unroll
        for (int ai = 0; ai < 2; ++ai)
#pragma unroll
            for (int m = 0; m < 4; ++m)
#pragma unroll
                for (int bj = 0; bj < 2; ++bj) { const size_t off = (size_t)(row0 + ai * HALF + m * 16) * 1024 + col0 + bj * HALF;
                    const u32x4 g = *(const u32x4*)(G + off); const f32x4 v0 = acc[ai][bj][m][0], v1 = acc[ai][bj][m][1];
                    float r[8] = { bf_lo(g.x) * v0[0], bf_hi(g.x) * v0[1], bf_lo(g.y) * v0[2], bf_hi(g.y) * v0[3], bf_lo(g.z) * v1[0], bf_hi(g.z) * v1[1], bf_lo(g.w) * v1[2], bf_hi(g.w) * v1[3] };
                    if (MODE == 1) { const u32x4 p = *(const u32x4*)(P + off);
                        r[0] += bf_lo(p.x); r[1] += bf_hi(p.x); r[2] += bf_lo(p.y); r[3] += bf_hi(p.y); r[4] += bf_lo(p.z); r[5] += bf_hi(p.z); r[6] += bf_lo(p.w); r[7] += bf_hi(p.w); }
                    u32x4 w; w.x = cvt_pk_bf16(r[0], r[1]); w.y = cvt_pk_bf16(r[2], r[3]); w.z = cvt_pk_bf16(r[4], r[5]); w.w = cvt_pk_bf16(r[6], r[7]);
                    *(u32x4*)(O + off) = w; }
    }
};

struct EpiBranchFused {
    static constexpr bool PERM = true, AFTER_DRAIN = false, TWO_PART = true;
    const bf16_t* GA; const bf16_t* GB; bf16_t* O;
    __device__ __forceinline__ void mid(f32x4 (&acc)[2][2][4][2], const Unit& u, int wr, int wc, int fr, int fq) const {
        const int row0 = u.pm * BM + wr * 64 + fr, col0 = u.pn * BM + wc * 32 + 8 * fq;
#pragma unroll
        for (int ai = 0; ai < 2; ++ai)
#pragma unroll
            for (int m = 0; m < 4; ++m)
#pragma unroll
                for (int bj = 0; bj < 2; ++bj) { const size_t off = (size_t)(row0 + ai * HALF + m * 16) * 1024 + col0 + bj * HALF;
                    const u32x4 a = *(const u32x4*)(GA + off), b = *(const u32x4*)(GB + off);
                    const float ra[8] = {bf_lo(a.x), bf_hi(a.x), bf_lo(a.y), bf_hi(a.y), bf_lo(a.z), bf_hi(a.z), bf_lo(a.w), bf_hi(a.w)}, rb[8] = {bf_lo(b.x), bf_hi(b.x), bf_lo(b.y), bf_hi(b.y), bf_lo(b.z), bf_hi(b.z), bf_lo(b.w), bf_hi(b.w)};
#pragma unroll
                    for (int j = 0; j < 4; ++j) { acc[ai][bj][m][0][j] *= ra[j] * __builtin_amdgcn_rcpf(fmaxf(rb[j], 1e-6f)); acc[ai][bj][m][1][j] *= ra[4 + j] * __builtin_amdgcn_rcpf(fmaxf(rb[4 + j], 1e-6f)); } }
    }
    __device__ __forceinline__ void operator()(const f32x4 (&acc)[2][2][4][2], const Unit& u, int wr, int wc, int fr, int fq) const {
        const int row0 = u.pm * BM + wr * 64 + fr, col0 = u.pn * BM + wc * 32 + 8 * fq;
#pragma unroll
        for (int ai = 0; ai < 2; ++ai)
#pragma unroll
            for (int m = 0; m < 4; ++m)
#pragma unroll
                for (int bj = 0; bj < 2; ++bj) { const size_t off = (size_t)(row0 + ai * HALF + m * 16) * 1024 + col0 + bj * HALF;
                    const u32x4 b = *(const u32x4*)(GB + off); const f32x4 v0 = acc[ai][bj][m][0], v1 = acc[ai][bj][m][1];
                    const float rb[8] = {bf_lo(b.x), bf_hi(b.x), bf_lo(b.y), bf_hi(b.y), bf_lo(b.z), bf_hi(b.z), bf_lo(b.w), bf_hi(b.w)};
                    u32x4 w; w.x = cvt_pk_bf16(fmaxf(rb[0], 1e-6f) * v0[0], fmaxf(rb[1], 1e-6f) * v0[1]); w.y = cvt_pk_bf16(fmaxf(rb[2], 1e-6f) * v0[2], fmaxf(rb[3], 1e-6f) * v0[3]);
                    w.z = cvt_pk_bf16(fmaxf(rb[4], 1e-6f) * v1[0], fmaxf(rb[5], 1e-6f) * v1[1]); w.w = cvt_pk_bf16(fmaxf(rb[6], 1e-6f) * v1[2], fmaxf(rb[7], 1e-6f) * v1[3]);
                    *(u32x4*)(O + off) = w; }
    }
};
struct BranchOrder : StaticOrder {
    const bf16_t* A2; const bf16_t* Bt2;
    __device__ __forceinline__ bool next(int i, Unit& u) const { const bool ok = StaticOrder::next(i >> 1, u); u.part = i & 1; return ok; }
    __device__ __forceinline__ const char* a_ptr(const Gemm& g, const Unit& u, size_t tstep) const { return (const char*)(u.part ? A2 : g.A) + (size_t)u.pm * tstep; }
    __device__ __forceinline__ const char* b_ptr(const Gemm& g, const Unit& u, size_t tstep) const { return (const char*)(u.part ? Bt2 : g.Bt) + (size_t)u.pn * tstep; }
};
struct SplitAOrder : StaticOrder {
    const bf16_t* A1;
    __device__ __forceinline__ const char* a_ptr(const Gemm& g, const Unit& u, size_t tstep) const { return u.pm < 128 ? (const char*)g.A + (size_t)u.pm * tstep : (const char*)A1 + (size_t)(u.pm - 128) * tstep; }
};

template <class Epi, class Sched, bool STAMP = false>
__device__ __forceinline__ void gemm_phase(PG8_LAS unsigned char* lds, const Gemm g, const Sched& S, const Epi& E, unsigned long long* stamps) {
    const int tid = opaque_tid(), wid = __builtin_amdgcn_readfirstlane(tid >> 6), lane = tid & 63, wr = wid >> 2, wc = wid & 3, fr = lane & 15, fq = lane >> 4;
    const int K = g.K, nt = K / BK;
    int ts_lo = 0, ts_hi = 0, nts = 0; const unsigned long long rt_entry = STAMP ? (unsigned long long)wall_clock64() : 0ull;
#define PG8_STAMP() do { if (STAMP && wid == 0 && nts < 64) { const unsigned long long _c = (unsigned long long)clock64(); \
        ts_lo = (lane == nts) ? (int)(unsigned)_c : ts_lo; ts_hi = (lane == nts) ? (int)(unsigned)(_c >> 32) : ts_hi; ++nts; } } while (0)
    PG8_STAMP();
    unsigned voffA[2], voffB[2];
#pragma unroll
    for (int i = 0; i < 2; ++i) { int R, C; stage_rc(tid * 16 + i * 8192, R, C); const int Rb = Epi::PERM ? ((R & ~31) + perm32(R & 31)) : R;
        voffA[i] = (unsigned)(R * K + C) * 2u; voffB[i] = (unsigned)(Rb * K + C) * 2u; }
    const size_t kstep = (size_t)(BK * 2);
    const size_t hstep = (size_t)HALF * K * 2;
    const size_t tstep = 2 * hstep;
    const unsigned ldsw = (unsigned)wid * 1024u;
    const int aoff = lds_byte(wr * 64 + fr, fq * 8), boff = lds_byte(wc * 32 + fr, fq * 8);
#define PG8_SA(b, h) (((b) * 2 + (h)) * HTB)
#define PG8_SB(b, h) ((4 + (b) * 2 + (h)) * HTB)
#define PG8_STAGE(bufoff, gbase, voff) do { _Pragma("unroll") for (int _i = 0; _i < 2; ++_i) \
        __builtin_amdgcn_global_load_lds((const unsigned*)((const char*)(gbase) + (voff)[_i]), (PG8_LAS unsigned*)(lds + (bufoff) + ldsw + _i * 8192), 16, 0, 0); } while (0)
#define PG8_LDA(dst, b, h) do { _Pragma("unroll") for (int m = 0; m < 4; ++m) _Pragma("unroll") for (int k = 0; k < 2; ++k) dst[m][k] = *(const PG8_LAS bf16x8*)(lds + PG8_SA(b, h) + aoff + m * 2048 + k * 1024); } while (0)
#define PG8_LDB(dst, b, h) do { _Pragma("unroll") for (int n = 0; n < 2; ++n) _Pragma("unroll") for (int k = 0; k < 2; ++k) dst[n][k] = *(const PG8_LAS bf16x8*)(lds + PG8_SB(b, h) + boff + n * 2048 + k * 1024); } while (0)
#define PG8_MMA(ai, bj, At, Bt) do { __builtin_amdgcn_s_setprio(1); _Pragma("unroll") for (int m = 0; m < 4; ++m) _Pragma("unroll") for (int n = 0; n < 2; ++n) _Pragma("unroll") for (int k = 0; k < 2; ++k) \
        acc[ai][bj][m][n] = __builtin_amdgcn_mfma_f32_16x16x32_bf16(Bt[n][k], At[m][k], acc[ai][bj][m][n], 0, 0, 0); __builtin_amdgcn_s_setprio(0); } while (0)
#define PG8_WAIT_V(n) asm volatile("s_waitcnt vmcnt(" #n ")" ::: "memory")
#define PG8_WAIT_L(n) asm volatile("s_waitcnt lgkmcnt(" #n ")" ::: "memory")
#define PG8_BAR __builtin_amdgcn_s_barrier()
#define PG8_SCHED __builtin_amdgcn_sched_barrier(0)
    Unit cur, nxt; int ui = 0;
    if (!S.next(0, cur)) return;
    f32x4 acc[2][2][4][2];
#pragma unroll
    for (int a = 0; a < 2; ++a)
#pragma unroll
        for (int b = 0; b < 2; ++b)
#pragma unroll
            for (int m = 0; m < 4; ++m)
#pragma unroll
                for (int n = 0; n < 2; ++n) acc[a][b][m][n] = (f32x4){0.f, 0.f, 0.f, 0.f};
    bf16x8 At[4][2], B0[2][2], B1[2][2];
    const char* cA = S.a_ptr(g, cur, tstep); const char* cB = S.b_ptr(g, cur, tstep);
    S.a_ready(cur);
    PG8_STAGE(PG8_SB(0, 0), cB, voffB); PG8_STAGE(PG8_SA(0, 0), cA, voffA); PG8_STAGE(PG8_SB(0, 1), cB + hstep, voffB); PG8_STAGE(PG8_SA(0, 1), cA + hstep, voffA);
    if (wr == 1) PG8_BAR;
    PG8_WAIT_V(4); PG8_BAR;
    PG8_STAGE(PG8_SB(1, 0), cB + kstep, voffB); PG8_STAGE(PG8_SA(1, 0), cA + kstep, voffA); PG8_STAGE(PG8_SB(1, 1), cB + hstep + kstep, voffB);
    PG8_WAIT_V(6); PG8_BAR;
    PG8_STAMP();
    for (;;) {
        const bool has_next = S.next(ui + 1, nxt);
        const char* nA = has_next ? S.a_ptr(g, nxt, tstep) : cA; const char* nB = has_next ? S.b_ptr(g, nxt, tstep) : cB;
        for (int t = 0; t < nt; t += 2) {
            const bool last = (t == nt - 2);
            const char* a1 = cA + (size_t)(t + 1) * kstep;
            const char* a2 = last ? nA : cA + (size_t)(t + 2) * kstep; const char* b2 = last ? nB : cB + (size_t)(t + 2) * kstep;
            const char* a3 = a2 + kstep; const char* b3 = b2 + kstep;
            if (last && has_next) S.a_ready(nxt);
            PG8_LDB(B0, 0, 0); PG8_SCHED; PG8_LDA(At, 0, 0); PG8_STAGE(PG8_SA(1, 1), a1 + hstep, voffA);
            PG8_WAIT_L(8); PG8_BAR; PG8_WAIT_L(0); PG8_MMA(0, 0, At, B0); PG8_BAR; PG8_SCHED;
            PG8_LDB(B1, 0, 1); PG8_STAGE(PG8_SB(0, 0), b2, voffB);
            PG8_BAR; PG8_WAIT_L(0); PG8_MMA(0, 1, At, B1); PG8_BAR;
            PG8_LDA(At, 0, 1); PG8_STAGE(PG8_SA(0, 0), a2, voffA);
            PG8_BAR; PG8_WAIT_L(0); PG8_MMA(1, 0, At, B0); PG8_BAR; PG8_SCHED;
            PG8_STAGE(PG8_SB(0, 1), b2 + hstep, voffB);
            PG8_WAIT_V(6); PG8_BAR; PG8_MMA(1, 1, At, B1); PG8_BAR;
            PG8_LDB(B0, 1, 0); PG8_SCHED; PG8_LDA(At, 1, 0); PG8_STAGE(PG8_SA(0, 1), a2 + hstep, voffA);
            PG8_WAIT_L(8); PG8_BAR; PG8_WAIT_L(0); PG8_MMA(0, 0, At, B0); PG8_BAR; PG8_SCHED;
            PG8_LDB(B1, 1, 1); PG8_STAGE(PG8_SB(1, 0), b3, voffB);
            PG8_BAR; PG8_WAIT_L(0); PG8_MMA(0, 1, At, B1); PG8_BAR;
            PG8_LDA(At, 1, 1); PG8_STAGE(PG8_SA(1, 0), a3, voffA);
            PG8_BAR; PG8_WAIT_L(0); PG8_MMA(1, 0, At, B0); PG8_BAR; PG8_SCHED;
            PG8_STAGE(PG8_SB(1, 1), b3 + hstep, voffB);
            PG8_WAIT_V(6); PG8_BAR; PG8_MMA(1, 1, At, B1); PG8_BAR;
        }
        PG8_STAMP();
        if constexpr (Epi::TWO_PART) { if (cur.part == 0) E.mid(acc, cur, wr, wc, fr, fq); else E(acc, cur, wr, wc, fr, fq); } else if constexpr (!Epi::AFTER_DRAIN) { E(acc, cur, wr, wc, fr, fq); S.done(cur); }
        PG8_STAMP();
        if (!has_next) break;
        bool keep_acc = false; if constexpr (Epi::TWO_PART) keep_acc = (cur.part == 0);
        if (!keep_acc)
#pragma unroll
        for (int a = 0; a < 2; ++a)
#pragma unroll
            for (int b = 0; b < 2; ++b)
#pragma unroll
                for (int m = 0; m < 4; ++m)
#pragma unroll
                    for (int n = 0; n < 2; ++n) acc[a][b][m][n] = (f32x4){0.f, 0.f, 0.f, 0.f};
        cur = nxt; cA = nA; cB = nB; ++ui;
    }
    PG8_WAIT_V(0);
    if (wr == 0) PG8_BAR;
    PG8_BAR;
    if constexpr (Epi::AFTER_DRAIN) { E.fused(acc, cur, wr, wc, fr, fq, lds, wid, lane); S.done(cur); }
    PG8_STAMP();
    if (STAMP && wid == 0) { stamps[lane] = lane < nts ? (((unsigned long long)(unsigned)ts_hi << 32) | (unsigned)ts_lo) : 0ull;
        if (lane == 62) stamps[62] = rt_entry; if (lane == 63) stamps[63] = (unsigned long long)wall_clock64(); }
#undef PG8_STAMP
#undef PG8_SA
#undef PG8_SB
#undef PG8_STAGE
#undef PG8_LDA
#undef PG8_LDB
#undef PG8_MMA
#undef PG8_WAIT_V
#undef PG8_WAIT_L
#undef PG8_BAR
#undef PG8_SCHED
}
}
using pg8::bf16_t; using pg8::bf16x8; using pg8::f32x4; using pg8::u32x4; using pg8::cvt_pk_bf16; using pg8::bf_lo; using pg8::bf_hi; using pg8::opaque_tid;
#define LAS __attribute__((address_space(3)))
typedef unsigned u32x2 __attribute__((ext_vector_type(2)));

constexpr int NT = 65536, DM = 1024, NL = 4, SEQ = 8192, FH = 2816, TH = 32768  ;
constexpr int LDS_BYTES = 144 * 1024, XB_ST_OFF = 143616;
constexpr size_t MiB = 1024ull * 1024ull;
constexpr size_t WS_MOD = 64 * 1024;
constexpr size_t WS_WST = 2 * MiB;
constexpr size_t WS_LB = 3 * MiB;
constexpr size_t WS_WIN = 4 * MiB;
constexpr size_t WS_W13 = 68 * MiB;
constexpr size_t WS_W2 = 156 * MiB;
constexpr size_t WS_WA = 200 * MiB, WS_WB = 208 * MiB, WS_WO = 216 * MiB;
constexpr size_t WS_HN = 224 * MiB;
constexpr size_t WS_BIG = 352 * MiB;
constexpr size_t ZB = 64 * MiB;
constexpr size_t WS_U = WS_BIG, WS_V = WS_BIG + ZB, WS_Q = WS_BIG + 2 * ZB, WS_F = WS_BIG + 3 * ZB  , WS_I = WS_BIG + 5 * ZB, WS_OG = WS_BIG + 6 * ZB, WS_GA = WS_BIG + 7 * ZB, WS_GB = WS_BIG + 8 * ZB;
constexpr size_t WS_HU = WS_BIG + 9 * ZB;
constexpr size_t WS_HD = WS_HU + 16 * MiB;
constexpr size_t WS_M0 = WS_HD + 1 * MiB;
constexpr size_t WS_END = WS_M0 + ZB;

struct Params { const float* in[15]; float* out; unsigned char* ws; int ph_lo, ph_hi; };
typedef const Params __attribute__((address_space(4))) * KP;

__device__ __forceinline__ float wave_sum(float v) {
#pragma unroll
    for (int o = 1; o < 64; o <<= 1) v += __shfl_xor(v, o);
    return v;
}

__device__ __forceinline__ void transpose_item(const float* __restrict__ W, int K, int N, bf16_t* __restrict__ WT, int item, int remap, LAS float* scr, int lane) {
    const int nblk = N / 32, kb = item / nblk, nb = item - kb * nblk, k0 = 64 * kb, n0 = 32 * nb;
    int drow0 = n0;
    if (remap) { const int bj = n0 / FH, nn = n0 - bj * FH; drow0 = (nn >> 7) * 256 + bj * 128 + (nn & 127); }
#pragma unroll 8
    for (int i = 0; i < 32; ++i) { const int kk = 2 * i + (lane >> 5); scr[kk * 33 + (lane & 31)] = W[(size_t)(k0 + kk) * N + n0 + (lane & 31)]; }
    asm volatile("s_waitcnt lgkmcnt(0)" ::: "memory");
    const int c = lane & 7;
#pragma unroll
    for (int j = 0; j < 4; ++j) { const int n = (lane >> 3) + 8 * j; const LAS float* s = scr + (8 * c) * 33 + n;
        u32x4 o; o.x = cvt_pk_bf16(s[0 * 33], s[1 * 33]); o.y = cvt_pk_bf16(s[2 * 33], s[3 * 33]); o.z = cvt_pk_bf16(s[4 * 33], s[5 * 33]); o.w = cvt_pk_bf16(s[6 * 33], s[7 * 33]);
        *(u32x4*)(WT + (size_t)(drow0 + n) * K + k0 + 8 * c) = o; }
    asm volatile("s_waitcnt lgkmcnt(0)" ::: "memory");
}

__device__ __forceinline__ void prologue_phase(KP p, LAS unsigned char* lds) {
    const int tid = opaque_tid(), lane = tid & 63, wave = tid >> 6, G = gridDim.x;
    unsigned char* ws = p->ws;
    {
        LAS float* cact = (LAS float*)lds;
        LAS float* red = (LAS float*)(lds + 32768);
        const float* c = p->in[1];
        for (int i = tid; i < 8192; i += 512) { const int b = i >> 10, k = i & 1023; const float x = c[i]; cact[k * 8 + b] = x / (1.0f + __expf(-x)); }
        __syncthreads();
        for (int task = blockIdx.x; task < 288; task += G) {
            const int idx = task * 128 + (tid & 127), kq = tid >> 7, l = idx / 9216, n = idx - l * 9216;
            const float* aw = p->in[12] + (size_t)l * 1024 * 9216 + n;
            float a[8];
#pragma unroll
            for (int b = 0; b < 8; ++b) a[b] = 0.f;
#pragma unroll 8
            for (int k = kq * 256; k < kq * 256 + 256; ++k) { const float w = aw[(size_t)k * 9216]; const f32x4 c0 = *(const LAS f32x4*)(cact + k * 8), c1 = *(const LAS f32x4*)(cact + k * 8 + 4);
                a[0] += c0[0] * w; a[1] += c0[1] * w; a[2] += c0[2] * w; a[3] += c0[3] * w; a[4] += c1[0] * w; a[5] += c1[1] * w; a[6] += c1[2] * w; a[7] += c1[3] * w; }
#pragma unroll
            for (int b = 0; b < 8; ++b) red[(kq * 8 + b) * 128 + (tid & 127)] = a[b];
            __syncthreads();
            if (kq == 0) { const float bias = p->in[13][idx]; float* mod = (float*)(ws + WS_MOD);
#pragma unroll
                for (int b = 0; b < 8; ++b) mod[((size_t)l * 8 + b) * 9216 + n] = ((red[b * 128 + tid] + red[(8 + b) * 128 + tid]) + (red[(16 + b) * 128 + tid] + red[(24 + b) * 128 + tid])) + bias; }
            __syncthreads();
        }
    }
    if (blockIdx.x == 72 % G) {
        const float* lg = p->in[5]; float* lb = (float*)(ws + WS_LB);
        for (int k = tid; k < 1024; k += 512) { const float a0 = lg[k], a1 = lg[1024 + k], a2 = lg[2048 + k], a3 = lg[3072 + k]; const float mx = fmaxf(fmaxf(a0, a1), fmaxf(a2, a3));
            const float e0 = __expf(a0 - mx), e1 = __expf(a1 - mx), e2 = __expf(a2 - mx), e3 = __expf(a3 - mx), inv = 1.0f / (e0 + e1 + e2 + e3);
            lb[k] = 0.f; lb[1024 + k] = e1 * inv; lb[2048 + k] = (e1 + e2) * inv; lb[3072 + k] = (e1 + e2 + e3) * inv; }
    }
    { const float* wsrc = p->in[3]; bf16_t* wst = (bf16_t*)(ws + WS_WST);
      for (int i = blockIdx.x * 512 + tid; i < 4 * 8 * 128 * 128 / 2; i += G * 512) { const int e = 2 * i, s = e & 127, t = (e >> 7) & 127;
          const float v0 = s <= t ? wsrc[e] : 0.f, v1 = (s + 1) <= t ? wsrc[e + 1] : 0.f; ((unsigned*)wst)[i] = cvt_pk_bf16(v0, v1); } }
    LAS float* scr = (LAS float*)(lds + 32768 + wave * 8704);
    const int gw = blockIdx.x * 8 + wave, NGW = G * 8;
    constexpr int I_IN = 16 * 256, I_13 = 16 * 176, I_2 = 44 * 32, I_SQ = 16 * 32, I_LAYER = I_IN + 2 * I_13 + 2 * I_2 + 3 * I_SQ;
    for (int it = gw; it < NL * I_LAYER; it += NGW) {
        const int l = it / I_LAYER; int r = it - l * I_LAYER;
        if (r < I_IN) { transpose_item(p->in[2] + (size_t)l * 1024 * 8192, 1024, 8192, (bf16_t*)(ws + WS_WIN) + (size_t)l * 8192 * 1024, r, 0, scr, lane); continue; } r -= I_IN;
        if (r < 2 * I_13) { const int s = r / I_13; r -= s * I_13; transpose_item(p->in[9] + (size_t)(l * 2 + s) * 1024 * 5632, 1024, 5632, (bf16_t*)(ws + WS_W13) + (size_t)(l * 2 + s) * 5632 * 1024, r, 1, scr, lane); continue; } r -= 2 * I_13;
        if (r < 2 * I_2) { const int s = r / I_2; r -= s * I_2; transpose_item(p->in[10] + (size_t)(l * 2 + s) * FH * 1024, FH, 1024, (bf16_t*)(ws + WS_W2) + (size_t)(l * 2 + s) * 1024 * FH, r, 0, scr, lane); continue; } r -= 2 * I_2;
        const int m = r / I_SQ; r -= m * I_SQ;
        const float* src = (m == 0 ? p->in[6] : (m == 1 ? p->in[7] : p->in[8])) + (size_t)l * 1024 * 1024;
        bf16_t* dst = (bf16_t*)(ws + (m == 0 ? WS_WA : (m == 1 ? WS_WB : WS_WO))) + (size_t)l * 1024 * 1024;
        transpose_item(src, 1024, 1024, dst, r, 0, scr, lane);
    }
}

template <bool FINAL> __device__ __forceinline__ void norm_phase(const float* hin, bf16_t* hn, float* fout, const float* nw, const float* modl  , int sub) {
    const int tid = opaque_tid(), lane = tid & 63, gw = blockIdx.x * 8 + (tid >> 6), NGW = gridDim.x * 8;
    f32x4 w4[4];
#pragma unroll
    for (int j = 0; j < 4; ++j) w4[j] = *(const f32x4*)(nw + 4 * lane + 256 * j);
    for (int row0 = gw; row0 < NT; row0 += 2 * NGW) {
        const int row1 = row0 + NGW; const bool has1 = row1 < NT;
        f32x4 v[2][4]; float s[2] = {0.f, 0.f};
#pragma unroll
        for (int r = 0; r < 2; ++r) { const int row = r ? (has1 ? row1 : row0) : row0; const float* xr = hin + (size_t)row * DM + 4 * lane;
#pragma unroll
            for (int j = 0; j < 4; ++j) v[r][j] = *(const f32x4*)(xr + 256 * j); }
#pragma unroll
        for (int r = 0; r < 2; ++r)
#pragma unroll
            for (int j = 0; j < 4; ++j) s[r] += (v[r][j][0] * v[r][j][0] + v[r][j][1] * v[r][j][1]) + (v[r][j][2] * v[r][j][2] + v[r][j][3] * v[r][j][3]);
#pragma unroll
        for (int o = 1; o < 64; o <<= 1) { s[0] += __shfl_xor(s[0], o); s[1] += __shfl_xor(s[1], o); }
#pragma unroll
        for (int r = 0; r < 2; ++r) { if (r == 1 && !has1) break; const int row = r ? row1 : row0;
            const float rstd = rsqrtf(s[r] * (1.0f / DM) + 1e-6f);
            if (FINAL) {
#pragma unroll
                for (int j = 0; j < 4; ++j) *(f32x4*)(fout + (size_t)row * DM + 4 * lane + 256 * j) = v[r][j] * rstd * w4[j];
            } else {
                const float* sh = modl + (size_t)(row >> 13) * 9216 + (3 * sub) * 1024 + 4 * lane; const float* sc = sh + 1024;
#pragma unroll
                for (int j = 0; j < 4; ++j) { const f32x4 a = *(const f32x4*)(sc + 256 * j), bb = *(const f32x4*)(sh + 256 * j); const f32x4 o = v[r][j] * rstd * w4[j] * (a + 1.0f) + bb;
                    u32x2 w; w.x = cvt_pk_bf16(o[0], o[1]); w.y = cvt_pk_bf16(o[2], o[3]); *(u32x2*)(hn + (size_t)row * DM + 4 * lane + 256 * j) = w; }
            }
        }
    }
}

__device__ __forceinline__ int tr64_off(int row, int col) { return row * 128 + ((((col >> 3) ^ (row ^ (row >> 3))) & 7) << 4) + ((col & 7) << 1); }
__device__ __forceinline__ int tr128_off(int row, int col) { return row * 256 + ((((col >> 3) ^ (row ^ (row >> 3))) & 15) << 4) + ((col & 7) << 1); }
constexpr int H_LF = 0, H_P = 0  , H_TOT = 32768, H_VEC = 34816, H_SS = 36864, H_QP = 38912, H_KP = 56320, H_KT = 73728, H_VT = 90112, H_ST = 106496, H_END = 141312;
static_assert(H_END <= LDS_BYTES, "LDS");
#define MFMA16(a, b, c) __builtin_amdgcn_mfma_f32_16x16x32_bf16((a), (b), (c), 0, 0, 0)

template <bool PRE> __device__ __forceinline__ void hgrn_seq(LAS unsigned char* lds, const bf16_t* __restrict__ Qb, const float* __restrict__ Fb, const bf16_t* __restrict__ Ib, const bf16_t* OGb, bf16_t* OUTb, size_t row_base, int colbase, int c0, int nch, float* Ubuf, float* Dbuf, int item0, int nprev) {
    const int tid = opaque_tid(), lane = tid & 63, w = __builtin_amdgcn_readfirstlane(tid >> 6), q4 = lane >> 4, l15 = lane & 15;
    const int pt = tid >> 4, pc8 = (tid & 15) * 8;
    const int sk = tid & 127, sseg = tid >> 7;
    LAS float* Lf = (LAS float*)(lds + H_LF); LAS float* Ltot = (LAS float*)(lds + H_TOT); LAS float* Lss = (LAS float*)(lds + H_SS);
    f32x4 S[8];
#pragma unroll
    for (int i = 0; i < 8; ++i) S[i] = (f32x4){0.f, 0.f, 0.f, 0.f};
    if (!PRE) { for (int j = 0; j < nprev; ++j) { const float* Uj = Ubuf + (size_t)(item0 + j) * 16384; const f32x4 dj = *(const f32x4*)(Dbuf + (size_t)(item0 + j) * 128 + 16 * w + 4 * q4);
#pragma unroll
            for (int vt = 0; vt < 8; ++vt) S[vt] = S[vt] * dj + *(const f32x4*)(Uj + (vt * 512 + tid) * 4); } }
    float dacc = 1.0f;
    u32x4 rq[2], rv[2]; float rfc[16];
#define HG_LOADF(c) do { const float* fp_ = Fb + (row_base + (size_t)(c) * 64 + 16 * sseg) * 1024 + colbase + sk; _Pragma("unroll") for (int i_ = 0; i_ < 16; ++i_) rfc[i_] = fp_[(size_t)i_ * 1024]; } while (0)
#define HG_LOADQV(c) do { _Pragma("unroll") for (int i_ = 0; i_ < 2; ++i_) { const size_t go_ = (row_base + (size_t)(c) * 64 + pt + 32 * i_) * 1024 + colbase + pc8; \
        if (!PRE) rq[i_] = *(const u32x4*)(Qb + go_); rv[i_] = *(const u32x4*)(Ib + go_); } } while (0)
    HG_LOADF(c0); HG_LOADQV(c0);
    for (int c = c0; c < c0 + nch; ++c) {
        u32x2 rog[4];
        if (!PRE) {
#pragma unroll
        for (int ti = 0; ti < 4; ++ti) rog[ti] = *(const u32x2*)(OGb + (row_base + (size_t)c * 64 + 16 * ti + l15) * 1024 + colbase + 16 * w + 4 * q4); }
        { float run = 0.f;
#pragma unroll
          for (int i = 0; i < 16; ++i) { run += rfc[i]; Lf[(16 * sseg + i) * 128 + sk] = run; }
          Ltot[sseg * 128 + sk] = run; }
        if (c + 1 < c0 + nch) HG_LOADF(c + 1);
        __syncthreads();
        f32x4 e4, d4, c4;
        { const int kk = 16 * w + 4 * q4; const f32x4 a0 = *(const LAS f32x4*)(Ltot + kk), a1 = *(const LAS f32x4*)(Ltot + 128 + kk), a2 = *(const LAS f32x4*)(Ltot + 256 + kk), a3 = *(const LAS f32x4*)(Ltot + 384 + kk);
          const f32x4 b31 = a0 + a1, b63 = b31 + (a2 + a3);
#pragma unroll
          for (int r = 0; r < 4; ++r) { e4[r] = __expf(b31[r]); d4[r] = __expf(b63[r]); c4[r] = __expf(b63[r] - b31[r]); } }
        if (PRE) { if (tid < 128) dacc *= __expf((Ltot[tid] + Ltot[128 + tid]) + (Ltot[256 + tid] + Ltot[384 + tid])); }
        { f32x4 tv[4][2];
#pragma unroll
          for (int sg = 0; sg < 4; ++sg) { tv[sg][0] = *(const LAS f32x4*)(Ltot + sg * 128 + pc8); tv[sg][1] = *(const LAS f32x4*)(Ltot + sg * 128 + pc8 + 4); }
#pragma unroll
          for (int i = 0; i < 2; ++i) { const int t = pt + 32 * i; const bool hi = (pt >> 4) != 0;
            f32x4 off[2], ref[2];
#pragma unroll
            for (int h = 0; h < 2; ++h) { ref[h] = tv[0][h] + tv[1][h];
                if (i == 0) off[h] = hi ? tv[0][h] : (f32x4){0.f, 0.f, 0.f, 0.f}; else off[h] = hi ? ref[h] + tv[2][h] : ref[h]; }
            const f32x4 b0 = *(const LAS f32x4*)(Lf + t * 128 + pc8), b1 = *(const LAS f32x4*)(Lf + t * 128 + pc8 + 4);
            f32x4 p0 = (f32x4){0.f, 0.f, 0.f, 0.f}, p1 = p0;
            if (t & 15) { p0 = *(const LAS f32x4*)(Lf + (t - 1) * 128 + pc8); p1 = *(const LAS f32x4*)(Lf + (t - 1) * 128 + pc8 + 4); }
            unsigned qw[4] = {0u, 0u, 0u, 0u}; if (!PRE) { qw[0] = rq[i].x; qw[1] = rq[i].y; qw[2] = rq[i].z; qw[3] = rq[i].w; } const unsigned vw[4] = {rv[i].x, rv[i].y, rv[i].z, rv[i].w};
            float qp[8], kp[8];
#pragma unroll
            for (int j = 0; j < 8; ++j) { const float bl = j < 4 ? b0[j & 3] : b1[j & 3], pl = j < 4 ? p0[j & 3] : p1[j & 3], of = j < 4 ? off[0][j & 3] : off[1][j & 3], rr = j < 4 ? ref[0][j & 3] : ref[1][j & 3];
                const float lf = bl - pl, d = fminf(fmaxf((bl + of) - rr, -80.f), 80.f);
                if (!PRE) { const float qv = (j & 1) ? bf_hi(qw[j >> 1]) : bf_lo(qw[j >> 1]); qp[j] = qv * __expf(d); } else qp[j] = 0.f;
                kp[j] = (1.0f - __expf(lf)) * __expf(-d); }
            u32x4 wq, wk; wq.x = cvt_pk_bf16(qp[0], qp[1]); wq.y = cvt_pk_bf16(qp[2], qp[3]); wq.z = cvt_pk_bf16(qp[4], qp[5]); wq.w = cvt_pk_bf16(qp[6], qp[7]);
            wk.x = cvt_pk_bf16(kp[0], kp[1]); wk.y = cvt_pk_bf16(kp[2], kp[3]); wk.z = cvt_pk_bf16(kp[4], kp[5]); wk.w = cvt_pk_bf16(kp[6], kp[7]);
            if (!PRE) { *(LAS u32x4*)(lds + H_QP + t * 272 + pc8 * 2) = wq; *(LAS u32x4*)(lds + H_KP + t * 272 + pc8 * 2) = wk; }
            const unsigned kw[4] = {wk.x, wk.y, wk.z, wk.w};
#pragma unroll
            for (int j = 0; j < 8; ++j) { const unsigned short kk = (unsigned short)((j & 1) ? (kw[j >> 1] >> 16) : (kw[j >> 1] & 0xffffu)), vv = (unsigned short)((j & 1) ? (vw[j >> 1] >> 16) : (vw[j >> 1] & 0xffffu));
                *(LAS unsigned short*)(lds + H_KT + tr64_off(pc8 + j, t)) = kk; *(LAS unsigned short*)(lds + H_VT + tr64_off(pc8 + j, t)) = vv; } } }
        if (!PRE) {
#pragma unroll
          for (int vt = 0; vt < 8; ++vt) { const f32x4 sv = S[vt] * e4; u32x2 o; o.x = cvt_pk_bf16(sv[0], sv[1]); o.y = cvt_pk_bf16(sv[2], sv[3]);
              *(LAS u32x2*)(lds + H_ST + (16 * vt + l15) * 272 + (16 * w + 4 * q4) * 2) = o; } }
        if (c + 1 < c0 + nch) HG_LOADQV(c + 1);
        __syncthreads();
        f32x4 oT[4];
        if (!PRE) {
        { const int ti = w >> 1;
#pragma unroll
          for (int sj = 0; sj < 2; ++sj) { const int si = 2 * (w & 1) + sj; f32x4 a4 = (f32x4){0.f, 0.f, 0.f, 0.f};
              if (si <= ti) {
#pragma unroll
                  for (int kb = 0; kb < 4; ++kb) { const bf16x8 a = *(const LAS bf16x8*)(lds + H_KP + (16 * si + l15) * 272 + kb * 64 + q4 * 16), b = *(const LAS bf16x8*)(lds + H_QP + (16 * ti + l15) * 272 + kb * 64 + q4 * 16); a4 = MFMA16(a, b, a4); }
                  const int t = 16 * ti + l15, s0 = 16 * si + 4 * q4;
#pragma unroll
                  for (int r = 0; r < 4; ++r) a4[r] = (s0 + r <= t) ? a4[r] : 0.f; }
              u32x2 o; o.x = cvt_pk_bf16(a4[0], a4[1]); o.y = cvt_pk_bf16(a4[2], a4[3]);
              *(LAS u32x2*)(lds + H_P + (16 * ti + l15) * 144 + (16 * si + 4 * q4) * 2) = o; } }
#pragma unroll
        for (int ti = 0; ti < 4; ++ti) oT[ti] = (f32x4){0.f, 0.f, 0.f, 0.f};
#pragma unroll
        for (int kb = 0; kb < 4; ++kb) { const bf16x8 a = *(const LAS bf16x8*)(lds + H_ST + (16 * w + l15) * 272 + kb * 64 + q4 * 16);
#pragma unroll
            for (int ti = 0; ti < 4; ++ti) { const bf16x8 b = *(const LAS bf16x8*)(lds + H_QP + (16 * ti + l15) * 272 + kb * 64 + q4 * 16); oT[ti] = MFMA16(a, b, oT[ti]); } }
        __syncthreads();
        }
        { f32x4 U[8];
#pragma unroll
          for (int vt = 0; vt < 8; ++vt) U[vt] = (f32x4){0.f, 0.f, 0.f, 0.f};
#pragma unroll
          for (int kb = 0; kb < 2; ++kb) { const bf16x8 av = *(const LAS bf16x8*)(lds + H_VT + tr64_off(16 * w + l15, 32 * kb + 8 * q4)), ak = *(const LAS bf16x8*)(lds + H_KT + tr64_off(16 * w + l15, 32 * kb + 8 * q4));
#pragma unroll
              for (int ti = 0; ti < 4; ++ti) { if (!PRE && (kb == 0 || ti >= 2)) { const bf16x8 b = *(const LAS bf16x8*)(lds + H_P + (16 * ti + l15) * 144 + (32 * kb + 8 * q4) * 2); oT[ti] = MFMA16(av, b, oT[ti]); } }
#pragma unroll
              for (int vt = 0; vt < 8; ++vt) { const bf16x8 b = *(const LAS bf16x8*)(lds + H_VT + tr64_off(16 * vt + l15, 32 * kb + 8 * q4)); U[vt] = MFMA16(ak, b, U[vt]); } }
#pragma unroll
          for (int vt = 0; vt < 8; ++vt) S[vt] = S[vt] * d4 + U[vt] * c4; }
        if (!PRE) {
#pragma unroll
        for (int ti = 0; ti < 4; ++ti) { float ss = (oT[ti][0] * oT[ti][0] + oT[ti][1] * oT[ti][1]) + (oT[ti][2] * oT[ti][2] + oT[ti][3] * oT[ti][3]); ss += __shfl_xor(ss, 16); ss += __shfl_xor(ss, 32);
            if (q4 == 0) Lss[(16 * ti + l15) * 8 + w] = ss; }
        __syncthreads();
#pragma unroll
        for (int ti = 0; ti < 4; ++ti) { const int t = 16 * ti + l15; const f32x4 s0 = *(const LAS f32x4*)(Lss + t * 8), s1 = *(const LAS f32x4*)(Lss + t * 8 + 4);
            const float tot = ((s0[0] + s0[1]) + (s0[2] + s0[3])) + ((s1[0] + s1[1]) + (s1[2] + s1[3]));
            const float rs = rsqrtf(tot * (1.0f / 128.0f) + 1e-6f);
            u32x2 o; o.x = cvt_pk_bf16(oT[ti][0] * rs * bf_lo(rog[ti].x), oT[ti][1] * rs * bf_hi(rog[ti].x)); o.y = cvt_pk_bf16(oT[ti][2] * rs * bf_lo(rog[ti].y), oT[ti][3] * rs * bf_hi(rog[ti].y));
            *(u32x2*)(OUTb + (row_base + (size_t)c * 64 + t) * 1024 + colbase + 16 * w + 4 * q4) = o; }
        }
    }
    if (PRE) { float* Uo = Ubuf + (size_t)item0 * 16384;
#pragma unroll
        for (int vt = 0; vt < 8; ++vt) *(f32x4*)(Uo + (vt * 512 + tid) * 4) = S[vt];
        if (tid < 128) Dbuf[(size_t)item0 * 128 + tid] = dacc; }
    __syncthreads();
#undef HG_LOADF
#undef HG_LOADQV
}

__device__ __forceinline__ void gmlp_loop(LAS unsigned char* lds, const bf16_t* __restrict__ Vb, const bf16_t* Ub, bf16_t* Ob, const bf16_t* __restrict__ wst  , const float* __restrict__ gbias  , int first, int stride, int nitems) {
    const int tid = opaque_tid(), lane = tid & 63, w = __builtin_amdgcn_readfirstlane(tid >> 6), q4 = lane >> 4, l15 = lane & 15;
    const int ps = tid >> 4, pc8 = (tid & 15) * 8, nkb = (w >> 1) + 1, t = 16 * w + l15;
    int it = first; if (it >= nitems) return;
    u32x4 rv[4]; u32x2 ru[8]; bf16x8 wf[4]; float bt;
#define GM_DEC(i_) const int g8_ = (i_) & 7; const size_t row0_ = (size_t)((i_) >> 9) * SEQ + (size_t)(((i_) >> 3) & 63) * 128; const int col0_ = g8_ * 128;
#define GM_LOADV(i_) do { GM_DEC(i_) _Pragma("unroll") for (int i = 0; i < 4; ++i) rv[i] = *(const u32x4*)(Vb + (row0_ + ps + 32 * i) * 1024 + col0_ + pc8); \
        _Pragma("unroll") for (int kb = 0; kb < 4; ++kb) if (kb < nkb) wf[kb] = *(const bf16x8*)(wst + (size_t)g8_ * 16384 + (16 * w + l15) * 128 + kb * 32 + q4 * 8); } while (0)
#define GM_LOADU(i_) do { GM_DEC(i_) bt = gbias[g8_ * 128 + t]; _Pragma("unroll") for (int ct = 0; ct < 8; ++ct) ru[ct] = *(const u32x2*)(Ub + (row0_ + t) * 1024 + col0_ + 16 * ct + 4 * q4); } while (0)
    GM_LOADV(it); GM_LOADU(it);
    for (;;) {
#pragma unroll
        for (int i = 0; i < 4; ++i) { const int s = ps + 32 * i; const u32x4 raw = rv[i];
            float x[8] = {bf_lo(raw.x), bf_hi(raw.x), bf_lo(raw.y), bf_hi(raw.y), bf_lo(raw.z), bf_hi(raw.z), bf_lo(raw.w), bf_hi(raw.w)};
            float sm = ((x[0] + x[1]) + (x[2] + x[3])) + ((x[4] + x[5]) + (x[6] + x[7]));
            sm += __shfl_xor(sm, 1); sm += __shfl_xor(sm, 2); sm += __shfl_xor(sm, 4); sm += __shfl_xor(sm, 8);
            const float mu = sm * (1.0f / 128.0f); float vs = 0.f;
#pragma unroll
            for (int j = 0; j < 8; ++j) { x[j] -= mu; vs += x[j] * x[j]; }
            vs += __shfl_xor(vs, 1); vs += __shfl_xor(vs, 2); vs += __shfl_xor(vs, 4); vs += __shfl_xor(vs, 8);
            const float rstd = rsqrtf(vs * (1.0f / 128.0f) + 1e-6f);
#pragma unroll
            for (int j = 0; j < 4; ++j) { const unsigned pk = cvt_pk_bf16(x[2 * j] * rstd, x[2 * j + 1] * rstd);
                *(LAS unsigned short*)(lds + tr128_off(pc8 + 2 * j, s)) = (unsigned short)(pk & 0xffffu); *(LAS unsigned short*)(lds + tr128_off(pc8 + 2 * j + 1, s)) = (unsigned short)(pk >> 16); } }
        bf16x8 wc[4];
#pragma unroll
        for (int kb = 0; kb < 4; ++kb) wc[kb] = wf[kb];
        const int nxt = it + stride; const bool more = nxt < nitems;
        if (more) GM_LOADV(nxt);
        __syncthreads();
        f32x4 acc[8];
#pragma unroll
        for (int ct = 0; ct < 8; ++ct) acc[ct] = (f32x4){0.f, 0.f, 0.f, 0.f};
#pragma unroll
        for (int kb = 0; kb < 4; ++kb) if (kb < nkb) {
#pragma unroll
            for (int ct = 0; ct < 8; ++ct) { const bf16x8 a = *(const LAS bf16x8*)(lds + tr128_off(16 * ct + l15, 32 * kb + 8 * q4)); acc[ct] = MFMA16(a, wc[kb], acc[ct]); } }
        { GM_DEC(it)
#pragma unroll
          for (int ct = 0; ct < 8; ++ct) { const u32x2 uu = ru[ct];
              u32x2 o; o.x = cvt_pk_bf16(bf_lo(uu.x) * (acc[ct][0] + bt), bf_hi(uu.x) * (acc[ct][1] + bt)); o.y = cvt_pk_bf16(bf_lo(uu.y) * (acc[ct][2] + bt), bf_hi(uu.y) * (acc[ct][3] + bt));
              *(u32x2*)(Ob + (row0_ + t) * 1024 + col0_ + 16 * ct + 4 * q4) = o; } }
        if (!more) break;
        GM_LOADU(nxt);
        __syncthreads();
        it = nxt;
    }
    __syncthreads();
#undef GM_DEC
#undef GM_LOADV
#undef GM_LOADU
}

#define XB_TMO      128
#define XB_XCNT(j)  (256  + 64 * (j))
#define XB_XSUB(j)  (1280 + 64 * (j))
#define XB_XGEN(j)  (2304 + 64 * (j))
#define XB_TOP      3328
#define XB_TOPGEN   3392
#define XCD_BAR_WORDS 3456
#define XB_SPIN_CAP (1u << 18)

__device__ __forceinline__ unsigned xb_ld(unsigned* p)              { return __hip_atomic_load(p, __ATOMIC_RELAXED, __HIP_MEMORY_SCOPE_AGENT); }
__device__ __forceinline__ unsigned xb_add(unsigned* p, unsigned v) { return __hip_atomic_fetch_add(p, v, __ATOMIC_RELAXED, __HIP_MEMORY_SCOPE_AGENT); }
__device__ __forceinline__ unsigned xb_xcc_id() { return (unsigned)__builtin_amdgcn_s_getreg((3 << 11) | 20) & 0xFu; }
#define XB_SPIN(cond, bar) do { unsigned _sp = 0; while (cond) { __builtin_amdgcn_s_sleep(1); \
    if ((++_sp & 255u) == 0u) { if (xb_ld(&(bar)[XB_TMO])) break; if (_sp > XB_SPIN_CAP) { atomicAdd(&(bar)[XB_TMO], 1u); break; } } } } while (0)

struct XcdBarrier {
    unsigned* bar; unsigned x;
    volatile LAS unsigned* st;
};

__device__ __forceinline__ XcdBarrier xcd_barrier_post(unsigned* bar, volatile LAS unsigned* st) {
    XcdBarrier b; b.bar = bar; b.x = xb_xcc_id(); b.st = st;
    if (threadIdx.x == 0) (void)xb_add(&bar[XB_XCNT(b.x)], 1u);
    return b;
}
__device__ __forceinline__ void xcd_barrier_complete(unsigned* bar, unsigned x, unsigned& nloc, unsigned& nx) {
    const unsigned G = gridDim.x * gridDim.y * gridDim.z;
    unsigned sum, cnt, mine, sp = 0u;
    for (;;) {
        sum = 0u; cnt = 0u; mine = 0u;
#pragma unroll
        for (unsigned j = 0; j < 16; ++j) { const unsigned c = xb_ld(&bar[XB_XCNT(j)]); sum += c; cnt += (c > 0u) ? 1u : 0u; mine = (j == x) ? c : mine; }
        if (sum == G) break;
        __builtin_amdgcn_s_sleep(1);
        if ((++sp & 255u) == 0u) { if (xb_ld(&bar[XB_TMO])) break; if (sp > XB_SPIN_CAP) { atomicAdd(&bar[XB_TMO], 1u); break; } }
    }
    nloc = mine > 0u ? mine : 1u; nx = cnt > 0u ? cnt : 1u;
}

__device__ __forceinline__ void xcd_barrier(const XcdBarrier& b) {
    asm volatile("s_waitcnt vmcnt(0)" ::: "memory");
    __syncthreads();
    if (threadIdx.x == 0) {
        unsigned* bar = b.bar;
        __builtin_amdgcn_s_waitcnt(0);
        unsigned nloc = b.st[0], nx = b.st[1];
        if (nloc == 0u) { xcd_barrier_complete(bar, b.x, nloc, nx); b.st[0] = nloc; b.st[1] = nx; }
        const unsigned old = xb_add(&bar[XB_XSUB(b.x)], 1u);
        const unsigned gen = old / nloc;
        if (old + 1u == (gen + 1u) * nloc) {
            __builtin_amdgcn_fence(__ATOMIC_RELEASE, "agent");
            asm volatile("s_waitcnt vmcnt(0)" ::: "memory");
            const unsigned og = xb_add(&bar[XB_TOP], 1u);
            const unsigned tg = og / nx;
            if (og + 1u == (tg + 1u) * nx) xb_add(&bar[XB_TOPGEN], 1u);
            else XB_SPIN(xb_ld(&bar[XB_TOPGEN]) == tg, bar);
            __builtin_amdgcn_fence(__ATOMIC_ACQUIRE, "agent");
            xb_add(&bar[XB_XGEN(b.x)], 1u);
            asm volatile("s_waitcnt vmcnt(0)" ::: "memory");
        } else {
            XB_SPIN(xb_ld(&bar[XB_XGEN(b.x)]) == gen, bar);
            __builtin_amdgcn_fence(__ATOMIC_ACQUIRE, "agent");
            asm volatile("s_waitcnt vmcnt(0)" ::: "memory");
        }
    }
    __syncthreads();
}


__device__ __forceinline__ void flat_barrier(unsigned* bar, unsigned round) {
    asm volatile("s_waitcnt vmcnt(0)" ::: "memory");
    __syncthreads();
    if (threadIdx.x == 0) {
        __builtin_amdgcn_fence(__ATOMIC_RELEASE, "agent");
        asm volatile("s_waitcnt vmcnt(0)" ::: "memory");
        const unsigned G = gridDim.x, old = __hip_atomic_fetch_add(bar + 64, 1u, __ATOMIC_RELAXED, __HIP_MEMORY_SCOPE_AGENT);
        if (old + 1u == round * G) __hip_atomic_store(bar + 128, round, __ATOMIC_RELAXED, __HIP_MEMORY_SCOPE_AGENT);
        else { unsigned sp = 0; while (__hip_atomic_load(bar + 128, __ATOMIC_RELAXED, __HIP_MEMORY_SCOPE_AGENT) < round) { __builtin_amdgcn_s_sleep(2); if (++sp > (1u << 22)) break; } }
        __builtin_amdgcn_fence(__ATOMIC_ACQUIRE, "agent");
        asm volatile("s_waitcnt vmcnt(0)" ::: "memory");
    }
    __syncthreads();
}

__device__ __forceinline__ void stagger_start(unsigned ticks) {
    const unsigned g = (blockIdx.x >> 3) & 3u;
    if (g) { const unsigned long long t0 = __builtin_amdgcn_s_memrealtime(); while (__builtin_amdgcn_s_memrealtime() - t0 < (unsigned long long)(g * ticks)) __builtin_amdgcn_s_sleep(8); }
}
constexpr int HSEG = 8, HCH = SEQ / 64 / HSEG;
#ifndef PHMASK
#define PHMASK 0xffff
#endif
#ifndef MK_STAG_UP
#define MK_STAG_UP 700u
#endif
__global__ void __launch_bounds__(512, 2) mk_fwd(Params p_arg) {
    extern __shared__ __attribute__((aligned(16))) unsigned char lds_raw[];
    LAS unsigned char* lds = (LAS unsigned char*)lds_raw;
    int pc = 0;
    { if (threadIdx.x == 0) { *(LAS u32x4*)(lds + XB_ST_OFF) = (u32x4){0u, 0u, 0u, 0u}; } __syncthreads();
      KP pp0 = (KP)__builtin_amdgcn_kernarg_segment_ptr(); if (blockIdx.x == 0) { unsigned* bar0 = (unsigned*)pp0->ws; for (int i = threadIdx.x; i < XCD_BAR_WORDS; i += 512) __hip_atomic_store(bar0 + i, 0u, __ATOMIC_RELAXED, __HIP_MEMORY_SCOPE_AGENT); } }
#define GETP KP pp = (KP)__builtin_amdgcn_kernarg_segment_ptr(); asm volatile("" : "+s"(pp))
#ifdef MK_TIME
    LAS unsigned long long* tacc = (LAS unsigned long long*)(lds + 143360); const bool timer = (blockIdx.x == 0 && threadIdx.x == 0); unsigned long long tph0 = 0, tph1 = 0; int tcls = 0;
    if (timer) { for (int i = 0; i < 16; ++i) tacc[i] = 0ull; }
#define T_BEGIN(c) if (timer) { tph0 = __builtin_amdgcn_s_memrealtime(); tcls = (c); }
#define T_MID if (timer) { tph1 = __builtin_amdgcn_s_memrealtime(); tacc[tcls] += tph1 - tph0; }
#define T_END if (timer) { tacc[15] += __builtin_amdgcn_s_memrealtime() - tph1; }
#else
#define T_BEGIN(c)
#define T_MID
#define T_END
#endif
#ifndef MK_DUP
#define MK_DUP 0
#endif
#define PH_BEGIN(bit, cls) { GETP; T_BEGIN(cls) if (pc >= pp->ph_lo && pc < pp->ph_hi && (PHMASK & (bit))) for (int rep_ = 0; rep_ < (((MK_DUP) & (bit)) ? 2 : 1); ++rep_) {
#define PH_END } } { GETP; T_MID ++pc; if (pc > pp->ph_lo && pc < pp->ph_hi) { if (pc == 1) { cg::this_grid().sync(); (void)xcd_barrier_post((unsigned*)pp->ws, (volatile LAS unsigned*)(lds + XB_ST_OFF)); } else { XcdBarrier xb_; xb_.bar = (unsigned*)pp->ws; xb_.x = xb_xcc_id(); xb_.st = (volatile LAS unsigned*)(lds + XB_ST_OFF); xcd_barrier(xb_); } } T_END }

    PH_BEGIN(1, 0) prologue_phase(pp, lds); PH_END

    for (int blk = 0; blk < 3 * NL; ++blk) {
        const int l = blk / 3, kind = blk - 3 * l;
        PH_BEGIN(2, 1) unsigned char* ws = pp->ws; const float* hin = (blk == 0) ? pp->in[0] : pp->out;
            norm_phase<false>(hin, (bf16_t*)(ws + WS_HN), nullptr, pp->in[11] + (size_t)(l * 3 + kind) * 1024, (const float*)(ws + WS_MOD) + (size_t)l * 8 * 9216, kind); PH_END
        if (kind != 1) {
            const int s = kind >> 1;
            PH_BEGIN(4, 2) unsigned char* ws = pp->ws;
                pg8::Gemm g{(const bf16_t*)(ws + WS_HN), (const bf16_t*)(ws + WS_W13) + (size_t)(l * 2 + s) * 5632 * 1024, NT, 5632, 1024}; pg8::StaticOrder S; S.init(NT, 5632, (int)gridDim.x, (int)blockIdx.x);
                pg8::EpiSwiGLU E{(bf16_t*)(ws + WS_BIG)}; pg8::gemm_phase<pg8::EpiSwiGLU, pg8::StaticOrder, false>(lds, g, S, E, nullptr); PH_END
            PH_BEGIN(8, 3) unsigned char* ws = pp->ws; const float* hin = (blk == 0) ? pp->in[0] : pp->out;
                pg8::Gemm g{(const bf16_t*)(ws + WS_BIG), (const bf16_t*)(ws + WS_W2) + (size_t)(l * 2 + s) * 1024 * FH, NT, 1024, FH}; pg8::StaticOrder S; S.init(NT, 1024, (int)gridDim.x, (int)blockIdx.x);
                pg8::EpiResid E{hin, pp->out, (const float*)(ws + WS_MOD) + (size_t)l * 8 * 9216 + (3 * kind + 2) * 1024, 0.5f}; pg8::gemm_phase<pg8::EpiResid, pg8::StaticOrder, false>(lds, g, S, E, nullptr); PH_END
        } else {
            for (int half = 0; half < 2; ++half) {
                PH_BEGIN(16, 4) unsigned char* ws = pp->ws;
                    pg8::Gemm g{(const bf16_t*)(ws + WS_HN) + (size_t)half * TH * 1024, (const bf16_t*)(ws + WS_WIN) + (size_t)l * 8192 * 1024, TH, 8192, 1024}; pg8::StaticOrder S; S.init(TH, 8192, (int)gridDim.x, (int)blockIdx.x);
                    pg8::EpiInproj E{(bf16_t*)(ws + WS_U), (bf16_t*)(ws + WS_V), (bf16_t*)(ws + WS_Q), (float*)(ws + WS_F), (bf16_t*)(ws + WS_I), (bf16_t*)(ws + WS_OG), (bf16_t*)(ws + WS_GA), (bf16_t*)(ws + WS_GB), (const float*)(ws + WS_LB) + l * 1024};
                    pg8::gemm_phase<pg8::EpiInproj, pg8::StaticOrder, false>(lds, g, S, E, nullptr); PH_END
                PH_BEGIN(32, 5) unsigned char* ws = pp->ws; const int G = (int)gridDim.x;
                    for (int it = (int)blockIdx.x; it < 32 * (HSEG - 1); it += G) { const int sq = it / (HSEG - 1), sg = it - sq * (HSEG - 1);
                        hgrn_seq<true>(lds, nullptr, (const float*)(ws + WS_F), (const bf16_t*)(ws + WS_I), nullptr, nullptr, (size_t)(sq >> 3) * SEQ, (sq & 7) * 128, sg * HCH, HCH, (float*)(ws + WS_HU), (float*)(ws + WS_HD), sq * HSEG + sg, 0); }
                    gmlp_loop(lds, (const bf16_t*)(ws + WS_V), (const bf16_t*)(ws + WS_U), (bf16_t*)(ws + WS_U), (const bf16_t*)(ws + WS_WST) + (size_t)l * 8 * 128 * 128, pp->in[4] + (size_t)l * 8 * 128, (int)blockIdx.x, G, 4 * 64 * 8);
                PH_END
                PH_BEGIN(64, 6) unsigned char* ws = pp->ws; const int G = (int)gridDim.x;
                    for (int it = (int)blockIdx.x; it < 32 * HSEG; it += G) { const int sq = it / HSEG, sg = it - sq * HSEG;
                        hgrn_seq<false>(lds, (const bf16_t*)(ws + WS_Q), (const float*)(ws + WS_F), (const bf16_t*)(ws + WS_I), (const bf16_t*)(ws + WS_OG), (bf16_t*)(ws + ((MK_DUP & 64) && rep_ == 0 ? WS_M0 : WS_OG)), (size_t)(sq >> 3) * SEQ, (sq & 7) * 128, sg * HCH, HCH, (float*)(ws + WS_HU), (float*)(ws + WS_HD), sq * HSEG, sg); }
                PH_END
                PH_BEGIN(128, 7) unsigned char* ws = pp->ws;
                    pg8::Gemm g{(const bf16_t*)(ws + WS_U), (const bf16_t*)(ws + WS_WA) + (size_t)l * 1024 * 1024, TH, 1024, 1024}; pg8::BranchOrder S; S.init(TH, 1024, (int)gridDim.x, (int)blockIdx.x);
                    S.A2 = (const bf16_t*)(ws + WS_OG); S.Bt2 = (const bf16_t*)(ws + WS_WB) + (size_t)l * 1024 * 1024;
                    pg8::EpiBranchFused E{(const bf16_t*)(ws + WS_GA), (const bf16_t*)(ws + WS_GB), (bf16_t*)(ws + (half == 0 ? WS_M0 : WS_Q))}; pg8::gemm_phase<pg8::EpiBranchFused, pg8::BranchOrder, false>(lds, g, S, E, nullptr); PH_END
            }
            PH_BEGIN(512, 9) unsigned char* ws = pp->ws; float* hh = pp->out;
                pg8::Gemm g{(const bf16_t*)(ws + WS_M0), (const bf16_t*)(ws + WS_WO) + (size_t)l * 1024 * 1024, NT, 1024, 1024}; pg8::SplitAOrder S; S.init(NT, 1024, (int)gridDim.x, (int)blockIdx.x); S.A1 = (const bf16_t*)(ws + WS_Q);
                pg8::EpiResid E{hh, hh, (const float*)(ws + WS_MOD) + (size_t)l * 8 * 9216 + 5 * 1024, 1.0f}; pg8::gemm_phase<pg8::EpiResid, pg8::SplitAOrder, false>(lds, g, S, E, nullptr); PH_END
        }
    }
    PH_BEGIN(1024, 10) norm_phase<true>(pp->out, nullptr, pp->out, pp->in[14], nullptr, 0); PH_END
#ifdef MK_TIME
    __syncthreads(); asm volatile("s_waitcnt vmcnt(0)" ::: "memory");
    if (timer) { GETP; unsigned long long a = 0, b = 0; for (int i = 0; i < 16; ++i) { if ((MK_TA >> i) & 1) a += tacc[i]; if ((MK_TB >> i) & 1) b += tacc[i]; }
        const float V = (float)a * 0.01f; int n = (int)((float)b * 0.01f / 20.0f); if (n < 1) n = 1; if (n > 1024) n = 1024;
        float* o = pp->out; for (int i = 0; i < n; ++i) o[i] = V; }
#endif
}
constexpr int N_PHASES = 1 + NL * (3 + 10 + 3) + 1;

extern "C" void kernel_launch(void* const* d_in, const int* in_sizes, int n_in, void* d_out, int out_size, void* d_ws, size_t ws_size, hipStream_t stream) {
    static int grid = 0;
    if (grid == 0) {
        if (n_in != 15 || out_size != NT * DM || ws_size < WS_END) { fprintf(stderr, "kernel_launch: unexpected shapes (n_in %d, out %d, ws %zu < %zu)\n", n_in, out_size, ws_size, (size_t)WS_END); grid = -1; return; }
        int dev = 0, cus = 0, per_cu = 0;
        hipGetDevice(&dev); hipDeviceGetAttribute(&cus, hipDeviceAttributeMultiprocessorCount, dev);
        if (hipFuncSetAttribute((const void*)mk_fwd, hipFuncAttributeMaxDynamicSharedMemorySize, LDS_BYTES) != hipSuccess) { fprintf(stderr, "kernel_launch: hipFuncSetAttribute failed\n"); grid = -1; return; }
        if (hipOccupancyMaxActiveBlocksPerMultiprocessor(&per_cu, (const void*)mk_fwd, 512, LDS_BYTES) != hipSuccess || per_cu < 1) { fprintf(stderr, "kernel_launch: occupancy query says %d\n", per_cu); per_cu = 1; }
        (void)hipGetLastError();
        grid = cus * 1;
    }
    if (grid < 0) return;
    Params p{};
    for (int i = 0; i < 15; ++i) p.in[i] = (const float*)d_in[i];
    p.out = (float*)d_out; p.ws = (unsigned char*)d_ws;
#if MK_COOP
    p.ph_lo = 0; p.ph_hi = N_PHASES;
    void* args[] = {&p};
    hipError_t e = hipLaunchCooperativeKernel((const void*)mk_fwd, dim3(grid), dim3(512), args, LDS_BYTES, stream);
    if (e != hipSuccess) fprintf(stderr, "cooperative launch failed: %s (grid %d)\n", hipGetErrorString(e), grid);
#else
    for (int i = 0; i < N_PHASES; ++i) { p.ph_lo = i; p.ph_hi = i + 1; hipLaunchKernelGGL(mk_fwd, dim3(grid), dim3(512), LDS_BYTES, stream, p); }
#endif
}
```

```cpp
#include <hip/hip_runtime.h>
#include <hip/hip_cooperative_groups.h>
#include <cstdio>
namespace cg = cooperative_groups;
#ifndef MK_COOP
#define MK_COOP 1
#endif
namespace pg8 {
#define PG8_LAS __attribute__((address_space(3)))
typedef unsigned short bf16_t;
typedef short bf16x8 __attribute__((ext_vector_type(8)));
typedef float f32x4 __attribute__((ext_vector_type(4)));
typedef unsigned u32x4 __attribute__((ext_vector_type(4)));
constexpr int BM = 256, BK = 64, HALF = 128, HTB = HALF * BK * 2  , STAGE_BYTES = 8 * HTB, NXCD = 8, WGM = 8;

__host__ __device__ __forceinline__ int lds_byte(int r, int c) { const int st = (r >> 4) * 2 + (c >> 5), rr = r & 15, cc = c & 31, ob = rr * 64 + cc * 2; return st * 1024 + (ob ^ (((ob >> 9) & 1) << 5)); }
__host__ __device__ __forceinline__ void stage_rc(int b, int& R, int& C) { const int st = b / 1024, sb = b % 1024, swz = sb ^ (((sb >> 9) & 1) << 5); R = (st >> 1) * 16 + swz / 64; C = (st & 1) * 32 + (swz % 64) / 2; }
__host__ __device__ __forceinline__ int perm32(int rho) { const int n = rho >> 4, i = rho & 15; return 8 * (i >> 2) + 4 * n + (i & 3); }

struct Unit { int pm, pn, part; };
struct Gemm { const bf16_t* A; const bf16_t* Bt; int M, N, K; };

struct StaticOrder {
    int nM, nN, nwg, G, c;
    __host__ __device__ void init(int M, int N, int G_, int c_) { nM = M / BM; nN = N / BM; nwg = nM * nN; G = G_; c = c_; }
    __host__ __device__ bool next(int i, Unit& u) const {
        const long L = (long)i * G + c; if (L >= nwg) return false;
        int wgid = (int)L; { const int q = nwg / NXCD, r = nwg % NXCD, xcd = wgid % NXCD, off = wgid / NXCD; wgid = (xcd < r ? xcd * (q + 1) : r * (q + 1) + (xcd - r) * q) + off; }
        const int nig = WGM * nN, gid = wgid / nig, fm = gid * WGM, gsz = (nM - fm) < WGM ? (nM - fm) : WGM;
        u.pm = fm + ((wgid % nig) % gsz); u.pn = (wgid % nig) / gsz; u.part = 0; return true;
    }
    __device__ __forceinline__ void a_ready(const Unit&) const {}
    __device__ __forceinline__ void done(const Unit&) const {}
    __device__ __forceinline__ const char* a_ptr(const Gemm& g, const Unit& u, size_t tstep) const { return (const char*)g.A + (size_t)u.pm * tstep; }
    __device__ __forceinline__ const char* b_ptr(const Gemm& g, const Unit& u, size_t tstep) const { return (const char*)g.Bt + (size_t)u.pn * tstep; }
};
__device__ __forceinline__ int opaque_tid() { int t = threadIdx.x; asm volatile("" : "+v"(t)); return t; }
typedef __bf16 bf16x2_t __attribute__((ext_vector_type(2)));
typedef float f32x2_t __attribute__((ext_vector_type(2)));
__device__ __forceinline__ unsigned cvt_pk_bf16(float lo, float hi) { const f32x2_t v = {lo, hi}; const bf16x2_t b = __builtin_convertvector(v, bf16x2_t); return __builtin_bit_cast(unsigned, b); }
__device__ __forceinline__ float bf_lo(unsigned w) { return __uint_as_float(w << 16); }
__device__ __forceinline__ float bf_hi(unsigned w) { return __uint_as_float(w & 0xffff0000u); }
template <int ACT> __device__ __forceinline__ float actf(float x) {
    if (ACT == 0) return x;
    if (ACT == 1) { const float u = 1.5957691216f * (x + 0.044715f * x * x * x); return x * __builtin_amdgcn_rcpf(1.0f + __expf(-u)); }
    if (ACT == 2) return x * __builtin_amdgcn_rcpf(1.0f + __expf(-x));
    return __builtin_amdgcn_rcpf(1.0f + __expf(-x));
}
template <int ACT> __device__ __forceinline__ void act8(float (&v)[8]) {
    if (ACT == 0) return;
    float a[8];
#pragma unroll
    for (int j = 0; j < 8; ++j) a[j] = (ACT == 1) ? -1.5957691216f * (v[j] + 0.044715f * v[j] * v[j] * v[j]) : -v[j];
#pragma unroll
    for (int j = 0; j < 8; ++j) a[j] = __expf(a[j]);
#pragma unroll
    for (int j = 0; j < 8; ++j) a[j] = 1.0f + a[j];
#pragma unroll
    for (int j = 0; j < 8; ++j) a[j] = __builtin_amdgcn_rcpf(a[j]);
#pragma unroll
    for (int j = 0; j < 8; ++j) v[j] = (ACT == 3) ? a[j] : v[j] * a[j];
}
struct EpiSwiGLU {
    static constexpr bool PERM = true, AFTER_DRAIN = false, TWO_PART = false;
    bf16_t* O;
    __device__ __forceinline__ void operator()(const f32x4 (&acc)[2][2][4][2], const Unit& u, int wr, int wc, int fr, int fq) const {
        const int row0 = u.pm * BM + wr * 64 + fr, col0 = u.pn * HALF + wc * 32 + 8 * fq;
#pragma unroll
        for (int ai = 0; ai < 2; ++ai)
#pragma unroll
            for (int m = 0; m < 4; ++m) {
                const f32x4 a0 = acc[ai][0][m][0], a1 = acc[ai][0][m][1], b0 = acc[ai][1][m][0], b1 = acc[ai][1][m][1];
                float v[8] = {a0[0], a0[1], a0[2], a0[3], a1[0], a1[1], a1[2], a1[3]};
                act8<2>(v);
#pragma unroll
                for (int j = 0; j < 4; ++j) { v[j] *= b0[j]; v[4 + j] *= b1[j]; }
                u32x4 w; w.x = cvt_pk_bf16(v[0], v[1]); w.y = cvt_pk_bf16(v[2], v[3]); w.z = cvt_pk_bf16(v[4], v[5]); w.w = cvt_pk_bf16(v[6], v[7]);
                *(u32x4*)(O + (size_t)(row0 + ai * HALF + m * 16) * 2816 + col0) = w;
            }
    }
};
struct EpiResid {
    static constexpr bool PERM = false, AFTER_DRAIN = false, TWO_PART = false;
    const float* hin; float* hout; const float* gmod; float scale;
    __device__ __forceinline__ void operator()(const f32x4 (&acc)[2][2][4][2], const Unit& u, int wr, int wc, int fr, int fq) const {
        const int row0 = u.pm * BM + wr * 64 + fr, col0 = u.pn * BM + wc * 32 + 4 * fq;
        const float* gp = gmod + (size_t)((u.pm * BM) >> 13) * 9216 + col0;
        f32x4 cf[2][2];
#pragma unroll
        for (int bj = 0; bj < 2; ++bj)
#pragma unroll
            for (int n = 0; n < 2; ++n) { const f32x4 g = *(const f32x4*)(gp + bj * HALF + n * 16); cf[bj][n] = (g + 1.0f) * scale; }
#pragma unroll
        for (int ai = 0; ai < 2; ++ai) {
            f32x4 hv[4][2][2];
#pragma unroll
            for (int m = 0; m < 4; ++m) { const size_t off = (size_t)(row0 + ai * HALF + m * 16) * 1024 + col0;
#pragma unroll
                for (int bj = 0; bj < 2; ++bj)
#pragma unroll
                    for (int n = 0; n < 2; ++n) hv[m][bj][n] = *(const f32x4*)(hin + off + bj * HALF + n * 16); }
#pragma unroll
            for (int m = 0; m < 4; ++m) { const size_t off = (size_t)(row0 + ai * HALF + m * 16) * 1024 + col0;
#pragma unroll
                for (int bj = 0; bj < 2; ++bj)
#pragma unroll
                    for (int n = 0; n < 2; ++n) *(f32x4*)(hout + off + bj * HALF + n * 16) = hv[m][bj][n] + cf[bj][n] * acc[ai][bj][m][n]; }
            asm volatile("" ::: "memory"); }
    }
};
struct EpiInproj {
    static constexpr bool PERM = true, AFTER_DRAIN = false, TWO_PART = false;
    bf16_t* U; bf16_t* V; bf16_t* Q; float* F; bf16_t* I; bf16_t* OG; bf16_t* GA; bf16_t* GB; const float* lb;
    template <int ACT> __device__ __forceinline__ void st16(const f32x4 (&acc)[2][2][4][2], bf16_t* dst, int row0, int colg) const {
#pragma unroll
        for (int ai = 0; ai < 2; ++ai)
#pragma unroll
            for (int m = 0; m < 4; ++m)
#pragma unroll
                for (int bj = 0; bj < 2; ++bj) { const f32x4 v0 = acc[ai][bj][m][0], v1 = acc[ai][bj][m][1];
                    float v[8] = {v0[0], v0[1], v0[2], v0[3], v1[0], v1[1], v1[2], v1[3]};
                    act8<ACT>(v);
                    u32x4 w; w.x = cvt_pk_bf16(v[0], v[1]); w.y = cvt_pk_bf16(v[2], v[3]); w.z = cvt_pk_bf16(v[4], v[5]); w.w = cvt_pk_bf16(v[6], v[7]);
                    *(u32x4*)(dst + (size_t)(row0 + ai * HALF + m * 16) * 1024 + colg + bj * HALF) = w; }
    }
    __device__ __forceinline__ void operator()(const f32x4 (&acc)[2][2][4][2], const Unit& u, int wr, int wc, int fr, int fq) const {
        const int grp = u.pn >> 2, colg = (u.pn & 3) * BM + wc * 32 + 8 * fq, row0 = u.pm * BM + wr * 64 + fr;
        if (grp == 3) {
#pragma unroll
            for (int bj = 0; bj < 2; ++bj) { const f32x4 l0 = *(const f32x4*)(lb + colg + bj * HALF), l1 = *(const f32x4*)(lb + colg + bj * HALF + 4);
#pragma unroll
                for (int ai = 0; ai < 2; ++ai)
#pragma unroll
                    for (int m = 0; m < 4; ++m) { const f32x4 v0 = acc[ai][bj][m][0], v1 = acc[ai][bj][m][1]; f32x4 o0, o1;
#pragma unroll
                        for (int j = 0; j < 4; ++j) { o0[j] = __logf(fmaxf(l0[j] + (1.0f - l0[j]) * actf<3>(v0[j]), 1e-30f)); o1[j] = __logf(fmaxf(l1[j] + (1.0f - l1[j]) * actf<3>(v1[j]), 1e-30f)); }
                        float* d = F + (size_t)(row0 + ai * HALF + m * 16) * 1024 + colg + bj * HALF; *(f32x4*)d = o0; *(f32x4*)(d + 4) = o1; } }
        } else if (grp < 2) st16<1>(acc, grp == 0 ? U : V, row0, colg);
        else if (grp == 2) st16<2>(acc, Q, row0, colg);
        else if (grp == 4) st16<0>(acc, I, row0, colg);
        else if (grp == 5) st16<3>(acc, OG, row0, colg);
        else {
            const int colo = (u.pn - 24) * HALF + wc * 32 + 8 * fq;
#pragma unroll
            for (int ai = 0; ai < 2; ++ai)
#pragma unroll
                for (int m = 0; m < 4; ++m) { const f32x4 a0 = acc[ai][0][m][0], a1 = acc[ai][0][m][1], b0 = acc[ai][1][m][0], b1 = acc[ai][1][m][1];
                    float ea[8] = {-a0[0], -a0[1], -a0[2], -a0[3], -a1[0], -a1[1], -a1[2], -a1[3]}, eb[8] = {-b0[0], -b0[1], -b0[2], -b0[3], -b1[0], -b1[1], -b1[2], -b1[3]}, r[8], g[8];
#pragma unroll
                    for (int j = 0; j < 8; ++j) ea[j] = __expf(ea[j]);
#pragma unroll
                    for (int j = 0; j < 8; ++j) eb[j] = __expf(eb[j]);
#pragma unroll
                    for (int j = 0; j < 8; ++j) { ea[j] = 1.0f + ea[j]; eb[j] = 1.0f + eb[j]; }
#pragma unroll
                    for (int j = 0; j < 8; ++j) ea[j] = __builtin_amdgcn_rcpf(ea[j]);
#pragma unroll
                    for (int j = 0; j < 8; ++j) g[j] = fmaxf(__builtin_amdgcn_rcpf(eb[j]), 1e-6f);
#pragma unroll
                    for (int j = 0; j < 8; ++j) r[j] = ea[j] * fminf(eb[j], 1e6f);
                    u32x4 wr_, wg_; wr_.x = cvt_pk_bf16(r[0], r[1]); wr_.y = cvt_pk_bf16(r[2], r[3]); wr_.z = cvt_pk_bf16(r[4], r[5]); wr_.w = cvt_pk_bf16(r[6], r[7]);
                    wg_.x = cvt_pk_bf16(g[0], g[1]); wg_.y = cvt_pk_bf16(g[2], g[3]); wg_.z = cvt_pk_bf16(g[4], g[5]); wg_.w = cvt_pk_bf16(g[6], g[7]);
                    const size_t off = (size_t)(row0 + ai * HALF + m * 16) * 1024 + colo;
                    *(u32x4*)(GA + off) = wr_; *(u32x4*)(GB + off) = wg_; }
        }
    }
};
template <int MODE> struct EpiBranch {
    static constexpr bool PERM = true, AFTER_DRAIN = false, TWO_PART = false;
    const bf16_t* G; const bf16_t* P; bf16_t* O;
    __device__ __forceinline__ void operator()(const f32x4 (&acc)[2][2][4][2], const Unit& u, int wr, int wc, int fr, int fq) const {
        const int row0 = u.pm * BM + wr * 64 + fr, col0 = u.pn * BM + wc * 32 + 8 * fq;
#pragma unroll
        for (int ai = 0; ai < 2; ++ai)
#pragma unroll
            for (int m = 0; m < 4; ++m)
#pragma unroll
                for (int bj = 0; bj < 2; ++bj) { const size_t off = (size_t)(row0 + ai * HALF + m * 16) * 1024 + col0 + bj * HALF;
                    const u32x4 g = *(const u32x4*)(G + off); const f32x4 v0 = acc[ai][bj][m][0], v1 = acc[ai][bj][m][1];
                    float r[8] = { bf_lo(g.x) * v0[0], bf_hi(g.x) * v0[1], bf_lo(g.y) * v0[2], bf_hi(g.y) * v0[3], bf_lo(g.z) * v1[0], bf_hi(g.z) * v1[1], bf_lo(g.w) * v1[2], bf_hi(g.w) * v1[3] };
                    if (MODE == 1) { const u32x4 p = *(const u32x4*)(P + off);
                        r[0] += bf_lo(p.x); r[1] += bf_hi(p.x); r[2] += bf_lo(p.y); r[3] += bf_hi(p.y); r[4] += bf_lo(p.z); r[5] += bf_hi(p.z); r[6] += bf_lo(p.w); r[7] += bf_hi(p.w); }
                    u32x4 w; w.x = cvt_pk_bf16(r[0], r[1]); w.y = cvt_pk_bf16(r[2], r[3]); w.z = cvt_pk_bf16(r[4], r[5]); w.w = cvt_pk_bf16(r[6], r[7]);
                    *(u32x4*)(O + off) = w; }
    }
};

struct EpiBranchFused {
    static constexpr bool PERM = true, AFTER_DRAIN = false, TWO_PART = true;
    const bf16_t* GA; const bf16_t* GB; bf16_t* O;
    __device__ __forceinline__ void mid(f32x4 (&acc)[2][2][4][2], const Unit& u, int wr, int wc, int fr, int fq) const {
        const int row0 = u.pm * BM + wr * 64 + fr, col0 = u.pn * BM + wc * 32 + 8 * fq;
#pragma unroll
        for (int ai = 0; ai < 2; ++ai)
#pragma unroll
            for (int m = 0; m < 4; ++m)
#pragma unroll
                for (int bj = 0; bj < 2; ++bj) { const size_t off = (size_t)(row0 + ai * HALF + m * 16) * 1024 + col0 + bj * HALF;
                    const u32x4 a = *(const u32x4*)(GA + off);
                    const float ra[8] = {bf_lo(a.x), bf_hi(a.x), bf_lo(a.y), bf_hi(a.y), bf_lo(a.z), bf_hi(a.z), bf_lo(a.w), bf_hi(a.w)};
#pragma unroll
                    for (int j = 0; j < 4; ++j) { acc[ai][bj][m][0][j] *= ra[j]; acc[ai][bj][m][1][j] *= ra[4 + j]; } }
    }
    __device__ __forceinline__ void operator()(const f32x4 (&acc)[2][2][4][2], const Unit& u, int wr, int wc, int fr, int fq) const {
        const int row0 = u.pm * BM + wr * 64 + fr, col0 = u.pn * BM + wc * 32 + 8 * fq;
#pragma unroll
        for (int ai = 0; ai < 2; ++ai)
#pragma unroll
            for (int m = 0; m < 4; ++m)
#pragma unroll
                for (int bj = 0; bj < 2; ++bj) { const size_t off = (size_t)(row0 + ai * HALF + m * 16) * 1024 + col0 + bj * HALF;
                    const u32x4 b = *(const u32x4*)(GB + off); const f32x4 v0 = acc[ai][bj][m][0], v1 = acc[ai][bj][m][1];
                    const float rb[8] = {bf_lo(b.x), bf_hi(b.x), bf_lo(b.y), bf_hi(b.y), bf_lo(b.z), bf_hi(b.z), bf_lo(b.w), bf_hi(b.w)};
                    u32x4 w; w.x = cvt_pk_bf16(rb[0] * v0[0], rb[1] * v0[1]); w.y = cvt_pk_bf16(rb[2] * v0[2], rb[3] * v0[3]);
                    w.z = cvt_pk_bf16(rb[4] * v1[0], rb[5] * v1[1]); w.w = cvt_pk_bf16(rb[6] * v1[2], rb[7] * v1[3]);
                    *(u32x4*)(O + off) = w; }
    }
};
struct BranchOrder : StaticOrder {
    const bf16_t* A2; const bf16_t* Bt2;
    __device__ __forceinline__ bool next(int i, Unit& u) const { const bool ok = StaticOrder::next(i >> 1, u); u.part = i & 1; return ok; }
    __device__ __forceinline__ const char* a_ptr(const Gemm& g, const Unit& u, size_t tstep) const { return (const char*)(u.part ? A2 : g.A) + (size_t)u.pm * tstep; }
    __device__ __forceinline__ const char* b_ptr(const Gemm& g, const Unit& u, size_t tstep) const { return (const char*)(u.part ? Bt2 : g.Bt) + (size_t)u.pn * tstep; }
};
struct SplitAOrder : StaticOrder {
    const bf16_t* A1;
    __device__ __forceinline__ const char* a_ptr(const Gemm& g, const Unit& u, size_t tstep) const { return u.pm < 128 ? (const char*)g.A + (size_t)u.pm * tstep : (const char*)A1 + (size_t)(u.pm - 128) * tstep; }
};

template <class Epi, class Sched, bool STAMP = false>
__device__ __forceinline__ void gemm_phase(PG8_LAS unsigned char* lds, const Gemm g, const Sched& S, const Epi& E, unsigned long long* stamps) {
    const int tid = opaque_tid(), wid = __builtin_amdgcn_readfirstlane(tid >> 6), lane = tid & 63, wr = wid >> 2, wc = wid & 3, fr = lane & 15, fq = lane >> 4;
    const int K = g.K, nt = K / BK;
    int ts_lo = 0, ts_hi = 0, nts = 0; const unsigned long long rt_entry = STAMP ? (unsigned long long)wall_clock64() : 0ull;
#define PG8_STAMP() do { if (STAMP && wid == 0 && nts < 64) { const unsigned long long _c = (unsigned long long)clock64(); \
        ts_lo = (lane == nts) ? (int)(unsigned)_c : ts_lo; ts_hi = (lane == nts) ? (int)(unsigned)(_c >> 32) : ts_hi; ++nts; } } while (0)
    PG8_STAMP();
    unsigned voffA[2], voffB[2];
#pragma unroll
    for (int i = 0; i < 2; ++i) { int R, C; stage_rc(tid * 16 + i * 8192, R, C); const int Rb = Epi::PERM ? ((R & ~31) + perm32(R & 31)) : R;
        voffA[i] = (unsigned)(R * K + C) * 2u; voffB[i] = (unsigned)(Rb * K + C) * 2u; }
    const size_t kstep = (size_t)(BK * 2);
    const size_t hstep = (size_t)HALF * K * 2;
    const size_t tstep = 2 * hstep;
    const unsigned ldsw = (unsigned)wid * 1024u;
    const int aoff = lds_byte(wr * 64 + fr, fq * 8), boff = lds_byte(wc * 32 + fr, fq * 8);
#define PG8_SA(b, h) (((b) * 2 + (h)) * HTB)
#define PG8_SB(b, h) ((4 + (b) * 2 + (h)) * HTB)
#define PG8_STAGE(bufoff, gbase, voff) do { _Pragma("unroll") for (int _i = 0; _i < 2; ++_i) \
        __builtin_amdgcn_global_load_lds((const unsigned*)((const char*)(gbase) + (voff)[_i]), (PG8_LAS unsigned*)(lds + (bufoff) + ldsw + _i * 8192), 16, 0, 0); } while (0)
#define PG8_LDA(dst, b, h) do { _Pragma("unroll") for (int m = 0; m < 4; ++m) _Pragma("unroll") for (int k = 0; k < 2; ++k) dst[m][k] = *(const PG8_LAS bf16x8*)(lds + PG8_SA(b, h) + aoff + m * 2048 + k * 1024); } while (0)
#define PG8_LDB(dst, b, h) do { _Pragma("unroll") for (int n = 0; n < 2; ++n) _Pragma("unroll") for (int k = 0; k < 2; ++k) dst[n][k] = *(const PG8_LAS bf16x8*)(lds + PG8_SB(b, h) + boff + n * 2048 + k * 1024); } while (0)
#define PG8_MMA(ai, bj, At, Bt) do { __builtin_amdgcn_s_setprio(1); _Pragma("unroll") for (int m = 0; m < 4; ++m) _Pragma("unroll") for (int n = 0; n < 2; ++n) _Pragma("unroll") for (int k = 0; k < 2; ++k) \
        acc[ai][bj][m][n] = __builtin_amdgcn_mfma_f32_16x16x32_bf16(Bt[n][k], At[m][k], acc[ai][bj][m][n], 0, 0, 0); __builtin_amdgcn_s_setprio(0); } while (0)
#define PG8_WAIT_V(n) asm volatile("s_waitcnt vmcnt(" #n ")" ::: "memory")
#define PG8_WAIT_L(n) asm volatile("s_waitcnt lgkmcnt(" #n ")" ::: "memory")
#define PG8_BAR __builtin_amdgcn_s_barrier()
#define PG8_SCHED __builtin_amdgcn_sched_barrier(0)
    Unit cur, nxt; int ui = 0;
    if (!S.next(0, cur)) return;
    f32x4 acc[2][2][4][2];
#pragma unroll
    for (int a = 0; a < 2; ++a)
#pragma unroll
        for (int b = 0; b < 2; ++b)
#pragma unroll
            for (int m = 0; m < 4; ++m)
#pragma unroll
                for (int n = 0; n < 2; ++n) acc[a][b][m][n] = (f32x4){0.f, 0.f, 0.f, 0.f};
    bf16x8 At[4][2], B0[2][2], B1[2][2];
    const char* cA = S.a_ptr(g, cur, tstep); const char* cB = S.b_ptr(g, cur, tstep);
    S.a_ready(cur);
    PG8_STAGE(PG8_SB(0, 0), cB, voffB); PG8_STAGE(PG8_SA(0, 0), cA, voffA); PG8_STAGE(PG8_SB(0, 1), cB + hstep, voffB); PG8_STAGE(PG8_SA(0, 1), cA + hstep, voffA);
    if (wr == 1) PG8_BAR;
    PG8_WAIT_V(4); PG8_BAR;
    PG8_STAGE(PG8_SB(1, 0), cB + kstep, voffB); PG8_STAGE(PG8_SA(1, 0), cA + kstep, voffA); PG8_STAGE(PG8_SB(1, 1), cB + hstep + kstep, voffB);
    PG8_WAIT_V(6); PG8_BAR;
    PG8_STAMP();
    for (;;) {
        const bool has_next = S.next(ui + 1, nxt);
        const char* nA = has_next ? S.a_ptr(g, nxt, tstep) : cA; const char* nB = has_next ? S.b_ptr(g, nxt, tstep) : cB;
        for (int t = 0; t < nt; t += 2) {
            const bool last = (t == nt - 2);
            const char* a1 = cA + (size_t)(t + 1) * kstep;
            const char* a2 = last ? nA : cA + (size_t)(t + 2) * kstep; const char* b2 = last ? nB : cB + (size_t)(t + 2) * kstep;
            const char* a3 = a2 + kstep; const char* b3 = b2 + kstep;
            if (last && has_next) S.a_ready(nxt);
            PG8_LDB(B0, 0, 0); PG8_SCHED; PG8_LDA(At, 0, 0); PG8_STAGE(PG8_SA(1, 1), a1 + hstep, voffA);
            PG8_WAIT_L(8); PG8_BAR; PG8_WAIT_L(0); PG8_MMA(0, 0, At, B0); PG8_BAR; PG8_SCHED;
            PG8_LDB(B1, 0, 1); PG8_STAGE(PG8_SB(0, 0), b2, voffB);
            PG8_BAR; PG8_WAIT_L(0); PG8_MMA(0, 1, At, B1); PG8_BAR;
            PG8_LDA(At, 0, 1); PG8_STAGE(PG8_SA(0, 0), a2, voffA);
            PG8_BAR; PG8_WAIT_L(0); PG8_MMA(1, 0, At, B0); PG8_BAR; PG8_SCHED;
            PG8_STAGE(PG8_SB(0, 1), b2 + hstep, voffB);
            PG8_WAIT_V(6); PG8_BAR; PG8_MMA(1, 1, At, B1); PG8_BAR;
            PG8_LDB(B0, 1, 0); PG8_SCHED; PG8_LDA(At, 1, 0); PG8_STAGE(PG8_SA(0, 1), a2 + hstep, voffA);
            PG8_WAIT_L(8); PG8_BAR; PG8_WAIT_L(0); PG8_MMA(0, 0, At, B0); PG8_BAR; PG8_SCHED;
            PG8_LDB(B1, 1, 1); PG8_STAGE(PG8_SB(1, 0), b3, voffB);
            PG8_BAR; PG8_WAIT_L(0); PG8_MMA(0, 1, At, B1); PG8_BAR;
            PG8_LDA(At, 1, 1); PG8_STAGE(PG8_SA(1, 0), a3, voffA);
            PG8_BAR; PG8_WAIT_L(0); PG8_MMA(1, 0, At, B0); PG8_BAR; PG8_SCHED;
            PG8_STAGE(PG8_SB(1, 1), b3 + hstep, voffB);
            PG8_WAIT_V(6); PG8_BAR; PG8_MMA(1, 1, At, B1); PG8_BAR;
        }
        PG8_STAMP();
        if constexpr (Epi::TWO_PART) { if (cur.part == 0) E.mid(acc, cur, wr, wc, fr, fq); else E(acc, cur, wr, wc, fr, fq); } else if constexpr (!Epi::AFTER_DRAIN) { E(acc, cur, wr, wc, fr, fq); S.done(cur); }
        PG8_STAMP();
        if (!has_next) break;
        bool keep_acc = false; if constexpr (Epi::TWO_PART) keep_acc = (cur.part == 0);
        if (!keep_acc)
#pragma unroll
        for (int a = 0; a < 2; ++a)
#pragma unroll
            for (int b = 0; b < 2; ++b)
#pragma unroll
                for (int m = 0; m < 4; ++m)
#pragma unroll
                    for (int n = 0; n < 2; ++n) acc[a][b][m][n] = (f32x4){0.f, 0.f, 0.f, 0.f};
        cur = nxt; cA = nA; cB = nB; ++ui;
    }
    PG8_WAIT_V(0);
    if (wr == 0) PG8_BAR;
    PG8_BAR;
    if constexpr (Epi::AFTER_DRAIN) { E.fused(acc, cur, wr, wc, fr, fq, lds, wid, lane); S.done(cur); }
    PG8_STAMP();
    if (STAMP && wid == 0) { stamps[lane] = lane < nts ? (((unsigned long long)(unsigned)ts_hi << 32) | (unsigned)ts_lo) : 0ull;
        if (lane == 62) stamps[62] = rt_entry; if (lane == 63) stamps[63] = (unsigned long long)wall_clock64(); }
#undef PG8_STAMP
#undef PG8_SA
#undef PG8_SB
#undef PG8_STAGE
#undef PG8_LDA
#undef PG8_LDB
#undef PG8_MMA
#undef PG8_WAIT_V
#undef PG8_WAIT_L
#undef PG8_BAR
#undef PG8_SCHED
}
}
using pg8::bf16_t; using pg8::bf16x8; using pg8::f32x4; using pg8::u32x4; using pg8::cvt_pk_bf16; using pg8::bf_lo; using pg8::bf_hi; using pg8::opaque_tid;
#define LAS __attribute__((address_space(3)))
typedef unsigned u32x2 __attribute__((ext_vector_type(2)));

constexpr int NT = 65536, DM = 1024, NL = 4, SEQ = 8192, FH = 2816, TH = 32768  ;
constexpr int LDS_BYTES = 144 * 1024, XB_ST_OFF = 143616;
constexpr size_t MiB = 1024ull * 1024ull;
constexpr size_t WS_MOD = 64 * 1024;
constexpr size_t WS_WST = 2 * MiB;
constexpr size_t WS_LB = 3 * MiB;
constexpr size_t WS_WIN = 4 * MiB;
constexpr size_t WS_W13 = 68 * MiB;
constexpr size_t WS_W2 = 156 * MiB;
constexpr size_t WS_WA = 200 * MiB, WS_WB = 208 * MiB, WS_WO = 216 * MiB;
constexpr size_t WS_HN = 224 * MiB;
constexpr size_t WS_BIG = 352 * MiB;
constexpr size_t ZB = 64 * MiB;
constexpr size_t WS_U = WS_BIG, WS_V = WS_BIG + ZB, WS_Q = WS_BIG + 2 * ZB, WS_F = WS_BIG + 3 * ZB  , WS_I = WS_BIG + 5 * ZB, WS_OG = WS_BIG + 6 * ZB, WS_GA = WS_BIG + 7 * ZB, WS_GB = WS_BIG + 8 * ZB;
constexpr size_t WS_HU = WS_BIG + 9 * ZB;
constexpr size_t WS_HD = WS_HU + 16 * MiB;
constexpr size_t WS_M0 = WS_HD + 1 * MiB;
constexpr size_t WS_END = WS_M0 + ZB;

struct Params { const float* in[15]; float* out; unsigned char* ws; int ph_lo, ph_hi; };
typedef const Params __attribute__((address_space(4))) * KP;

__device__ __forceinline__ float wave_sum(float v) {
#pragma unroll
    for (int o = 1; o < 64; o <<= 1) v += __shfl_xor(v, o);
    return v;
}

__device__ __forceinline__ void transpose_item(const float* __restrict__ W, int K, int N, bf16_t* __restrict__ WT, int item, int remap, LAS float* scr, int lane) {
    const int nblk = N / 32, kb = item / nblk, nb = item - kb * nblk, k0 = 64 * kb, n0 = 32 * nb;
    int drow0 = n0;
    if (remap == 1) { const int bj = n0 / FH, nn = n0 - bj * FH; drow0 = (nn >> 7) * 256 + bj * 128 + (nn & 127); }
    if (remap == 2 && n0 >= 6144) { const int j = n0 - 6144, bj = j >> 10, nn = j & 1023; drow0 = 6144 + (nn >> 7) * 256 + bj * 128 + (nn & 127); }
#pragma unroll 8
    for (int i = 0; i < 32; ++i) { const int kk = 2 * i + (lane >> 5); scr[kk * 33 + (lane & 31)] = W[(size_t)(k0 + kk) * N + n0 + (lane & 31)]; }
    asm volatile("s_waitcnt lgkmcnt(0)" ::: "memory");
    const int c = lane & 7;
#pragma unroll
    for (int j = 0; j < 4; ++j) { const int n = (lane >> 3) + 8 * j; const LAS float* s = scr + (8 * c) * 33 + n;
        u32x4 o; o.x = cvt_pk_bf16(s[0 * 33], s[1 * 33]); o.y = cvt_pk_bf16(s[2 * 33], s[3 * 33]); o.z = cvt_pk_bf16(s[4 * 33], s[5 * 33]); o.w = cvt_pk_bf16(s[6 * 33], s[7 * 33]);
        *(u32x4*)(WT + (size_t)(drow0 + n) * K + k0 + 8 * c) = o; }
    asm volatile("s_waitcnt lgkmcnt(0)" ::: "memory");
}

__device__ __forceinline__ void prologue_phase(KP p, LAS unsigned char* lds) {
    const int tid = opaque_tid(), lane = tid & 63, wave = tid >> 6, G = gridDim.x;
    unsigned char* ws = p->ws;
    {
        LAS float* cact = (LAS float*)lds;
        LAS float* red = (LAS float*)(lds + 32768);
        const float* c = p->in[1];
        for (int i = tid; i < 8192; i += 512) { const int b = i >> 10, k = i & 1023; const float x = c[i]; cact[k * 8 + b] = x / (1.0f + __expf(-x)); }
        __syncthreads();
        for (int task = blockIdx.x; task < 288; task += G) {
            const int idx = task * 128 + (tid & 127), kq = tid >> 7, l = idx / 9216, n = idx - l * 9216;
            const float* aw = p->in[12] + (size_t)l * 1024 * 9216 + n;
            float a[8];
#pragma unroll
            for (int b = 0; b < 8; ++b) a[b] = 0.f;
#pragma unroll 8
            for (int k = kq * 256; k < kq * 256 + 256; ++k) { const float w = aw[(size_t)k * 9216]; const f32x4 c0 = *(const LAS f32x4*)(cact + k * 8), c1 = *(const LAS f32x4*)(cact + k * 8 + 4);
                a[0] += c0[0] * w; a[1] += c0[1] * w; a[2] += c0[2] * w; a[3] += c0[3] * w; a[4] += c1[0] * w; a[5] += c1[1] * w; a[6] += c1[2] * w; a[7] += c1[3] * w; }
#pragma unroll
            for (int b = 0; b < 8; ++b) red[(kq * 8 + b) * 128 + (tid & 127)] = a[b];
            __syncthreads();
            if (kq == 0) { const float bias = p->in[13][idx]; float* mod = (float*)(ws + WS_MOD);
#pragma unroll
                for (int b = 0; b < 8; ++b) mod[((size_t)l * 8 + b) * 9216 + n] = ((red[b * 128 + tid] + red[(8 + b) * 128 + tid]) + (red[(16 + b) * 128 + tid] + red[(24 + b) * 128 + tid])) + bias; }
            __syncthreads();
        }
    }
    if (blockIdx.x == 72 % G) {
        const float* lg = p->in[5]; float* lb = (float*)(ws + WS_LB);
        for (int k = tid; k < 1024; k += 512) { const float a0 = lg[k], a1 = lg[1024 + k], a2 = lg[2048 + k], a3 = lg[3072 + k]; const float mx = fmaxf(fmaxf(a0, a1), fmaxf(a2, a3));
            const float e0 = __expf(a0 - mx), e1 = __expf(a1 - mx), e2 = __expf(a2 - mx), e3 = __expf(a3 - mx), inv = 1.0f / (e0 + e1 + e2 + e3);
            lb[k] = 0.f; lb[1024 + k] = e1 * inv; lb[2048 + k] = (e1 + e2) * inv; lb[3072 + k] = (e1 + e2 + e3) * inv; }
    }
    { const float* wsrc = p->in[3]; bf16_t* wst = (bf16_t*)(ws + WS_WST);
      for (int i = blockIdx.x * 512 + tid; i < 4 * 8 * 128 * 128 / 2; i += G * 512) { const int e = 2 * i, s = e & 127, t = (e >> 7) & 127;
          const float v0 = s <= t ? wsrc[e] : 0.f, v1 = (s + 1) <= t ? wsrc[e + 1] : 0.f; ((unsigned*)wst)[i] = cvt_pk_bf16(v0, v1); } }
    LAS float* scr = (LAS float*)(lds + 32768 + wave * 8704);
    const int gw = blockIdx.x * 8 + wave, NGW = G * 8;
    constexpr int I_IN = 16 * 256, I_13 = 16 * 176, I_2 = 44 * 32, I_SQ = 16 * 32, I_LAYER = I_IN + 2 * I_13 + 2 * I_2 + 3 * I_SQ;
    for (int it = gw; it < NL * I_LAYER; it += NGW) {
        const int l = it / I_LAYER; int r = it - l * I_LAYER;
        if (r < I_IN) { transpose_item(p->in[2] + (size_t)l * 1024 * 8192, 1024, 8192, (bf16_t*)(ws + WS_WIN) + (size_t)l * 8192 * 1024, r, 2, scr, lane); continue; } r -= I_IN;
        if (r < 2 * I_13) { const int s = r / I_13; r -= s * I_13; transpose_item(p->in[9] + (size_t)(l * 2 + s) * 1024 * 5632, 1024, 5632, (bf16_t*)(ws + WS_W13) + (size_t)(l * 2 + s) * 5632 * 1024, r, 1, scr, lane); continue; } r -= 2 * I_13;
        if (r < 2 * I_2) { const int s = r / I_2; r -= s * I_2; transpose_item(p->in[10] + (size_t)(l * 2 + s) * FH * 1024, FH, 1024, (bf16_t*)(ws + WS_W2) + (size_t)(l * 2 + s) * 1024 * FH, r, 0, scr, lane); continue; } r -= 2 * I_2;
        const int m = r / I_SQ; r -= m * I_SQ;
        const float* src = (m == 0 ? p->in[6] : (m == 1 ? p->in[7] : p->in[8])) + (size_t)l * 1024 * 1024;
        bf16_t* dst = (bf16_t*)(ws + (m == 0 ? WS_WA : (m == 1 ? WS_WB : WS_WO))) + (size_t)l * 1024 * 1024;
        transpose_item(src, 1024, 1024, dst, r, 0, scr, lane);
    }
}

template <bool FINAL> __device__ __forceinline__ void norm_phase(const float* hin, bf16_t* hn, float* fout, const float* nw, const float* modl  , int sub) {
    const int tid = opaque_tid(), lane = tid & 63, gw = blockIdx.x * 8 + (tid >> 6), NGW = gridDim.x * 8;
    f32x4 w4[4];
#pragma unroll
    for (int j = 0; j < 4; ++j) w4[j] = *(const f32x4*)(nw + 4 * lane + 256 * j);
    for (int row0 = gw; row0 < NT; row0 += 2 * NGW) {
        const int row1 = row0 + NGW; const bool has1 = row1 < NT;
        f32x4 v[2][4]; float s[2] = {0.f, 0.f};
#pragma unroll
        for (int r = 0; r < 2; ++r) { const int row = r ? (has1 ? row1 : row0) : row0; const float* xr = hin + (size_t)row * DM + 4 * lane;
#pragma unroll
            for (int j = 0; j < 4; ++j) v[r][j] = *(const f32x4*)(xr + 256 * j); }
#pragma unroll
        for (int r = 0; r < 2; ++r)
#pragma unroll
            for (int j = 0; j < 4; ++j) s[r] += (v[r][j][0] * v[r][j][0] + v[r][j][1] * v[r][j][1]) + (v[r][j][2] * v[r][j][2] + v[r][j][3] * v[r][j][3]);
#pragma unroll
        for (int o = 1; o < 64; o <<= 1) { s[0] += __shfl_xor(s[0], o); s[1] += __shfl_xor(s[1], o); }
#pragma unroll
        for (int r = 0; r < 2; ++r) { if (r == 1 && !has1) break; const int row = r ? row1 : row0;
            const float rstd = rsqrtf(s[r] * (1.0f / DM) + 1e-6f);
            if (FINAL) {
#pragma unroll
                for (int j = 0; j < 4; ++j) *(f32x4*)(fout + (size_t)row * DM + 4 * lane + 256 * j) = v[r][j] * rstd * w4[j];
            } else {
                const float* sh = modl + (size_t)(row >> 13) * 9216 + (3 * sub) * 1024 + 4 * lane; const float* sc = sh + 1024;
#pragma unroll
                for (int j = 0; j < 4; ++j) { const f32x4 a = *(const f32x4*)(sc + 256 * j), bb = *(const f32x4*)(sh + 256 * j); const f32x4 o = v[r][j] * rstd * w4[j] * (a + 1.0f) + bb;
                    u32x2 w; w.x = cvt_pk_bf16(o[0], o[1]); w.y = cvt_pk_bf16(o[2], o[3]); *(u32x2*)(hn + (size_t)row * DM + 4 * lane + 256 * j) = w; }
            }
        }
    }
}

__device__ __forceinline__ int tr64_off(int row, int col) { return row * 128 + ((((col >> 3) ^ (row ^ (row >> 3))) & 7) << 4) + ((col & 7) << 1); }
__device__ __forceinline__ int tr128_off(int row, int col) { return row * 256 + ((((col >> 3) ^ (row ^ (row >> 3))) & 15) << 4) + ((col & 7) << 1); }
constexpr int H_LF = 0, H_P = 0  , H_TOT = 32768, H_VEC = 34816, H_SS = 36864, H_QP = 38912, H_KP = 56320, H_KT = 73728, H_VT = 90112, H_ST = 106496, H_END = 141312;
static_assert(H_END <= LDS_BYTES, "LDS");
#define MFMA16(a, b, c) __builtin_amdgcn_mfma_f32_16x16x32_bf16((a), (b), (c), 0, 0, 0)

template <bool PRE> __device__ __forceinline__ void hgrn_seq(LAS unsigned char* lds, const bf16_t* __restrict__ Qb, const float* __restrict__ Fb, const bf16_t* __restrict__ Ib, const bf16_t* OGb, bf16_t* OUTb, size_t row_base, int colbase, int c0, int nch, float* Ubuf, float* Dbuf, int item0, int nprev) {
    const int tid = opaque_tid(), lane = tid & 63, w = __builtin_amdgcn_readfirstlane(tid >> 6), q4 = lane >> 4, l15 = lane & 15;
    const int pt = tid >> 4, pc8 = (tid & 15) * 8;
    const int sk = tid & 127, sseg = tid >> 7;
    LAS float* Lf = (LAS float*)(lds + H_LF); LAS float* Ltot = (LAS float*)(lds + H_TOT); LAS float* Lss = (LAS float*)(lds + H_SS);
    f32x4 S[8];
#pragma unroll
    for (int i = 0; i < 8; ++i) S[i] = (f32x4){0.f, 0.f, 0.f, 0.f};
    if (!PRE) { for (int j = 0; j < nprev; ++j) { const float* Uj = Ubuf + (size_t)(item0 + j) * 16384; const f32x4 dj = *(const f32x4*)(Dbuf + (size_t)(item0 + j) * 128 + 16 * w + 4 * q4);
#pragma unroll
            for (int vt = 0; vt < 8; ++vt) S[vt] = S[vt] * dj + *(const f32x4*)(Uj + (vt * 512 + tid) * 4); } }
    float dacc = 1.0f;
    u32x4 rq[2], rv[2]; float rfc[16];
#define HG_LOADF(c) do { const float* fp_ = Fb + (row_base + (size_t)(c) * 64 + 16 * sseg) * 1024 + colbase + sk; _Pragma("unroll") for (int i_ = 0; i_ < 16; ++i_) rfc[i_] = fp_[(size_t)i_ * 1024]; } while (0)
#define HG_LOADQV(c) do { _Pragma("unroll") for (int i_ = 0; i_ < 2; ++i_) { const size_t go_ = (row_base + (size_t)(c) * 64 + pt + 32 * i_) * 1024 + colbase + pc8; \
        if (!PRE) rq[i_] = *(const u32x4*)(Qb + go_); rv[i_] = *(const u32x4*)(Ib + go_); } } while (0)
    HG_LOADF(c0); HG_LOADQV(c0);
    for (int c = c0; c < c0 + nch; ++c) {
        u32x2 rog[4];
        if (!PRE) {
#pragma unroll
        for (int ti = 0; ti < 4; ++ti) rog[ti] = *(const u32x2*)(OGb + (row_base + (size_t)c * 64 + 16 * ti + l15) * 1024 + colbase + 16 * w + 4 * q4); }
        { float run = 0.f;
#pragma unroll
          for (int i = 0; i < 16; ++i) { run += rfc[i]; Lf[(16 * sseg + i) * 128 + sk] = run; }
          Ltot[sseg * 128 + sk] = run; }
        if (c + 1 < c0 + nch) HG_LOADF(c + 1);
        __syncthreads();
        f32x4 e4, d4, c4;
        { const int kk = 16 * w + 4 * q4; const f32x4 a0 = *(const LAS f32x4*)(Ltot + kk), a1 = *(const LAS f32x4*)(Ltot + 128 + kk), a2 = *(const LAS f32x4*)(Ltot + 256 + kk), a3 = *(const LAS f32x4*)(Ltot + 384 + kk);
          const f32x4 b31 = a0 + a1, b63 = b31 + (a2 + a3);
#pragma unroll
          for (int r = 0; r < 4; ++r) { e4[r] = __expf(b31[r]); d4[r] = __expf(b63[r]); c4[r] = __expf(b63[r] - b31[r]); } }
        if (PRE) { if (tid < 128) dacc *= __expf((Ltot[tid] + Ltot[128 + tid]) + (Ltot[256 + tid] + Ltot[384 + tid])); }
        { f32x4 tv[4][2];
#pragma unroll
          for (int sg = 0; sg < 4; ++sg) { tv[sg][0] = *(const LAS f32x4*)(Ltot + sg * 128 + pc8); tv[sg][1] = *(const LAS f32x4*)(Ltot + sg * 128 + pc8 + 4); }
#pragma unroll
          for (int i = 0; i < 2; ++i) { const int t = pt + 32 * i; const bool hi = (pt >> 4) != 0;
            f32x4 off[2], ref[2];
#pragma unroll
            for (int h = 0; h < 2; ++h) { ref[h] = tv[0][h] + tv[1][h];
                if (i == 0) off[h] = hi ? tv[0][h] : (f32x4){0.f, 0.f, 0.f, 0.f}; else off[h] = hi ? ref[h] + tv[2][h] : ref[h]; }
            const f32x4 b0 = *(const LAS f32x4*)(Lf + t * 128 + pc8), b1 = *(const LAS f32x4*)(Lf + t * 128 + pc8 + 4);
            f32x4 p0 = (f32x4){0.f, 0.f, 0.f, 0.f}, p1 = p0;
            if (t & 15) { p0 = *(const LAS f32x4*)(Lf + (t - 1) * 128 + pc8); p1 = *(const LAS f32x4*)(Lf + (t - 1) * 128 + pc8 + 4); }
            unsigned qw[4] = {0u, 0u, 0u, 0u}; if (!PRE) { qw[0] = rq[i].x; qw[1] = rq[i].y; qw[2] = rq[i].z; qw[3] = rq[i].w; } const unsigned vw[4] = {rv[i].x, rv[i].y, rv[i].z, rv[i].w};
            float qp[8], kp[8];
#pragma unroll
            for (int j = 0; j < 8; ++j) { const float bl = j < 4 ? b0[j & 3] : b1[j & 3], pl = j < 4 ? p0[j & 3] : p1[j & 3], of = j < 4 ? off[0][j & 3] : off[1][j & 3], rr = j < 4 ? ref[0][j & 3] : ref[1][j & 3];
                const float lf = bl - pl, d = fminf(fmaxf((bl + of) - rr, -80.f), 80.f);
                if (!PRE) { const float qv = (j & 1) ? bf_hi(qw[j >> 1]) : bf_lo(qw[j >> 1]); qp[j] = qv * __expf(d); } else qp[j] = 0.f;
                kp[j] = (1.0f - __expf(lf)) * __expf(-d); }
            u32x4 wq, wk; wq.x = cvt_pk_bf16(qp[0], qp[1]); wq.y = cvt_pk_bf16(qp[2], qp[3]); wq.z = cvt_pk_bf16(qp[4], qp[5]); wq.w = cvt_pk_bf16(qp[6], qp[7]);
            wk.x = cvt_pk_bf16(kp[0], kp[1]); wk.y = cvt_pk_bf16(kp[2], kp[3]); wk.z = cvt_pk_bf16(kp[4], kp[5]); wk.w = cvt_pk_bf16(kp[6], kp[7]);
            if (!PRE) { *(LAS u32x4*)(lds + H_QP + t * 272 + pc8 * 2) = wq; *(LAS u32x4*)(lds + H_KP + t * 272 + pc8 * 2) = wk; }
            const unsigned kw[4] = {wk.x, wk.y, wk.z, wk.w};
#pragma unroll
            for (int j = 0; j < 8; ++j) { const unsigned short kk = (unsigned short)((j & 1) ? (kw[j >> 1] >> 16) : (kw[j >> 1] & 0xffffu)), vv = (unsigned short)((j & 1) ? (vw[j >> 1] >> 16) : (vw[j >> 1] & 0xffffu));
                *(LAS unsigned short*)(lds + H_KT + tr64_off(pc8 + j, t)) = kk; *(LAS unsigned short*)(lds + H_VT + tr64_off(pc8 + j, t)) = vv; } } }
        if (!PRE) {
#pragma unroll
          for (int vt = 0; vt < 8; ++vt) { const f32x4 sv = S[vt] * e4; u32x2 o; o.x = cvt_pk_bf16(sv[0], sv[1]); o.y = cvt_pk_bf16(sv[2], sv[3]);
              *(LAS u32x2*)(lds + H_ST + (16 * vt + l15) * 272 + (16 * w + 4 * q4) * 2) = o; } }
        if (c + 1 < c0 + nch) HG_LOADQV(c + 1);
        __syncthreads();
        f32x4 oT[4];
        if (!PRE) {
        { const int ti = w >> 1;
#pragma unroll
          for (int sj = 0; sj < 2; ++sj) { const int si = 2 * (w & 1) + sj; f32x4 a4 = (f32x4){0.f, 0.f, 0.f, 0.f};
              if (si <= ti) {
#pragma unroll
                  for (int kb = 0; kb < 4; ++kb) { const bf16x8 a = *(const LAS bf16x8*)(lds + H_KP + (16 * si + l15) * 272 + kb * 64 + q4 * 16), b = *(const LAS bf16x8*)(lds + H_QP + (16 * ti + l15) * 272 + kb * 64 + q4 * 16); a4 = MFMA16(a, b, a4); }
                  const int t = 16 * ti + l15, s0 = 16 * si + 4 * q4;
#pragma unroll
                  for (int r = 0; r < 4; ++r) a4[r] = (s0 + r <= t) ? a4[r] : 0.f; }
              u32x2 o; o.x = cvt_pk_bf16(a4[0], a4[1]); o.y = cvt_pk_bf16(a4[2], a4[3]);
              *(LAS u32x2*)(lds + H_P + (16 * ti + l15) * 144 + (16 * si + 4 * q4) * 2) = o; } }
#pragma unroll
        for (int ti = 0; ti < 4; ++ti) oT[ti] = (f32x4){0.f, 0.f, 0.f, 0.f};
#pragma unroll
        for (int kb = 0; kb < 4; ++kb) { const bf16x8 a = *(const LAS bf16x8*)(lds + H_ST + (16 * w + l15) * 272 + kb * 64 + q4 * 16);
#pragma unroll
            for (int ti = 0; ti < 4; ++ti) { const bf16x8 b = *(const LAS bf16x8*)(lds + H_QP + (16 * ti + l15) * 272 + kb * 64 + q4 * 16); oT[ti] = MFMA16(a, b, oT[ti]); } }
        __syncthreads();
        }
        { f32x4 U[8];
#pragma unroll
          for (int vt = 0; vt < 8; ++vt) U[vt] = (f32x4){0.f, 0.f, 0.f, 0.f};
#pragma unroll
          for (int kb = 0; kb < 2; ++kb) { const bf16x8 av = *(const LAS bf16x8*)(lds + H_VT + tr64_off(16 * w + l15, 32 * kb + 8 * q4)), ak = *(const LAS bf16x8*)(lds + H_KT + tr64_off(16 * w + l15, 32 * kb + 8 * q4));
#pragma unroll
              for (int ti = 0; ti < 4; ++ti) { if (!PRE && (kb == 0 || ti >= 2)) { const bf16x8 b = *(const LAS bf16x8*)(lds + H_P + (16 * ti + l15) * 144 + (32 * kb + 8 * q4) * 2); oT[ti] = MFMA16(av, b, oT[ti]); } }
#pragma unroll
              for (int vt = 0; vt < 8; ++vt) { const bf16x8 b = *(const LAS bf16x8*)(lds + H_VT + tr64_off(16 * vt + l15, 32 * kb + 8 * q4)); U[vt] = MFMA16(ak, b, U[vt]); } }
#pragma unroll
          for (int vt = 0; vt < 8; ++vt) S[vt] = S[vt] * d4 + U[vt] * c4; }
        if (!PRE) {
#pragma unroll
        for (int ti = 0; ti < 4; ++ti) { float ss = (oT[ti][0] * oT[ti][0] + oT[ti][1] * oT[ti][1]) + (oT[ti][2] * oT[ti][2] + oT[ti][3] * oT[ti][3]); ss += __shfl_xor(ss, 16); ss += __shfl_xor(ss, 32);
            if (q4 == 0) Lss[(16 * ti + l15) * 8 + w] = ss; }
        __syncthreads();
#pragma unroll
        for (int ti = 0; ti < 4; ++ti) { const int t = 16 * ti + l15; const f32x4 s0 = *(const LAS f32x4*)(Lss + t * 8), s1 = *(const LAS f32x4*)(Lss + t * 8 + 4);
            const float tot = ((s0[0] + s0[1]) + (s0[2] + s0[3])) + ((s1[0] + s1[1]) + (s1[2] + s1[3]));
            const float rs = rsqrtf(tot * (1.0f / 128.0f) + 1e-6f);
            u32x2 o; o.x = cvt_pk_bf16(oT[ti][0] * rs * bf_lo(rog[ti].x), oT[ti][1] * rs * bf_hi(rog[ti].x)); o.y = cvt_pk_bf16(oT[ti][2] * rs * bf_lo(rog[ti].y), oT[ti][3] * rs * bf_hi(rog[ti].y));
            *(u32x2*)(OUTb + (row_base + (size_t)c * 64 + t) * 1024 + colbase + 16 * w + 4 * q4) = o; }
        }
    }
    if (PRE) { float* Uo = Ubuf + (size_t)item0 * 16384;
#pragma unroll
        for (int vt = 0; vt < 8; ++vt) *(f32x4*)(Uo + (vt * 512 + tid) * 4) = S[vt];
        if (tid < 128) Dbuf[(size_t)item0 * 128 + tid] = dacc; }
    __syncthreads();
#undef HG_LOADF
#undef HG_LOADQV
}

__device__ __forceinline__ void gmlp_loop(LAS unsigned char* lds, const bf16_t* __restrict__ Vb, const bf16_t* Ub, bf16_t* Ob, const bf16_t* __restrict__ wst  , const float* __restrict__ gbias  , int first, int stride, int nitems) {
    const int tid = opaque_tid(), lane = tid & 63, w = __builtin_amdgcn_readfirstlane(tid >> 6), q4 = lane >> 4, l15 = lane & 15;
    const int ps = tid >> 4, pc8 = (tid & 15) * 8, nkb = (w >> 1) + 1, t = 16 * w + l15;
    int it = first; if (it >= nitems) return;
    u32x4 rv[4]; u32x2 ru[8]; bf16x8 wf[4]; float bt;
#define GM_DEC(i_) const int g8_ = (i_) & 7; const size_t row0_ = (size_t)((i_) >> 9) * SEQ + (size_t)(((i_) >> 3) & 63) * 128; const int col0_ = g8_ * 128;
#define GM_LOADV(i_) do { GM_DEC(i_) _Pragma("unroll") for (int i = 0; i < 4; ++i) rv[i] = *(const u32x4*)(Vb + (row0_ + ps + 32 * i) * 1024 + col0_ + pc8); \
        _Pragma("unroll") for (int kb = 0; kb < 4; ++kb) if (kb < nkb) wf[kb] = *(const bf16x8*)(wst + (size_t)g8_ * 16384 + (16 * w + l15) * 128 + kb * 32 + q4 * 8); } while (0)
#define GM_LOADU(i_) do { GM_DEC(i_) bt = gbias[g8_ * 128 + t]; _Pragma("unroll") for (int ct = 0; ct < 8; ++ct) ru[ct] = *(const u32x2*)(Ub + (row0_ + t) * 1024 + col0_ + 16 * ct + 4 * q4); } while (0)
    GM_LOADV(it); GM_LOADU(it);
    for (;;) {
#pragma unroll
        for (int i = 0; i < 4; ++i) { const int s = ps + 32 * i; const u32x4 raw = rv[i];
            float x[8] = {bf_lo(raw.x), bf_hi(raw.x), bf_lo(raw.y), bf_hi(raw.y), bf_lo(raw.z), bf_hi(raw.z), bf_lo(raw.w), bf_hi(raw.w)};
            float sm = ((x[0] + x[1]) + (x[2] + x[3])) + ((x[4] + x[5]) + (x[6] + x[7]));
            sm += __shfl_xor(sm, 1); sm += __shfl_xor(sm, 2); sm += __shfl_xor(sm, 4); sm += __shfl_xor(sm, 8);
            const float mu = sm * (1.0f / 128.0f); float vs = 0.f;
#pragma unroll
            for (int j = 0; j < 8; ++j) { x[j] -= mu; vs += x[j] * x[j]; }
            vs += __shfl_xor(vs, 1); vs += __shfl_xor(vs, 2); vs += __shfl_xor(vs, 4); vs += __shfl_xor(vs, 8);
            const float rstd = rsqrtf(vs * (1.0f / 128.0f) + 1e-6f);
#pragma unroll
            for (int j = 0; j < 4; ++j) { const unsigned pk = cvt_pk_bf16(x[2 * j] * rstd, x[2 * j + 1] * rstd);
                *(LAS unsigned short*)(lds + tr128_off(pc8 + 2 * j, s)) = (unsigned short)(pk & 0xffffu); *(LAS unsigned short*)(lds + tr128_off(pc8 + 2 * j + 1, s)) = (unsigned short)(pk >> 16); } }
        bf16x8 wc[4];
#pragma unroll
        for (int kb = 0; kb < 4; ++kb) wc[kb] = wf[kb];
        const int nxt = it + stride; const bool more = nxt < nitems;
        if (more) GM_LOADV(nxt);
        __syncthreads();
        f32x4 acc[8];
#pragma unroll
        for (int ct = 0; ct < 8; ++ct) acc[ct] = (f32x4){0.f, 0.f, 0.f, 0.f};
#pragma unroll
        for (int kb = 0; kb < 4; ++kb) if (kb < nkb) {
#pragma unroll
            for (int ct = 0; ct < 8; ++ct) { const bf16x8 a = *(const LAS bf16x8*)(lds + tr128_off(16 * ct + l15, 32 * kb + 8 * q4)); acc[ct] = MFMA16(a, wc[kb], acc[ct]); } }
        { GM_DEC(it)
#pragma unroll
          for (int ct = 0; ct < 8; ++ct) { const u32x2 uu = ru[ct];
              u32x2 o; o.x = cvt_pk_bf16(bf_lo(uu.x) * (acc[ct][0] + bt), bf_hi(uu.x) * (acc[ct][1] + bt)); o.y = cvt_pk_bf16(bf_lo(uu.y) * (acc[ct][2] + bt), bf_hi(uu.y) * (acc[ct][3] + bt));
              *(u32x2*)(Ob + (row0_ + t) * 1024 + col0_ + 16 * ct + 4 * q4) = o; } }
        if (!more) break;
        GM_LOADU(nxt);
        __syncthreads();
        it = nxt;
    }
    __syncthreads();
#undef GM_DEC
#undef GM_LOADV
#undef GM_LOADU
}

#define XB_TMO      128
#define XB_XCNT(j)  (256  + 64 * (j))
#define XB_XSUB(j)  (1280 + 64 * (j))
#define XB_XGEN(j)  (2304 + 64 * (j))
#define XB_TOP      3328
#define XB_TOPGEN   3392
#define XCD_BAR_WORDS 3456
#define XB_SPIN_CAP (1u << 18)

__device__ __forceinline__ unsigned xb_ld(unsigned* p)              { return __hip_atomic_load(p, __ATOMIC_RELAXED, __HIP_MEMORY_SCOPE_AGENT); }
__device__ __forceinline__ unsigned xb_add(unsigned* p, unsigned v) { return __hip_atomic_fetch_add(p, v, __ATOMIC_RELAXED, __HIP_MEMORY_SCOPE_AGENT); }
__device__ __forceinline__ unsigned xb_xcc_id() { return (unsigned)__builtin_amdgcn_s_getreg((3 << 11) | 20) & 0xFu; }
#define XB_SPIN(cond, bar) do { unsigned _sp = 0; while (cond) { __builtin_amdgcn_s_sleep(1); \
    if ((++_sp & 255u) == 0u) { if (xb_ld(&(bar)[XB_TMO])) break; if (_sp > XB_SPIN_CAP) { atomicAdd(&(bar)[XB_TMO], 1u); break; } } } } while (0)

struct XcdBarrier {
    unsigned* bar; unsigned x;
    volatile LAS unsigned* st;
};

__device__ __forceinline__ XcdBarrier xcd_barrier_post(unsigned* bar, volatile LAS unsigned* st) {
    XcdBarrier b; b.bar = bar; b.x = xb_xcc_id(); b.st = st;
    if (threadIdx.x == 0) (void)xb_add(&bar[XB_XCNT(b.x)], 1u);
    return b;
}
__device__ __forceinline__ void xcd_barrier_complete(unsigned* bar, unsigned x, unsigned& nloc, unsigned& nx) {
    const unsigned G = gridDim.x * gridDim.y * gridDim.z;
    unsigned sum, cnt, mine, sp = 0u;
    for (;;) {
        sum = 0u; cnt = 0u; mine = 0u;
#pragma unroll
        for (unsigned j = 0; j < 16; ++j) { const unsigned c = xb_ld(&bar[XB_XCNT(j)]); sum += c; cnt += (c > 0u) ? 1u : 0u; mine = (j == x) ? c : mine; }
        if (sum == G) break;
        __builtin_amdgcn_s_sleep(1);
        if ((++sp & 255u) == 0u) { if (xb_ld(&bar[XB_TMO])) break; if (sp > XB_SPIN_CAP) { atomicAdd(&bar[XB_TMO], 1u); break; } }
    }
    nloc = mine > 0u ? mine : 1u; nx = cnt > 0u ? cnt : 1u;
}

__device__ __forceinline__ void xcd_barrier(const XcdBarrier& b) {
    asm volatile("s_waitcnt vmcnt(0)" ::: "memory");
    __syncthreads();
    if (threadIdx.x == 0) {
        unsigned* bar = b.bar;
        __builtin_amdgcn_s_waitcnt(0);
        unsigned nloc = b.st[0], nx = b.st[1];
        if (nloc == 0u) { xcd_barrier_complete(bar, b.x, nloc, nx); b.st[0] = nloc; b.st[1] = nx; }
        const unsigned old = xb_add(&bar[XB_XSUB(b.x)], 1u);
        const unsigned gen = old / nloc;
        if (old + 1u == (gen + 1u) * nloc) {
            __builtin_amdgcn_fence(__ATOMIC_RELEASE, "agent");
            asm volatile("s_waitcnt vmcnt(0)" ::: "memory");
            const unsigned og = xb_add(&bar[XB_TOP], 1u);
            const unsigned tg = og / nx;
            if (og + 1u == (tg + 1u) * nx) xb_add(&bar[XB_TOPGEN], 1u);
            else XB_SPIN(xb_ld(&bar[XB_TOPGEN]) == tg, bar);
            __builtin_amdgcn_fence(__ATOMIC_ACQUIRE, "agent");
            xb_add(&bar[XB_XGEN(b.x)], 1u);
            asm volatile("s_waitcnt vmcnt(0)" ::: "memory");
        } else {
            XB_SPIN(xb_ld(&bar[XB_XGEN(b.x)]) == gen, bar);
            __builtin_amdgcn_fence(__ATOMIC_ACQUIRE, "agent");
            asm volatile("s_waitcnt vmcnt(0)" ::: "memory");
        }
    }
    __syncthreads();
}


__device__ __forceinline__ void flat_barrier(unsigned* bar, unsigned round) {
    asm volatile("s_waitcnt vmcnt(0)" ::: "memory");
    __syncthreads();
    if (threadIdx.x == 0) {
        __builtin_amdgcn_fence(__ATOMIC_RELEASE, "agent");
        asm volatile("s_waitcnt vmcnt(0)" ::: "memory");
        const unsigned G = gridDim.x, old = __hip_atomic_fetch_add(bar + 64, 1u, __ATOMIC_RELAXED, __HIP_MEMORY_SCOPE_AGENT);
        if (old + 1u == round * G) __hip_atomic_store(bar + 128, round, __ATOMIC_RELAXED, __HIP_MEMORY_SCOPE_AGENT);
        else { unsigned sp = 0; while (__hip_atomic_load(bar + 128, __ATOMIC_RELAXED, __HIP_MEMORY_SCOPE_AGENT) < round) { __builtin_amdgcn_s_sleep(2); if (++sp > (1u << 22)) break; } }
        __builtin_amdgcn_fence(__ATOMIC_ACQUIRE, "agent");
        asm volatile("s_waitcnt vmcnt(0)" ::: "memory");
    }
    __syncthreads();
}

__device__ __forceinline__ void stagger_start(unsigned ticks) {
    const unsigned g = (blockIdx.x >> 3) & 3u;
    if (g) { const unsigned long long t0 = __builtin_amdgcn_s_memrealtime(); while (__builtin_amdgcn_s_memrealtime() - t0 < (unsigned long long)(g * ticks)) __builtin_amdgcn_s_sleep(8); }
}
constexpr int HSEG = 8, HCH = SEQ / 64 / HSEG;
#ifndef PHMASK
#define PHMASK 0xffff
#endif
#ifndef MK_STAG_UP
#define MK_STAG_UP 700u
#endif
__global__ void __launch_bounds__(512, 2) mk_fwd(Params p_arg) {
    extern __shared__ __attribute__((aligned(16))) unsigned char lds_raw[];
    LAS unsigned char* lds = (LAS unsigned char*)lds_raw;
    int pc = 0;
    { if (threadIdx.x == 0) { *(LAS u32x4*)(lds + XB_ST_OFF) = (u32x4){0u, 0u, 0u, 0u}; } __syncthreads();
      KP pp0 = (KP)__builtin_amdgcn_kernarg_segment_ptr(); if (blockIdx.x == 0) { unsigned* bar0 = (unsigned*)pp0->ws; for (int i = threadIdx.x; i < XCD_BAR_WORDS; i += 512) __hip_atomic_store(bar0 + i, 0u, __ATOMIC_RELAXED, __HIP_MEMORY_SCOPE_AGENT); } }
#define GETP KP pp = (KP)__builtin_amdgcn_kernarg_segment_ptr(); asm volatile("" : "+s"(pp))
#ifdef MK_TIME
    LAS unsigned long long* tacc = (LAS unsigned long long*)(lds + 143360); const bool timer = (blockIdx.x == 0 && threadIdx.x == 0); unsigned long long tph0 = 0, tph1 = 0; int tcls = 0;
    if (timer) { for (int i = 0; i < 16; ++i) tacc[i] = 0ull; }
#define T_BEGIN(c) if (timer) { tph0 = __builtin_amdgcn_s_memrealtime(); tcls = (c); }
#define T_MID if (timer) { tph1 = __builtin_amdgcn_s_memrealtime(); tacc[tcls] += tph1 - tph0; }
#define T_END if (timer) { tacc[15] += __builtin_amdgcn_s_memrealtime() - tph1; }
#else
#define T_BEGIN(c)
#define T_MID
#define T_END
#endif
#ifndef MK_DUP
#define MK_DUP 0
#endif
#define PH_BEGIN(bit, cls) { GETP; T_BEGIN(cls) if (pc >= pp->ph_lo && pc < pp->ph_hi && (PHMASK & (bit))) for (int rep_ = 0; rep_ < (((MK_DUP) & (bit)) ? 2 : 1); ++rep_) {
#define PH_END } } { GETP; T_MID ++pc; if (pc > pp->ph_lo && pc < pp->ph_hi) { if (pc == 1) { cg::this_grid().sync(); (void)xcd_barrier_post((unsigned*)pp->ws, (volatile LAS unsigned*)(lds + XB_ST_OFF)); } else { XcdBarrier xb_; xb_.bar = (unsigned*)pp->ws; xb_.x = xb_xcc_id(); xb_.st = (volatile LAS unsigned*)(lds + XB_ST_OFF); xcd_barrier(xb_); } } T_END }

    PH_BEGIN(1, 0) prologue_phase(pp, lds); PH_END

    for (int blk = 0; blk < 3 * NL; ++blk) {
        const int l = blk / 3, kind = blk - 3 * l;
        PH_BEGIN(2, 1) unsigned char* ws = pp->ws; const float* hin = (blk == 0) ? pp->in[0] : pp->out;
            norm_phase<false>(hin, (bf16_t*)(ws + WS_HN), nullptr, pp->in[11] + (size_t)(l * 3 + kind) * 1024, (const float*)(ws + WS_MOD) + (size_t)l * 8 * 9216, kind); PH_END
        if (kind != 1) {
            const int s = kind >> 1;
            PH_BEGIN(4, 2) unsigned char* ws = pp->ws;
                pg8::Gemm g{(const bf16_t*)(ws + WS_HN), (const bf16_t*)(ws + WS_W13) + (size_t)(l * 2 + s) * 5632 * 1024, NT, 5632, 1024}; pg8::StaticOrder S; S.init(NT, 5632, (int)gridDim.x, (int)blockIdx.x);
                pg8::EpiSwiGLU E{(bf16_t*)(ws + WS_BIG)}; pg8::gemm_phase<pg8::EpiSwiGLU, pg8::StaticOrder, false>(lds, g, S, E, nullptr); PH_END
            PH_BEGIN(8, 3) unsigned char* ws = pp->ws; const float* hin = (blk == 0) ? pp->in[0] : pp->out;
                pg8::Gemm g{(const bf16_t*)(ws + WS_BIG), (const bf16_t*)(ws + WS_W2) + (size_t)(l * 2 + s) * 1024 * FH, NT, 1024, FH}; pg8::StaticOrder S; S.init(NT, 1024, (int)gridDim.x, (int)blockIdx.x);
                pg8::EpiResid E{hin, pp->out, (const float*)(ws + WS_MOD) + (size_t)l * 8 * 9216 + (3 * kind + 2) * 1024, 0.5f}; pg8::gemm_phase<pg8::EpiResid, pg8::StaticOrder, false>(lds, g, S, E, nullptr); PH_END
        } else {
            for (int half = 0; half < 2; ++half) {
                PH_BEGIN(16, 4) unsigned char* ws = pp->ws;
                    pg8::Gemm g{(const bf16_t*)(ws + WS_HN) + (size_t)half * TH * 1024, (const bf16_t*)(ws + WS_WIN) + (size_t)l * 8192 * 1024, TH, 8192, 1024}; pg8::StaticOrder S; S.init(TH, 8192, (int)gridDim.x, (int)blockIdx.x);
                    pg8::EpiInproj E{(bf16_t*)(ws + WS_U), (bf16_t*)(ws + WS_V), (bf16_t*)(ws + WS_Q), (float*)(ws + WS_F), (bf16_t*)(ws + WS_I), (bf16_t*)(ws + WS_OG), (bf16_t*)(ws + WS_GA), (bf16_t*)(ws + WS_GB), (const float*)(ws + WS_LB) + l * 1024};
                    pg8::gemm_phase<pg8::EpiInproj, pg8::StaticOrder, false>(lds, g, S, E, nullptr); PH_END
                PH_BEGIN(32, 5) unsigned char* ws = pp->ws; const int G = (int)gridDim.x;
                    for (int it = (int)blockIdx.x; it < 32 * (HSEG - 1); it += G) { const int sq = it / (HSEG - 1), sg = it - sq * (HSEG - 1);
                        hgrn_seq<true>(lds, nullptr, (const float*)(ws + WS_F), (const bf16_t*)(ws + WS_I), nullptr, nullptr, (size_t)(sq >> 3) * SEQ, (sq & 7) * 128, sg * HCH, HCH, (float*)(ws + WS_HU), (float*)(ws + WS_HD), sq * HSEG + sg, 0); }
                    gmlp_loop(lds, (const bf16_t*)(ws + WS_V), (const bf16_t*)(ws + WS_U), (bf16_t*)(ws + WS_U), (const bf16_t*)(ws + WS_WST) + (size_t)l * 8 * 128 * 128, pp->in[4] + (size_t)l * 8 * 128, (int)blockIdx.x, G, 4 * 64 * 8);
                PH_END
                PH_BEGIN(64, 6) unsigned char* ws = pp->ws; const int G = (int)gridDim.x;
                    for (int it = (int)blockIdx.x; it < 32 * HSEG; it += G) { const int sq = it / HSEG, sg = it - sq * HSEG;
                        hgrn_seq<false>(lds, (const bf16_t*)(ws + WS_Q), (const float*)(ws + WS_F), (const bf16_t*)(ws + WS_I), (const bf16_t*)(ws + WS_OG), (bf16_t*)(ws + ((MK_DUP & 64) && rep_ == 0 ? WS_M0 : WS_OG)), (size_t)(sq >> 3) * SEQ, (sq & 7) * 128, sg * HCH, HCH, (float*)(ws + WS_HU), (float*)(ws + WS_HD), sq * HSEG, sg); }
                PH_END
                PH_BEGIN(128, 7) unsigned char* ws = pp->ws;
                    pg8::Gemm g{(const bf16_t*)(ws + WS_U), (const bf16_t*)(ws + WS_WA) + (size_t)l * 1024 * 1024, TH, 1024, 1024}; pg8::BranchOrder S; S.init(TH, 1024, (int)gridDim.x, (int)blockIdx.x);
                    S.A2 = (const bf16_t*)(ws + WS_OG); S.Bt2 = (const bf16_t*)(ws + WS_WB) + (size_t)l * 1024 * 1024;
                    pg8::EpiBranchFused E{(const bf16_t*)(ws + WS_GA), (const bf16_t*)(ws + WS_GB), (bf16_t*)(ws + (half == 0 ? WS_M0 : WS_Q))}; pg8::gemm_phase<pg8::EpiBranchFused, pg8::BranchOrder, false>(lds, g, S, E, nullptr); PH_END
            }
            PH_BEGIN(512, 9) unsigned char* ws = pp->ws; float* hh = pp->out;
                pg8::Gemm g{(const bf16_t*)(ws + WS_M0), (const bf16_t*)(ws + WS_WO) + (size_t)l * 1024 * 1024, NT, 1024, 1024}; pg8::SplitAOrder S; S.init(NT, 1024, (int)gridDim.x, (int)blockIdx.x); S.A1 = (const bf16_t*)(ws + WS_Q);
                pg8::EpiResid E{hh, hh, (const float*)(ws + WS_MOD) + (size_t)l * 8 * 9216 + 5 * 1024, 1.0f}; pg8::gemm_phase<pg8::EpiResid, pg8::SplitAOrder, false>(lds, g, S, E, nullptr); PH_END
        }
    }
    PH_BEGIN(1024, 10) norm_phase<true>(pp->out, nullptr, pp->out, pp->in[14], nullptr, 0); PH_END
#ifdef MK_TIME
    __syncthreads(); asm volatile("s_waitcnt vmcnt(0)" ::: "memory");
    if (timer) { GETP; unsigned long long a = 0, b = 0; for (int i = 0; i < 16; ++i) { if ((MK_TA >> i) & 1) a += tacc[i]; if ((MK_TB >> i) & 1) b += tacc[i]; }
        const float V = (float)a * 0.01f; int n = (int)((float)b * 0.01f / 20.0f); if (n < 1) n = 1; if (n > 1024) n = 1024;
        float* o = pp->out; for (int i = 0; i < n; ++i) o[i] = V; }
#endif
}
constexpr int N_PHASES = 1 + NL * (3 + 10 + 3) + 1;

extern "C" void kernel_launch(void* const* d_in, const int* in_sizes, int n_in, void* d_out, int out_size, void* d_ws, size_t ws_size, hipStream_t stream) {
    static int grid = 0;
    if (grid == 0) {
        if (n_in != 15 || out_size != NT * DM || ws_size < WS_END) { fprintf(stderr, "kernel_launch: unexpected shapes (n_in %d, out %d, ws %zu < %zu)\n", n_in, out_size, ws_size, (size_t)WS_END); grid = -1; return; }
        int dev = 0, cus = 0, per_cu = 0;
        hipGetDevice(&dev); hipDeviceGetAttribute(&cus, hipDeviceAttributeMultiprocessorCount, dev);
        if (hipFuncSetAttribute((const void*)mk_fwd, hipFuncAttributeMaxDynamicSharedMemorySize, LDS_BYTES) != hipSuccess) { fprintf(stderr, "kernel_launch: hipFuncSetAttribute failed\n"); grid = -1; return; }
        if (hipOccupancyMaxActiveBlocksPerMultiprocessor(&per_cu, (const void*)mk_fwd, 512, LDS_BYTES) != hipSuccess || per_cu < 1) { fprintf(stderr, "kernel_launch: occupancy query says %d\n", per_cu); per_cu = 1; }
        (void)hipGetLastError();
        grid = cus * 1;
    }
    if (grid < 0) return;
    Params p{};
    for (int i = 0; i < 15; ++i) p.in[i] = (const float*)d_in[i];
    p.out = (float*)d_out; p.ws = (unsigned char*)d_ws;
#if MK_COOP
    p.ph_lo = 0; p.ph_hi = N_PHASES;
    void* args[] = {&p};
    hipError_t e = hipLaunchCooperativeKernel((const void*)mk_fwd, dim3(grid), dim3(512), args, LDS_BYTES, stream);
    if (e != hipSuccess) fprintf(stderr, "cooperative launch failed: %s (grid %d)\n", hipGetErrorString(e), grid);
#else
    for (int i = 0; i < N_PHASES; ++i) { p.ph_lo = i; p.ph_hi = i + 1; hipLaunchKernelGGL(mk_fwd, dim3(grid), dim3(512), LDS_BYTES, stream, p); }
#endif
}
```

```cpp
#include <hip/hip_runtime.h>
#include <hip/hip_cooperative_groups.h>
#include <cstdio>
namespace cg = cooperative_groups;
#ifndef MK_SP2
#define MK_SP2 true
#endif
#ifndef MK_ALIGN
#define MK_ALIGN true
#endif
#ifndef MK_COOP
#define MK_COOP 1
#endif
namespace pg8 {
#define PG8_LAS __attribute__((address_space(3)))
typedef unsigned short bf16_t;
typedef short bf16x8 __attribute__((ext_vector_type(8)));
typedef float f32x4 __attribute__((ext_vector_type(4)));
typedef unsigned u32x4 __attribute__((ext_vector_type(4)));
constexpr int BM = 256, BK = 64, HALF = 128, HTB = HALF * BK * 2  , STAGE_BYTES = 8 * HTB, NXCD = 8, WGM = 8;

__host__ __device__ __forceinline__ int lds_byte(int r, int c) { const int st = (r >> 4) * 2 + (c >> 5), rr = r & 15, cc = c & 31, ob = rr * 64 + cc * 2; return st * 1024 + (ob ^ (((ob >> 9) & 1) << 5)); }
__host__ __device__ __forceinline__ void stage_rc(int b, int& R, int& C) { const int st = b / 1024, sb = b % 1024, swz = sb ^ (((sb >> 9) & 1) << 5); R = (st >> 1) * 16 + swz / 64; C = (st & 1) * 32 + (swz % 64) / 2; }
__host__ __device__ __forceinline__ int perm32(int rho) { const int n = rho >> 4, i = rho & 15; return 8 * (i >> 2) + 4 * n + (i & 3); }

struct Unit { int pm, pn, part; };
struct Gemm { const bf16_t* A; const bf16_t* Bt; int M, N, K; };

struct StaticOrder {
    int nM, nN, nwg, G, c;
    __host__ __device__ void init(int M, int N, int G_, int c_) { nM = M / BM; nN = N / BM; nwg = nM * nN; G = G_; c = c_; }
    __host__ __device__ bool next(int i, Unit& u) const {
        const long L = (long)i * G + c; if (L >= nwg) return false;
        int wgid = (int)L; { const int q = nwg / NXCD, r = nwg % NXCD, xcd = wgid % NXCD, off = wgid / NXCD; wgid = (xcd < r ? xcd * (q + 1) : r * (q + 1) + (xcd - r) * q) + off; }
        const int nig = WGM * nN, gid = wgid / nig, fm = gid * WGM, gsz = (nM - fm) < WGM ? (nM - fm) : WGM;
        u.pm = fm + ((wgid % nig) % gsz); u.pn = (wgid % nig) / gsz; u.part = 0; return true;
    }
    __device__ __forceinline__ void a_ready(const Unit&) const {}
    __device__ __forceinline__ void done(const Unit&) const {}
    __device__ __forceinline__ const char* a_ptr(const Gemm& g, const Unit& u, size_t tstep) const { return (const char*)g.A + (size_t)u.pm * tstep; }
    __device__ __forceinline__ const char* b_ptr(const Gemm& g, const Unit& u, size_t tstep) const { return (const char*)g.Bt + (size_t)u.pn * tstep; }
};
__device__ __forceinline__ int opaque_tid() { int t = threadIdx.x; asm volatile("" : "+v"(t)); return t; }
typedef __bf16 bf16x2_t __attribute__((ext_vector_type(2)));
typedef float f32x2_t __attribute__((ext_vector_type(2)));
__device__ __forceinline__ unsigned cvt_pk_bf16(float lo, float hi) { const f32x2_t v = {lo, hi}; const bf16x2_t b = __builtin_convertvector(v, bf16x2_t); return __builtin_bit_cast(unsigned, b); }
__device__ __forceinline__ float bf_lo(unsigned w) { return __uint_as_float(w << 16); }
__device__ __forceinline__ float bf_hi(unsigned w) { return __uint_as_float(w & 0xffff0000u); }
template <int ACT> __device__ __forceinline__ float actf(float x) {
    if (ACT == 0) return x;
    if (ACT == 1) { const float u = 1.5957691216f * (x + 0.044715f * x * x * x); return x * __builtin_amdgcn_rcpf(1.0f + __expf(-u)); }
    if (ACT == 2) return x * __builtin_amdgcn_rcpf(1.0f + __expf(-x));
    return __builtin_amdgcn_rcpf(1.0f + __expf(-x));
}
template <int ACT> __device__ __forceinline__ void act8(float (&v)[8]) {
    if (ACT == 0) return;
    float a[8];
#pragma unroll
    for (int j = 0; j < 8; ++j) a[j] = (ACT == 1) ? -1.5957691216f * (v[j] + 0.044715f * v[j] * v[j] * v[j]) : -v[j];
#pragma unroll
    for (int j = 0; j < 8; ++j) a[j] = __expf(a[j]);
#pragma unroll
    for (int j = 0; j < 8; ++j) a[j] = 1.0f + a[j];
#pragma unroll
    for (int j = 0; j < 8; ++j) a[j] = __builtin_amdgcn_rcpf(a[j]);
#pragma unroll
    for (int j = 0; j < 8; ++j) v[j] = (ACT == 3) ? a[j] : v[j] * a[j];
}
struct EpiSwiGLU {
    static constexpr bool PERM = true, AFTER_DRAIN = false, TWO_PART = false;
    bf16_t* O;
    __device__ __forceinline__ void operator()(const f32x4 (&acc)[2][2][4][2], const Unit& u, int wr, int wc, int fr, int fq) const {
        const int row0 = u.pm * BM + wr * 64 + fr, col0 = u.pn * HALF + wc * 32 + 8 * fq;
#pragma unroll
        for (int ai = 0; ai < 2; ++ai)
#pragma unroll
            for (int m = 0; m < 4; ++m) {
                const f32x4 a0 = acc[ai][0][m][0], a1 = acc[ai][0][m][1], b0 = acc[ai][1][m][0], b1 = acc[ai][1][m][1];
                float v[8] = {a0[0], a0[1], a0[2], a0[3], a1[0], a1[1], a1[2], a1[3]};
                act8<2>(v);
#pragma unroll
                for (int j = 0; j < 4; ++j) { v[j] *= b0[j]; v[4 + j] *= b1[j]; }
                u32x4 w; w.x = cvt_pk_bf16(v[0], v[1]); w.y = cvt_pk_bf16(v[2], v[3]); w.z = cvt_pk_bf16(v[4], v[5]); w.w = cvt_pk_bf16(v[6], v[7]);
                *(u32x4*)(O + (size_t)(row0 + ai * HALF + m * 16) * 2816 + col0) = w;
            }
    }
};
struct EpiResid {
    static constexpr bool PERM = false, AFTER_DRAIN = false, TWO_PART = false;
    const float* hin; float* hout; const float* gmod; float scale;
    __device__ __forceinline__ void operator()(const f32x4 (&acc)[2][2][4][2], const Unit& u, int wr, int wc, int fr, int fq) const {
        const int row0 = u.pm * BM + wr * 64 + fr, col0 = u.pn * BM + wc * 32 + 4 * fq;
        const float* gp = gmod + (size_t)((u.pm * BM) >> 13) * 9216 + col0;
        f32x4 cf[2][2];
#pragma unroll
        for (int bj = 0; bj < 2; ++bj)
#pragma unroll
            for (int n = 0; n < 2; ++n) { const f32x4 g = *(const f32x4*)(gp + bj * HALF + n * 16); cf[bj][n] = (g + 1.0f) * scale; }
#pragma unroll
        for (int ai = 0; ai < 2; ++ai) {
            f32x4 hv[4][2][2];
#pragma unroll
            for (int m = 0; m < 4; ++m) { const size_t off = (size_t)(row0 + ai * HALF + m * 16) * 1024 + col0;
#pragma unroll
                for (int bj = 0; bj < 2; ++bj)
#pragma unroll
                    for (int n = 0; n < 2; ++n) hv[m][bj][n] = *(const f32x4*)(hin + off + bj * HALF + n * 16); }
#pragma unroll
            for (int m = 0; m < 4; ++m) { const size_t off = (size_t)(row0 + ai * HALF + m * 16) * 1024 + col0;
#pragma unroll
                for (int bj = 0; bj < 2; ++bj)
#pragma unroll
                    for (int n = 0; n < 2; ++n) *(f32x4*)(hout + off + bj * HALF + n * 16) = hv[m][bj][n] + cf[bj][n] * acc[ai][bj][m][n]; }
            asm volatile("" ::: "memory"); }
    }
};
struct EpiInproj {
    static constexpr bool PERM = true, AFTER_DRAIN = false, TWO_PART = false;
    bf16_t* U; bf16_t* V; bf16_t* Q; float* F; bf16_t* I; bf16_t* OG; bf16_t* GA; bf16_t* GB; const float* lb;
    template <int ACT> __device__ __forceinline__ void st16(const f32x4 (&acc)[2][2][4][2], bf16_t* dst, int row0, int colg) const {
#pragma unroll
        for (int ai = 0; ai < 2; ++ai)
#pragma unroll
            for (int m = 0; m < 4; ++m)
#pragma unroll
                for (int bj = 0; bj < 2; ++bj) { const f32x4 v0 = acc[ai][bj][m][0], v1 = acc[ai][bj][m][1];
                    float v[8] = {v0[0], v0[1], v0[2], v0[3], v1[0], v1[1], v1[2], v1[3]};
                    act8<ACT>(v);
                    u32x4 w; w.x = cvt_pk_bf16(v[0], v[1]); w.y = cvt_pk_bf16(v[2], v[3]); w.z = cvt_pk_bf16(v[4], v[5]); w.w = cvt_pk_bf16(v[6], v[7]);
                    *(u32x4*)(dst + (size_t)(row0 + ai * HALF + m * 16) * 1024 + colg + bj * HALF) = w; }
    }
    __device__ __forceinline__ void operator()(const f32x4 (&acc)[2][2][4][2], const Unit& u, int wr, int wc, int fr, int fq) const {
        const int grp = u.pn >> 2, colg = (u.pn & 3) * BM + wc * 32 + 8 * fq, row0 = u.pm * BM + wr * 64 + fr;
        if (grp == 3) {
#pragma unroll
            for (int bj = 0; bj < 2; ++bj) { const f32x4 l0 = *(const f32x4*)(lb + colg + bj * HALF), l1 = *(const f32x4*)(lb + colg + bj * HALF + 4);
#pragma unroll
                for (int ai = 0; ai < 2; ++ai)
#pragma unroll
                    for (int m = 0; m < 4; ++m) { const f32x4 v0 = acc[ai][bj][m][0], v1 = acc[ai][bj][m][1]; f32x4 o0, o1;
#pragma unroll
                        for (int j = 0; j < 4; ++j) { o0[j] = __logf(fmaxf(l0[j] + (1.0f - l0[j]) * actf<3>(v0[j]), 1e-30f)); o1[j] = __logf(fmaxf(l1[j] + (1.0f - l1[j]) * actf<3>(v1[j]), 1e-30f)); }
                        float* d = F + (size_t)(row0 + ai * HALF + m * 16) * 1024 + colg + bj * HALF; *(f32x4*)d = o0; *(f32x4*)(d + 4) = o1; } }
        } else if (grp < 2) st16<1>(acc, grp == 0 ? U : V, row0, colg);
        else if (grp == 2) st16<2>(acc, Q, row0, colg);
        else if (grp == 4) st16<0>(acc, I, row0, colg);
        else if (grp == 5) st16<3>(acc, OG, row0, colg);
        else {
            const int colo = (u.pn - 24) * HALF + wc * 32 + 8 * fq;
#pragma unroll
            for (int ai = 0; ai < 2; ++ai)
#pragma unroll
                for (int m = 0; m < 4; ++m) { const f32x4 a0 = acc[ai][0][m][0], a1 = acc[ai][0][m][1], b0 = acc[ai][1][m][0], b1 = acc[ai][1][m][1];
                    float ea[8] = {-a0[0], -a0[1], -a0[2], -a0[3], -a1[0], -a1[1], -a1[2], -a1[3]}, eb[8] = {-b0[0], -b0[1], -b0[2], -b0[3], -b1[0], -b1[1], -b1[2], -b1[3]}, r[8], g[8];
#pragma unroll
                    for (int j = 0; j < 8; ++j) ea[j] = __expf(ea[j]);
#pragma unroll
                    for (int j = 0; j < 8; ++j) eb[j] = __expf(eb[j]);
#pragma unroll
                    for (int j = 0; j < 8; ++j) { ea[j] = 1.0f + ea[j]; eb[j] = 1.0f + eb[j]; }
#pragma unroll
                    for (int j = 0; j < 8; ++j) ea[j] = __builtin_amdgcn_rcpf(ea[j]);
#pragma unroll
                    for (int j = 0; j < 8; ++j) g[j] = fmaxf(__builtin_amdgcn_rcpf(eb[j]), 1e-6f);
#pragma unroll
                    for (int j = 0; j < 8; ++j) r[j] = ea[j] * fminf(eb[j], 1e6f);
                    u32x4 wr_, wg_; wr_.x = cvt_pk_bf16(r[0], r[1]); wr_.y = cvt_pk_bf16(r[2], r[3]); wr_.z = cvt_pk_bf16(r[4], r[5]); wr_.w = cvt_pk_bf16(r[6], r[7]);
                    wg_.x = cvt_pk_bf16(g[0], g[1]); wg_.y = cvt_pk_bf16(g[2], g[3]); wg_.z = cvt_pk_bf16(g[4], g[5]); wg_.w = cvt_pk_bf16(g[6], g[7]);
                    const size_t off = (size_t)(row0 + ai * HALF + m * 16) * 1024 + colo;
                    *(u32x4*)(GA + off) = wr_; *(u32x4*)(GB + off) = wg_; }
        }
    }
};
template <int MODE> struct EpiBranch {
    static constexpr bool PERM = true, AFTER_DRAIN = false, TWO_PART = false;
    const bf16_t* G; const bf16_t* P; bf16_t* O;
    __device__ __forceinline__ void operator()(const f32x4 (&acc)[2][2][4][2], const Unit& u, int wr, int wc, int fr, int fq) const {
        const int row0 = u.pm * BM + wr * 64 + fr, col0 = u.pn * BM + wc * 32 + 8 * fq;
#pragma unroll
        for (int ai = 0; ai < 2; ++ai)
#pragma unroll
            for (int m = 0; m < 4; ++m)
#pragma unroll
                for (int bj = 0; bj < 2; ++bj) { const size_t off = (size_t)(row0 + ai * HALF + m * 16) * 1024 + col0 + bj * HALF;
                    const u32x4 g = *(const u32x4*)(G + off); const f32x4 v0 = acc[ai][bj][m][0], v1 = acc[ai][bj][m][1];
                    float r[8] = { bf_lo(g.x) * v0[0], bf_hi(g.x) * v0[1], bf_lo(g.y) * v0[2], bf_hi(g.y) * v0[3], bf_lo(g.z) * v1[0], bf_hi(g.z) * v1[1], bf_lo(g.w) * v1[2], bf_hi(g.w) * v1[3] };
                    if (MODE == 1) { const u32x4 p = *(const u32x4*)(P + off);
                        r[0] += bf_lo(p.x); r[1] += bf_hi(p.x); r[2] += bf_lo(p.y); r[3] += bf_hi(p.y); r[4] += bf_lo(p.z); r[5] += bf_hi(p.z); r[6] += bf_lo(p.w); r[7] += bf_hi(p.w); }
                    u32x4 w; w.x = cvt_pk_bf16(r[0], r[1]); w.y = cvt_pk_bf16(r[2], r[3]); w.z = cvt_pk_bf16(r[4], r[5]); w.w = cvt_pk_bf16(r[6], r[7]);
                    *(u32x4*)(O + off) = w; }
    }
};

struct EpiBranchFused {
    static constexpr bool PERM = true, AFTER_DRAIN = false, TWO_PART = true;
    const bf16_t* GA; const bf16_t* GB; bf16_t* O;
    __device__ __forceinline__ void mid(f32x4 (&acc)[2][2][4][2], const Unit& u, int wr, int wc, int fr, int fq) const {
        const int row0 = u.pm * BM + wr * 64 + fr, col0 = u.pn * BM + wc * 32 + 8 * fq;
#pragma unroll
        for (int ai = 0; ai < 2; ++ai)
#pragma unroll
            for (int m = 0; m < 4; ++m)
#pragma unroll
                for (int bj = 0; bj < 2; ++bj) { const size_t off = (size_t)(row0 + ai * HALF + m * 16) * 1024 + col0 + bj * HALF;
                    const u32x4 a = *(const u32x4*)(GA + off);
                    const float ra[8] = {bf_lo(a.x), bf_hi(a.x), bf_lo(a.y), bf_hi(a.y), bf_lo(a.z), bf_hi(a.z), bf_lo(a.w), bf_hi(a.w)};
#pragma unroll
                    for (int j = 0; j < 4; ++j) { acc[ai][bj][m][0][j] *= ra[j]; acc[ai][bj][m][1][j] *= ra[4 + j]; } }
    }
    __device__ __forceinline__ void operator()(const f32x4 (&acc)[2][2][4][2], const Unit& u, int wr, int wc, int fr, int fq) const {
        const int row0 = u.pm * BM + wr * 64 + fr, col0 = u.pn * BM + wc * 32 + 8 * fq;
#pragma unroll
        for (int ai = 0; ai < 2; ++ai)
#pragma unroll
            for (int m = 0; m < 4; ++m)
#pragma unroll
                for (int bj = 0; bj < 2; ++bj) { const size_t off = (size_t)(row0 + ai * HALF + m * 16) * 1024 + col0 + bj * HALF;
                    const u32x4 b = *(const u32x4*)(GB + off); const f32x4 v0 = acc[ai][bj][m][0], v1 = acc[ai][bj][m][1];
                    const float rb[8] = {bf_lo(b.x), bf_hi(b.x), bf_lo(b.y), bf_hi(b.y), bf_lo(b.z), bf_hi(b.z), bf_lo(b.w), bf_hi(b.w)};
                    u32x4 w; w.x = cvt_pk_bf16(rb[0] * v0[0], rb[1] * v0[1]); w.y = cvt_pk_bf16(rb[2] * v0[2], rb[3] * v0[3]);
                    w.z = cvt_pk_bf16(rb[4] * v1[0], rb[5] * v1[1]); w.w = cvt_pk_bf16(rb[6] * v1[2], rb[7] * v1[3]);
                    *(u32x4*)(O + off) = w; }
    }
};
struct BranchOrder : StaticOrder {
    const bf16_t* A2; const bf16_t* Bt2;
    __device__ __forceinline__ bool next(int i, Unit& u) const { const bool ok = StaticOrder::next(i >> 1, u); u.part = i & 1; return ok; }
    __device__ __forceinline__ const char* a_ptr(const Gemm& g, const Unit& u, size_t tstep) const { return (const char*)(u.part ? A2 : g.A) + (size_t)u.pm * tstep; }
    __device__ __forceinline__ const char* b_ptr(const Gemm& g, const Unit& u, size_t tstep) const { return (const char*)(u.part ? Bt2 : g.Bt) + (size_t)u.pn * tstep; }
};
struct SplitAOrder : StaticOrder {
    const bf16_t* A1;
    __device__ __forceinline__ const char* a_ptr(const Gemm& g, const Unit& u, size_t tstep) const { return u.pm < 128 ? (const char*)g.A + (size_t)u.pm * tstep : (const char*)A1 + (size_t)(u.pm - 128) * tstep; }
};

template <class Epi, class Sched, bool ALIGN_EPI = false, bool SP2 = false>
__device__ __forceinline__ void gemm_phase(PG8_LAS unsigned char* lds, const Gemm g, const Sched& S, const Epi& E) {
    const int tid = opaque_tid(), wid = __builtin_amdgcn_readfirstlane(tid >> 6), lane = tid & 63, wr = wid >> 2, wc = wid & 3, fr = lane & 15, fq = lane >> 4;
    const int K = g.K, nt = K / BK;
    unsigned voffA[2], voffB[2];
#pragma unroll
    for (int i = 0; i < 2; ++i) { int R, C; stage_rc(tid * 16 + i * 8192, R, C); const int Rb = Epi::PERM ? ((R & ~31) + perm32(R & 31)) : R;
        voffA[i] = (unsigned)(R * K + C) * 2u; voffB[i] = (unsigned)(Rb * K + C) * 2u; }
    const size_t kstep = (size_t)(BK * 2);
    const size_t hstep = (size_t)HALF * K * 2;
    const size_t tstep = 2 * hstep;
    const unsigned ldsw = (unsigned)wid * 1024u;
    const int aoff = lds_byte(wr * 64 + fr, fq * 8), boff = lds_byte(wc * 32 + fr, fq * 8);
#define PG8_SA(b, h) (((b) * 2 + (h)) * HTB)
#define PG8_SB(b, h) ((4 + (b) * 2 + (h)) * HTB)
#define PG8_STAGE(bufoff, gbase, voff) do { _Pragma("unroll") for (int _i = 0; _i < 2; ++_i) \
        __builtin_amdgcn_global_load_lds((const unsigned*)((const char*)(gbase) + (voff)[_i]), (PG8_LAS unsigned*)(lds + (bufoff) + ldsw + _i * 8192), 16, 0, 0); } while (0)
#define PG8_LDA(dst, b, h) do { _Pragma("unroll") for (int m = 0; m < 4; ++m) _Pragma("unroll") for (int k = 0; k < 2; ++k) dst[m][k] = *(const PG8_LAS bf16x8*)(lds + PG8_SA(b, h) + aoff + m * 2048 + k * 1024); } while (0)
#define PG8_LDB(dst, b, h) do { _Pragma("unroll") for (int n = 0; n < 2; ++n) _Pragma("unroll") for (int k = 0; k < 2; ++k) dst[n][k] = *(const PG8_LAS bf16x8*)(lds + PG8_SB(b, h) + boff + n * 2048 + k * 1024); } while (0)
#define PG8_MMA(ai, bj, At, Bt) do { __builtin_amdgcn_s_setprio(1); _Pragma("unroll") for (int m = 0; m < 4; ++m) _Pragma("unroll") for (int n = 0; n < 2; ++n) _Pragma("unroll") for (int k = 0; k < 2; ++k) \
        acc[ai][bj][m][n] = __builtin_amdgcn_mfma_f32_16x16x32_bf16(Bt[n][k], At[m][k], acc[ai][bj][m][n], 0, 0, 0); __builtin_amdgcn_s_setprio(0); } while (0)
#define PG8_WAIT_V(n) asm volatile("s_waitcnt vmcnt(" #n ")" ::: "memory")
#define PG8_WAIT_L(n) asm volatile("s_waitcnt lgkmcnt(" #n ")" ::: "memory")
#define PG8_BAR __builtin_amdgcn_s_barrier()
#define PG8_SCHED __builtin_amdgcn_sched_barrier(0)
    Unit cur, nxt; int ui = 0;
    if (!S.next(0, cur)) return;
    f32x4 acc[2][2][4][2];
#pragma unroll
    for (int a = 0; a < 2; ++a)
#pragma unroll
        for (int b = 0; b < 2; ++b)
#pragma unroll
            for (int m = 0; m < 4; ++m)
#pragma unroll
                for (int n = 0; n < 2; ++n) acc[a][b][m][n] = (f32x4){0.f, 0.f, 0.f, 0.f};
    bf16x8 At[4][2], B0[2][2], B1[2][2];
    const char* cA = S.a_ptr(g, cur, tstep); const char* cB = S.b_ptr(g, cur, tstep);
    S.a_ready(cur);
    if constexpr (SP2) {
        PG8_STAGE(PG8_SB(0, 0), cB, voffB); PG8_STAGE(PG8_SB(0, 1), cB + hstep, voffB); PG8_STAGE(PG8_SA(0, 0), cA, voffA); PG8_STAGE(PG8_SA(0, 1), cA + hstep, voffA);
        if (wr == 1) PG8_BAR;
        PG8_WAIT_V(2); PG8_BAR;
        PG8_STAGE(PG8_SB(1, 0), cB + kstep, voffB); PG8_STAGE(PG8_SA(1, 0), cA + kstep, voffA); PG8_STAGE(PG8_SB(1, 1), cB + hstep + kstep, voffB);
        PG8_WAIT_V(6); PG8_BAR;
    } else {
        PG8_STAGE(PG8_SB(0, 0), cB, voffB); PG8_STAGE(PG8_SA(0, 0), cA, voffA); PG8_STAGE(PG8_SB(0, 1), cB + hstep, voffB); PG8_STAGE(PG8_SA(0, 1), cA + hstep, voffA);
        if (wr == 1) PG8_BAR;
        PG8_WAIT_V(4); PG8_BAR;
        PG8_STAGE(PG8_SB(1, 0), cB + kstep, voffB); PG8_STAGE(PG8_SA(1, 0), cA + kstep, voffA); PG8_STAGE(PG8_SB(1, 1), cB + hstep + kstep, voffB);
        PG8_WAIT_V(6); PG8_BAR;
    }
    for (;;) {
        const bool has_next = S.next(ui + 1, nxt);
        const char* nA = has_next ? S.a_ptr(g, nxt, tstep) : cA; const char* nB = has_next ? S.b_ptr(g, nxt, tstep) : cB;
        for (int t = 0; t < nt; t += 2) {
            const bool last = (t == nt - 2);
            const char* a1 = cA + (size_t)(t + 1) * kstep;
            const char* a2 = last ? nA : cA + (size_t)(t + 2) * kstep; const char* b2 = last ? nB : cB + (size_t)(t + 2) * kstep;
            const char* a3 = a2 + kstep; const char* b3 = b2 + kstep;
            if (last && has_next) S.a_ready(nxt);
            if constexpr (SP2) {
            PG8_LDB(B0, 0, 0); PG8_LDB(B1, 0, 1); PG8_SCHED; PG8_LDA(At, 0, 0); PG8_STAGE(PG8_SA(1, 1), a1 + hstep, voffA);
            PG8_WAIT_V(8); PG8_WAIT_L(0); PG8_BAR; PG8_MMA(0, 0, At, B0); PG8_MMA(0, 1, At, B1); PG8_BAR; PG8_SCHED;
            PG8_LDA(At, 0, 1); PG8_STAGE(PG8_SB(0, 0), b2, voffB); PG8_STAGE(PG8_SB(0, 1), b2 + hstep, voffB); PG8_STAGE(PG8_SA(0, 0), a2, voffA);
            PG8_WAIT_V(8); PG8_WAIT_L(0); PG8_BAR; PG8_MMA(1, 0, At, B0); PG8_MMA(1, 1, At, B1); PG8_BAR; PG8_SCHED;
            PG8_LDB(B0, 1, 0); PG8_LDB(B1, 1, 1); PG8_SCHED; PG8_LDA(At, 1, 0); PG8_STAGE(PG8_SA(0, 1), a2 + hstep, voffA);
            PG8_WAIT_V(8); PG8_WAIT_L(0); PG8_BAR; PG8_MMA(0, 0, At, B0); PG8_MMA(0, 1, At, B1); PG8_BAR; PG8_SCHED;
            PG8_LDA(At, 1, 1); PG8_STAGE(PG8_SB(1, 0), b3, voffB); PG8_STAGE(PG8_SB(1, 1), b3 + hstep, voffB); PG8_STAGE(PG8_SA(1, 0), a3, voffA);
            PG8_WAIT_V(8); PG8_WAIT_L(0); PG8_BAR; PG8_MMA(1, 0, At, B0); PG8_MMA(1, 1, At, B1); PG8_BAR; PG8_SCHED;
            } else {
            PG8_LDB(B0, 0, 0); PG8_SCHED; PG8_LDA(At, 0, 0); PG8_STAGE(PG8_SA(1, 1), a1 + hstep, voffA);
            PG8_WAIT_L(8); PG8_BAR; PG8_WAIT_L(0); PG8_MMA(0, 0, At, B0); PG8_BAR; PG8_SCHED;
            PG8_LDB(B1, 0, 1); PG8_STAGE(PG8_SB(0, 0), b2, voffB);
            PG8_BAR; PG8_WAIT_L(0); PG8_MMA(0, 1, At, B1); PG8_BAR;
            PG8_LDA(At, 0, 1); PG8_STAGE(PG8_SA(0, 0), a2, voffA);
            PG8_BAR; PG8_WAIT_L(0); PG8_MMA(1, 0, At, B0); PG8_BAR; PG8_SCHED;
            PG8_STAGE(PG8_SB(0, 1), b2 + hstep, voffB);
            PG8_WAIT_V(6); PG8_BAR; PG8_MMA(1, 1, At, B1); PG8_BAR;
            PG8_LDB(B0, 1, 0); PG8_SCHED; PG8_LDA(At, 1, 0); PG8_STAGE(PG8_SA(0, 1), a2 + hstep, voffA);
            PG8_WAIT_L(8); PG8_BAR; PG8_WAIT_L(0); PG8_MMA(0, 0, At, B0); PG8_BAR; PG8_SCHED;
            PG8_LDB(B1, 1, 1); PG8_STAGE(PG8_SB(1, 0), b3, voffB);
            PG8_BAR; PG8_WAIT_L(0); PG8_MMA(0, 1, At, B1); PG8_BAR;
            PG8_LDA(At, 1, 1); PG8_STAGE(PG8_SA(1, 0), a3, voffA);
            PG8_BAR; PG8_WAIT_L(0); PG8_MMA(1, 0, At, B0); PG8_BAR; PG8_SCHED;
            PG8_STAGE(PG8_SB(1, 1), b3 + hstep, voffB);
            PG8_WAIT_V(6); PG8_BAR; PG8_MMA(1, 1, At, B1); PG8_BAR;
            }
        }
        if constexpr (ALIGN_EPI) { if (wr == 0) PG8_BAR; }
        if constexpr (Epi::TWO_PART) { if (cur.part == 0) E.mid(acc, cur, wr, wc, fr, fq); else E(acc, cur, wr, wc, fr, fq); } else if constexpr (!Epi::AFTER_DRAIN) { E(acc, cur, wr, wc, fr, fq); S.done(cur); }
        if (!has_next) break;
        bool keep_acc = false; if constexpr (Epi::TWO_PART) keep_acc = (cur.part == 0);
        if (!keep_acc)
#pragma unroll
        for (int a = 0; a < 2; ++a)
#pragma unroll
            for (int b = 0; b < 2; ++b)
#pragma unroll
                for (int m = 0; m < 4; ++m)
#pragma unroll
                    for (int n = 0; n < 2; ++n) acc[a][b][m][n] = (f32x4){0.f, 0.f, 0.f, 0.f};
        cur = nxt; cA = nA; cB = nB; ++ui;
        if constexpr (ALIGN_EPI) { if (wr == 1) PG8_BAR; }
    }
    PG8_WAIT_V(0);
    if constexpr (!ALIGN_EPI) { if (wr == 0) PG8_BAR; }
    PG8_BAR;
    if constexpr (Epi::AFTER_DRAIN) { E.fused(acc, cur, wr, wc, fr, fq, lds, wid, lane); S.done(cur); }
#undef PG8_SA
#undef PG8_SB
#undef PG8_STAGE
#undef PG8_LDA
#undef PG8_LDB
#undef PG8_MMA
#undef PG8_WAIT_V
#undef PG8_WAIT_L
#undef PG8_BAR
#undef PG8_SCHED
}
}
using pg8::bf16_t; using pg8::bf16x8; using pg8::f32x4; using pg8::u32x4; using pg8::cvt_pk_bf16; using pg8::bf_lo; using pg8::bf_hi; using pg8::opaque_tid;
#define LAS __attribute__((address_space(3)))
typedef unsigned u32x2 __attribute__((ext_vector_type(2)));

constexpr int NT = 65536, DM = 1024, NL = 4, SEQ = 8192, FH = 2816, TH = 32768  ;
constexpr int LDS_BYTES = 144 * 1024, XB_ST_OFF = 143616;
constexpr size_t MiB = 1024ull * 1024ull;
constexpr size_t WS_MOD = 64 * 1024;
constexpr size_t WS_WST = 2 * MiB;
constexpr size_t WS_LB = 3 * MiB;
constexpr size_t WS_WIN = 4 * MiB;
constexpr size_t WS_W13 = 68 * MiB;
constexpr size_t WS_W2 = 156 * MiB;
constexpr size_t WS_WA = 200 * MiB, WS_WB = 208 * MiB, WS_WO = 216 * MiB;
constexpr size_t WS_HN = 224 * MiB;
constexpr size_t WS_BIG = 352 * MiB;
constexpr size_t ZB = 64 * MiB;
constexpr size_t WS_U = WS_BIG, WS_V = WS_BIG + ZB, WS_Q = WS_BIG + 2 * ZB, WS_F = WS_BIG + 3 * ZB  , WS_I = WS_BIG + 5 * ZB, WS_OG = WS_BIG + 6 * ZB, WS_GA = WS_BIG + 7 * ZB, WS_GB = WS_BIG + 8 * ZB;
constexpr size_t WS_HU = WS_BIG + 9 * ZB;
constexpr size_t WS_HD = WS_HU + 16 * MiB;
constexpr size_t WS_M0 = WS_HD + 1 * MiB;
constexpr size_t WS_END = WS_M0 + ZB;

struct Params { const float* in[15]; float* out; unsigned char* ws; int ph_lo, ph_hi; };
typedef const Params __attribute__((address_space(4))) * KP;

__device__ __forceinline__ float wave_sum(float v) {
#pragma unroll
    for (int o = 1; o < 64; o <<= 1) v += __shfl_xor(v, o);
    return v;
}

__device__ __forceinline__ void transpose_item(const float* __restrict__ W, int K, int N, bf16_t* __restrict__ WT, int item, int remap, LAS float* scr, int lane) {
    const int nblk = N / 32, kb = item / nblk, nb = item - kb * nblk, k0 = 64 * kb, n0 = 32 * nb;
    int drow0 = n0;
    if (remap == 1) { const int bj = n0 / FH, nn = n0 - bj * FH; drow0 = (nn >> 7) * 256 + bj * 128 + (nn & 127); }
    if (remap == 2 && n0 >= 6144) { const int j = n0 - 6144, bj = j >> 10, nn = j & 1023; drow0 = 6144 + (nn >> 7) * 256 + bj * 128 + (nn & 127); }
#pragma unroll 8
    for (int i = 0; i < 32; ++i) { const int kk = 2 * i + (lane >> 5); scr[kk * 33 + (lane & 31)] = W[(size_t)(k0 + kk) * N + n0 + (lane & 31)]; }
    asm volatile("s_waitcnt lgkmcnt(0)" ::: "memory");
    const int c = lane & 7;
#pragma unroll
    for (int j = 0; j < 4; ++j) { const int n = (lane >> 3) + 8 * j; const LAS float* s = scr + (8 * c) * 33 + n;
        u32x4 o; o.x = cvt_pk_bf16(s[0 * 33], s[1 * 33]); o.y = cvt_pk_bf16(s[2 * 33], s[3 * 33]); o.z = cvt_pk_bf16(s[4 * 33], s[5 * 33]); o.w = cvt_pk_bf16(s[6 * 33], s[7 * 33]);
        *(u32x4*)(WT + (size_t)(drow0 + n) * K + k0 + 8 * c) = o; }
    asm volatile("s_waitcnt lgkmcnt(0)" ::: "memory");
}

__device__ __forceinline__ void prologue_phase(KP p, LAS unsigned char* lds) {
    const int tid = opaque_tid(), lane = tid & 63, wave = tid >> 6, G = gridDim.x;
    unsigned char* ws = p->ws;
    {
        LAS float* cact = (LAS float*)lds;
        LAS float* red = (LAS float*)(lds + 32768);
        const float* c = p->in[1];
        for (int i = tid; i < 8192; i += 512) { const int b = i >> 10, k = i & 1023; const float x = c[i]; cact[k * 8 + b] = x / (1.0f + __expf(-x)); }
        __syncthreads();
        for (int task = blockIdx.x; task < 288; task += G) {
            const int idx = task * 128 + (tid & 127), kq = tid >> 7, l = idx / 9216, n = idx - l * 9216;
            const float* aw = p->in[12] + (size_t)l * 1024 * 9216 + n;
            float a[8];
#pragma unroll
            for (int b = 0; b < 8; ++b) a[b] = 0.f;
#pragma unroll 8
            for (int k = kq * 256; k < kq * 256 + 256; ++k) { const float w = aw[(size_t)k * 9216]; const f32x4 c0 = *(const LAS f32x4*)(cact + k * 8), c1 = *(const LAS f32x4*)(cact + k * 8 + 4);
                a[0] += c0[0] * w; a[1] += c0[1] * w; a[2] += c0[2] * w; a[3] += c0[3] * w; a[4] += c1[0] * w; a[5] += c1[1] * w; a[6] += c1[2] * w; a[7] += c1[3] * w; }
#pragma unroll
            for (int b = 0; b < 8; ++b) red[(kq * 8 + b) * 128 + (tid & 127)] = a[b];
            __syncthreads();
            if (kq == 0) { const float bias = p->in[13][idx]; float* mod = (float*)(ws + WS_MOD);
#pragma unroll
                for (int b = 0; b < 8; ++b) mod[((size_t)l * 8 + b) * 9216 + n] = ((red[b * 128 + tid] + red[(8 + b) * 128 + tid]) + (red[(16 + b) * 128 + tid] + red[(24 + b) * 128 + tid])) + bias; }
            __syncthreads();
        }
    }
    if (blockIdx.x == 72 % G) {
        const float* lg = p->in[5]; float* lb = (float*)(ws + WS_LB);
        for (int k = tid; k < 1024; k += 512) { const float a0 = lg[k], a1 = lg[1024 + k], a2 = lg[2048 + k], a3 = lg[3072 + k]; const float mx = fmaxf(fmaxf(a0, a1), fmaxf(a2, a3));
            const float e0 = __expf(a0 - mx), e1 = __expf(a1 - mx), e2 = __expf(a2 - mx), e3 = __expf(a3 - mx), inv = 1.0f / (e0 + e1 + e2 + e3);
            lb[k] = 0.f; lb[1024 + k] = e1 * inv; lb[2048 + k] = (e1 + e2) * inv; lb[3072 + k] = (e1 + e2 + e3) * inv; }
    }
    { const float* wsrc = p->in[3]; bf16_t* wst = (bf16_t*)(ws + WS_WST);
      for (int i = blockIdx.x * 512 + tid; i < 4 * 8 * 128 * 128 / 2; i += G * 512) { const int e = 2 * i, s = e & 127, t = (e >> 7) & 127;
          const float v0 = s <= t ? wsrc[e] : 0.f, v1 = (s + 1) <= t ? wsrc[e + 1] : 0.f; ((unsigned*)wst)[i] = cvt_pk_bf16(v0, v1); } }
    LAS float* scr = (LAS float*)(lds + 32768 + wave * 8704);
    const int gw = blockIdx.x * 8 + wave, NGW = G * 8;
    constexpr int I_IN = 16 * 256, I_13 = 16 * 176, I_2 = 44 * 32, I_SQ = 16 * 32, I_LAYER = I_IN + 2 * I_13 + 2 * I_2 + 3 * I_SQ;
    for (int it = gw; it < NL * I_LAYER; it += NGW) {
        const int l = it / I_LAYER; int r = it - l * I_LAYER;
        if (r < I_IN) { transpose_item(p->in[2] + (size_t)l * 1024 * 8192, 1024, 8192, (bf16_t*)(ws + WS_WIN) + (size_t)l * 8192 * 1024, r, 2, scr, lane); continue; } r -= I_IN;
        if (r < 2 * I_13) { const int s = r / I_13; r -= s * I_13; transpose_item(p->in[9] + (size_t)(l * 2 + s) * 1024 * 5632, 1024, 5632, (bf16_t*)(ws + WS_W13) + (size_t)(l * 2 + s) * 5632 * 1024, r, 1, scr, lane); continue; } r -= 2 * I_13;
        if (r < 2 * I_2) { const int s = r / I_2; r -= s * I_2; transpose_item(p->in[10] + (size_t)(l * 2 + s) * FH * 1024, FH, 1024, (bf16_t*)(ws + WS_W2) + (size_t)(l * 2 + s) * 1024 * FH, r, 0, scr, lane); continue; } r -= 2 * I_2;
        const int m = r / I_SQ; r -= m * I_SQ;
        const float* src = (m == 0 ? p->in[6] : (m == 1 ? p->in[7] : p->in[8])) + (size_t)l * 1024 * 1024;
        bf16_t* dst = (bf16_t*)(ws + (m == 0 ? WS_WA : (m == 1 ? WS_WB : WS_WO))) + (size_t)l * 1024 * 1024;
        transpose_item(src, 1024, 1024, dst, r, 0, scr, lane);
    }
}

template <bool FINAL> __device__ __forceinline__ void norm_phase(const float* hin, bf16_t* hn, float* fout, const float* nw, const float* modl  , int sub) {
    const int tid = opaque_tid(), lane = tid & 63, gw = blockIdx.x * 8 + (tid >> 6), NGW = gridDim.x * 8;
    f32x4 w4[4];
#pragma unroll
    for (int j = 0; j < 4; ++j) w4[j] = *(const f32x4*)(nw + 4 * lane + 256 * j);
    for (int row0 = gw; row0 < NT; row0 += 2 * NGW) {
        const int row1 = row0 + NGW; const bool has1 = row1 < NT;
        f32x4 v[2][4]; float s[2] = {0.f, 0.f};
#pragma unroll
        for (int r = 0; r < 2; ++r) { const int row = r ? (has1 ? row1 : row0) : row0; const float* xr = hin + (size_t)row * DM + 4 * lane;
#pragma unroll
            for (int j = 0; j < 4; ++j) v[r][j] = *(const f32x4*)(xr + 256 * j); }
#pragma unroll
        for (int r = 0; r < 2; ++r)
#pragma unroll
            for (int j = 0; j < 4; ++j) s[r] += (v[r][j][0] * v[r][j][0] + v[r][j][1] * v[r][j][1]) + (v[r][j][2] * v[r][j][2] + v[r][j][3] * v[r][j][3]);
#pragma unroll
        for (int o = 1; o < 64; o <<= 1) { s[0] += __shfl_xor(s[0], o); s[1] += __shfl_xor(s[1], o); }
#pragma unroll
        for (int r = 0; r < 2; ++r) { if (r == 1 && !has1) break; const int row = r ? row1 : row0;
            const float rstd = rsqrtf(s[r] * (1.0f / DM) + 1e-6f);
            if (FINAL) {
#pragma unroll
                for (int j = 0; j < 4; ++j) *(f32x4*)(fout + (size_t)row * DM + 4 * lane + 256 * j) = v[r][j] * rstd * w4[j];
            } else {
                const float* sh = modl + (size_t)(row >> 13) * 9216 + (3 * sub) * 1024 + 4 * lane; const float* sc = sh + 1024;
#pragma unroll
                for (int j = 0; j < 4; ++j) { const f32x4 a = *(const f32x4*)(sc + 256 * j), bb = *(const f32x4*)(sh + 256 * j); const f32x4 o = v[r][j] * rstd * w4[j] * (a + 1.0f) + bb;
                    u32x2 w; w.x = cvt_pk_bf16(o[0], o[1]); w.y = cvt_pk_bf16(o[2], o[3]); *(u32x2*)(hn + (size_t)row * DM + 4 * lane + 256 * j) = w; }
            }
        }
    }
}

__device__ __forceinline__ int tr64_off(int row, int col) { return row * 128 + ((((col >> 3) ^ (row ^ (row >> 3))) & 7) << 4) + ((col & 7) << 1); }
__device__ __forceinline__ int tr128_off(int row, int col) { return row * 256 + ((((col >> 3) ^ (row ^ (row >> 3))) & 15) << 4) + ((col & 7) << 1); }
constexpr int H_LF = 0, H_P = 0  , H_TOT = 32768, H_VEC = 34816, H_SS = 36864, H_QP = 38912, H_KP = 56320, H_KT = 73728, H_VT = 90112, H_ST = 106496, H_END = 141312;
static_assert(H_END <= LDS_BYTES, "LDS");
#define MFMA16(a, b, c) __builtin_amdgcn_mfma_f32_16x16x32_bf16((a), (b), (c), 0, 0, 0)

template <bool PRE> __device__ __forceinline__ void hgrn_seq(LAS unsigned char* lds, const bf16_t* __restrict__ Qb, const float* __restrict__ Fb, const bf16_t* __restrict__ Ib, const bf16_t* OGb, bf16_t* OUTb, size_t row_base, int colbase, int c0, int nch, float* Ubuf, float* Dbuf, int item0, int nprev) {
    const int tid = opaque_tid(), lane = tid & 63, w = __builtin_amdgcn_readfirstlane(tid >> 6), q4 = lane >> 4, l15 = lane & 15;
    const int pt = tid >> 4, pc8 = (tid & 15) * 8;
    const int sk = tid & 127, sseg = tid >> 7;
    LAS float* Lf = (LAS float*)(lds + H_LF); LAS float* Ltot = (LAS float*)(lds + H_TOT); LAS float* Lss = (LAS float*)(lds + H_SS);
    f32x4 S[8];
#pragma unroll
    for (int i = 0; i < 8; ++i) S[i] = (f32x4){0.f, 0.f, 0.f, 0.f};
    if (!PRE) { for (int j = 0; j < nprev; ++j) { const float* Uj = Ubuf + (size_t)(item0 + j) * 16384; const f32x4 dj = *(const f32x4*)(Dbuf + (size_t)(item0 + j) * 128 + 16 * w + 4 * q4);
#pragma unroll
            for (int vt = 0; vt < 8; ++vt) S[vt] = S[vt] * dj + *(const f32x4*)(Uj + (vt * 512 + tid) * 4); } }
    float dacc = 1.0f;
    u32x4 rq[2], rv[2]; float rfc[16];
#define HG_LOADF(c) do { const float* fp_ = Fb + (row_base + (size_t)(c) * 64 + 16 * sseg) * 1024 + colbase + sk; _Pragma("unroll") for (int i_ = 0; i_ < 16; ++i_) rfc[i_] = fp_[(size_t)i_ * 1024]; } while (0)
#define HG_LOADQV(c) do { _Pragma("unroll") for (int i_ = 0; i_ < 2; ++i_) { const size_t go_ = (row_base + (size_t)(c) * 64 + pt + 32 * i_) * 1024 + colbase + pc8; \
        if (!PRE) rq[i_] = *(const u32x4*)(Qb + go_); rv[i_] = *(const u32x4*)(Ib + go_); } } while (0)
    HG_LOADF(c0); HG_LOADQV(c0);
    for (int c = c0; c < c0 + nch; ++c) {
        u32x2 rog[4];
        if (!PRE) {
#pragma unroll
        for (int ti = 0; ti < 4; ++ti) rog[ti] = *(const u32x2*)(OGb + (row_base + (size_t)c * 64 + 16 * ti + l15) * 1024 + colbase + 16 * w + 4 * q4); }
        { float run = 0.f;
#pragma unroll
          for (int i = 0; i < 16; ++i) { run += rfc[i]; Lf[(16 * sseg + i) * 128 + sk] = run; }
          Ltot[sseg * 128 + sk] = run; }
        if (c + 1 < c0 + nch) HG_LOADF(c + 1);
        __syncthreads();
        f32x4 e4, d4, c4;
        { const int kk = 16 * w + 4 * q4; const f32x4 a0 = *(const LAS f32x4*)(Ltot + kk), a1 = *(const LAS f32x4*)(Ltot + 128 + kk), a2 = *(const LAS f32x4*)(Ltot + 256 + kk), a3 = *(const LAS f32x4*)(Ltot + 384 + kk);
          const f32x4 b31 = a0 + a1, b63 = b31 + (a2 + a3);
#pragma unroll
          for (int r = 0; r < 4; ++r) { e4[r] = __expf(b31[r]); d4[r] = __expf(b63[r]); c4[r] = __expf(b63[r] - b31[r]); } }
        if (PRE) { if (tid < 128) dacc *= __expf((Ltot[tid] + Ltot[128 + tid]) + (Ltot[256 + tid] + Ltot[384 + tid])); }
        { f32x4 tv[4][2];
#pragma unroll
          for (int sg = 0; sg < 4; ++sg) { tv[sg][0] = *(const LAS f32x4*)(Ltot + sg * 128 + pc8); tv[sg][1] = *(const LAS f32x4*)(Ltot + sg * 128 + pc8 + 4); }
#pragma unroll
          for (int i = 0; i < 2; ++i) { const int t = pt + 32 * i; const bool hi = (pt >> 4) != 0;
            f32x4 off[2], ref[2];
#pragma unroll
            for (int h = 0; h < 2; ++h) { ref[h] = tv[0][h] + tv[1][h];
                if (i == 0) off[h] = hi ? tv[0][h] : (f32x4){0.f, 0.f, 0.f, 0.f}; else off[h] = hi ? ref[h] + tv[2][h] : ref[h]; }
            const f32x4 b0 = *(const LAS f32x4*)(Lf + t * 128 + pc8), b1 = *(const LAS f32x4*)(Lf + t * 128 + pc8 + 4);
            f32x4 p0 = (f32x4){0.f, 0.f, 0.f, 0.f}, p1 = p0;
            if (t & 15) { p0 = *(const LAS f32x4*)(Lf + (t - 1) * 128 + pc8); p1 = *(const LAS f32x4*)(Lf + (t - 1) * 128 + pc8 + 4); }
            unsigned qw[4] = {0u, 0u, 0u, 0u}; if (!PRE) { qw[0] = rq[i].x; qw[1] = rq[i].y; qw[2] = rq[i].z; qw[3] = rq[i].w; } const unsigned vw[4] = {rv[i].x, rv[i].y, rv[i].z, rv[i].w};
            float qp[8], kp[8];
#pragma unroll
            for (int j = 0; j < 8; ++j) { const float bl = j < 4 ? b0[j & 3] : b1[j & 3], pl = j < 4 ? p0[j & 3] : p1[j & 3], of = j < 4 ? off[0][j & 3] : off[1][j & 3], rr = j < 4 ? ref[0][j & 3] : ref[1][j & 3];
                const float lf = bl - pl, d = fminf(fmaxf((bl + of) - rr, -80.f), 80.f);
                if (!PRE) { const float qv = (j & 1) ? bf_hi(qw[j >> 1]) : bf_lo(qw[j >> 1]); qp[j] = qv * __expf(d); } else qp[j] = 0.f;
                kp[j] = (1.0f - __expf(lf)) * __expf(-d); }
            u32x4 wq, wk; wq.x = cvt_pk_bf16(qp[0], qp[1]); wq.y = cvt_pk_bf16(qp[2], qp[3]); wq.z = cvt_pk_bf16(qp[4], qp[5]); wq.w = cvt_pk_bf16(qp[6], qp[7]);
            wk.x = cvt_pk_bf16(kp[0], kp[1]); wk.y = cvt_pk_bf16(kp[2], kp[3]); wk.z = cvt_pk_bf16(kp[4], kp[5]); wk.w = cvt_pk_bf16(kp[6], kp[7]);
            if (!PRE) { *(LAS u32x4*)(lds + H_QP + t * 272 + pc8 * 2) = wq; *(LAS u32x4*)(lds + H_KP + t * 272 + pc8 * 2) = wk; }
            const unsigned kw[4] = {wk.x, wk.y, wk.z, wk.w};
#pragma unroll
            for (int j = 0; j < 8; ++j) { const unsigned short kk = (unsigned short)((j & 1) ? (kw[j >> 1] >> 16) : (kw[j >> 1] & 0xffffu)), vv = (unsigned short)((j & 1) ? (vw[j >> 1] >> 16) : (vw[j >> 1] & 0xffffu));
                *(LAS unsigned short*)(lds + H_KT + tr64_off(pc8 + j, t)) = kk; *(LAS unsigned short*)(lds + H_VT + tr64_off(pc8 + j, t)) = vv; } } }
        if (!PRE) {
#pragma unroll
          for (int vt = 0; vt < 8; ++vt) { const f32x4 sv = S[vt] * e4; u32x2 o; o.x = cvt_pk_bf16(sv[0], sv[1]); o.y = cvt_pk_bf16(sv[2], sv[3]);
              *(LAS u32x2*)(lds + H_ST + (16 * vt + l15) * 272 + (16 * w + 4 * q4) * 2) = o; } }
        if (c + 1 < c0 + nch) HG_LOADQV(c + 1);
        __syncthreads();
        f32x4 oT[4];
        if (!PRE) {
        { const int ti = w >> 1;
#pragma unroll
          for (int sj = 0; sj < 2; ++sj) { const int si = 2 * (w & 1) + sj; f32x4 a4 = (f32x4){0.f, 0.f, 0.f, 0.f};
              if (si <= ti) {
#pragma unroll
                  for (int kb = 0; kb < 4; ++kb) { const bf16x8 a = *(const LAS bf16x8*)(lds + H_KP + (16 * si + l15) * 272 + kb * 64 + q4 * 16), b = *(const LAS bf16x8*)(lds + H_QP + (16 * ti + l15) * 272 + kb * 64 + q4 * 16); a4 = MFMA16(a, b, a4); }
                  const int t = 16 * ti + l15, s0 = 16 * si + 4 * q4;
#pragma unroll
                  for (int r = 0; r < 4; ++r) a4[r] = (s0 + r <= t) ? a4[r] : 0.f; }
              u32x2 o; o.x = cvt_pk_bf16(a4[0], a4[1]); o.y = cvt_pk_bf16(a4[2], a4[3]);
              *(LAS u32x2*)(lds + H_P + (16 * ti + l15) * 144 + (16 * si + 4 * q4) * 2) = o; } }
#pragma unroll
        for (int ti = 0; ti < 4; ++ti) oT[ti] = (f32x4){0.f, 0.f, 0.f, 0.f};
#pragma unroll
        for (int kb = 0; kb < 4; ++kb) { const bf16x8 a = *(const LAS bf16x8*)(lds + H_ST + (16 * w + l15) * 272 + kb * 64 + q4 * 16);
#pragma unroll
            for (int ti = 0; ti < 4; ++ti) { const bf16x8 b = *(const LAS bf16x8*)(lds + H_QP + (16 * ti + l15) * 272 + kb * 64 + q4 * 16); oT[ti] = MFMA16(a, b, oT[ti]); } }
        __syncthreads();
        }
        { f32x4 U[8];
#pragma unroll
          for (int vt = 0; vt < 8; ++vt) U[vt] = (f32x4){0.f, 0.f, 0.f, 0.f};
#pragma unroll
          for (int kb = 0; kb < 2; ++kb) { const bf16x8 av = *(const LAS bf16x8*)(lds + H_VT + tr64_off(16 * w + l15, 32 * kb + 8 * q4)), ak = *(const LAS bf16x8*)(lds + H_KT + tr64_off(16 * w + l15, 32 * kb + 8 * q4));
#pragma unroll
              for (int ti = 0; ti < 4; ++ti) { if (!PRE && (kb == 0 || ti >= 2)) { const bf16x8 b = *(const LAS bf16x8*)(lds + H_P + (16 * ti + l15) * 144 + (32 * kb + 8 * q4) * 2); oT[ti] = MFMA16(av, b, oT[ti]); } }
#pragma unroll
              for (int vt = 0; vt < 8; ++vt) { const bf16x8 b = *(const LAS bf16x8*)(lds + H_VT + tr64_off(16 * vt + l15, 32 * kb + 8 * q4)); U[vt] = MFMA16(ak, b, U[vt]); } }
#pragma unroll
          for (int vt = 0; vt < 8; ++vt) S[vt] = S[vt] * d4 + U[vt] * c4; }
        if (!PRE) {
#pragma unroll
        for (int ti = 0; ti < 4; ++ti) { float ss = (oT[ti][0] * oT[ti][0] + oT[ti][1] * oT[ti][1]) + (oT[ti][2] * oT[ti][2] + oT[ti][3] * oT[ti][3]); ss += __shfl_xor(ss, 16); ss += __shfl_xor(ss, 32);
            if (q4 == 0) Lss[(16 * ti + l15) * 8 + w] = ss; }
        __syncthreads();
#pragma unroll
        for (int ti = 0; ti < 4; ++ti) { const int t = 16 * ti + l15; const f32x4 s0 = *(const LAS f32x4*)(Lss + t * 8), s1 = *(const LAS f32x4*)(Lss + t * 8 + 4);
            const float tot = ((s0[0] + s0[1]) + (s0[2] + s0[3])) + ((s1[0] + s1[1]) + (s1[2] + s1[3]));
            const float rs = rsqrtf(tot * (1.0f / 128.0f) + 1e-6f);
            u32x2 o; o.x = cvt_pk_bf16(oT[ti][0] * rs * bf_lo(rog[ti].x), oT[ti][1] * rs * bf_hi(rog[ti].x)); o.y = cvt_pk_bf16(oT[ti][2] * rs * bf_lo(rog[ti].y), oT[ti][3] * rs * bf_hi(rog[ti].y));
            *(u32x2*)(OUTb + (row_base + (size_t)c * 64 + t) * 1024 + colbase + 16 * w + 4 * q4) = o; }
        }
    }
    if (PRE) { float* Uo = Ubuf + (size_t)item0 * 16384;
#pragma unroll
        for (int vt = 0; vt < 8; ++vt) *(f32x4*)(Uo + (vt * 512 + tid) * 4) = S[vt];
        if (tid < 128) Dbuf[(size_t)item0 * 128 + tid] = dacc; }
    __syncthreads();
#undef HG_LOADF
#undef HG_LOADQV
}

__device__ __forceinline__ void gmlp_loop(LAS unsigned char* lds, const bf16_t* __restrict__ Vb, const bf16_t* Ub, bf16_t* Ob, const bf16_t* __restrict__ wst  , const float* __restrict__ gbias  , int first, int stride, int nitems) {
    const int tid = opaque_tid(), lane = tid & 63, w = __builtin_amdgcn_readfirstlane(tid >> 6), q4 = lane >> 4, l15 = lane & 15;
    const int ps = tid >> 4, pc8 = (tid & 15) * 8, nkb = (w >> 1) + 1, t = 16 * w + l15;
    int it = first; if (it >= nitems) return;
    u32x4 rv[4]; u32x2 ru[8]; bf16x8 wf[4]; float bt;
#define GM_DEC(i_) const int g8_ = (i_) & 7; const size_t row0_ = (size_t)((i_) >> 9) * SEQ + (size_t)(((i_) >> 3) & 63) * 128; const int col0_ = g8_ * 128;
#define GM_LOADV(i_) do { GM_DEC(i_) _Pragma("unroll") for (int i = 0; i < 4; ++i) rv[i] = *(const u32x4*)(Vb + (row0_ + ps + 32 * i) * 1024 + col0_ + pc8); \
        _Pragma("unroll") for (int kb = 0; kb < 4; ++kb) if (kb < nkb) wf[kb] = *(const bf16x8*)(wst + (size_t)g8_ * 16384 + (16 * w + l15) * 128 + kb * 32 + q4 * 8); } while (0)
#define GM_LOADU(i_) do { GM_DEC(i_) bt = gbias[g8_ * 128 + t]; _Pragma("unroll") for (int ct = 0; ct < 8; ++ct) ru[ct] = *(const u32x2*)(Ub + (row0_ + t) * 1024 + col0_ + 16 * ct + 4 * q4); } while (0)
    GM_LOADV(it); GM_LOADU(it);
    for (;;) {
#pragma unroll
        for (int i = 0; i < 4; ++i) { const int s = ps + 32 * i; const u32x4 raw = rv[i];
            float x[8] = {bf_lo(raw.x), bf_hi(raw.x), bf_lo(raw.y), bf_hi(raw.y), bf_lo(raw.z), bf_hi(raw.z), bf_lo(raw.w), bf_hi(raw.w)};
            float sm = ((x[0] + x[1]) + (x[2] + x[3])) + ((x[4] + x[5]) + (x[6] + x[7]));
            sm += __shfl_xor(sm, 1); sm += __shfl_xor(sm, 2); sm += __shfl_xor(sm, 4); sm += __shfl_xor(sm, 8);
            const float mu = sm * (1.0f / 128.0f); float vs = 0.f;
#pragma unroll
            for (int j = 0; j < 8; ++j) { x[j] -= mu; vs += x[j] * x[j]; }
            vs += __shfl_xor(vs, 1); vs += __shfl_xor(vs, 2); vs += __shfl_xor(vs, 4); vs += __shfl_xor(vs, 8);
            const float rstd = rsqrtf(vs * (1.0f / 128.0f) + 1e-6f);
#pragma unroll
            for (int j = 0; j < 4; ++j) { const unsigned pk = cvt_pk_bf16(x[2 * j] * rstd, x[2 * j + 1] * rstd);
                *(LAS unsigned short*)(lds + tr128_off(pc8 + 2 * j, s)) = (unsigned short)(pk & 0xffffu); *(LAS unsigned short*)(lds + tr128_off(pc8 + 2 * j + 1, s)) = (unsigned short)(pk >> 16); } }
        bf16x8 wc[4];
#pragma unroll
        for (int kb = 0; kb < 4; ++kb) wc[kb] = wf[kb];
        const int nxt = it + stride; const bool more = nxt < nitems;
        if (more) GM_LOADV(nxt);
        __syncthreads();
        f32x4 acc[8];
#pragma unroll
        for (int ct = 0; ct < 8; ++ct) acc[ct] = (f32x4){0.f, 0.f, 0.f, 0.f};
#pragma unroll
        for (int kb = 0; kb < 4; ++kb) if (kb < nkb) {
#pragma unroll
            for (int ct = 0; ct < 8; ++ct) { const bf16x8 a = *(const LAS bf16x8*)(lds + tr128_off(16 * ct + l15, 32 * kb + 8 * q4)); acc[ct] = MFMA16(a, wc[kb], acc[ct]); } }
        { GM_DEC(it)
#pragma unroll
          for (int ct = 0; ct < 8; ++ct) { const u32x2 uu = ru[ct];
              u32x2 o; o.x = cvt_pk_bf16(bf_lo(uu.x) * (acc[ct][0] + bt), bf_hi(uu.x) * (acc[ct][1] + bt)); o.y = cvt_pk_bf16(bf_lo(uu.y) * (acc[ct][2] + bt), bf_hi(uu.y) * (acc[ct][3] + bt));
              *(u32x2*)(Ob + (row0_ + t) * 1024 + col0_ + 16 * ct + 4 * q4) = o; } }
        if (!more) break;
        GM_LOADU(nxt);
        __syncthreads();
        it = nxt;
    }
    __syncthreads();
#undef GM_DEC
#undef GM_LOADV
#undef GM_LOADU
}

#define XB_TMO      128
#define XB_XCNT(j)  (256  + 64 * (j))
#define XB_XSUB(j)  (1280 + 64 * (j))
#define XB_XGEN(j)  (2304 + 64 * (j))
#define XB_TOP      3328
#define XB_TOPGEN   3392
#define XCD_BAR_WORDS 3456
#define XB_SPIN_CAP (1u << 18)

__device__ __forceinline__ unsigned xb_ld(unsigned* p)              { return __hip_atomic_load(p, __ATOMIC_RELAXED, __HIP_MEMORY_SCOPE_AGENT); }
__device__ __forceinline__ unsigned xb_add(unsigned* p, unsigned v) { return __hip_atomic_fetch_add(p, v, __ATOMIC_RELAXED, __HIP_MEMORY_SCOPE_AGENT); }
__device__ __forceinline__ unsigned xb_xcc_id() { return (unsigned)__builtin_amdgcn_s_getreg((3 << 11) | 20) & 0xFu; }
#define XB_SPIN(cond, bar) do { unsigned _sp = 0; while (cond) { __builtin_amdgcn_s_sleep(1); \
    if ((++_sp & 255u) == 0u) { if (xb_ld(&(bar)[XB_TMO])) break; if (_sp > XB_SPIN_CAP) { atomicAdd(&(bar)[XB_TMO], 1u); break; } } } } while (0)

struct XcdBarrier {
    unsigned* bar; unsigned x;
    volatile LAS unsigned* st;
};

__device__ __forceinline__ XcdBarrier xcd_barrier_post(unsigned* bar, volatile LAS unsigned* st) {
    XcdBarrier b; b.bar = bar; b.x = xb_xcc_id(); b.st = st;
    if (threadIdx.x == 0) (void)xb_add(&bar[XB_XCNT(b.x)], 1u);
    return b;
}
__device__ __forceinline__ void xcd_barrier_complete(unsigned* bar, unsigned x, unsigned& nloc, unsigned& nx) {
    const unsigned G = gridDim.x * gridDim.y * gridDim.z;
    unsigned sum, cnt, mine, sp = 0u;
    for (;;) {
        sum = 0u; cnt = 0u; mine = 0u;
#pragma unroll
        for (unsigned j = 0; j < 16; ++j) { const unsigned c = xb_ld(&bar[XB_XCNT(j)]); sum += c; cnt += (c > 0u) ? 1u : 0u; mine = (j == x) ? c : mine; }
        if (sum == G) break;
        __builtin_amdgcn_s_sleep(1);
        if ((++sp & 255u) == 0u) { if (xb_ld(&bar[XB_TMO])) break; if (sp > XB_SPIN_CAP) { atomicAdd(&bar[XB_TMO], 1u); break; } }
    }
    nloc = mine > 0u ? mine : 1u; nx = cnt > 0u ? cnt : 1u;
}

__device__ __forceinline__ void xcd_barrier(const XcdBarrier& b) {
    asm volatile("s_waitcnt vmcnt(0)" ::: "memory");
    __syncthreads();
    if (threadIdx.x == 0) {
        unsigned* bar = b.bar;
        __builtin_amdgcn_s_waitcnt(0);
        unsigned nloc = b.st[0], nx = b.st[1];
        if (nloc == 0u) { xcd_barrier_complete(bar, b.x, nloc, nx); b.st[0] = nloc; b.st[1] = nx; }
        const unsigned old = xb_add(&bar[XB_XSUB(b.x)], 1u);
        const unsigned gen = old / nloc;
        if (old + 1u == (gen + 1u) * nloc) {
            __builtin_amdgcn_fence(__ATOMIC_RELEASE, "agent");
            asm volatile("s_waitcnt vmcnt(0)" ::: "memory");
            const unsigned og = xb_add(&bar[XB_TOP], 1u);
            const unsigned tg = og / nx;
            if (og + 1u == (tg + 1u) * nx) xb_add(&bar[XB_TOPGEN], 1u);
            else XB_SPIN(xb_ld(&bar[XB_TOPGEN]) == tg, bar);
            __builtin_amdgcn_fence(__ATOMIC_ACQUIRE, "agent");
            xb_add(&bar[XB_XGEN(b.x)], 1u);
            asm volatile("s_waitcnt vmcnt(0)" ::: "memory");
        } else {
            XB_SPIN(xb_ld(&bar[XB_XGEN(b.x)]) == gen, bar);
            __builtin_amdgcn_fence(__ATOMIC_ACQUIRE, "agent");
            asm volatile("s_waitcnt vmcnt(0)" ::: "memory");
        }
    }
    __syncthreads();
}


__device__ __forceinline__ void flat_barrier(unsigned* bar, unsigned round) {
    asm volatile("s_waitcnt vmcnt(0)" ::: "memory");
    __syncthreads();
    if (threadIdx.x == 0) {
        __builtin_amdgcn_fence(__ATOMIC_RELEASE, "agent");
        asm volatile("s_waitcnt vmcnt(0)" ::: "memory");
        const unsigned G = gridDim.x, old = __hip_atomic_fetch_add(bar + 64, 1u, __ATOMIC_RELAXED, __HIP_MEMORY_SCOPE_AGENT);
        if (old + 1u == round * G) __hip_atomic_store(bar + 128, round, __ATOMIC_RELAXED, __HIP_MEMORY_SCOPE_AGENT);
        else { unsigned sp = 0; while (__hip_atomic_load(bar + 128, __ATOMIC_RELAXED, __HIP_MEMORY_SCOPE_AGENT) < round) { __builtin_amdgcn_s_sleep(2); if (++sp > (1u << 22)) break; } }
        __builtin_amdgcn_fence(__ATOMIC_ACQUIRE, "agent");
        asm volatile("s_waitcnt vmcnt(0)" ::: "memory");
    }
    __syncthreads();
}

__device__ __forceinline__ void stagger_start(unsigned ticks) {
    const unsigned g = (blockIdx.x >> 3) & 3u;
    if (g) { const unsigned long long t0 = __builtin_amdgcn_s_memrealtime(); while (__builtin_amdgcn_s_memrealtime() - t0 < (unsigned long long)(g * ticks)) __builtin_amdgcn_s_sleep(8); }
}
constexpr int HSEG = 8, HCH = SEQ / 64 / HSEG;
#ifndef PHMASK
#define PHMASK 0xffff
#endif
#ifndef MK_STAG_UP
#define MK_STAG_UP 700u
#endif
__global__ void __launch_bounds__(512, 2) mk_fwd(Params p_arg) {
    extern __shared__ __attribute__((aligned(16))) unsigned char lds_raw[];
    LAS unsigned char* lds = (LAS unsigned char*)lds_raw;
    int pc = 0;
    { if (threadIdx.x == 0) { *(LAS u32x4*)(lds + XB_ST_OFF) = (u32x4){0u, 0u, 0u, 0u}; } __syncthreads();
      KP pp0 = (KP)__builtin_amdgcn_kernarg_segment_ptr(); if (blockIdx.x == 0) { unsigned* bar0 = (unsigned*)pp0->ws; for (int i = threadIdx.x; i < XCD_BAR_WORDS; i += 512) __hip_atomic_store(bar0 + i, 0u, __ATOMIC_RELAXED, __HIP_MEMORY_SCOPE_AGENT); } }
#define GETP KP pp = (KP)__builtin_amdgcn_kernarg_segment_ptr(); asm volatile("" : "+s"(pp))
#ifdef MK_TIME
    LAS unsigned long long* tacc = (LAS unsigned long long*)(lds + 143360); const bool timer = (blockIdx.x == 0 && threadIdx.x == 0); unsigned long long tph0 = 0, tph1 = 0; int tcls = 0;
    if (timer) { for (int i = 0; i < 16; ++i) tacc[i] = 0ull; }
#define T_BEGIN(c) if (timer) { tph0 = __builtin_amdgcn_s_memrealtime(); tcls = (c); }
#define T_MID if (timer) { tph1 = __builtin_amdgcn_s_memrealtime(); tacc[tcls] += tph1 - tph0; }
#define T_END if (timer) { tacc[15] += __builtin_amdgcn_s_memrealtime() - tph1; }
#else
#define T_BEGIN(c)
#define T_MID
#define T_END
#endif
#ifndef MK_DUP
#define MK_DUP 0
#endif
#define PH_BEGIN(bit, cls) { GETP; T_BEGIN(cls) if (pc >= pp->ph_lo && pc < pp->ph_hi && (PHMASK & (bit))) for (int rep_ = 0; rep_ < (((MK_DUP) & (bit)) ? 2 : 1); ++rep_) {
#define PH_END } } { GETP; T_MID ++pc; if (pc > pp->ph_lo && pc < pp->ph_hi) { if (pc == 1) { cg::this_grid().sync(); (void)xcd_barrier_post((unsigned*)pp->ws, (volatile LAS unsigned*)(lds + XB_ST_OFF)); } else { XcdBarrier xb_; xb_.bar = (unsigned*)pp->ws; xb_.x = xb_xcc_id(); xb_.st = (volatile LAS unsigned*)(lds + XB_ST_OFF); xcd_barrier(xb_); } } T_END }

    PH_BEGIN(1, 0) prologue_phase(pp, lds); PH_END

    for (int blk = 0; blk < 3 * NL; ++blk) {
        const int l = blk / 3, kind = blk - 3 * l;
        PH_BEGIN(2, 1) unsigned char* ws = pp->ws; const float* hin = (blk == 0) ? pp->in[0] : pp->out;
            norm_phase<false>(hin, (bf16_t*)(ws + WS_HN), nullptr, pp->in[11] + (size_t)(l * 3 + kind) * 1024, (const float*)(ws + WS_MOD) + (size_t)l * 8 * 9216, kind); PH_END
        if (kind != 1) {
            const int s = kind >> 1;
            PH_BEGIN(4, 2) unsigned char* ws = pp->ws;
                pg8::Gemm g{(const bf16_t*)(ws + WS_HN), (const bf16_t*)(ws + WS_W13) + (size_t)(l * 2 + s) * 5632 * 1024, NT, 5632, 1024}; pg8::StaticOrder S; S.init(NT, 5632, (int)gridDim.x, (int)blockIdx.x);
                pg8::EpiSwiGLU E{(bf16_t*)(ws + WS_BIG)}; pg8::gemm_phase<pg8::EpiSwiGLU, pg8::StaticOrder, MK_ALIGN, MK_SP2>(lds, g, S, E); PH_END
            PH_BEGIN(8, 3) unsigned char* ws = pp->ws; const float* hin = (blk == 0) ? pp->in[0] : pp->out;
                pg8::Gemm g{(const bf16_t*)(ws + WS_BIG), (const bf16_t*)(ws + WS_W2) + (size_t)(l * 2 + s) * 1024 * FH, NT, 1024, FH}; pg8::StaticOrder S; S.init(NT, 1024, (int)gridDim.x, (int)blockIdx.x);
                pg8::EpiResid E{hin, pp->out, (const float*)(ws + WS_MOD) + (size_t)l * 8 * 9216 + (3 * kind + 2) * 1024, 0.5f}; pg8::gemm_phase<pg8::EpiResid, pg8::StaticOrder, MK_ALIGN, MK_SP2>(lds, g, S, E); PH_END
        } else {
            for (int half = 0; half < 2; ++half) {
                PH_BEGIN(16, 4) unsigned char* ws = pp->ws;
                    pg8::Gemm g{(const bf16_t*)(ws + WS_HN) + (size_t)half * TH * 1024, (const bf16_t*)(ws + WS_WIN) + (size_t)l * 8192 * 1024, TH, 8192, 1024}; pg8::StaticOrder S; S.init(TH, 8192, (int)gridDim.x, (int)blockIdx.x);
                    pg8::EpiInproj E{(bf16_t*)(ws + WS_U), (bf16_t*)(ws + WS_V), (bf16_t*)(ws + WS_Q), (float*)(ws + WS_F), (bf16_t*)(ws + WS_I), (bf16_t*)(ws + WS_OG), (bf16_t*)(ws + WS_GA), (bf16_t*)(ws + WS_GB), (const float*)(ws + WS_LB) + l * 1024};
                    pg8::gemm_phase<pg8::EpiInproj, pg8::StaticOrder, MK_ALIGN, MK_SP2>(lds, g, S, E); PH_END
                PH_BEGIN(32, 5) unsigned char* ws = pp->ws; const int G = (int)gridDim.x;
                    for (int it = (int)blockIdx.x; it < 32 * (HSEG - 1); it += G) { const int sq = it / (HSEG - 1), sg = it - sq * (HSEG - 1);
                        hgrn_seq<true>(lds, nullptr, (const float*)(ws + WS_F), (const bf16_t*)(ws + WS_I), nullptr, nullptr, (size_t)(sq >> 3) * SEQ, (sq & 7) * 128, sg * HCH, HCH, (float*)(ws + WS_HU), (float*)(ws + WS_HD), sq * HSEG + sg, 0); }
                    gmlp_loop(lds, (const bf16_t*)(ws + WS_V), (const bf16_t*)(ws + WS_U), (bf16_t*)(ws + WS_U), (const bf16_t*)(ws + WS_WST) + (size_t)l * 8 * 128 * 128, pp->in[4] + (size_t)l * 8 * 128, (int)blockIdx.x, G, 4 * 64 * 8);
                PH_END
                PH_BEGIN(64, 6) unsigned char* ws = pp->ws; const int G = (int)gridDim.x;
                    for (int it = (int)blockIdx.x; it < 32 * HSEG; it += G) { const int sq = it / HSEG, sg = it - sq * HSEG;
                        hgrn_seq<false>(lds, (const bf16_t*)(ws + WS_Q), (const float*)(ws + WS_F), (const bf16_t*)(ws + WS_I), (const bf16_t*)(ws + WS_OG), (bf16_t*)(ws + ((MK_DUP & 64) && rep_ == 0 ? WS_M0 : WS_OG)), (size_t)(sq >> 3) * SEQ, (sq & 7) * 128, sg * HCH, HCH, (float*)(ws + WS_HU), (float*)(ws + WS_HD), sq * HSEG, sg); }
                PH_END
                PH_BEGIN(128, 7) unsigned char* ws = pp->ws;
                    pg8::Gemm g{(const bf16_t*)(ws + WS_U), (const bf16_t*)(ws + WS_WA) + (size_t)l * 1024 * 1024, TH, 1024, 1024}; pg8::BranchOrder S; S.init(TH, 1024, (int)gridDim.x, (int)blockIdx.x);
                    S.A2 = (const bf16_t*)(ws + WS_OG); S.Bt2 = (const bf16_t*)(ws + WS_WB) + (size_t)l * 1024 * 1024;
                    pg8::EpiBranchFused E{(const bf16_t*)(ws + WS_GA), (const bf16_t*)(ws + WS_GB), (bf16_t*)(ws + (half == 0 ? WS_M0 : WS_Q))}; pg8::gemm_phase<pg8::EpiBranchFused, pg8::BranchOrder, MK_ALIGN, MK_SP2>(lds, g, S, E); PH_END
            }
            PH_BEGIN(512, 9) unsigned char* ws = pp->ws; float* hh = pp->out;
                pg8::Gemm g{(const bf16_t*)(ws + WS_M0), (const bf16_t*)(ws + WS_WO) + (size_t)l * 1024 * 1024, NT, 1024, 1024}; pg8::SplitAOrder S; S.init(NT, 1024, (int)gridDim.x, (int)blockIdx.x); S.A1 = (const bf16_t*)(ws + WS_Q);
                pg8::EpiResid E{hh, hh, (const float*)(ws + WS_MOD) + (size_t)l * 8 * 9216 + 5 * 1024, 1.0f}; pg8::gemm_phase<pg8::EpiResid, pg8::SplitAOrder, MK_ALIGN, MK_SP2>(lds, g, S, E); PH_END
        }
    }
    PH_BEGIN(1024, 10) norm_phase<true>(pp->out, nullptr, pp->out, pp->in[14], nullptr, 0); PH_END
#ifdef MK_TIME
    __syncthreads(); asm volatile("s_waitcnt vmcnt(0)" ::: "memory");
    if (timer) { GETP; unsigned long long a = 0, b = 0; for (int i = 0; i < 16; ++i) { if ((MK_TA >> i) & 1) a += tacc[i]; if ((MK_TB >> i) & 1) b += tacc[i]; }
        const float V = (float)a * 0.01f; int n = (int)((float)b * 0.01f / 20.0f); if (n < 1) n = 1; if (n > 1024) n = 1024;
        float* o = pp->out; for (int i = 0; i < n; ++i) o[i] = V; }
#endif
}
constexpr int N_PHASES = 1 + NL * (3 + 10 + 3) + 1;

extern "C" void kernel_launch(void* const* d_in, const int* in_sizes, int n_in, void* d_out, int out_size, void* d_ws, size_t ws_size, hipStream_t stream) {
    static int grid = 0;
    if (grid == 0) {
        if (n_in != 15 || out_size != NT * DM || ws_size < WS_END) { fprintf(stderr, "kernel_launch: unexpected shapes (n_in %d, out %d, ws %zu < %zu)\n", n_in, out_size, ws_size, (size_t)WS_END); grid = -1; return; }
        int dev = 0, cus = 0, per_cu = 0;
        hipGetDevice(&dev); hipDeviceGetAttribute(&cus, hipDeviceAttributeMultiprocessorCount, dev);
        if (hipFuncSetAttribute((const void*)mk_fwd, hipFuncAttributeMaxDynamicSharedMemorySize, LDS_BYTES) != hipSuccess) { fprintf(stderr, "kernel_launch: hipFuncSetAttribute failed\n"); grid = -1; return; }
        if (hipOccupancyMaxActiveBlocksPerMultiprocessor(&per_cu, (const void*)mk_fwd, 512, LDS_BYTES) != hipSuccess || per_cu < 1) { fprintf(stderr, "kernel_launch: occupancy query says %d\n", per_cu); per_cu = 1; }
        (void)hipGetLastError();
        grid = cus * 1;
    }
    if (grid < 0) return;
    Params p{};
    for (int i = 0; i < 15; ++i) p.in[i] = (const float*)d_in[i];
    p.out = (float*)d_out; p.ws = (unsigned char*)d_ws;
#if MK_COOP
    p.ph_lo = 0; p.ph_hi = N_PHASES;
    void* args[] = {&p};
    hipError_t e = hipLaunchCooperativeKernel((const void*)mk_fwd, dim3(grid), dim3(512), args, LDS_BYTES, stream);
    if (e != hipSuccess) fprintf(stderr, "cooperative launch failed: %s (grid %d)\n", hipGetErrorString(e), grid);
#else
    for (int i = 0; i < N_PHASES; ++i) { p.ph_lo = i; p.ph_hi = i + 1; hipLaunchKernelGGL(mk_fwd, dim3(grid), dim3(512), LDS_BYTES, stream, p); }
#endif
}
```
